# Optimizing an MI355X kernel written in HIP

```python
import jax, jax.numpy as jnp
from jax import lax
import numpy as np

D_MODEL = 1024
BATCH = 4
SEQ = 8192
DEPTH = 4

CHUNK = 64
MIX_DIM = D_MODEL
MLA_HEADS = 8
MLA_NOPE = 64
MLA_ROPE = 32
MLA_V = 64
Q_LORA = 384
KV_LORA = 256
Q_BLOCK = 128
ROPE_THETA = 10000.0
CA_HEADS = 8
CA_HEAD_DIM = 64
LEFT_CHUNKS = 8
REL_CLIP = 128
FFN_DIM = 3584
N_EXPERTS = 8
TOP_K = 2
EXPERT_BLOCK = 256
EPS = 1e-6
NEG_INF = -1e30

CA_DIM = CA_HEADS * CA_HEAD_DIM
IN_SPLITS = (Q_LORA, KV_LORA, MLA_ROPE, CA_DIM, CA_DIM, CA_DIM)
IN_DIM = sum(IN_SPLITS)
N_DENSE = (DEPTH + 1) // 2
N_MOE = DEPTH // 2

kernel_name = 'hybrid_mla_chunkattn_moe_encoder'


def rms_norm(x, g):
    xf = x.astype(jnp.float32)
    y = xf * lax.rsqrt(jnp.mean(xf * xf, axis=-1, keepdims=True) + EPS)
    return (y * g.astype(jnp.float32)).astype(x.dtype)


def rope_tables(seq, dim, dtype):
    inv = 1.0 / (ROPE_THETA ** (jnp.arange(0, dim, 2, dtype=jnp.float32) / dim))
    ang = jnp.arange(seq, dtype=jnp.float32)[:, None] * inv[None, :]
    return jnp.cos(ang).astype(dtype), jnp.sin(ang).astype(dtype)


def apply_rope(x, cos, sin):
    x1, x2 = jnp.split(x, 2, axis=-1)
    return jnp.concatenate([x1 * cos - x2 * sin, x1 * sin + x2 * cos], axis=-1)


def mla_attention(c_q, c_kv, k_r, q_norm, w_uq, kv_norm, w_ukv):
    B, S, _ = c_q.shape
    cos, sin = rope_tables(S, MLA_ROPE, c_q.dtype)
    q = (rms_norm(c_q, q_norm) @ w_uq).reshape(B, S, MLA_HEADS, MLA_NOPE + MLA_ROPE)
    q_nope = q[..., :MLA_NOPE]
    q_rope = apply_rope(q[..., MLA_NOPE:], cos[:, None, :], sin[:, None, :])
    kv = (rms_norm(c_kv, kv_norm) @ w_ukv).reshape(B, S, MLA_HEADS, MLA_NOPE + MLA_V)
    k_nope, v = kv[..., :MLA_NOPE], kv[..., MLA_NOPE:]
    k_rope = apply_rope(k_r, cos, sin)
    scale = (MLA_NOPE + MLA_ROPE) ** -0.5
    n_blk = S // Q_BLOCK
    k_chunk = jnp.arange(S) // CHUNK

    def to_blocks(t):
        return jnp.moveaxis(t.reshape(B, n_blk, Q_BLOCK, *t.shape[2:]), 1, 0)

    def one_block(args):
        qn, qr, start = args
        s = (jnp.einsum('bqhd,bkhd->bhqk', qn, k_nope)
             + jnp.einsum('bqhr,bkr->bhqk', qr, k_rope)).astype(jnp.float32) * scale
        q_chunk = (start + jnp.arange(Q_BLOCK)) // CHUNK
        mask = k_chunk[None, :] <= q_chunk[:, None]
        p = jax.nn.softmax(jnp.where(mask, s, NEG_INF), axis=-1).astype(v.dtype)
        return jnp.einsum('bhqk,bkhd->bqhd', p, v)

    out = lax.map(one_block, (to_blocks(q_nope), to_blocks(q_rope), jnp.arange(n_blk) * Q_BLOCK))
    return jnp.moveaxis(out, 0, 1).reshape(B, S, MLA_HEADS * MLA_V)


def chunk_attention(q, k, v, rel_bias):
    B, S, _ = q.shape
    n_chunks = S // CHUNK
    band = LEFT_CHUNKS + 1
    shp = (B, n_chunks, CHUNK, CA_HEADS, CA_HEAD_DIM)
    q, k, v = q.reshape(shp), k.reshape(shp), v.reshape(shp)
    pad = ((0, 0), (LEFT_CHUNKS, 0), (0, 0), (0, 0), (0, 0))
    band_idx = jnp.arange(n_chunks)[:, None] + jnp.arange(band)[None, :]
    band_shape = (B, n_chunks, band * CHUNK, CA_HEADS, CA_HEAD_DIM)
    kb = jnp.pad(k, pad)[:, band_idx].reshape(band_shape)
    vb = jnp.pad(v, pad)[:, band_idx].reshape(band_shape)
    valid = jnp.repeat(band_idx >= LEFT_CHUNKS, CHUNK, axis=1)
    q_pos = LEFT_CHUNKS * CHUNK + jnp.arange(CHUNK)
    k_pos = jnp.arange(band * CHUNK)
    rel = jnp.clip(q_pos[:, None] - k_pos[None, :], -REL_CLIP, REL_CLIP) + REL_CLIP
    bias = rel_bias[:, rel].astype(jnp.float32)
    s = jnp.einsum('bcqhd,bckhd->bchqk', q, kb).astype(jnp.float32) * (CA_HEAD_DIM ** -0.5) + bias
    s = jnp.where(valid[None, :, None, None, :], s, NEG_INF)
    p = jax.nn.softmax(s, axis=-1).astype(v.dtype)
    o = jnp.einsum('bchqk,bckhd->bcqhd', p, vb)
    return o.reshape(B, S, CA_DIM)


def swiglu(x, w1, w3, w2):
    return (jax.nn.silu(x @ w1) * (x @ w3)) @ w2


def moe_swiglu(x, w_router, w1, w3, w2):
    B, S, D = x.shape
    T = B * S
    n_assign = T * TOP_K
    xt = x.reshape(T, D)
    logits = (xt @ w_router).astype(jnp.float32)
    top_vals, top_idx = lax.top_k(logits, TOP_K)
    gates = jax.nn.softmax(top_vals, axis=-1)
    expert_ids = top_idx.reshape(-1).astype(jnp.int32)
    token_ids = (jnp.arange(n_assign) // TOP_K).astype(jnp.int32)
    gate_flat = gates.reshape(-1)
    order = jnp.argsort(expert_ids)
    sorted_e = expert_ids[order]
    counts = jnp.bincount(expert_ids, length=N_EXPERTS)
    padded = (counts + EXPERT_BLOCK - 1) // EXPERT_BLOCK * EXPERT_BLOCK
    starts = jnp.cumsum(counts) - counts
    pends = jnp.cumsum(padded)
    pstarts = pends - padded
    dest = pstarts[sorted_e] + (jnp.arange(n_assign) - starts[sorted_e])
    n_rows = n_assign + N_EXPERTS * EXPERT_BLOCK
    n_blocks = n_rows // EXPERT_BLOCK
    row_token = jnp.zeros((n_rows,), jnp.int32).at[dest].set(token_ids[order])
    row_gate = jnp.zeros((n_rows,), jnp.float32).at[dest].set(gate_flat[order])
    block_expert = jnp.minimum(
        jnp.searchsorted(pends, jnp.arange(n_blocks) * EXPERT_BLOCK, side='right'), N_EXPERTS - 1)
    xs = xt[row_token].reshape(n_blocks, EXPERT_BLOCK, D)

    def run(args):
        xb, e = args
        return swiglu(xb, w1[e], w3[e], w2[e])

    ys = lax.map(run, (xs, block_expert)).reshape(n_rows, D)
    ys = ys * row_gate[:, None].astype(ys.dtype)
    return jnp.zeros_like(xt).at[row_token].add(ys).reshape(B, S, D)


def setup_inputs(seed: int = 0) -> dict:
    key = jax.random.key(seed)
    ks = jax.random.split(key, 20)
    nrm = lambda k, shape, fan: jax.random.normal(k, shape, jnp.float32) * (fan ** -0.5)
    gain = lambda k, shape: 1.0 + 0.02 * jax.random.normal(k, shape, jnp.float32)
    return {
        'x': jax.random.normal(ks[0], (BATCH, SEQ, D_MODEL), jnp.float32),
        'attn_norm': gain(ks[1], (DEPTH, D_MODEL)),
        'w_in': nrm(ks[2], (DEPTH, D_MODEL, IN_DIM), D_MODEL),
        'q_norm': gain(ks[3], (DEPTH, Q_LORA)),
        'w_uq': nrm(ks[4], (DEPTH, Q_LORA, MLA_HEADS * (MLA_NOPE + MLA_ROPE)), Q_LORA),
        'kv_norm': gain(ks[5], (DEPTH, KV_LORA)),
        'w_ukv': nrm(ks[6], (DEPTH, KV_LORA, MLA_HEADS * (MLA_NOPE + MLA_V)), KV_LORA),
        'rel_bias': 0.1 * jax.random.normal(ks[7], (DEPTH, CA_HEADS, 2 * REL_CLIP + 1), jnp.float32),
        'w_out': nrm(ks[8], (DEPTH, MIX_DIM, D_MODEL), MIX_DIM),
        'ffn_norm': gain(ks[9], (DEPTH, D_MODEL)),
        'dense_w1': nrm(ks[10], (N_DENSE, D_MODEL, FFN_DIM), D_MODEL),
        'dense_w3': nrm(ks[11], (N_DENSE, D_MODEL, FFN_DIM), D_MODEL),
        'dense_w2': nrm(ks[12], (N_DENSE, FFN_DIM, D_MODEL), FFN_DIM),
        'w_router': nrm(ks[13], (N_MOE, D_MODEL, N_EXPERTS), D_MODEL),
        'moe_w1': nrm(ks[14], (N_MOE, N_EXPERTS, D_MODEL, FFN_DIM), D_MODEL),
        'moe_w3': nrm(ks[15], (N_MOE, N_EXPERTS, D_MODEL, FFN_DIM), D_MODEL),
        'moe_w2': nrm(ks[16], (N_MOE, N_EXPERTS, FFN_DIM, D_MODEL), FFN_DIM),
        'final_norm': gain(ks[17], (D_MODEL,)),
    }


def reference(x, attn_norm, w_in, q_norm, w_uq, kv_norm, w_ukv, rel_bias, w_out, ffn_norm,
              dense_w1, dense_w3, dense_w2, w_router, moe_w1, moe_w3, moe_w2, final_norm):
    split_points = [int(v) for v in np.cumsum(IN_SPLITS)[:-1]]
    for i in range(DEPTH):
        h = rms_norm(x, attn_norm[i])
        c_q, c_kv, k_r, q_b, k_b, v_b = jnp.split(h @ w_in[i], split_points, axis=-1)
        a = mla_attention(c_q, c_kv, k_r, q_norm[i], w_uq[i], kv_norm[i], w_ukv[i])
        b = chunk_attention(q_b, k_b, v_b, rel_bias[i])
        x = x + jnp.concatenate([a, b], axis=-1) @ w_out[i]
        h = rms_norm(x, ffn_norm[i])
        j = i // 2
        if i % 2 == 0:
            f = swiglu(h, dense_w1[j], dense_w3[j], dense_w2[j])
        else:
            f = moe_swiglu(h, w_router[j], moe_w1[j], moe_w3[j], moe_w2[j])
        x = x + f
    return rms_norm(x, final_norm)
```

```cpp
#include <hip/hip_runtime.h>
#include <cstdio>
#include <cstdint>
constexpr int NWAVES = 8;
constexpr int T_ = 32768, D_ = 1024, DEPTH_ = 4, IN_DIM = 2208, IN_PAD = 2304, FF_ = 3584, NEXP = 8, QL_ = 384, KVL_ = 256;
constexpr int MAXROWS = 2 * T_ + NEXP * 256;
constexpr float EPS_ = 1e-6f, LOG2E_ = 1.4426950408889634f;
#ifndef MK_ONE_LAUNCH
#define MK_ONE_LAUNCH 0
#endif
constexpr int NSTEPS = 31;
constexpr size_t MiB = 1u << 20;
constexpr size_t WS_CTL = 0, CTL_ZERO_BYTES = 65536;
constexpr size_t WS_RCOS = 1 * MiB, WS_RSIN = WS_RCOS + 512 * 1024;
constexpr size_t WS_SSX = 2 * MiB;
constexpr size_t WS_SSQ = 4 * MiB;
constexpr size_t WS_TOKE = 7 * MiB, WS_TOKG = WS_TOKE + 128 * 1024, WS_TOKRS = WS_TOKG + 256 * 1024, WS_POS = WS_TOKRS + 128 * 1024,
                 WS_CNT = WS_POS + 256 * 1024, WS_META = WS_CNT + 8192, WS_ROWG = 8 * MiB, WS_ROWRS = WS_ROWG + 512 * 1024;
constexpr size_t WATT_L = (size_t)(IN_PAD * D_ + 768 * QL_ + 1024 * KVL_ + D_ * D_) * 2;
constexpr size_t WS_WATT = 10 * MiB;
constexpr size_t WD_L = (size_t)3 * D_ * FF_ * 2;
constexpr size_t WS_WD = 41 * MiB;
constexpr size_t WS_WM = 83 * MiB;
constexpr size_t WS_XB = 251 * MiB;
constexpr size_t WS_XS = 315 * MiB;
constexpr size_t WS_HM = 447 * MiB;
constexpr size_t WS_CQ = WS_HM, WS_CKV = WS_CQ + 24 * MiB, WS_KR = WS_CKV + 16 * MiB, WS_QB = WS_KR + 2 * MiB, WS_KB = WS_QB + 32 * MiB, WS_VB = WS_KB + 32 * MiB,
                 WS_Q = WS_VB + 32 * MiB, WS_KN = WS_Q + 48 * MiB, WS_V = WS_KN + 32 * MiB, WS_AO = WS_V + 32 * MiB;
constexpr size_t WS_END = WS_HM + (size_t)MAXROWS * FF_ * 2;
static_assert(WS_AO + 64 * MiB <= WS_END && WS_WATT + 4 * WATT_L <= WS_WD && WS_WD + 2 * WD_L <= WS_WM && WS_WM + 8 * WD_L <= WS_XB && WS_XS + (size_t)MAXROWS * D_ * 2 <= WS_HM, "d_ws map");
constexpr int RING_BYTES = 131072, LDSCTL_OFF = RING_BYTES, MISC_OFF = LDSCTL_OFF + 320, RSTAB_OFF = LDSCTL_OFF + 1024, LDS_BYTES = 147456;

namespace pg8 {
#define PG8_LAS __attribute__((address_space(3)))
typedef unsigned short bf16_t;
typedef short bf16x8 __attribute__((ext_vector_type(8)));
typedef float f32x4 __attribute__((ext_vector_type(4)));
typedef unsigned u32x4 __attribute__((ext_vector_type(4)));
constexpr int BM = 256, BK = 64, HALF = 128, HTB = HALF * BK * 2  , STAGE_BYTES = 8 * HTB, NXCD = 8, WGM = 8;

__host__ __device__ __forceinline__ int lds_byte(int r, int c) { const int st = (r >> 4) * 2 + (c >> 5), rr = r & 15, cc = c & 31, ob = rr * 64 + cc * 2; return st * 1024 + (ob ^ (((ob >> 9) & 1) << 5)); }
__host__ __device__ __forceinline__ void stage_rc(int b, int& R, int& C) { const int st = b / 1024, sb = b % 1024, swz = sb ^ (((sb >> 9) & 1) << 5); R = (st >> 1) * 16 + swz / 64; C = (st & 1) * 32 + (swz % 64) / 2; }
__host__ __device__ __forceinline__ int perm32(int rho) { const int n = rho >> 4, i = rho & 15; return 8 * (i >> 2) + 4 * n + (i & 3); }

struct Unit { int pm, pn; };
struct Gemm { const bf16_t* A; const bf16_t* Bt; int M, N, K; };

struct StaticOrder {
    int nM, nN, nwg, G, c;
    __host__ __device__ void init(int M, int N, int G_, int c_) { nM = M / BM; nN = N / BM; nwg = nM * nN; G = G_; c = c_; }
    __host__ __device__ bool next(int i, Unit& u) const {
        const long L = (long)i * G + c; if (L >= nwg) return false;
        int wgid = (int)L; { const int q = nwg / NXCD, r = nwg % NXCD, xcd = wgid % NXCD, off = wgid / NXCD; wgid = (xcd < r ? xcd * (q + 1) : r * (q + 1) + (xcd - r) * q) + off; }
        const int nig = WGM * nN, gid = wgid / nig, fm = gid * WGM, gsz = (nM - fm) < WGM ? (nM - fm) : WGM;
        u.pm = fm + ((wgid % nig) % gsz); u.pn = (wgid % nig) / gsz; return true;
    }
    __device__ __forceinline__ size_t boff(const Unit&) const { return 0; }
    __device__ __forceinline__ void a_ready(const Unit&) const {}
    __device__ __forceinline__ void done(const Unit&) const {}
};

__device__ __forceinline__ unsigned cvt_pk_bf16(float lo, float hi) { unsigned r; asm volatile("v_cvt_pk_bf16_f32 %0, %1, %2" : "=v"(r) : "v"(lo), "v"(hi)); return r; }
typedef float f32x2 __attribute__((ext_vector_type(2)));
__device__ __forceinline__ u32x4 pack8(const f32x4 a, const f32x4 b) { u32x4 w; w.x = cvt_pk_bf16(a[0], a[1]); w.y = cvt_pk_bf16(a[2], a[3]); w.z = cvt_pk_bf16(b[0], b[1]); w.w = cvt_pk_bf16(b[2], b[3]); return w; }
__device__ __forceinline__ float sumsq4(const f32x4 v) { return (v[0] * v[0] + v[1] * v[1]) + (v[2] * v[2] + v[3] * v[3]); }
__device__ __forceinline__ float xor16_add(float v) { return v + __int_as_float(__builtin_amdgcn_ds_swizzle(__float_as_int(v), 0x401F)); }
__device__ __forceinline__ float xor32_add(float v) { auto rr = __builtin_amdgcn_permlane32_swap(__float_as_uint(v), __float_as_uint(v), false, false); return __uint_as_float(rr[0]) + __uint_as_float(rr[1]); }
__device__ __forceinline__ float silu_f(float x) { return x * __builtin_amdgcn_rcpf(1.0f + __builtin_amdgcn_exp2f(-1.4426950409f * x)); }
template <int NP4, int PITCH, int OFF>
__device__ __forceinline__ void rs_table(const float* part, int rowbase, int wr, int lane, float inv_dim, PG8_LAS float* t) {
#pragma unroll
    for (int ai = 0; ai < 2; ++ai) {
        const f32x4* p = (const f32x4*)(part + (size_t)(rowbase + ai * 128 + wr * 64 + lane) * PITCH + OFF);
        f32x4 s = p[0];
#pragma unroll
        for (int j = 1; j < NP4; ++j) s += p[j];
        t[ai * 64 + lane] = __builtin_amdgcn_rsqf(((s[0] + s[1]) + (s[2] + s[3])) * inv_dim + 1e-6f);
    }
    asm volatile("s_waitcnt lgkmcnt(0)" ::: "memory");
}
constexpr int DM = 1024, FFN = 3584, SEQ_ = 8192;

struct EpiRes {
    static constexpr bool PERM = true, AFTER_DRAIN = false;
    float* x; unsigned char* ws;
    __device__ __forceinline__ void operator()(const f32x4 (&acc)[2][2][4][2], const Unit& u, int wr, int wc, int fr, int fq) const {
        bf16_t* xb = (bf16_t*)(ws + WS_XB); float* ssx = (float*)(ws + WS_SSX);
        const int row0 = u.pm * BM + wr * 64 + fr, col0 = u.pn * BM + wc * 32 + 8 * fq;
#pragma unroll
        for (int ai = 0; ai < 2; ++ai)
#pragma unroll
            for (int m = 0; m < 4; ++m) {
                const int row = row0 + ai * HALF + m * 16; float ss = 0.f;
                float* xr = x + (size_t)row * DM + col0; bf16_t* br = xb + (size_t)row * DM + col0;
#pragma unroll
                for (int bj = 0; bj < 2; ++bj) {
                    const f32x4 v0 = *(const f32x4*)(xr + bj * HALF) + acc[ai][bj][m][0];
                    const f32x4 v1 = *(const f32x4*)(xr + bj * HALF + 4) + acc[ai][bj][m][1];
                    *(f32x4*)(xr + bj * HALF) = v0; *(f32x4*)(xr + bj * HALF + 4) = v1;
                    ss += sumsq4(v0) + sumsq4(v1);
                    *(u32x4*)(br + bj * HALF) = pack8(v0, v1);
                }
                ss = xor32_add(xor16_add(ss));
                if (fq == 0) ssx[(size_t)row * 16 + u.pn * 4 + wc] = ss;
            }
    }
};
template <bool MOE> struct EpiGLU {
    static constexpr bool PERM = true, AFTER_DRAIN = false;
    unsigned char* ws; PG8_LAS float* tab;
    __device__ __forceinline__ void operator()(const f32x4 (&acc)[2][2][4][2], const Unit& u, int wr, int wc, int fr, int fq) const {
        const int lane = fq * 16 + fr, wid = wr * 4 + wc; float rs[2][4];
        bf16_t* h = (bf16_t*)(ws + WS_HM); const float* part = (const float*)(ws + (MOE ? WS_ROWRS : WS_SSX));
        if (MOE) {
#pragma unroll
            for (int ai = 0; ai < 2; ++ai)
#pragma unroll
                for (int m = 0; m < 4; ++m) rs[ai][m] = part[u.pm * BM + ai * HALF + wr * 64 + m * 16 + fr];
        } else {
            PG8_LAS float* t = tab + wid * 128; rs_table<4, 16, 0>(part, u.pm * BM, wr, lane, 1.0f / DM, t);
#pragma unroll
            for (int ai = 0; ai < 2; ++ai)
#pragma unroll
                for (int m = 0; m < 4; ++m) rs[ai][m] = t[ai * 64 + m * 16 + fr];
        }
        const int row0 = u.pm * BM + wr * 64 + fr, col0 = u.pn * HALF + wc * 32 + 8 * fq;
#pragma unroll
        for (int ai = 0; ai < 2; ++ai)
#pragma unroll
            for (int m = 0; m < 4; ++m) {
                const float r = rs[ai][m]; f32x4 o[2];
#pragma unroll
                for (int n = 0; n < 2; ++n) { const f32x4 a = acc[ai][0][m][n] * r, b = acc[ai][1][m][n] * r;
                    o[n] = (f32x4){silu_f(a[0]) * b[0], silu_f(a[1]) * b[1], silu_f(a[2]) * b[2], silu_f(a[3]) * b[3]}; }
                *(u32x4*)(h + (size_t)(row0 + ai * HALF + m * 16) * FFN + col0) = pack8(o[0], o[1]);
            }
    }
};
struct EpiY {
    static constexpr bool PERM = true, AFTER_DRAIN = false;
    unsigned char* ws;
    __device__ __forceinline__ void operator()(const f32x4 (&acc)[2][2][4][2], const Unit& u, int wr, int wc, int fr, int fq) const {
        bf16_t* y = (bf16_t*)(ws + WS_XS); const float* rowg = (const float*)(ws + WS_ROWG);
        const int row0 = u.pm * BM + wr * 64 + fr, col0 = u.pn * BM + wc * 32 + 8 * fq;
#pragma unroll
        for (int ai = 0; ai < 2; ++ai)
#pragma unroll
            for (int m = 0; m < 4; ++m) { const int row = row0 + ai * HALF + m * 16; const float g = rowg[row];
#pragma unroll
                for (int bj = 0; bj < 2; ++bj) *(u32x4*)(y + (size_t)row * DM + col0 + bj * HALF) = pack8(acc[ai][bj][m][0] * g, acc[ai][bj][m][1] * g); }
    }
};
__device__ __forceinline__ void rope8(f32x4& v0, f32x4& v1, const float* rcos, const float* rsin, int pos, int fq) {
    const f32x4 c = *(const f32x4*)(rcos + pos * 16 + 4 * fq), s = *(const f32x4*)(rsin + pos * 16 + 4 * fq);
    const f32x4 o0 = v0 * c - v1 * s, o1 = v0 * s + v1 * c; v0 = o0; v1 = o1;
}
struct EpiIn {
    static constexpr bool PERM = true, AFTER_DRAIN = false;
    unsigned char* ws; float qbscale; PG8_LAS float* tab;
    __device__ __forceinline__ void operator()(const f32x4 (&acc)[2][2][4][2], const Unit& u, int wr, int wc, int fr, int fq) const {
        const int lane = fq * 16 + fr, wid = wr * 4 + wc;
        const float* ssx = (const float*)(ws + WS_SSX); float* ssq = (float*)(ws + WS_SSQ); const float* rcos = (const float*)(ws + WS_RCOS); const float* rsin = (const float*)(ws + WS_RSIN);
        bf16_t *cq = (bf16_t*)(ws + WS_CQ), *ckv = (bf16_t*)(ws + WS_CKV), *kr = (bf16_t*)(ws + WS_KR), *qb = (bf16_t*)(ws + WS_QB), *kb = (bf16_t*)(ws + WS_KB), *vb = (bf16_t*)(ws + WS_VB);
        PG8_LAS float* t = tab + wid * 128; rs_table<4, 16, 0>(ssx, u.pm * BM, wr, lane, 1.0f / DM, t);
        const int row0 = u.pm * BM + wr * 64 + fr;
#pragma unroll
        for (int bj = 0; bj < 2; ++bj) {
            const int colg = u.pn * BM + bj * HALF + wc * 32;
            if (colg >= 672 && colg < 768) continue;
            bf16_t* dst; int pitch, kind = 0, sidx = 0; float sc = 1.f;
            if (colg < 384) { dst = cq + colg; pitch = 384; kind = 1; sidx = colg >> 5; }
            else if (colg < 640) { dst = ckv + (colg - 384); pitch = 256; kind = 1; sidx = colg >> 5; }
            else if (colg < 672) { dst = kr; pitch = 32; kind = 2; }
            else if (colg < 1280) { dst = qb + (colg - 768); pitch = 512; sc = qbscale; }
            else if (colg < 1792) { dst = kb + (colg - 1280); pitch = 512; }
            else { dst = vb + (colg - 1792); pitch = 512; }
#pragma unroll
            for (int ai = 0; ai < 2; ++ai)
#pragma unroll
                for (int m = 0; m < 4; ++m) {
                    const int row = row0 + ai * HALF + m * 16; const float r = t[ai * 64 + m * 16 + fr] * sc;
                    f32x4 v0 = acc[ai][bj][m][0] * r, v1 = acc[ai][bj][m][1] * r;
                    if (kind == 2) rope8(v0, v1, rcos, rsin, row & (SEQ_ - 1), fq);
                    *(u32x4*)(dst + (size_t)row * pitch + 8 * fq) = pack8(v0, v1);
                    if (kind == 1) { float ss = sumsq4(v0) + sumsq4(v1); ss = xor32_add(xor16_add(ss)); if (fq == 0) ssq[(size_t)row * 20 + sidx] = ss; }
                }
        }
    }
};
struct EpiQ {
    static constexpr bool PERM = true, AFTER_DRAIN = false;
    unsigned char* ws; float qscale; PG8_LAS float* tab;
    __device__ __forceinline__ void operator()(const f32x4 (&acc)[2][2][4][2], const Unit& u, int wr, int wc, int fr, int fq) const {
        const int lane = fq * 16 + fr, wid = wr * 4 + wc;
        const float* ssq = (const float*)(ws + WS_SSQ); bf16_t* q = (bf16_t*)(ws + WS_Q); const float* rcos = (const float*)(ws + WS_RCOS); const float* rsin = (const float*)(ws + WS_RSIN);
        PG8_LAS float* t = tab + wid * 128; rs_table<3, 20, 0>(ssq, u.pm * BM, wr, lane, 1.0f / 384.0f, t);
        const int row0 = u.pm * BM + wr * 64 + fr;
#pragma unroll
        for (int bj = 0; bj < 2; ++bj) {
            const int colg = u.pn * BM + bj * HALF + wc * 32; const bool rope = ((colg >> 5) % 3) == 2;
#pragma unroll
            for (int ai = 0; ai < 2; ++ai)
#pragma unroll
                for (int m = 0; m < 4; ++m) {
                    const int row = row0 + ai * HALF + m * 16; const float r = t[ai * 64 + m * 16 + fr] * qscale;
                    f32x4 v0 = acc[ai][bj][m][0] * r, v1 = acc[ai][bj][m][1] * r;
                    if (rope) rope8(v0, v1, rcos, rsin, row & (SEQ_ - 1), fq);
                    *(u32x4*)(q + (size_t)row * 768 + colg + 8 * fq) = pack8(v0, v1);
                }
        }
    }
};
struct EpiKV {
    static constexpr bool PERM = true, AFTER_DRAIN = false;
    unsigned char* ws; PG8_LAS float* tab;
    __device__ __forceinline__ void operator()(const f32x4 (&acc)[2][2][4][2], const Unit& u, int wr, int wc, int fr, int fq) const {
        const int lane = fq * 16 + fr, wid = wr * 4 + wc;
        const float* ssq = (const float*)(ws + WS_SSQ); bf16_t* kn = (bf16_t*)(ws + WS_KN); bf16_t* v = (bf16_t*)(ws + WS_V);
        PG8_LAS float* t = tab + wid * 128; rs_table<2, 20, 12>(ssq, u.pm * BM, wr, lane, 1.0f / 256.0f, t);
        const int row0 = u.pm * BM + wr * 64 + fr;
#pragma unroll
        for (int bj = 0; bj < 2; ++bj) {
            const int colg = u.pn * BM + bj * HALF + wc * 32; bf16_t* dst = colg < 512 ? kn + colg : v + (colg - 512);
#pragma unroll
            for (int ai = 0; ai < 2; ++ai)
#pragma unroll
                for (int m = 0; m < 4; ++m) {
                    const int row = row0 + ai * HALF + m * 16; const float r = t[ai * 64 + m * 16 + fr];
                    *(u32x4*)(dst + (size_t)row * 512 + 8 * fq) = pack8(acc[ai][bj][m][0] * r, acc[ai][bj][m][1] * r);
                }
        }
    }
};
struct MoeOrder {
    StaticOrder so; int pe[8]; size_t estride;
    __device__ __forceinline__ bool next(int i, Unit& u) const { return so.next(i, u); }
    __device__ __forceinline__ size_t boff(const Unit& u) const { int e = 0;
#pragma unroll
        for (int j = 0; j < 7; ++j) e += (u.pm * BM >= pe[j]) ? 1 : 0;
        return (size_t)e * estride; }
    __device__ __forceinline__ void a_ready(const Unit&) const {}
    __device__ __forceinline__ void done(const Unit&) const {}
};
template <class Epi, class Sched, bool ALIGN_EPI = false, bool SP2 = false>
__device__ __forceinline__ void gemm_phase(PG8_LAS unsigned char* lds, const Gemm g, const Sched& S, const Epi& E) {
    int tid_l = threadIdx.x; asm volatile("" : "+v"(tid_l));
    const int tid = tid_l, wid = __builtin_amdgcn_readfirstlane(tid >> 6), lane = tid & 63, wr = wid >> 2, wc = wid & 3, fr = lane & 15, fq = lane >> 4;
    int K_l = g.K; asm volatile("" : "+s"(K_l));
    const int K = K_l, nt = K / BK;
    unsigned voffA[2], voffB[2];
#pragma unroll
    for (int i = 0; i < 2; ++i) { int R, C; stage_rc(tid * 16 + i * 8192, R, C); const int Rb = Epi::PERM ? ((R & ~31) + perm32(R & 31)) : R;
        voffA[i] = (unsigned)(R * K + C) * 2u; voffB[i] = (unsigned)(Rb * K + C) * 2u; }
    const size_t kstep = (size_t)(BK * 2);
    const size_t hstep = (size_t)HALF * K * 2;
    const size_t tstep = 2 * hstep;
    const unsigned ldsw = (unsigned)wid * 1024u;
    const int aoff = lds_byte(wr * 64 + fr, fq * 8), boff = lds_byte(wc * 32 + fr, fq * 8);
#define PG8_SA(b, h) (((b) * 2 + (h)) * HTB)
#define PG8_SB(b, h) ((4 + (b) * 2 + (h)) * HTB)
#define PG8_STAGE(bufoff, gbase, voff) do { _Pragma("unroll") for (int _i = 0; _i < 2; ++_i) \
        __builtin_amdgcn_global_load_lds((const unsigned*)((const char*)(gbase) + (voff)[_i]), (PG8_LAS unsigned*)(lds + (bufoff) + ldsw + _i * 8192), 16, 0, 0); } while (0)
#define PG8_LDA(dst, b, h) do { _Pragma("unroll") for (int m = 0; m < 4; ++m) _Pragma("unroll") for (int k = 0; k < 2; ++k) dst[m][k] = *(const PG8_LAS bf16x8*)(lds + PG8_SA(b, h) + aoff + m * 2048 + k * 1024); } while (0)
#define PG8_LDB(dst, b, h) do { _Pragma("unroll") for (int n = 0; n < 2; ++n) _Pragma("unroll") for (int k = 0; k < 2; ++k) dst[n][k] = *(const PG8_LAS bf16x8*)(lds + PG8_SB(b, h) + boff + n * 2048 + k * 1024); } while (0)
#define PG8_MMA(ai, bj, At, Bt) do { __builtin_amdgcn_s_setprio(1); _Pragma("unroll") for (int m = 0; m < 4; ++m) _Pragma("unroll") for (int n = 0; n < 2; ++n) _Pragma("unroll") for (int k = 0; k < 2; ++k) \
        acc[ai][bj][m][n] = __builtin_amdgcn_mfma_f32_16x16x32_bf16(Bt[n][k], At[m][k], acc[ai][bj][m][n], 0, 0, 0); __builtin_amdgcn_s_setprio(0); } while (0)
#define PG8_WAIT_V(n) asm volatile("s_waitcnt vmcnt(" #n ")" ::: "memory")
#define PG8_WAIT_L(n) asm volatile("s_waitcnt lgkmcnt(" #n ")" ::: "memory")
#define PG8_BAR __builtin_amdgcn_s_barrier()
#define PG8_SCHED __builtin_amdgcn_sched_barrier(0)
    Unit cur, nxt; int ui = 0;
    if (!S.next(0, cur)) return;
    f32x4 acc[2][2][4][2];
#pragma unroll
    for (int a = 0; a < 2; ++a)
#pragma unroll
        for (int b = 0; b < 2; ++b)
#pragma unroll
            for (int m = 0; m < 4; ++m)
#pragma unroll
                for (int n = 0; n < 2; ++n) acc[a][b][m][n] = (f32x4){0.f, 0.f, 0.f, 0.f};
    bf16x8 At[4][2], B0[2][2], B1[2][2];
    const char* cA = (const char*)g.A + (size_t)cur.pm * tstep; const char* cB = (const char*)g.Bt + S.boff(cur) + (size_t)cur.pn * tstep;
    S.a_ready(cur);
    if constexpr (SP2) {
        PG8_STAGE(PG8_SB(0, 0), cB, voffB); PG8_STAGE(PG8_SB(0, 1), cB + hstep, voffB); PG8_STAGE(PG8_SA(0, 0), cA, voffA); PG8_STAGE(PG8_SA(0, 1), cA + hstep, voffA);
        if (wr == 1) PG8_BAR;
        PG8_WAIT_V(2); PG8_BAR;
        PG8_STAGE(PG8_SB(1, 0), cB + kstep, voffB); PG8_STAGE(PG8_SA(1, 0), cA + kstep, voffA); PG8_STAGE(PG8_SB(1, 1), cB + hstep + kstep, voffB);
        PG8_WAIT_V(6); PG8_BAR;
    } else {
        PG8_STAGE(PG8_SB(0, 0), cB, voffB); PG8_STAGE(PG8_SA(0, 0), cA, voffA); PG8_STAGE(PG8_SB(0, 1), cB + hstep, voffB); PG8_STAGE(PG8_SA(0, 1), cA + hstep, voffA);
        if (wr == 1) PG8_BAR;
        PG8_WAIT_V(4); PG8_BAR;
        PG8_STAGE(PG8_SB(1, 0), cB + kstep, voffB); PG8_STAGE(PG8_SA(1, 0), cA + kstep, voffA); PG8_STAGE(PG8_SB(1, 1), cB + hstep + kstep, voffB);
        PG8_WAIT_V(6); PG8_BAR;
    }
    for (;;) {
        const bool has_next = S.next(ui + 1, nxt);
        const char* nA = has_next ? (const char*)g.A + (size_t)nxt.pm * tstep : cA; const char* nB = has_next ? (const char*)g.Bt + S.boff(nxt) + (size_t)nxt.pn * tstep : cB;
        for (int t = 0; t < nt; t += 2) {
            const bool last = (t == nt - 2);
            const char* a1 = cA + (size_t)(t + 1) * kstep;
            const char* a2 = last ? nA : cA + (size_t)(t + 2) * kstep; const char* b2 = last ? nB : cB + (size_t)(t + 2) * kstep;
            const char* a3 = a2 + kstep; const char* b3 = b2 + kstep;
            if (last && has_next) S.a_ready(nxt);
            if constexpr (SP2) {
            PG8_LDB(B0, 0, 0); PG8_LDB(B1, 0, 1); PG8_SCHED; PG8_LDA(At, 0, 0); PG8_STAGE(PG8_SA(1, 1), a1 + hstep, voffA);
            PG8_WAIT_V(8); PG8_WAIT_L(0); PG8_BAR; PG8_MMA(0, 0, At, B0); PG8_MMA(0, 1, At, B1); PG8_BAR; PG8_SCHED;
            PG8_LDA(At, 0, 1); PG8_STAGE(PG8_SB(0, 0), b2, voffB); PG8_STAGE(PG8_SB(0, 1), b2 + hstep, voffB); PG8_STAGE(PG8_SA(0, 0), a2, voffA);
            PG8_WAIT_V(8); PG8_WAIT_L(0); PG8_BAR; PG8_MMA(1, 0, At, B0); PG8_MMA(1, 1, At, B1); PG8_BAR; PG8_SCHED;
            PG8_LDB(B0, 1, 0); PG8_LDB(B1, 1, 1); PG8_SCHED; PG8_LDA(At, 1, 0); PG8_STAGE(PG8_SA(0, 1), a2 + hstep, voffA);
            PG8_WAIT_V(8); PG8_WAIT_L(0); PG8_BAR; PG8_MMA(0, 0, At, B0); PG8_MMA(0, 1, At, B1); PG8_BAR; PG8_SCHED;
            PG8_LDA(At, 1, 1); PG8_STAGE(PG8_SB(1, 0), b3, voffB); PG8_STAGE(PG8_SB(1, 1), b3 + hstep, voffB); PG8_STAGE(PG8_SA(1, 0), a3, voffA);
            PG8_WAIT_V(8); PG8_WAIT_L(0); PG8_BAR; PG8_MMA(1, 0, At, B0); PG8_MMA(1, 1, At, B1); PG8_BAR; PG8_SCHED;
            } else {
            PG8_LDB(B0, 0, 0); PG8_SCHED; PG8_LDA(At, 0, 0); PG8_STAGE(PG8_SA(1, 1), a1 + hstep, voffA);
            PG8_WAIT_L(8); PG8_BAR; PG8_WAIT_L(0); PG8_MMA(0, 0, At, B0); PG8_BAR; PG8_SCHED;
            PG8_LDB(B1, 0, 1); PG8_STAGE(PG8_SB(0, 0), b2, voffB);
            PG8_BAR; PG8_WAIT_L(0); PG8_MMA(0, 1, At, B1); PG8_BAR;
            PG8_LDA(At, 0, 1); PG8_STAGE(PG8_SA(0, 0), a2, voffA);
            PG8_BAR; PG8_WAIT_L(0); PG8_MMA(1, 0, At, B0); PG8_BAR; PG8_SCHED;
            PG8_STAGE(PG8_SB(0, 1), b2 + hstep, voffB);
            PG8_WAIT_V(6); PG8_BAR; PG8_MMA(1, 1, At, B1); PG8_BAR;
            PG8_LDB(B0, 1, 0); PG8_SCHED; PG8_LDA(At, 1, 0); PG8_STAGE(PG8_SA(0, 1), a2 + hstep, voffA);
            PG8_WAIT_L(8); PG8_BAR; PG8_WAIT_L(0); PG8_MMA(0, 0, At, B0); PG8_BAR; PG8_SCHED;
            PG8_LDB(B1, 1, 1); PG8_STAGE(PG8_SB(1, 0), b3, voffB);
            PG8_BAR; PG8_WAIT_L(0); PG8_MMA(0, 1, At, B1); PG8_BAR;
            PG8_LDA(At, 1, 1); PG8_STAGE(PG8_SA(1, 0), a3, voffA);
            PG8_BAR; PG8_WAIT_L(0); PG8_MMA(1, 0, At, B0); PG8_BAR; PG8_SCHED;
            PG8_STAGE(PG8_SB(1, 1), b3 + hstep, voffB);
            PG8_WAIT_V(6); PG8_BAR; PG8_MMA(1, 1, At, B1); PG8_BAR;
            }
        }
        if constexpr (ALIGN_EPI) { if (wr == 0) PG8_BAR; }
        if constexpr (!Epi::AFTER_DRAIN) { E(acc, cur, wr, wc, fr, fq); S.done(cur); }
        if (!has_next) break;
#pragma unroll
        for (int a = 0; a < 2; ++a)
#pragma unroll
            for (int b = 0; b < 2; ++b)
#pragma unroll
                for (int m = 0; m < 4; ++m)
#pragma unroll
                    for (int n = 0; n < 2; ++n) acc[a][b][m][n] = (f32x4){0.f, 0.f, 0.f, 0.f};
        cur = nxt; cA = nA; cB = nB; ++ui;
        if constexpr (ALIGN_EPI) { if (wr == 1) PG8_BAR; }
    }
    PG8_WAIT_V(0);
    if constexpr (!ALIGN_EPI) { if (wr == 0) PG8_BAR; }
    PG8_BAR;
    if constexpr (Epi::AFTER_DRAIN) { E.fused(acc, cur, wr, wc, fr, fq, lds, wid, lane); S.done(cur); }
#undef PG8_SA
#undef PG8_SB
#undef PG8_STAGE
#undef PG8_LDA
#undef PG8_LDB
#undef PG8_MMA
#undef PG8_WAIT_V
#undef PG8_WAIT_L
#undef PG8_BAR
#undef PG8_SCHED
}
}
namespace att {
#define ALAS __attribute__((address_space(3)))
using bf16 = unsigned short;
using bf16x8 = __attribute__((ext_vector_type(8))) short;
using s16x4 = __attribute__((ext_vector_type(4))) short;
using f32x16 = __attribute__((ext_vector_type(16))) float;
using u32x4 = __attribute__((ext_vector_type(4))) unsigned;
typedef short v4i16_t __attribute__((ext_vector_type(4)));
typedef float f32x2_t __attribute__((ext_vector_type(2))); typedef __bf16 bf16x2_t __attribute__((ext_vector_type(2)));
constexpr int SEQ = 8192;
constexpr int KSLOT_MAX = 12288, VSLOT = 8192;
constexpr int L_K = 0, L_V = 2 * KSLOT_MAX, L_WS = L_V + 2 * VSLOT, L_OST = L_WS + 8 * 256, L_BIAS = L_OST + 8 * 4096, L_END = L_BIAS + 1280;
constexpr float LOG2E = 1.4426950408889634f;
struct Args { const bf16* Q; const bf16* KN; const bf16* KR; const bf16* V; const bf16* QB; const bf16* KB; const bf16* VB; bf16* AO; const float* bias; };

__device__ __forceinline__ int crow(int r, int hi) { return (r & 3) + 8 * (r >> 2) + 4 * hi; }
__device__ __forceinline__ void glds16(const void* gsrc, unsigned lds_dst) { unsigned keep;
    asm volatile("s_mov_b32 %0, m0\n\ts_mov_b32 m0, %2\n\ts_nop 0\n\tglobal_load_lds_dwordx4 %1, off\n\ts_mov_b32 m0, %0" : "=&s"(keep) : "v"(gsrc), "s"(lds_dst) : "memory"); }
__device__ __forceinline__ unsigned cvtpk(float lo, float hi) { f32x2_t v = {lo, hi}; bf16x2_t b = __builtin_convertvector(v, bf16x2_t); return __builtin_bit_cast(unsigned, b); }
__device__ __forceinline__ s16x4 vtr(ALAS const char* p) { return __builtin_bit_cast(s16x4, __builtin_amdgcn_ds_read_tr16_b64_v4i16((ALAS v4i16_t*)p)); }
__device__ __forceinline__ float xhalf_max(float m) { auto rr = __builtin_amdgcn_permlane32_swap(__float_as_uint(m), __float_as_uint(m), false, false); return fmaxf(__uint_as_float(rr[0]), __uint_as_float(rr[1])); }
__device__ __forceinline__ float xhalf_sum(float m) { auto rr = __builtin_amdgcn_permlane32_swap(__float_as_uint(m), __float_as_uint(m), false, false); return __uint_as_float(rr[0]) + __uint_as_float(rr[1]); }
#define ATT_WAIT_BAR() asm volatile("s_waitcnt vmcnt(0) lgkmcnt(0)\n\ts_barrier" ::: "memory")

template <bool CHUNK>
__device__ __forceinline__ void attn_unit(const Args& A, int b, int h, int qb, ALAS char* shm) {
    constexpr int NDK = CHUNK ? 4 : 6, KSLOT = NDK * 2048;
    constexpr float THR = 8.0f;
    int tid_l = threadIdx.x; asm volatile("" : "+v"(tid_l));
    const int tid = tid_l, lane = tid & 63, r32 = lane & 31, hi = lane >> 5;
    const int wid = __builtin_amdgcn_readfirstlane(tid >> 6);
    const long rowbase = (long)b * SEQ; const int q0 = qb * 256;
    const unsigned lds0 = (unsigned)(size_t)shm;
    ALAS float* wsf = (ALAS float*)(shm + L_WS) + wid * 64;
    ALAS float* bt = (ALAS float*)(shm + L_BIAS);
    const bf16* ksrc = (CHUNK ? A.KB : A.KN) + (rowbase + lane) * 512 + h * 64 + wid * 8;
    const bf16* krsrc = A.KR + (rowbase + lane) * 32 + (wid & 3) * 8;
    const bf16* vsrc = (CHUNK ? A.VB : A.V) + (rowbase + 16 * (wid & 3) + (lane >> 2)) * 512 + h * 64 + (wid >> 2) * 32 + (lane & 3) * 8;
    const unsigned kdst = lds0 + L_K + wid * 1024, krdst = lds0 + L_K + (8 + (wid & 3)) * 1024, vdst = lds0 + L_V + wid * 1024;
#define ATT_ISSUE(t, s) do { glds16(ksrc + (long)(t) * 64 * 512, (unsigned)__builtin_amdgcn_readfirstlane(kdst + (s) * KSLOT)); \
        if (!CHUNK && wid < 4) glds16(krsrc + (long)(t) * 64 * 32, (unsigned)__builtin_amdgcn_readfirstlane(krdst + (s) * KSLOT)); \
        glds16(vsrc + (long)(t) * 64 * 512, (unsigned)__builtin_amdgcn_readfirstlane(vdst + (s) * VSLOT)); } while (0)
    const int t_end = 4 * qb + 4, t_begin = CHUNK ? (4 * qb - 8 > 0 ? 4 * qb - 8 : 0) : 0;
    const int cw = 4 * qb + (wid >> 1);
    const int vis_lo = CHUNK ? (cw - 8 > 0 ? cw - 8 : 0) : 0;
    if (CHUNK) { if (tid < 257) bt[tid] = A.bias[h * 257 + tid] * LOG2E; }
    ATT_ISSUE(t_begin, 0);
    const bf16* Qw = CHUNK ? A.QB + (rowbase + q0 + wid * 32 + r32) * 512 + h * 64 + hi * 8 : A.Q + (rowbase + q0 + wid * 32 + r32) * 768 + h * 96 + hi * 8;
    bf16x8 qr[NDK];
#pragma unroll
    for (int d0 = 0; d0 < NDK; ++d0) qr[d0] = *(const bf16x8*)(Qw + d0 * 16);
    float mhat = 0.f, lsum = 0.f; f32x16 o0 = {}, o1 = {}; bool first = true;
    const int vbo = ((lane >> 4) & 1) * 32 + (lane & 3) * 8 + (4 * hi + ((lane & 15) >> 2)) * 64;
    for (int t = t_begin, i = 0; t < t_end; ++t, ++i) {
        ATT_WAIT_BAR();
        if (t + 1 < t_end) ATT_ISSUE(t + 1, (i + 1) & 1);
        if (t >= vis_lo && t <= cw) {
            ALAS const char* Ks = shm + L_K + (i & 1) * KSLOT + hi * 1024 + r32 * 16;
            float cinit = -mhat;
            if (CHUNK) { if (t < cw - 2) cinit += bt[256]; }
            f32x16 c0, c1;
#pragma unroll
            for (int r = 0; r < 16; ++r) { c0[r] = cinit; c1[r] = cinit; }
#pragma unroll
            for (int d0 = 0; d0 < NDK; ++d0) {
                const bf16x8 a0 = *(ALAS const bf16x8*)(Ks + d0 * 2048), a1 = *(ALAS const bf16x8*)(Ks + d0 * 2048 + 512);
                c0 = __builtin_amdgcn_mfma_f32_32x32x16_bf16(a0, qr[d0], c0, 0, 0, 0);
                c1 = __builtin_amdgcn_mfma_f32_32x32x16_bf16(a1, qr[d0], c1, 0, 0, 0);
            }
            if (CHUNK) { if (t >= cw - 2) {
                const int dq = 64 * (cw - t) + 32 * (wid & 1) + r32 + 128;
#pragma unroll
                for (int r = 0; r < 16; ++r) { int i0 = dq - crow(r, hi), i1 = i0 - 32; i0 = i0 < 0 ? 0 : (i0 > 256 ? 256 : i0); i1 = i1 < 0 ? 0 : (i1 > 256 ? 256 : i1); c0[r] += bt[i0]; c1[r] += bt[i1]; }
            } }
            float rm = fmaxf(c0[0], c1[0]);
#pragma unroll
            for (int r = 1; r < 16; ++r) rm = fmaxf(rm, fmaxf(c0[r], c1[r]));
            rm = xhalf_max(rm);
            if (first) { first = false; mhat = rm;
#pragma unroll
                for (int r = 0; r < 16; ++r) { c0[r] -= rm; c1[r] -= rm; }
            } else if (__any(rm > THR)) {
                const float dl = fmaxf(rm, 0.f); mhat += dl;
#pragma unroll
                for (int r = 0; r < 16; ++r) { c0[r] -= dl; c1[r] -= dl; }
                const float f = __builtin_amdgcn_exp2f(-dl); lsum *= f;
                if (hi == 0) wsf[r32] = f;
                asm volatile("s_waitcnt lgkmcnt(0)" ::: "memory");
#pragma unroll
                for (int r = 0; r < 16; ++r) { const float fr_ = wsf[crow(r, hi)]; o0[r] *= fr_; o1[r] *= fr_; }
            }
            float sacc = 0.f;
#pragma unroll
            for (int r = 0; r < 16; ++r) { c0[r] = __builtin_amdgcn_exp2f(c0[r]); c1[r] = __builtin_amdgcn_exp2f(c1[r]); sacc += c0[r] + c1[r]; }
            lsum += sacc;
            u32x4 pw[4];
#pragma unroll
            for (int k = 0; k < 2; ++k) {
                pw[k]     = (u32x4){cvtpk(c0[8 * k], c0[8 * k + 1]), cvtpk(c0[8 * k + 2], c0[8 * k + 3]), cvtpk(c0[8 * k + 4], c0[8 * k + 5]), cvtpk(c0[8 * k + 6], c0[8 * k + 7])};
                pw[2 + k] = (u32x4){cvtpk(c1[8 * k], c1[8 * k + 1]), cvtpk(c1[8 * k + 2], c1[8 * k + 3]), cvtpk(c1[8 * k + 4], c1[8 * k + 5]), cvtpk(c1[8 * k + 6], c1[8 * k + 7])};
            }
            ALAS const char* vb = shm + L_V + (i & 1) * VSLOT + vbo;
#pragma unroll
            for (int ks = 0; ks < 4; ++ks) {
                const s16x4 l0 = vtr(vb + ks * 1024), h0 = vtr(vb + ks * 1024 + 512), l1 = vtr(vb + 4096 + ks * 1024), h1 = vtr(vb + 4096 + ks * 1024 + 512);
                const bf16x8 v0 = (bf16x8){l0[0], l0[1], l0[2], l0[3], h0[0], h0[1], h0[2], h0[3]}, v1 = (bf16x8){l1[0], l1[1], l1[2], l1[3], h1[0], h1[1], h1[2], h1[3]};
                o0 = __builtin_amdgcn_mfma_f32_32x32x16_bf16(__builtin_bit_cast(bf16x8, pw[ks]), v0, o0, 0, 0, 0);
                o1 = __builtin_amdgcn_mfma_f32_32x32x16_bf16(__builtin_bit_cast(bf16x8, pw[ks]), v1, o1, 0, 0, 0);
            }
        }
    }
    const float lt = xhalf_sum(lsum);
    if (hi == 0) wsf[32 + r32] = lt;
    asm volatile("s_waitcnt lgkmcnt(0)" ::: "memory");
    ALAS bf16* stg = (ALAS bf16*)(shm + L_OST) + wid * 2048;
#pragma unroll
    for (int r = 0; r < 16; ++r) { const int orow = crow(r, hi); const float rl = __builtin_amdgcn_rcpf(wsf[32 + orow]);
        stg[orow * 64 + r32] = (bf16)(cvtpk(o0[r] * rl, 0.f) & 0xffffu); stg[orow * 64 + 32 + r32] = (bf16)(cvtpk(o1[r] * rl, 0.f) & 0xffffu); }
    asm volatile("s_waitcnt lgkmcnt(0)" ::: "memory");
    bf16* Ow = A.AO + (rowbase + q0 + wid * 32) * 1024 + (CHUNK ? 512 : 0) + h * 64;
#pragma unroll
    for (int i = 0; i < 4; ++i) { const int row = i * 8 + (lane >> 3), ch = lane & 7; const u32x4 v = *(ALAS const u32x4*)(stg + row * 64 + ch * 8); *(u32x4*)(Ow + (long)row * 1024 + ch * 8) = v; }
    asm volatile("s_waitcnt lgkmcnt(0)\n\ts_barrier" ::: "memory");
#undef ATT_ISSUE
}
template <bool CHUNK>
__device__ __forceinline__ void attn_phase(const Args& A, int vcu, int G, ALAS char* shm) {
    if (G == 256) {
        for (int i = 0; i < 4; ++i) {
            int bh, qb;
            if (CHUNK) { const int u = vcu * 4 + i; bh = u >> 5; qb = u & 31; }
            else { const int s = vcu & 7; bh = vcu >> 3; qb = (i == 0) ? s : (i == 1) ? 15 - s : (i == 2) ? 16 + s : 31 - s; }
            attn_unit<CHUNK>(A, bh >> 3, bh & 7, qb, shm);
        }
    } else {
        for (int u = vcu; u < 1024; u += G) attn_unit<CHUNK>(A, u >> 8, (u >> 5) & 7, u & 31, shm);
    }
}
#undef ATT_WAIT_BAR
}
#define GAS __attribute__((address_space(1)))
#define LAS __attribute__((address_space(3)))
typedef unsigned short bf16;
typedef unsigned v4u __attribute__((ext_vector_type(4)));
typedef float f32x4 __attribute__((ext_vector_type(4)));
typedef short bf16x8 __attribute__((ext_vector_type(8)));
typedef GAS unsigned gu32;
typedef GAS unsigned long long gu64;
#define RLX_AGENT __ATOMIC_RELAXED, __HIP_MEMORY_SCOPE_AGENT
#define LDS_WAIT() asm volatile("s_waitcnt lgkmcnt(0)" ::: "memory")
#define VM_WAIT() asm volatile("s_waitcnt vmcnt(0)" ::: "memory")
__device__ __forceinline__ unsigned long long rt() { return __builtin_amdgcn_s_memrealtime(); }
__device__ __forceinline__ unsigned f2bf(float f) { unsigned u = __builtin_bit_cast(unsigned, f); return (u + 0x7fffu + ((u >> 16) & 1u)) >> 16; }
__device__ __forceinline__ unsigned pk2(float lo, float hi) { return f2bf(lo) | (f2bf(hi) << 16); }

#define XB_TMO      128
#define XB_XCNT(j)  (256  + 64 * (j))
#define XB_XSUB(j)  (1280 + 64 * (j))
#define XB_XGEN(j)  (2304 + 64 * (j))
#define XB_TOP      3328
#define XB_TOPGEN   3392
#define XCD_BAR_WORDS 3456
#define XB_SPIN_CAP (1u << 18)

__device__ __forceinline__ unsigned xb_ld(unsigned* p)              { return __hip_atomic_load(p, __ATOMIC_RELAXED, __HIP_MEMORY_SCOPE_AGENT); }
__device__ __forceinline__ unsigned xb_add(unsigned* p, unsigned v) { return __hip_atomic_fetch_add(p, v, __ATOMIC_RELAXED, __HIP_MEMORY_SCOPE_AGENT); }
__device__ __forceinline__ unsigned xb_xcc_id() { return (unsigned)__builtin_amdgcn_s_getreg((3 << 11) | 20) & 0xFu; }
#define XB_SPIN(cond, bar) do { unsigned _sp = 0; while (cond) { __builtin_amdgcn_s_sleep(1); \
    if ((++_sp & 255u) == 0u) { if (xb_ld(&(bar)[XB_TMO])) break; if (_sp > XB_SPIN_CAP) { atomicAdd(&(bar)[XB_TMO], 1u); break; } } } } while (0)

struct XcdBarrier {
    unsigned* bar; unsigned x;
    volatile LAS unsigned* st;
};

__device__ __forceinline__ XcdBarrier xcd_barrier_post(unsigned* bar, volatile LAS unsigned* st) {
    XcdBarrier b; b.bar = bar; b.x = xb_xcc_id(); b.st = st;
    if (threadIdx.x == 0) (void)xb_add(&bar[XB_XCNT(b.x)], 1u);
    return b;
}
__device__ __forceinline__ void xcd_barrier_complete(unsigned* bar, unsigned x, unsigned& nloc, unsigned& nx) {
    const unsigned G = gridDim.x * gridDim.y * gridDim.z;
    unsigned sum, cnt, mine, sp = 0u;
    for (;;) {
        sum = 0u; cnt = 0u; mine = 0u;
#pragma unroll
        for (unsigned j = 0; j < 16; ++j) { const unsigned c = xb_ld(&bar[XB_XCNT(j)]); sum += c; cnt += (c > 0u) ? 1u : 0u; mine = (j == x) ? c : mine; }
        if (sum == G) break;
        __builtin_amdgcn_s_sleep(1);
        if ((++sp & 255u) == 0u) { if (xb_ld(&bar[XB_TMO])) break; if (sp > XB_SPIN_CAP) { atomicAdd(&bar[XB_TMO], 1u); break; } }
    }
    nloc = mine > 0u ? mine : 1u; nx = cnt > 0u ? cnt : 1u;
}

template <bool CENSUS> __device__ __forceinline__ void xcd_barrier(const XcdBarrier& b) {
    asm volatile("s_waitcnt vmcnt(0)" ::: "memory");
    __syncthreads();
    if (threadIdx.x == 0) {
        unsigned* bar = b.bar;
        __builtin_amdgcn_s_waitcnt(0);
        unsigned nloc = b.st[0], nx = b.st[1];
        if (CENSUS) { if (nloc == 0u) { xcd_barrier_complete(bar, b.x, nloc, nx); b.st[0] = nloc; b.st[1] = nx; } }
        const unsigned old = xb_add(&bar[XB_XSUB(b.x)], 1u);
        const unsigned gen = old / nloc;
        if (old + 1u == (gen + 1u) * nloc) {
            __builtin_amdgcn_fence(__ATOMIC_RELEASE, "agent");
            asm volatile("s_waitcnt vmcnt(0)" ::: "memory");
            const unsigned og = xb_add(&bar[XB_TOP], 1u);
            const unsigned tg = og / nx;
            if (og + 1u == (tg + 1u) * nx) xb_add(&bar[XB_TOPGEN], 1u);
            else XB_SPIN(xb_ld(&bar[XB_TOPGEN]) == tg, bar);
            __builtin_amdgcn_fence(__ATOMIC_ACQUIRE, "agent");
            xb_add(&bar[XB_XGEN(b.x)], 1u);
            asm volatile("s_waitcnt vmcnt(0)" ::: "memory");
        } else {
            XB_SPIN(xb_ld(&bar[XB_XGEN(b.x)]) == gen, bar);
            __builtin_amdgcn_fence(__ATOMIC_ACQUIRE, "agent");
            asm volatile("s_waitcnt vmcnt(0)" ::: "memory");
        }
    }
    __syncthreads();
}
static_assert(att::L_END <= RING_BYTES && RSTAB_OFF + 8 * 512 <= LDS_BYTES, "LDS map");
typedef unsigned v2u __attribute__((ext_vector_type(2)));
typedef int v4i __attribute__((ext_vector_type(4)));
#define SWZ_XOR(x) (((x) << 10) | 0x1F)
__device__ __forceinline__ float wave_sum(float v) {
    v += __int_as_float(__builtin_amdgcn_ds_swizzle(__float_as_int(v), SWZ_XOR(1))); v += __int_as_float(__builtin_amdgcn_ds_swizzle(__float_as_int(v), SWZ_XOR(2)));
    v += __int_as_float(__builtin_amdgcn_ds_swizzle(__float_as_int(v), SWZ_XOR(4))); v += __int_as_float(__builtin_amdgcn_ds_swizzle(__float_as_int(v), SWZ_XOR(8)));
    v += __int_as_float(__builtin_amdgcn_ds_swizzle(__float_as_int(v), SWZ_XOR(16)));
    auto rr = __builtin_amdgcn_permlane32_swap(__float_as_uint(v), __float_as_uint(v), false, false); return __uint_as_float(rr[0]) + __uint_as_float(rr[1]);
}
__device__ __forceinline__ int wave_sum_i(int v) {
    v += __builtin_amdgcn_ds_swizzle(v, SWZ_XOR(1)); v += __builtin_amdgcn_ds_swizzle(v, SWZ_XOR(2)); v += __builtin_amdgcn_ds_swizzle(v, SWZ_XOR(4)); v += __builtin_amdgcn_ds_swizzle(v, SWZ_XOR(8)); v += __builtin_amdgcn_ds_swizzle(v, SWZ_XOR(16));
    auto rr = __builtin_amdgcn_permlane32_swap((unsigned)v, (unsigned)v, false, false); return (int)(rr[0] + rr[1]);
}
enum { TM_ID = 0, TM_IN, TM_UQ, TM_UKV, TM_W1, TM_W3 };
__device__ __forceinline__ int rope_pos(int j) { return j < 16 ? 8 * (j >> 2) + (j & 3) : 8 * ((j - 16) >> 2) + 4 + (j & 3); }
__device__ __forceinline__ int tr_dest_row(int mode, int n0, int n) {
    if (mode == TM_IN) { const int gb = n0 < 672 ? n0 : n0 + 96; return gb + (n0 == 640 ? rope_pos(n) : n); }
    if (mode == TM_UQ) return n0 + ((((n0 >> 5) % 3) == 2) ? rope_pos(n) : n);
    if (mode == TM_UKV) { const int h = n0 >> 7, j0 = n0 & 127; return (j0 < 64 ? h * 64 + j0 : 512 + h * 64 + (j0 - 64)) + n; }
    if (mode == TM_W1) return (n0 >> 7) * 256 + (n0 & 127) + n;
    if (mode == TM_W3) return (n0 >> 7) * 256 + 128 + (n0 & 127) + n;
    return n0 + n;
}
struct TrJob { const float* W; int K, N; bf16* dst; const float* gain; int mode; };
__device__ __forceinline__ void tr_item(const TrJob& J, int item, LAS float* scr, int lane) {
    const int nblk = J.N / 32, kb = item / nblk, nb = item % nblk, k0 = 64 * kb, n0 = 32 * nb;
#pragma unroll 8
    for (int i = 0; i < 32; ++i) { const int kk = 2 * i + (lane >> 5); scr[kk * 33 + (lane & 31)] = J.W[(size_t)(k0 + kk) * J.N + n0 + (lane & 31)]; }
    LDS_WAIT(); asm volatile("" ::: "memory");
    const int c = lane & 7; float g[8];
#pragma unroll
    for (int e = 0; e < 8; ++e) g[e] = J.gain ? J.gain[k0 + 8 * c + e] : 1.f;
#pragma unroll
    for (int j = 0; j < 4; ++j) { const int n = (lane >> 3) + 8 * j; const LAS float* s = scr + (8 * c) * 33 + n;
        v4u o; o.x = pk2(s[0 * 33] * g[0], s[1 * 33] * g[1]); o.y = pk2(s[2 * 33] * g[2], s[3 * 33] * g[3]); o.z = pk2(s[4 * 33] * g[4], s[5 * 33] * g[5]); o.w = pk2(s[6 * 33] * g[6], s[7 * 33] * g[7]);
        *(GAS v4u*)(J.dst + (size_t)tr_dest_row(J.mode, n0, n) * J.K + k0 + 8 * c) = o; }
    LDS_WAIT(); asm volatile("" ::: "memory");
}
__device__ __forceinline__ void tr_run(const TrJob& J, int& base, int gw, int NGW, LAS float* scr, int lane) {
    const int nitems = (J.K / 64) * (J.N / 32);
    int first = gw - (base % NGW); if (first < 0) first += NGW;
    for (int it = first; it < nitems; it += NGW) tr_item(J, it, scr, lane);
    base += nitems;
}
template <bool ADD, bool FINAL>
__device__ __forceinline__ void row_pass(const float* xin, float* xout, bf16* xb, float* ssx, const bf16* Y, const int* pos, const float* gfin, int gw, int NGW, int lane) {
    for (int t = gw; t < T_; t += NGW) {
        const GAS f32x4* xr = (const GAS f32x4*)(xin + (size_t)t * D_) + lane;
        f32x4 v[4];
#pragma unroll
        for (int j = 0; j < 4; ++j) v[j] = xr[64 * j];
        if (ADD) {
            const int p0 = pos[2 * t], p1 = pos[2 * t + 1];
            const GAS v2u* y0 = (const GAS v2u*)(Y + (size_t)p0 * D_) + lane; const GAS v2u* y1 = (const GAS v2u*)(Y + (size_t)p1 * D_) + lane;
#pragma unroll
            for (int j = 0; j < 4; ++j) { const v2u a = y0[64 * j], b = y1[64 * j];
                v[j].x += __uint_as_float(a.x << 16) + __uint_as_float(b.x << 16); v[j].y += __uint_as_float(a.x & 0xffff0000u) + __uint_as_float(b.x & 0xffff0000u);
                v[j].z += __uint_as_float(a.y << 16) + __uint_as_float(b.y << 16); v[j].w += __uint_as_float(a.y & 0xffff0000u) + __uint_as_float(b.y & 0xffff0000u); }
        }
        float ss = 0.f;
#pragma unroll
        for (int j = 0; j < 4; ++j) ss += (v[j].x * v[j].x + v[j].y * v[j].y) + (v[j].z * v[j].z + v[j].w * v[j].w);
        ss = wave_sum(ss);
        GAS f32x4* xo = (GAS f32x4*)(xout + (size_t)t * D_) + lane;
        if (FINAL) {
            const float rs = 1.0f / sqrtf(ss * (1.0f / D_) + EPS_);
#pragma unroll
            for (int j = 0; j < 4; ++j) { const f32x4 g = ((const GAS f32x4*)gfin)[lane + 64 * j]; xo[64 * j] = v[j] * rs * g; }
        } else {
            GAS v2u* bo = (GAS v2u*)(xb + (size_t)t * D_) + lane;
#pragma unroll
            for (int j = 0; j < 4; ++j) { xo[64 * j] = v[j]; v2u w; w.x = pk2(v[j].x, v[j].y); w.y = pk2(v[j].z, v[j].w); bo[64 * j] = w; }
            if (lane < 16) ssx[(size_t)t * 16 + lane] = lane == 0 ? ss : 0.f;
        }
    }
}
__device__ __forceinline__ void moe_route1(LAS unsigned char* lds, const float* x, const float* ssx, const float* wr, const float* g, int* tok_e, float* tok_g, float* tok_rs, int* counts, int bx, int G, int tid, int wave, int lane) {
    LAS float* wrgT = (LAS float*)lds;
    LAS int* hist = (LAS int*)(lds + 32768);
    for (int idx = tid; idx < 8192; idx += 512) { const int k = idx >> 3, e = idx & 7; wrgT[e * 1024 + k] = wr[idx] * g[k]; }
    __syncthreads();
    for (int ch = bx; ch < T_ / 128; ch += G) {
        if (tid < 8) hist[tid] = 0;
        __syncthreads();
        for (int i = 0; i < 16; ++i) {
            const int t = ch * 128 + wave * 16 + i;
            const GAS f32x4* xr = (const GAS f32x4*)(x + (size_t)t * D_) + lane;
            f32x4 xv[4];
#pragma unroll
            for (int j = 0; j < 4; ++j) xv[j] = xr[64 * j];
            float lg[8];
#pragma unroll
            for (int e = 0; e < 8; ++e) { float a = 0.f;
#pragma unroll
                for (int j = 0; j < 4; ++j) { const f32x4 w = *(const LAS f32x4*)(wrgT + e * 1024 + 256 * j + 4 * lane); a += (xv[j].x * w.x + xv[j].y * w.y) + (xv[j].z * w.z + xv[j].w * w.w); }
                lg[e] = wave_sum(a); }
            const float ssp = lane < 16 ? ssx[(size_t)t * 16 + lane] : 0.f;
            const float rs = 1.0f / sqrtf(wave_sum(ssp) * (1.0f / D_) + EPS_);
#pragma unroll
            for (int e = 0; e < 8; ++e) lg[e] *= rs;
            int e0 = 0; float b0 = lg[0];
#pragma unroll
            for (int e = 1; e < 8; ++e) if (lg[e] > b0) { b0 = lg[e]; e0 = e; }
            int e1 = -1; float b1 = -3.0e38f;
#pragma unroll
            for (int e = 0; e < 8; ++e) if (e != e0 && (e1 < 0 || lg[e] > b1)) { b1 = lg[e]; e1 = e; }
            const float g0 = 1.0f / (1.0f + __builtin_amdgcn_exp2f((b1 - b0) * LOG2E_)), g1 = 1.0f - g0;
            if (lane == 0) { tok_e[t] = e0 | (e1 << 8); tok_g[2 * t] = g0; tok_g[2 * t + 1] = g1; tok_rs[t] = rs; atomicAdd((int*)&hist[e0], 1); atomicAdd((int*)&hist[e1], 1); }
        }
        __syncthreads();
        if (tid < 8) counts[ch * 8 + tid] = hist[tid];
        __syncthreads();
    }
}
__device__ __forceinline__ void moe_route2(LAS unsigned char* lds, const bf16* xb, bf16* xs, const int* tok_e, const float* tok_g, const float* tok_rs, const int* counts, int* pos, float* rowg, float* rowrs, int* meta,
                                           int bx, int G, int tid, int wave, int lane) {
    LAS int* lcnt = (LAS int*)lds; LAS int* ltot = lcnt + 2048; LAS int* lbef = ltot + 8; LAS int* ldest = lbef + 8;
    for (int ch = bx; ch < T_ / 128; ch += G) {
        { const v4i v = ((const v4i*)counts)[tid]; ((LAS v4i*)lcnt)[tid] = v; }
        __syncthreads();
        { const int e = wave; int tot = 0, bef = 0;
#pragma unroll
          for (int i = 0; i < 4; ++i) { const int c2 = lane + 64 * i; const int v = lcnt[c2 * 8 + e]; tot += v; bef += (c2 < ch) ? v : 0; }
          tot = wave_sum_i(tot); bef = wave_sum_i(bef); if (lane == 0) { ltot[e] = tot; lbef[e] = bef; } }
        __syncthreads();
        int pst[8], pen[8]; { int run = 0;
#pragma unroll
            for (int e = 0; e < 8; ++e) { const int tt = ltot[e]; pst[e] = run; run += (tt + 255) & ~255; pen[e] = run; } }
        if (wave == 0) {
            int runc[8];
#pragma unroll
            for (int e = 0; e < 8; ++e) runc[e] = pst[e] + lbef[e];
#pragma unroll
            for (int half = 0; half < 2; ++half) {
                const int tl = half * 64 + lane, t = ch * 128 + tl; const int ee = tok_e[t]; const int e0 = ee & 255, e1 = ee >> 8;
                int d0 = 0, d1 = 0;
#pragma unroll
                for (int e = 0; e < 8; ++e) { const bool m0 = (e0 == e), m1 = (e1 == e); const unsigned long long mk = __ballot(m0 || m1);
                    const int rank = __popcll(mk & ((1ull << lane) - 1ull)); if (m0) d0 = runc[e] + rank; if (m1) d1 = runc[e] + rank; runc[e] += __popcll(mk); }
                ldest[2 * tl] = d0; ldest[2 * tl + 1] = d1; pos[2 * t] = d0; pos[2 * t + 1] = d1;
                const float g0 = tok_g[2 * t], g1 = tok_g[2 * t + 1], rs = tok_rs[t];
                rowg[d0] = g0; rowg[d1] = g1; rowrs[d0] = rs; rowrs[d1] = rs;
            }
        }
        __syncthreads();
        for (int a = wave; a < 256; a += 8) { const int t = ch * 128 + (a >> 1); const int d = ldest[a];
            const GAS v4u* s = (const GAS v4u*)(xb + (size_t)t * D_) + lane; GAS v4u* o = (GAS v4u*)(xs + (size_t)d * D_) + lane;
            const v4u a0 = s[0], a1 = s[64]; o[0] = a0; o[64] = a1; }
        if (ch == 0) {
            int pv = 0, ps = 0, tt = 0, pe_ = 0;
#pragma unroll
            for (int e = 0; e < 8; ++e) { if (tid == e) pv = pen[e]; if (wave == e) { ps = pst[e]; pe_ = pen[e]; tt = ltot[e]; } }
            if (tid < 8) meta[tid] = pv;
            for (int r = ps + tt + lane; r < pe_; r += 64) { rowrs[r] = 0.f; rowg[r] = 0.f; }
        }
        __syncthreads();
    }
}

struct Params { const float* in[18]; float* out; unsigned char* ws; int ph_lo, ph_hi; };
typedef __attribute__((address_space(4))) Params KP;
__device__ __forceinline__ const KP* kargs() { const KP* p = (const KP*)__builtin_amdgcn_kernarg_segment_ptr(); asm volatile("" : "+s"(p)); return p; }
__global__ void __launch_bounds__(NWAVES * 64, 2) hybrid_fwd(Params P) {
    extern __shared__ __attribute__((aligned(16))) unsigned char lds_raw[];
    LAS unsigned char* lds = (LAS unsigned char*)lds_raw;
    const int tid = threadIdx.x, lane = tid & 63, wave = __builtin_amdgcn_readfirstlane(tid >> 6);
    const int G = gridDim.x, bx = blockIdx.x, vcu = (G % 8 == 0) ? (bx % 8) * (G / 8) + bx / 8 : bx;
    const int gw = vcu * NWAVES + wave, NGW = G * NWAVES;
    for (int u = tid; u < (LDS_BYTES - LDSCTL_OFF) / 4; u += NWAVES * 64) ((LAS unsigned*)(lds + LDSCTL_OFF))[u] = 0u;
    __syncthreads();
    const int lo = P.ph_lo, hi = P.ph_hi;
    XcdBarrier bar; bar.bar = (unsigned*)(P.ws + WS_CTL); bar.x = 0; bar.st = nullptr;
    if (hi - lo > 1) { bar = xcd_barrier_post((unsigned*)(P.ws + WS_CTL), (volatile LAS unsigned*)(lds + MISC_OFF) + 8);
        if (lo != 0) { if (tid == 0) { unsigned nloc, nx; xcd_barrier_complete(bar.bar, bar.x, nloc, nx); bar.st[0] = nloc; bar.st[1] = nx; } __syncthreads(); } }
#define RUN(k) (lo <= (k) && (k) < hi)
#define SEAM(k) do { if (RUN(k) && RUN((k) + 1)) xcd_barrier<false>(bar); } while (0)
#define SEAM_FIRST(k) do { if (RUN(k) && RUN((k) + 1)) xcd_barrier<true>(bar); } while (0)
#define PHASE_ENV() const KP* kp = kargs(); unsigned char* ws = kp->ws; (void)ws; int tid_p = threadIdx.x; asm volatile("" : "+v"(tid_p)); const int lane_p = tid_p & 63; (void)lane_p; \
    float* X = kp->out; bf16* XB = (bf16*)(ws + WS_XB); float* SSX = (float*)(ws + WS_SSX); float* SSQ = (float*)(ws + WS_SSQ); float* RCOS = (float*)(ws + WS_RCOS); float* RSIN = (float*)(ws + WS_RSIN); \
    LAS float* rstab = (LAS float*)(lds + RSTAB_OFF); (void)X; (void)XB; (void)SSX; (void)SSQ; (void)RCOS; (void)RSIN; (void)rstab
#define ATT_PTRS() bf16 *CQ = (bf16*)(ws + WS_CQ), *CKV = (bf16*)(ws + WS_CKV), *KR = (bf16*)(ws + WS_KR), *QBb = (bf16*)(ws + WS_QB), *KBb = (bf16*)(ws + WS_KB), *VBb = (bf16*)(ws + WS_VB), \
         *Qm = (bf16*)(ws + WS_Q), *KN = (bf16*)(ws + WS_KN), *Vm = (bf16*)(ws + WS_V), *AO = (bf16*)(ws + WS_AO); (void)CQ; (void)CKV; (void)KR; (void)QBb; (void)KBb; (void)VBb; (void)Qm; (void)KN; (void)Vm; (void)AO
#define MOE_PTRS() bf16 *HM = (bf16*)(ws + WS_HM), *XS = (bf16*)(ws + WS_XS); int* TOKE = (int*)(ws + WS_TOKE); float* TOKG = (float*)(ws + WS_TOKG); float* TOKRS = (float*)(ws + WS_TOKRS); int* POS = (int*)(ws + WS_POS); \
    int* CNT = (int*)(ws + WS_CNT); int* META = (int*)(ws + WS_META); float* ROWG = (float*)(ws + WS_ROWG); float* ROWRS = (float*)(ws + WS_ROWRS); bf16* WM13 = (bf16*)(ws + WS_WM); bf16* WM2 = WM13 + (size_t)NEXP * 2 * FF_ * D_; \
    (void)HM; (void)XS; (void)TOKE; (void)TOKG; (void)TOKRS; (void)POS; (void)CNT; (void)META; (void)ROWG; (void)ROWRS; (void)WM13; (void)WM2
#define WATT_PTRS() const bf16* WIN = (const bf16*)(ws + WS_WATT + (size_t)l * WATT_L); const bf16* WUQ = WIN + (size_t)IN_PAD * D_; const bf16* WUKV = WUQ + 768 * QL_; const bf16* WOUT = WUKV + 1024 * KVL_; (void)WIN; (void)WUQ; (void)WUKV; (void)WOUT

    if (RUN(0)) {
        PHASE_ENV();
        LAS float* scr = (LAS float*)(lds + wave * 16384);
        int base = 0;
        for (int j = 0; j < 22; ++j) {
            TrJob J;
            if (j < 16) { const int l = j >> 2, k = j & 3; bf16* wl = (bf16*)(ws + WS_WATT + (size_t)l * WATT_L);
                if (k == 0) J = TrJob{kp->in[2] + (size_t)l * D_ * IN_DIM, D_, IN_DIM, wl, kp->in[1] + l * D_, TM_IN};
                else if (k == 1) J = TrJob{kp->in[4] + (size_t)l * QL_ * 768, QL_, 768, wl + (size_t)IN_PAD * D_, kp->in[3] + l * QL_, TM_UQ};
                else if (k == 2) J = TrJob{kp->in[6] + (size_t)l * KVL_ * 1024, KVL_, 1024, wl + (size_t)IN_PAD * D_ + 768 * QL_, kp->in[5] + l * KVL_, TM_UKV};
                else J = TrJob{kp->in[8] + (size_t)l * D_ * D_, D_, D_, wl + (size_t)IN_PAD * D_ + 768 * QL_ + 1024 * KVL_, nullptr, TM_ID};
            } else { const int dl = (j - 16) / 3, k = (j - 16) % 3; bf16* wl = (bf16*)(ws + WS_WD + (size_t)dl * WD_L);
                if (k == 0) J = TrJob{kp->in[10] + (size_t)dl * D_ * FF_, D_, FF_, wl, kp->in[9] + (2 * dl) * D_, TM_W1};
                else if (k == 1) J = TrJob{kp->in[11] + (size_t)dl * D_ * FF_, D_, FF_, wl, kp->in[9] + (2 * dl) * D_, TM_W3};
                else J = TrJob{kp->in[12] + (size_t)dl * FF_ * D_, FF_, D_, wl + (size_t)2 * FF_ * D_, nullptr, TM_ID};
            }
            tr_run(J, base, gw, NGW, scr, lane_p);
        }
        for (int r = gw; r < DEPTH_ * 96; r += NGW) {
            GAS v4u* o = (GAS v4u*)((bf16*)(ws + WS_WATT + (size_t)(r / 96) * WATT_L) + (size_t)(672 + r % 96) * D_) + lane_p; const v4u z = {0u, 0u, 0u, 0u}; o[0] = z; o[64] = z; }
        for (int idx = gw * 64 + lane_p; idx < 8192 * 16; idx += NGW * 64) {
            const int pos = idx >> 4, j = idx & 15, j4 = j & 3, jq = j >> 2;
            const double c4 = j4 == 0 ? 1.0 : j4 == 1 ? 0.5623413251903491 : j4 == 2 ? 0.31622776601683794 : 0.17782794100389228;
            const double p10 = jq == 0 ? 1.0 : jq == 1 ? 0.1 : jq == 2 ? 0.01 : 0.001;
            double a = (double)pos * (c4 * p10) * 0.15915494309189535; a -= __builtin_floor(a);
            const float rv = (float)a; RCOS[idx] = __builtin_amdgcn_cosf(rv); RSIN[idx] = __builtin_amdgcn_sinf(rv);
        }
        row_pass<false, false>(kp->in[0], X, XB, SSX, nullptr, nullptr, nullptr, gw, NGW, lane_p);
    }
    SEAM_FIRST(0);
    int step = 1;
    for (int l = 0; l < DEPTH_; ++l) {
        if (RUN(step)) {
            PHASE_ENV(); ATT_PTRS(); WATT_PTRS();
            pg8::Gemm g{XB, WIN, T_, IN_PAD, D_}; pg8::StaticOrder S; S.init(T_, IN_PAD, G, bx);
            pg8::EpiIn E{ws, 0.125f * LOG2E_, rstab};
            pg8::gemm_phase<pg8::EpiIn, pg8::StaticOrder, true, true>(lds, g, S, E);
        }
        SEAM(step); ++step;
        if (RUN(step)) {
            { PHASE_ENV(); ATT_PTRS(); WATT_PTRS();
              pg8::Gemm g{CQ, WUQ, T_, 768, QL_}; pg8::StaticOrder S; S.init(T_, 768, G, bx);
              pg8::EpiQ E{ws, 0.10206207261596575f * LOG2E_, rstab};
              pg8::gemm_phase<pg8::EpiQ, pg8::StaticOrder, true, true>(lds, g, S, E); }
            { PHASE_ENV(); ATT_PTRS(); WATT_PTRS();
              pg8::Gemm g{CKV, WUKV, T_, 1024, KVL_}; pg8::StaticOrder S; S.init(T_, 1024, G, bx);
              pg8::EpiKV E{ws, rstab};
              pg8::gemm_phase<pg8::EpiKV, pg8::StaticOrder, true, true>(lds, g, S, E); }
        }
        SEAM(step); ++step;
        if (RUN(step)) {
            { PHASE_ENV(); ATT_PTRS();
              const att::Args A{Qm, KN, KR, Vm, QBb, KBb, VBb, AO, kp->in[7] + (size_t)l * 8 * 257};
              att::attn_phase<false>(A, vcu, G, (LAS char*)lds); }
            { PHASE_ENV(); ATT_PTRS();
              const att::Args A{Qm, KN, KR, Vm, QBb, KBb, VBb, AO, kp->in[7] + (size_t)l * 8 * 257};
              att::attn_phase<true>(A, vcu, G, (LAS char*)lds); }
        }
        SEAM(step); ++step;
        if (RUN(step)) {
            PHASE_ENV(); ATT_PTRS(); WATT_PTRS();
            pg8::Gemm g{AO, WOUT, T_, D_, D_}; pg8::StaticOrder S; S.init(T_, D_, G, bx);
            pg8::EpiRes E{X, ws};
            pg8::gemm_phase<pg8::EpiRes, pg8::StaticOrder, true, true>(lds, g, S, E);
        }
        SEAM(step); ++step;
        if ((l & 1) == 0) {
            if (RUN(step)) {
                PHASE_ENV(); MOE_PTRS();
                const bf16* W13 = (const bf16*)(ws + WS_WD + (size_t)(l >> 1) * WD_L);
                pg8::Gemm g{XB, W13, T_, 2 * FF_, D_}; pg8::StaticOrder S; S.init(T_, 2 * FF_, G, bx);
                pg8::EpiGLU<false> E{ws, rstab};
                pg8::gemm_phase<pg8::EpiGLU<false>, pg8::StaticOrder, true, true>(lds, g, S, E);
            }
            SEAM(step); ++step;
            if (RUN(step)) {
                PHASE_ENV(); MOE_PTRS();
                const bf16* W2 = (const bf16*)(ws + WS_WD + (size_t)(l >> 1) * WD_L) + (size_t)2 * FF_ * D_;
                pg8::Gemm g{HM, W2, T_, D_, FF_}; pg8::StaticOrder S; S.init(T_, D_, G, bx);
                pg8::EpiRes E{X, ws};
                pg8::gemm_phase<pg8::EpiRes, pg8::StaticOrder, true, true>(lds, g, S, E);
            }
            SEAM(step); ++step;
        } else {
            const int mj = l >> 1;
            if (RUN(step)) {
                PHASE_ENV(); MOE_PTRS();
                moe_route1(lds, X, SSX, kp->in[13] + (size_t)mj * D_ * NEXP, kp->in[9] + l * D_, TOKE, TOKG, TOKRS, CNT, bx, G, tid_p, wave, lane_p);
                __syncthreads();
                LAS float* scr = (LAS float*)(lds + wave * 16384);
                int base = 0;
                for (int j = 0; j < 24; ++j) { const int e = j / 3, k = j % 3; TrJob J;
                    if (k == 0) J = TrJob{kp->in[14] + (size_t)(mj * NEXP + e) * D_ * FF_, D_, FF_, WM13 + (size_t)e * 2 * FF_ * D_, kp->in[9] + l * D_, TM_W1};
                    else if (k == 1) J = TrJob{kp->in[15] + (size_t)(mj * NEXP + e) * D_ * FF_, D_, FF_, WM13 + (size_t)e * 2 * FF_ * D_, kp->in[9] + l * D_, TM_W3};
                    else J = TrJob{kp->in[16] + (size_t)(mj * NEXP + e) * FF_ * D_, FF_, D_, WM2 + (size_t)e * FF_ * D_, nullptr, TM_ID};
                    tr_run(J, base, gw, NGW, scr, lane_p); }
            }
            SEAM(step); ++step;
            if (RUN(step)) { PHASE_ENV(); MOE_PTRS(); moe_route2(lds, XB, XS, TOKE, TOKG, TOKRS, CNT, POS, ROWG, ROWRS, META, bx, G, tid_p, wave, lane_p); }
            SEAM(step); ++step;
            if (RUN(step)) {
                PHASE_ENV(); MOE_PTRS();
                pg8::MoeOrder S;
#pragma unroll
                for (int e = 0; e < 8; ++e) S.pe[e] = __builtin_amdgcn_readfirstlane(META[e]);
                const int mrows = S.pe[7];
                S.estride = (size_t)2 * FF_ * D_ * 2; S.so.init(mrows, 2 * FF_, G, bx);
                pg8::Gemm g{XS, WM13, mrows, 2 * FF_, D_};
                pg8::EpiGLU<true> E{ws, rstab};
                pg8::gemm_phase<pg8::EpiGLU<true>, pg8::MoeOrder, true, true>(lds, g, S, E);
            }
            SEAM(step); ++step;
            if (RUN(step)) {
                PHASE_ENV(); MOE_PTRS();
                pg8::MoeOrder S;
#pragma unroll
                for (int e = 0; e < 8; ++e) S.pe[e] = __builtin_amdgcn_readfirstlane(META[e]);
                const int mrows = S.pe[7];
                S.estride = (size_t)FF_ * D_ * 2; S.so.init(mrows, D_, G, bx);
                pg8::Gemm g{HM, WM2, mrows, D_, FF_};
                pg8::EpiY E{ws};
                pg8::gemm_phase<pg8::EpiY, pg8::MoeOrder, true, true>(lds, g, S, E);
            }
            SEAM(step); ++step;
            if (RUN(step)) {
                PHASE_ENV(); MOE_PTRS();
                if (l == DEPTH_ - 1) row_pass<true, true>(X, X, XB, SSX, XS, POS, kp->in[17], gw, NGW, lane_p);
                else row_pass<true, false>(X, X, XB, SSX, XS, POS, nullptr, gw, NGW, lane_p);
            }
            SEAM(step); ++step;
        }
    }
#undef RUN
#undef SEAM
#undef SEAM_FIRST
}

extern "C" void kernel_launch(void* const* d_in, const int* in_sizes, int n_in, void* d_out, int out_size, void* d_ws, size_t ws_size, hipStream_t stream) {
    static int grid = 0;
    if (grid == 0) {
        if (n_in != 18 || in_sizes[0] != T_ * D_ || out_size != T_ * D_ || ws_size < WS_END) { fprintf(stderr, "kernel_launch: unexpected shapes / workspace (n_in %d, ws %zu, need %zu); nothing launched\n", n_in, ws_size, (size_t)WS_END); grid = -1; return; }
        int dev = 0, cus = 0;
        if (hipGetDevice(&dev) != hipSuccess || hipDeviceGetAttribute(&cus, hipDeviceAttributeMultiprocessorCount, dev) != hipSuccess) { grid = -1; return; }
        if (hipFuncSetAttribute((const void*)hybrid_fwd, hipFuncAttributeMaxDynamicSharedMemorySize, LDS_BYTES) != hipSuccess) { fprintf(stderr, "kernel_launch: hipFuncSetAttribute failed\n"); grid = -1; return; }
        int per_cu = 0;
        if (hipOccupancyMaxActiveBlocksPerMultiprocessor(&per_cu, (const void*)hybrid_fwd, NWAVES * 64, LDS_BYTES) != hipSuccess || per_cu < 1) fprintf(stderr, "kernel_launch: occupancy query reports %d blocks per CU\n", per_cu);
        (void)hipGetLastError();
        grid = cus;
    }
    if (grid < 0) return;
    (void)hipMemsetAsync((char*)d_ws + WS_CTL, 0, CTL_ZERO_BYTES, stream);
    Params p{};
    for (int i = 0; i < 18; ++i) p.in[i] = (const float*)d_in[i];
    p.out = (float*)d_out; p.ws = (unsigned char*)d_ws;
#if MK_ONE_LAUNCH
    p.ph_lo = 0; p.ph_hi = NSTEPS;
    hipLaunchKernelGGL(hybrid_fwd, dim3(grid), dim3(NWAVES * 64), LDS_BYTES, stream, p);
#else
    for (int s = 0; s < NSTEPS; ++s) { p.ph_lo = s; p.ph_hi = s + 1; hipLaunchKernelGGL(hybrid_fwd, dim3(grid), dim3(NWAVES * 64), LDS_BYTES, stream, p); }
#endif
}
```

```cpp
#include <hip/hip_runtime.h>
#include <cstdio>
#include <cstdint>
constexpr int NWAVES = 8;
constexpr int T_ = 32768, D_ = 1024, DEPTH_ = 4, IN_DIM = 2208, IN_PAD = 2304, FF_ = 3584, NEXP = 8, QL_ = 384, KVL_ = 256;
constexpr int MAXROWS = 2 * T_ + NEXP * 256;
constexpr float EPS_ = 1e-6f, LOG2E_ = 1.4426950408889634f;
#ifndef MK_ONE_LAUNCH
#define MK_ONE_LAUNCH 1
#endif
#ifndef F8_LAYERS
#define F8_LAYERS 0xE
#endif
constexpr bool f8_layer(int l) { return ((F8_LAYERS) >> l) & 1; }
#ifndef F8_UP_LAYERS
#define F8_UP_LAYERS 0x4
#endif
constexpr bool f8_up_layer(int l) { return ((F8_UP_LAYERS) >> l) & 1; }
#ifndef F8_QK_LAYERS
#define F8_QK_LAYERS 0xF
#endif
constexpr bool f8_qk_layer(int l) { return l >= 0 && l < 4 && (((F8_QK_LAYERS) >> l) & 1); }
#ifndef F8_OUT_LAYERS
#define F8_OUT_LAYERS 0xC
#endif
constexpr bool f8_out_layer(int l) { return l >= 0 && l < 4 && (((F8_OUT_LAYERS) >> l) & 1); }
#ifndef F8_IN_LAYERS
#define F8_IN_LAYERS 0xC
#endif
constexpr bool f8_in_layer(int l) { return l >= 0 && l < 4 && (((F8_IN_LAYERS) >> l) & 1); }
static_assert(((F8_UP_LAYERS) & ~(F8_LAYERS) & 0xF) == 0 && ((F8_UP_LAYERS) & 0xA) == 0, "fp8 up-projection: dense layers whose down-projection is fp8");
constexpr bool F8_DENSE_ANY = (F8_LAYERS & 0x5) != 0, F8_DENSE_ALL = (F8_LAYERS & 0x5) == 0x5, F8_MOE_ANY = (F8_LAYERS & 0xA) != 0, F8_MOE_ALL = (F8_LAYERS & 0xA) == 0xA;
constexpr int NSTEPS = 31;
constexpr size_t MiB = 1u << 20;
constexpr size_t WS_CTL = 0, CTL_ZERO_BYTES = 65536;
constexpr size_t WS_RCOS = 1 * MiB, WS_RSIN = WS_RCOS + 512 * 1024;
constexpr size_t WS_SSX = 2 * MiB;
constexpr size_t WS_SSQ = 4 * MiB;
constexpr size_t WS_TOKE = 7 * MiB, WS_TOKG = WS_TOKE + 128 * 1024, WS_TOKRS = WS_TOKG + 256 * 1024, WS_POS = WS_TOKRS + 128 * 1024,
                 WS_CNT = WS_POS + 256 * 1024, WS_META = WS_CNT + 8192, WS_ROWG = 8 * MiB, WS_ROWRS = WS_ROWG + 512 * 1024;
constexpr size_t WATT_L = (size_t)(IN_PAD * D_ + 768 * QL_ + 1024 * KVL_ + D_ * D_) * 2;
constexpr size_t WS_WATT = 10 * MiB;
constexpr size_t WD_L = (size_t)3 * D_ * FF_ * 2;
constexpr size_t WS_WD = 41 * MiB;
constexpr size_t WS_WM = 83 * MiB;
constexpr size_t WS_XQ2 = WS_WM + 56 * MiB;
static_assert((F8_IN_LAYERS) == 0 || F8_MOE_ALL, "WS_XQ2 overlays the bf16 half of the MoE W13 buffer");
constexpr size_t WS_XB = 251 * MiB;
constexpr size_t WS_XS = 315 * MiB;
constexpr size_t WS_HM = 447 * MiB;
constexpr size_t WS_CQ = WS_HM, WS_CKV = WS_CQ + 24 * MiB, WS_KR = WS_CKV + 16 * MiB, WS_QB = WS_KR + 2 * MiB, WS_KB = WS_QB + 32 * MiB, WS_VB = WS_KB + 32 * MiB,
                 WS_Q = WS_VB + 32 * MiB, WS_KN = WS_Q + 48 * MiB, WS_V = WS_KN + 32 * MiB, WS_AO = WS_V + 32 * MiB;
constexpr size_t WS_Q8 = WS_AO + 64 * MiB, WS_KN8 = WS_Q8 + 24 * MiB, WS_KR8 = WS_KN8 + 16 * MiB, WS_ZERO = WS_KR8 + 1 * MiB, WS_QB8 = WS_ZERO + 1 * MiB, WS_KB8 = WS_QB8 + 16 * MiB;
constexpr size_t WS_END = WS_HM + (size_t)MAXROWS * FF_ * 2;
static_assert(WS_KB8 + 16 * MiB <= WS_END && WS_Q8 >= WS_HM + (size_t)MAXROWS * FF_ && WS_Q8 >= WS_HM + (size_t)T_ * FF_ * 2 && ((F8_QK_LAYERS) == 0 || F8_MOE_ALL), "fp8 attention copies sit above the FFN hidden rows");
static_assert(WS_AO + 64 * MiB <= WS_END && WS_WATT + 4 * WATT_L <= WS_WD && WS_WD + 2 * WD_L <= WS_WM && WS_WM + 8 * WD_L <= WS_XB && WS_XS + (size_t)MAXROWS * D_ * 2 <= WS_HM, "d_ws map");
constexpr int RING_BYTES = 131072, LDSCTL_OFF = RING_BYTES, MISC_OFF = LDSCTL_OFF + 320, RSTAB_OFF = LDSCTL_OFF + 1024, LDS_BYTES = 147456;

namespace pg8 {
#define PG8_LAS __attribute__((address_space(3)))
typedef unsigned short bf16_t;
typedef short bf16x8 __attribute__((ext_vector_type(8)));
typedef float f32x4 __attribute__((ext_vector_type(4)));
typedef unsigned u32x4 __attribute__((ext_vector_type(4)));
typedef int v4i32 __attribute__((ext_vector_type(4)));
typedef int v8i32 __attribute__((ext_vector_type(8)));
typedef unsigned u32x2 __attribute__((ext_vector_type(2)));
constexpr int BM = 256, BK = 64, HALF = 128, HTB = HALF * BK * 2  , STAGE_BYTES = 8 * HTB, NXCD = 8, WGM = 8;

__host__ __device__ __forceinline__ int lds_byte(int r, int c) { const int st = (r >> 4) * 2 + (c >> 5), rr = r & 15, cc = c & 31, ob = rr * 64 + cc * 2; return st * 1024 + (ob ^ (((ob >> 9) & 1) << 5)); }
__host__ __device__ __forceinline__ void stage_rc(int b, int& R, int& C) { const int st = b / 1024, sb = b % 1024, swz = sb ^ (((sb >> 9) & 1) << 5); R = (st >> 1) * 16 + swz / 64; C = (st & 1) * 32 + (swz % 64) / 2; }
__host__ __device__ __forceinline__ int perm32(int rho) { const int n = rho >> 4, i = rho & 15; return 8 * (i >> 2) + 4 * n + (i & 3); }

struct Unit { int pm, pn; };
struct Gemm { const bf16_t* A; const bf16_t* Bt; int M, N, K; int scw = 0x79797979, sch = 0x7c7c7c7c; };

struct StaticOrder {
    int nM, nN, nwg, G, c;
    __host__ __device__ void init(int M, int N, int G_, int c_) { nM = M / BM; nN = N / BM; nwg = nM * nN; G = G_; c = c_; }
    __host__ __device__ bool next(int i, Unit& u) const {
        const long L = (long)i * G + c; if (L >= nwg) return false;
        int wgid = (int)L; { const int q = nwg / NXCD, r = nwg % NXCD, xcd = wgid % NXCD, off = wgid / NXCD; wgid = (xcd < r ? xcd * (q + 1) : r * (q + 1) + (xcd - r) * q) + off; }
        const int nig = WGM * nN, gid = wgid / nig, fm = gid * WGM, gsz = (nM - fm) < WGM ? (nM - fm) : WGM;
        u.pm = fm + ((wgid % nig) % gsz); u.pn = (wgid % nig) / gsz; return true;
    }
    __device__ __forceinline__ size_t boff(const Unit&) const { return 0; }
    __device__ __forceinline__ void a_ready(const Unit&) const {}
    __device__ __forceinline__ void done(const Unit&) const {}
};

__device__ __forceinline__ unsigned cvt_pk_bf16(float lo, float hi) { unsigned r; asm volatile("v_cvt_pk_bf16_f32 %0, %1, %2" : "=v"(r) : "v"(lo), "v"(hi)); return r; }
typedef float f32x2 __attribute__((ext_vector_type(2)));
__device__ __forceinline__ u32x4 pack8(const f32x4 a, const f32x4 b) { u32x4 w; w.x = cvt_pk_bf16(a[0], a[1]); w.y = cvt_pk_bf16(a[2], a[3]); w.z = cvt_pk_bf16(b[0], b[1]); w.w = cvt_pk_bf16(b[2], b[3]); return w; }
__device__ __forceinline__ float sumsq4(const f32x4 v) { return (v[0] * v[0] + v[1] * v[1]) + (v[2] * v[2] + v[3] * v[3]); }
__device__ __forceinline__ float xor16_add(float v) { return v + __int_as_float(__builtin_amdgcn_ds_swizzle(__float_as_int(v), 0x401F)); }
__device__ __forceinline__ float xor32_add(float v) { auto rr = __builtin_amdgcn_permlane32_swap(__float_as_uint(v), __float_as_uint(v), false, false); return __uint_as_float(rr[0]) + __uint_as_float(rr[1]); }
__device__ __forceinline__ float silu_f(float x) { return x * __builtin_amdgcn_rcpf(1.0f + __builtin_amdgcn_exp2f(-1.4426950409f * x)); }
template <int NP4, int PITCH, int OFF>
__device__ __forceinline__ void rs_table(const float* part, int rowbase, int wr, int lane, float inv_dim, PG8_LAS float* t) {
    f32x4 s[2][NP4];
#pragma unroll
    for (int ai = 0; ai < 2; ++ai) { const f32x4* p = (const f32x4*)(part + (size_t)(rowbase + ai * 128 + wr * 64 + lane) * PITCH + OFF);
#pragma unroll
        for (int j = 0; j < NP4; ++j) s[ai][j] = p[j]; }
#pragma unroll
    for (int ai = 0; ai < 2; ++ai) { f32x4 a = s[ai][0];
#pragma unroll
        for (int j = 1; j < NP4; ++j) a += s[ai][j];
        t[ai * 64 + lane] = __builtin_amdgcn_rsqf(((a[0] + a[1]) + (a[2] + a[3])) * inv_dim + 1e-6f); }
    asm volatile("s_waitcnt lgkmcnt(0)" ::: "memory");
}
constexpr int DM = 1024, FFN = 3584, SEQ_ = 8192;

__device__ __forceinline__ f32x4 bf2f_lo(const u32x4 w, int h) { const unsigned a = h ? w.z : w.x, b = h ? w.w : w.y; return (f32x4){__uint_as_float(a << 16), __uint_as_float(a & 0xffff0000u), __uint_as_float(b << 16), __uint_as_float(b & 0xffff0000u)}; }
struct EpiRes {
    static constexpr bool PERM = true, AFTER_DRAIN = false, PREFETCH = false;
    unsigned char* ws; bool dummy;
    __device__ __forceinline__ void operator()(const f32x4 (&acc)[2][2][4][2], const Unit& u, int wr, int wc, int fr, int fq) const {
        bf16_t* xb = (bf16_t*)(ws + (dummy ? WS_XS : WS_XB)); float* ssx = (float*)(ws + (dummy ? WS_SSQ : WS_SSX));
        const int row0 = u.pm * BM + wr * 64 + fr, col0 = u.pn * BM + wc * 32 + 8 * fq;
        u32x4 old[2][4][2];
#pragma unroll
        for (int ai = 0; ai < 2; ++ai)
#pragma unroll
            for (int m = 0; m < 4; ++m)
#pragma unroll
                for (int bj = 0; bj < 2; ++bj) old[ai][m][bj] = *(const u32x4*)(xb + (size_t)(row0 + ai * HALF + m * 16) * DM + col0 + bj * HALF);
#pragma unroll
        for (int ai = 0; ai < 2; ++ai)
#pragma unroll
            for (int m = 0; m < 4; ++m) {
                const int row = row0 + ai * HALF + m * 16; float ss = 0.f;
#pragma unroll
                for (int bj = 0; bj < 2; ++bj) {
                    const f32x4 v0 = bf2f_lo(old[ai][m][bj], 0) + acc[ai][bj][m][0], v1 = bf2f_lo(old[ai][m][bj], 1) + acc[ai][bj][m][1];
                    ss += sumsq4(v0) + sumsq4(v1);
                    *(u32x4*)(xb + (size_t)row * DM + col0 + bj * HALF) = pack8(v0, v1);
                }
                ss = xor32_add(xor16_add(ss));
                if (fq == 0) ssx[(size_t)row * 16 + u.pn * 4 + wc] = ss;
            }
    }
};
__device__ __forceinline__ unsigned pack4_fp8_x16(const f32x4 v) { int w = 0; w = __builtin_amdgcn_cvt_pk_fp8_f32(__builtin_amdgcn_fmed3f(v[0] * 16.0f, -448.0f, 448.0f), __builtin_amdgcn_fmed3f(v[1] * 16.0f, -448.0f, 448.0f), w, false);
    w = __builtin_amdgcn_cvt_pk_fp8_f32(__builtin_amdgcn_fmed3f(v[2] * 16.0f, -448.0f, 448.0f), __builtin_amdgcn_fmed3f(v[3] * 16.0f, -448.0f, 448.0f), w, true); return (unsigned)w; }
__device__ __forceinline__ unsigned pack4_fp8_x8(const f32x4 v) { int w = 0; w = __builtin_amdgcn_cvt_pk_fp8_f32(__builtin_amdgcn_fmed3f(v[0] * 8.0f, -448.0f, 448.0f), __builtin_amdgcn_fmed3f(v[1] * 8.0f, -448.0f, 448.0f), w, false);
    w = __builtin_amdgcn_cvt_pk_fp8_f32(__builtin_amdgcn_fmed3f(v[2] * 8.0f, -448.0f, 448.0f), __builtin_amdgcn_fmed3f(v[3] * 8.0f, -448.0f, 448.0f), w, true); return (unsigned)w; }
struct EpiResQ {
    static constexpr bool PERM = true, AFTER_DRAIN = false, PREFETCH = false;
    unsigned char* ws; bool dummy;
    __device__ __forceinline__ void operator()(const f32x4 (&acc)[2][2][4][2], const Unit& u, int wr, int wc, int fr, int fq) const {
        bf16_t* xb = (bf16_t*)(ws + (dummy ? WS_XS : WS_XB)); float* ssx = (float*)(ws + (dummy ? WS_SSQ : WS_SSX)); unsigned char* xq = ws + WS_XS + (dummy ? (size_t)64 * 1024 * 1024 : 0);
        const int row0 = u.pm * BM + wr * 64 + fr, col0 = u.pn * BM + wc * 32 + 8 * fq;
#pragma unroll
        for (int ai = 0; ai < 2; ++ai) {
            u32x4 old[4][2];
#pragma unroll
            for (int m = 0; m < 4; ++m)
#pragma unroll
                for (int bj = 0; bj < 2; ++bj) old[m][bj] = *(const u32x4*)(xb + (size_t)(row0 + ai * HALF + m * 16) * DM + col0 + bj * HALF);
#pragma unroll
            for (int m = 0; m < 4; ++m) {
                const int row = row0 + ai * HALF + m * 16; float ss = 0.f;
#pragma unroll
                for (int bj = 0; bj < 2; ++bj) {
                    const f32x4 v0 = bf2f_lo(old[m][bj], 0) + acc[ai][bj][m][0], v1 = bf2f_lo(old[m][bj], 1) + acc[ai][bj][m][1];
                    ss += sumsq4(v0) + sumsq4(v1);
                    *(u32x4*)(xb + (size_t)row * DM + col0 + bj * HALF) = pack8(v0, v1);
                    { u32x2 w8; w8.x = pack4_fp8_x8(v0); w8.y = pack4_fp8_x8(v1); *(u32x2*)(xq + (size_t)row * DM + col0 + bj * HALF) = w8; }
                }
                ss = xor32_add(xor16_add(ss));
                if (fq == 0) ssx[(size_t)row * 16 + u.pn * 4 + wc] = ss;
            }
        }
    }
};
__device__ __forceinline__ unsigned pack4_fp8(const f32x4 v) { int w = 0; w = __builtin_amdgcn_cvt_pk_fp8_f32(__builtin_amdgcn_fmed3f(v[0] * 8.0f, -448.0f, 448.0f), __builtin_amdgcn_fmed3f(v[1] * 8.0f, -448.0f, 448.0f), w, false);
    w = __builtin_amdgcn_cvt_pk_fp8_f32(__builtin_amdgcn_fmed3f(v[2] * 8.0f, -448.0f, 448.0f), __builtin_amdgcn_fmed3f(v[3] * 8.0f, -448.0f, 448.0f), w, true); return (unsigned)w; }
template <bool MOE, bool F8OUT = true, bool NORS = false> struct EpiGLU {
    static constexpr bool PERM = true, AFTER_DRAIN = false, PREFETCH = false;
    unsigned char* ws; PG8_LAS float* tab;
    __device__ __forceinline__ void operator()(const f32x4 (&acc)[2][2][4][2], const Unit& u, int wr, int wc, int fr, int fq) const {
        const int lane = fq * 16 + fr, wid = wr * 4 + wc; float rs[2][4];
        bf16_t* h = (bf16_t*)(ws + WS_HM); const float* part = (const float*)(ws + (MOE ? WS_ROWRS : WS_SSX));
        if (NORS) {
            asm volatile("s_waitcnt vmcnt(0)" ::: "memory");
#pragma unroll
            for (int ai = 0; ai < 2; ++ai)
#pragma unroll
                for (int m = 0; m < 4; ++m) rs[ai][m] = 1.0f;
        } else if (MOE) {
#pragma unroll
            for (int ai = 0; ai < 2; ++ai)
#pragma unroll
                for (int m = 0; m < 4; ++m) rs[ai][m] = part[u.pm * BM + ai * HALF + wr * 64 + m * 16 + fr];
        } else {
            PG8_LAS float* t = tab + wid * 128; rs_table<4, 16, 0>(part, u.pm * BM, wr, lane, 1.0f / DM, t);
#pragma unroll
            for (int ai = 0; ai < 2; ++ai)
#pragma unroll
                for (int m = 0; m < 4; ++m) rs[ai][m] = t[ai * 64 + m * 16 + fr];
        }
        const int row0 = u.pm * BM + wr * 64 + fr, col0 = u.pn * HALF + wc * 32 + 8 * fq;
#pragma unroll
        for (int ai = 0; ai < 2; ++ai)
#pragma unroll
            for (int m = 0; m < 4; ++m) {
                const float r = rs[ai][m]; f32x4 o[2];
#pragma unroll
                for (int n = 0; n < 2; ++n) { const f32x4 a = acc[ai][0][m][n] * r, b = acc[ai][1][m][n] * r;
                    o[n] = (f32x4){silu_f(a[0]) * b[0], silu_f(a[1]) * b[1], silu_f(a[2]) * b[2], silu_f(a[3]) * b[3]}; }
                if (F8OUT) { u32x2 w; w.x = pack4_fp8(o[0]); w.y = pack4_fp8(o[1]); *(u32x2*)((unsigned char*)h + (size_t)(row0 + ai * HALF + m * 16) * FFN + col0) = w; }
                else *(u32x4*)(h + (size_t)(row0 + ai * HALF + m * 16) * FFN + col0) = pack8(o[0], o[1]);
            }
    }
};
struct EpiY {
    static constexpr bool PERM = true, AFTER_DRAIN = false, PREFETCH = true;
    unsigned char* ws; PG8_LAS float* tab;
    __device__ __forceinline__ void prefetch(const Unit& u, int wid, int lane) const {
        const float* rowg = (const float*)(ws + WS_ROWG);
        __builtin_amdgcn_global_load_lds((const unsigned*)(rowg + (size_t)u.pm * BM + lane * 4), (PG8_LAS unsigned*)(tab + wid * 256), 16, 0, 0);
    }
    __device__ __forceinline__ void operator()(const f32x4 (&acc)[2][2][4][2], const Unit& u, int wr, int wc, int fr, int fq) const {
        bf16_t* y = (bf16_t*)(ws + WS_XS); const PG8_LAS float* t = tab + (wr * 4 + wc) * 256;
        const int row0 = u.pm * BM + wr * 64 + fr, col0 = u.pn * BM + wc * 32 + 8 * fq;
#pragma unroll
        for (int ai = 0; ai < 2; ++ai)
#pragma unroll
            for (int m = 0; m < 4; ++m) { const int row = row0 + ai * HALF + m * 16; const float g = t[ai * HALF + wr * 64 + m * 16 + fr];
#pragma unroll
                for (int bj = 0; bj < 2; ++bj) *(u32x4*)(y + (size_t)row * DM + col0 + bj * HALF) = pack8(acc[ai][bj][m][0] * g, acc[ai][bj][m][1] * g); }
    }
};
__device__ __forceinline__ void rope8(f32x4& v0, f32x4& v1, const float* rcos, const float* rsin, int pos, int fq) {
    const f32x4 c = *(const f32x4*)(rcos + pos * 16 + 4 * fq), s = *(const f32x4*)(rsin + pos * 16 + 4 * fq);
    const f32x4 o0 = v0 * c - v1 * s, o1 = v0 * s + v1 * c; v0 = o0; v1 = o1;
}
struct EpiIn {
    static constexpr bool PERM = true, AFTER_DRAIN = false, PREFETCH = false;
    unsigned char* ws; float qbscale; PG8_LAS float* tab; int f8qk = 0;
    __device__ __forceinline__ void operator()(const f32x4 (&acc)[2][2][4][2], const Unit& u, int wr, int wc, int fr, int fq) const {
        const int lane = fq * 16 + fr, wid = wr * 4 + wc;
        const float* ssx = (const float*)(ws + WS_SSX); float* ssq = (float*)(ws + WS_SSQ); const float* rcos = (const float*)(ws + WS_RCOS); const float* rsin = (const float*)(ws + WS_RSIN);
        bf16_t *cq = (bf16_t*)(ws + WS_CQ), *ckv = (bf16_t*)(ws + WS_CKV), *kr = (bf16_t*)(ws + WS_KR), *qb = (bf16_t*)(ws + WS_QB), *kb = (bf16_t*)(ws + WS_KB), *vb = (bf16_t*)(ws + WS_VB);
        PG8_LAS float* t = tab + wid * 128; rs_table<4, 16, 0>(ssx, u.pm * BM, wr, lane, 1.0f / DM, t);
        const int row0 = u.pm * BM + wr * 64 + fr;
#pragma unroll
        for (int bj = 0; bj < 2; ++bj) {
            const int colg = u.pn * BM + bj * HALF + wc * 32;
            if (colg >= 672 && colg < 768) continue;
            bf16_t* dst; int pitch, kind = 0, sidx = 0; float sc = 1.f;
            if (colg < 384) { dst = cq + colg; pitch = 384; kind = 1; sidx = colg >> 5; }
            else if (colg < 640) { dst = ckv + (colg - 384); pitch = 256; kind = 1; sidx = colg >> 5; }
            else if (colg < 672) { dst = kr; pitch = 32; kind = 2; }
            else if (colg < 1280) { dst = qb + (colg - 768); pitch = 512; sc = qbscale; }
            else if (colg < 1792) { dst = kb + (colg - 1280); pitch = 512; }
            else { dst = vb + (colg - 1792); pitch = 512; }
#pragma unroll
            for (int ai = 0; ai < 2; ++ai)
#pragma unroll
                for (int m = 0; m < 4; ++m) {
                    const int row = row0 + ai * HALF + m * 16; const float r = t[ai * 64 + m * 16 + fr] * sc;
                    f32x4 v0 = acc[ai][bj][m][0] * r, v1 = acc[ai][bj][m][1] * r;
                    if (kind == 2) rope8(v0, v1, rcos, rsin, row & (SEQ_ - 1), fq);
                    *(u32x4*)(dst + (size_t)row * pitch + 8 * fq) = pack8(v0, v1);
                    if (f8qk && colg >= 768 && colg < 1280) { u32x2 w8; w8.x = pack4_fp8_x16(v0); w8.y = pack4_fp8_x16(v1); *(u32x2*)(ws + WS_QB8 + (size_t)row * 512 + (colg - 768) + 8 * fq) = w8; }
                    if (f8qk && colg >= 1280 && colg < 1792) { u32x2 w8; w8.x = pack4_fp8_x8(v0); w8.y = pack4_fp8_x8(v1); *(u32x2*)(ws + WS_KB8 + (size_t)row * 512 + (colg - 1280) + 8 * fq) = w8; }
                    if (kind == 2 && f8qk) { u32x2 w8; w8.x = pack4_fp8_x8(v0); w8.y = pack4_fp8_x8(v1); *(u32x2*)(ws + WS_KR8 + (size_t)row * 32 + 8 * fq) = w8; }
                    if (kind == 1) { float ss = sumsq4(v0) + sumsq4(v1); ss = xor32_add(xor16_add(ss)); if (fq == 0) ssq[(size_t)row * 20 + sidx] = ss; }
                }
        }
    }
};
struct EpiQ {
    static constexpr bool PERM = true, AFTER_DRAIN = false, PREFETCH = false;
    unsigned char* ws; float qscale; PG8_LAS float* tab; int f8qk = 0;
    __device__ __forceinline__ void operator()(const f32x4 (&acc)[2][2][4][2], const Unit& u, int wr, int wc, int fr, int fq) const {
        const int lane = fq * 16 + fr, wid = wr * 4 + wc;
        const float* ssq = (const float*)(ws + WS_SSQ); bf16_t* q = (bf16_t*)(ws + WS_Q); const float* rcos = (const float*)(ws + WS_RCOS); const float* rsin = (const float*)(ws + WS_RSIN);
        PG8_LAS float* t = tab + wid * 128; rs_table<3, 20, 0>(ssq, u.pm * BM, wr, lane, 1.0f / 384.0f, t);
        const int row0 = u.pm * BM + wr * 64 + fr;
#pragma unroll
        for (int bj = 0; bj < 2; ++bj) {
            const int colg = u.pn * BM + bj * HALF + wc * 32; const bool rope = ((colg >> 5) % 3) == 2;
#pragma unroll
            for (int ai = 0; ai < 2; ++ai)
#pragma unroll
                for (int m = 0; m < 4; ++m) {
                    const int row = row0 + ai * HALF + m * 16; const float r = t[ai * 64 + m * 16 + fr] * qscale;
                    f32x4 v0 = acc[ai][bj][m][0] * r, v1 = acc[ai][bj][m][1] * r;
                    if (rope) rope8(v0, v1, rcos, rsin, row & (SEQ_ - 1), fq);
                    *(u32x4*)(q + (size_t)row * 768 + colg + 8 * fq) = pack8(v0, v1);
                    if (f8qk) { u32x2 w8; w8.x = pack4_fp8_x16(v0); w8.y = pack4_fp8_x16(v1); *(u32x2*)(ws + WS_Q8 + (size_t)row * 768 + colg + 8 * fq) = w8; }
                }
        }
    }
};
struct EpiKV {
    static constexpr bool PERM = true, AFTER_DRAIN = false, PREFETCH = false;
    unsigned char* ws; PG8_LAS float* tab; int f8qk = 0;
    __device__ __forceinline__ void operator()(const f32x4 (&acc)[2][2][4][2], const Unit& u, int wr, int wc, int fr, int fq) const {
        const int lane = fq * 16 + fr, wid = wr * 4 + wc;
        const float* ssq = (const float*)(ws + WS_SSQ); bf16_t* kn = (bf16_t*)(ws + WS_KN); bf16_t* v = (bf16_t*)(ws + WS_V);
        PG8_LAS float* t = tab + wid * 128; rs_table<2, 20, 12>(ssq, u.pm * BM, wr, lane, 1.0f / 256.0f, t);
        const int row0 = u.pm * BM + wr * 64 + fr;
#pragma unroll
        for (int bj = 0; bj < 2; ++bj) {
            const int colg = u.pn * BM + bj * HALF + wc * 32; bf16_t* dst = colg < 512 ? kn + colg : v + (colg - 512);
#pragma unroll
            for (int ai = 0; ai < 2; ++ai)
#pragma unroll
                for (int m = 0; m < 4; ++m) {
                    const int row = row0 + ai * HALF + m * 16; const float r = t[ai * 64 + m * 16 + fr];
                    *(u32x4*)(dst + (size_t)row * 512 + 8 * fq) = pack8(acc[ai][bj][m][0] * r, acc[ai][bj][m][1] * r);
                    if (f8qk && colg < 512) { u32x2 w8; w8.x = pack4_fp8_x8(acc[ai][bj][m][0] * r); w8.y = pack4_fp8_x8(acc[ai][bj][m][1] * r); *(u32x2*)(ws + WS_KN8 + (size_t)row * 512 + colg + 8 * fq) = w8; }
                }
        }
    }
};
struct EpiNull {
    static constexpr bool PERM = true, AFTER_DRAIN = false, PREFETCH = false;
    unsigned char* ws;
    __device__ __forceinline__ void operator()(const f32x4 (&acc)[2][2][4][2], const Unit& u, int wr, int wc, int fr, int fq) const {
        float s = 0.f;
#pragma unroll
        for (int ai = 0; ai < 2; ++ai)
#pragma unroll
            for (int bj = 0; bj < 2; ++bj)
#pragma unroll
                for (int m = 0; m < 4; ++m)
#pragma unroll
                    for (int n = 0; n < 2; ++n) s += acc[ai][bj][m][n][0] + acc[ai][bj][m][n][3];
        if (s == 123456.789f) *(float*)(ws + WS_SSQ) = s;
    }
};
struct MoeOrder {
    StaticOrder so; int pe[8]; size_t estride;
    __device__ __forceinline__ bool next(int i, Unit& u) const { return so.next(i, u); }
    __device__ __forceinline__ size_t boff(const Unit& u) const { int e = 0;
#pragma unroll
        for (int j = 0; j < 7; ++j) e += (u.pm * BM >= pe[j]) ? 1 : 0;
        return (size_t)e * estride; }
    __device__ __forceinline__ void a_ready(const Unit&) const {}
    __device__ __forceinline__ void done(const Unit&) const {}
};
template <class Epi, class Sched, bool ALIGN_EPI = false, bool SP2 = false, bool F8 = false>
__device__ __forceinline__ void gemm_phase(PG8_LAS unsigned char* lds, const Gemm g, const Sched& S, const Epi& E, const int tidb  ) {
    int tid_l; asm volatile("v_mbcnt_lo_u32_b32 %0, -1, 0\n\tv_mbcnt_hi_u32_b32 %0, -1, %0" : "=v"(tid_l)); tid_l += tidb;
    const int tid = tid_l, wid = __builtin_amdgcn_readfirstlane(tid >> 6), lane = tid & 63, wr = wid >> 2, wc = wid & 3, fr = lane & 15, fq = lane >> 4;
    int K_l = g.K; asm volatile("" : "+s"(K_l));
    constexpr int ES = F8 ? 1 : 2;
    const int K = K_l, nt = K * ES / (BK * 2);
    unsigned voffA[2], voffB[2];
#pragma unroll
    for (int i = 0; i < 2; ++i) { int R, C; stage_rc(tid * 16 + i * 8192, R, C); const int Rb = Epi::PERM ? ((R & ~31) + perm32(R & 31)) : R;
        voffA[i] = (unsigned)(R * K) * ES + C * 2u; voffB[i] = (unsigned)(Rb * K) * ES + C * 2u; }
    const size_t kstep = (size_t)(BK * 2);
    const size_t hstep = (size_t)HALF * K * ES;
    const size_t tstep = 2 * hstep;
    const unsigned ldsw = (unsigned)wid * 1024u;
    const int aoff = lds_byte(wr * 64 + fr, fq * 8), boff = lds_byte(wc * 32 + fr, fq * 8);
#define PG8_SA(b, h) (((b) * 2 + (h)) * HTB)
#define PG8_SB(b, h) ((4 + (b) * 2 + (h)) * HTB)
#define PG8_STAGE(bufoff, gbase, voff) do { _Pragma("unroll") for (int _i = 0; _i < 2; ++_i) \
        __builtin_amdgcn_global_load_lds((const unsigned*)((const char*)(gbase) + (voff)[_i]), (PG8_LAS unsigned*)(lds + (bufoff) + ldsw + _i * 8192), 16, 0, 0); } while (0)
#define PG8_LDA(dst, b, h) do { if constexpr (F8) { _Pragma("unroll") for (int m = 0; m < 4; ++m) _Pragma("unroll") for (int k = 0; k < 2; ++k) { const v4i32 t_ = *(const PG8_LAS v4i32*)(lds + PG8_SA(b, h) + aoff + m * 2048 + k * 1024); dst##8[m][4 * k] = t_[0]; dst##8[m][4 * k + 1] = t_[1]; dst##8[m][4 * k + 2] = t_[2]; dst##8[m][4 * k + 3] = t_[3]; } } else { _Pragma("unroll") for (int m = 0; m < 4; ++m) _Pragma("unroll") for (int k = 0; k < 2; ++k) dst[m][k] = *(const PG8_LAS bf16x8*)(lds + PG8_SA(b, h) + aoff + m * 2048 + k * 1024); } } while (0)
#define PG8_LDB(dst, b, h) do { if constexpr (F8) { _Pragma("unroll") for (int n = 0; n < 2; ++n) _Pragma("unroll") for (int k = 0; k < 2; ++k) { const v4i32 t_ = *(const PG8_LAS v4i32*)(lds + PG8_SB(b, h) + boff + n * 2048 + k * 1024); dst##8[n][4 * k] = t_[0]; dst##8[n][4 * k + 1] = t_[1]; dst##8[n][4 * k + 2] = t_[2]; dst##8[n][4 * k + 3] = t_[3]; } } else { _Pragma("unroll") for (int n = 0; n < 2; ++n) _Pragma("unroll") for (int k = 0; k < 2; ++k) dst[n][k] = *(const PG8_LAS bf16x8*)(lds + PG8_SB(b, h) + boff + n * 2048 + k * 1024); } } while (0)
#define PG8_MMA(ai, bj, At, Bt) do { __builtin_amdgcn_s_setprio(1); if constexpr (F8) { _Pragma("unroll") for (int m = 0; m < 4; ++m) _Pragma("unroll") for (int n = 0; n < 2; ++n) \
        asm volatile("v_mfma_scale_f32_16x16x128_f8f6f4 %0, %1, %2, %0, %3, %4 op_sel_hi:[0,0,0]" : "+v"(acc[ai][bj][m][n]) : "v"(Bt##8[n]), "v"(At##8[m]), "v"(sc_w), "v"(sc_h)); } else { \
        _Pragma("unroll") for (int m = 0; m < 4; ++m) _Pragma("unroll") for (int n = 0; n < 2; ++n) _Pragma("unroll") for (int k = 0; k < 2; ++k) \
        acc[ai][bj][m][n] = __builtin_amdgcn_mfma_f32_16x16x32_bf16(Bt[n][k], At[m][k], acc[ai][bj][m][n], 0, 0, 0); } __builtin_amdgcn_s_setprio(0); } while (0)
#define PG8_WAIT_V(n) asm volatile("s_waitcnt vmcnt(" #n ")" ::: "memory")
#define PG8_WAIT_L(n) asm volatile("s_waitcnt lgkmcnt(" #n ")" ::: "memory")
#define PG8_BAR __builtin_amdgcn_s_barrier()
#define PG8_SCHED __builtin_amdgcn_sched_barrier(0)
    Unit cur, nxt; int ui = 0;
    if (!S.next(0, cur)) return;
    f32x4 acc[2][2][4][2];
#pragma unroll
    for (int a = 0; a < 2; ++a)
#pragma unroll
        for (int b = 0; b < 2; ++b)
#pragma unroll
            for (int m = 0; m < 4; ++m)
#pragma unroll
                for (int n = 0; n < 2; ++n) acc[a][b][m][n] = (f32x4){0.f, 0.f, 0.f, 0.f};
    bf16x8 At[4][2], B0[2][2], B1[2][2];
    const int sc_w = g.scw, sc_h = g.sch;
    v8i32 At8[4], B08[2], B18[2];
    const char* cA = (const char*)g.A + (size_t)cur.pm * tstep; const char* cB = (const char*)g.Bt + S.boff(cur) + (size_t)cur.pn * tstep;
    S.a_ready(cur);
    if constexpr (SP2) {
        PG8_STAGE(PG8_SB(0, 0), cB, voffB); PG8_STAGE(PG8_SB(0, 1), cB + hstep, voffB); PG8_STAGE(PG8_SA(0, 0), cA, voffA); PG8_STAGE(PG8_SA(0, 1), cA + hstep, voffA);
        if (wr == 1) PG8_BAR;
        PG8_WAIT_V(2); PG8_BAR;
        PG8_STAGE(PG8_SB(1, 0), cB + kstep, voffB); PG8_STAGE(PG8_SA(1, 0), cA + kstep, voffA); PG8_STAGE(PG8_SB(1, 1), cB + hstep + kstep, voffB);
        PG8_WAIT_V(6); PG8_BAR;
    } else {
        PG8_STAGE(PG8_SB(0, 0), cB, voffB); PG8_STAGE(PG8_SA(0, 0), cA, voffA); PG8_STAGE(PG8_SB(0, 1), cB + hstep, voffB); PG8_STAGE(PG8_SA(0, 1), cA + hstep, voffA);
        if (wr == 1) PG8_BAR;
        PG8_WAIT_V(4); PG8_BAR;
        PG8_STAGE(PG8_SB(1, 0), cB + kstep, voffB); PG8_STAGE(PG8_SA(1, 0), cA + kstep, voffA); PG8_STAGE(PG8_SB(1, 1), cB + hstep + kstep, voffB);
        PG8_WAIT_V(6); PG8_BAR;
    }
    for (;;) {
        const bool has_next = S.next(ui + 1, nxt);
        const char* nA = has_next ? (const char*)g.A + (size_t)nxt.pm * tstep : cA; const char* nB = has_next ? (const char*)g.Bt + S.boff(nxt) + (size_t)nxt.pn * tstep : cB;
        for (int t = 0; t < nt; t += 2) {
            const bool last = (t == nt - 2);
            if constexpr (Epi::PREFETCH) { if (t == 0) E.prefetch(cur, wid, lane); }
            const char* a1 = cA + (size_t)(t + 1) * kstep;
            const char* a2 = last ? nA : cA + (size_t)(t + 2) * kstep; const char* b2 = last ? nB : cB + (size_t)(t + 2) * kstep;
            const char* a3 = a2 + kstep; const char* b3 = b2 + kstep;
            if (last && has_next) S.a_ready(nxt);
            if constexpr (SP2) {
            PG8_LDB(B0, 0, 0); PG8_LDB(B1, 0, 1); PG8_SCHED; PG8_LDA(At, 0, 0); PG8_STAGE(PG8_SA(1, 1), a1 + hstep, voffA);
            PG8_WAIT_V(8); PG8_WAIT_L(0); PG8_BAR; PG8_MMA(0, 0, At, B0); PG8_MMA(0, 1, At, B1); PG8_BAR; PG8_SCHED;
            PG8_LDA(At, 0, 1); PG8_STAGE(PG8_SB(0, 0), b2, voffB); PG8_STAGE(PG8_SB(0, 1), b2 + hstep, voffB); PG8_STAGE(PG8_SA(0, 0), a2, voffA);
            PG8_WAIT_V(8); PG8_WAIT_L(0); PG8_BAR; PG8_MMA(1, 0, At, B0); PG8_MMA(1, 1, At, B1); PG8_BAR; PG8_SCHED;
            PG8_LDB(B0, 1, 0); PG8_LDB(B1, 1, 1); PG8_SCHED; PG8_LDA(At, 1, 0); PG8_STAGE(PG8_SA(0, 1), a2 + hstep, voffA);
            PG8_WAIT_V(8); PG8_WAIT_L(0); PG8_BAR; PG8_MMA(0, 0, At, B0); PG8_MMA(0, 1, At, B1); PG8_BAR; PG8_SCHED;
            PG8_LDA(At, 1, 1); PG8_STAGE(PG8_SB(1, 0), b3, voffB); PG8_STAGE(PG8_SB(1, 1), b3 + hstep, voffB); PG8_STAGE(PG8_SA(1, 0), a3, voffA);
            PG8_WAIT_V(8); PG8_WAIT_L(0); PG8_BAR; PG8_MMA(1, 0, At, B0); PG8_MMA(1, 1, At, B1); PG8_BAR; PG8_SCHED;
            } else {
            PG8_LDB(B0, 0, 0); PG8_SCHED; PG8_LDA(At, 0, 0); PG8_STAGE(PG8_SA(1, 1), a1 + hstep, voffA);
            PG8_WAIT_L(8); PG8_BAR; PG8_WAIT_L(0); PG8_MMA(0, 0, At, B0); PG8_BAR; PG8_SCHED;
            PG8_LDB(B1, 0, 1); PG8_STAGE(PG8_SB(0, 0), b2, voffB);
            PG8_BAR; PG8_WAIT_L(0); PG8_MMA(0, 1, At, B1); PG8_BAR;
            PG8_LDA(At, 0, 1); PG8_STAGE(PG8_SA(0, 0), a2, voffA);
            PG8_BAR; PG8_WAIT_L(0); PG8_MMA(1, 0, At, B0); PG8_BAR; PG8_SCHED;
            PG8_STAGE(PG8_SB(0, 1), b2 + hstep, voffB);
            PG8_WAIT_V(6); PG8_BAR; PG8_MMA(1, 1, At, B1); PG8_BAR;
            PG8_LDB(B0, 1, 0); PG8_SCHED; PG8_LDA(At, 1, 0); PG8_STAGE(PG8_SA(0, 1), a2 + hstep, voffA);
            PG8_WAIT_L(8); PG8_BAR; PG8_WAIT_L(0); PG8_MMA(0, 0, At, B0); PG8_BAR; PG8_SCHED;
            PG8_LDB(B1, 1, 1); PG8_STAGE(PG8_SB(1, 0), b3, voffB);
            PG8_BAR; PG8_WAIT_L(0); PG8_MMA(0, 1, At, B1); PG8_BAR;
            PG8_LDA(At, 1, 1); PG8_STAGE(PG8_SA(1, 0), a3, voffA);
            PG8_BAR; PG8_WAIT_L(0); PG8_MMA(1, 0, At, B0); PG8_BAR; PG8_SCHED;
            PG8_STAGE(PG8_SB(1, 1), b3 + hstep, voffB);
            PG8_WAIT_V(6); PG8_BAR; PG8_MMA(1, 1, At, B1); PG8_BAR;
            }
        }
        if constexpr (ALIGN_EPI) { if (wr == 0) PG8_BAR; }
        if constexpr (F8) asm volatile("s_nop 15\n\ts_nop 15" ::: "memory");
        if constexpr (!Epi::AFTER_DRAIN) { E(acc, cur, wr, wc, fr, fq); S.done(cur); }
        if (!has_next) break;
#pragma unroll
        for (int a = 0; a < 2; ++a)
#pragma unroll
            for (int b = 0; b < 2; ++b)
#pragma unroll
                for (int m = 0; m < 4; ++m)
#pragma unroll
                    for (int n = 0; n < 2; ++n) acc[a][b][m][n] = (f32x4){0.f, 0.f, 0.f, 0.f};
        cur = nxt; cA = nA; cB = nB; ++ui;
        if constexpr (ALIGN_EPI) { if (wr == 1) PG8_BAR; }
    }
    PG8_WAIT_V(0);
    if constexpr (!ALIGN_EPI) { if (wr == 0) PG8_BAR; }
    PG8_BAR;
    if constexpr (Epi::AFTER_DRAIN) { E.fused(acc, cur, wr, wc, fr, fq, lds, wid, lane); S.done(cur); }
#undef PG8_SA
#undef PG8_SB
#undef PG8_STAGE
#undef PG8_LDA
#undef PG8_LDB
#undef PG8_MMA
#undef PG8_WAIT_V
#undef PG8_WAIT_L
#undef PG8_BAR
#undef PG8_SCHED
}
}
namespace att {
#define ALAS __attribute__((address_space(3)))
using bf16 = unsigned short;
using bf16x8 = __attribute__((ext_vector_type(8))) short;
using s16x4 = __attribute__((ext_vector_type(4))) short;
using f32x16 = __attribute__((ext_vector_type(16))) float;
using u32x4 = __attribute__((ext_vector_type(4))) unsigned;
typedef short v4i16_t __attribute__((ext_vector_type(4)));
typedef float f32x2_t __attribute__((ext_vector_type(2))); typedef __bf16 bf16x2_t __attribute__((ext_vector_type(2)));
constexpr int SEQ = 8192;
constexpr int KSLOT_MAX = 12288, VSLOT = 8192;
constexpr int L_K = 0, L_V = 3 * KSLOT_MAX, L_WS = L_V + 2 * VSLOT, L_OST = L_WS + 8 * 256, L_BIAS = L_OST + 8 * 4096, L_END = L_BIAS + 1280;
constexpr float LOG2E = 1.4426950408889634f;
struct Args { const bf16* Q; const bf16* KN; const bf16* KR; const bf16* V; const bf16* QB; const bf16* KB; const bf16* VB; bf16* AO; const float* bias; int f8; const unsigned char* Q8; const unsigned char* KN8; const unsigned char* KR8; const unsigned char* ZERO; int qk8; const unsigned char* QB8; const unsigned char* KB8; };

__device__ __forceinline__ int crow(int r, int hi) { return (r & 3) + 8 * (r >> 2) + 4 * hi; }
__device__ __forceinline__ void glds16(const void* gsrc, unsigned lds_dst) { unsigned keep;
    asm volatile("s_mov_b32 %0, m0\n\ts_mov_b32 m0, %2\n\ts_nop 0\n\tglobal_load_lds_dwordx4 %1, off\n\ts_mov_b32 m0, %0" : "=&s"(keep) : "v"(gsrc), "s"(lds_dst) : "memory"); }
__device__ __forceinline__ unsigned cvtpk(float lo, float hi) { f32x2_t v = {lo, hi}; bf16x2_t b = __builtin_convertvector(v, bf16x2_t); return __builtin_bit_cast(unsigned, b); }
__device__ __forceinline__ s16x4 vtr(ALAS const char* p) { return __builtin_bit_cast(s16x4, __builtin_amdgcn_ds_read_tr16_b64_v4i16((ALAS v4i16_t*)p)); }
__device__ __forceinline__ float xhalf_max(float m) { auto rr = __builtin_amdgcn_permlane32_swap(__float_as_uint(m), __float_as_uint(m), false, false); return fmaxf(__uint_as_float(rr[0]), __uint_as_float(rr[1])); }
__device__ __forceinline__ float xhalf_sum(float m) { auto rr = __builtin_amdgcn_permlane32_swap(__float_as_uint(m), __float_as_uint(m), false, false); return __uint_as_float(rr[0]) + __uint_as_float(rr[1]); }
#define ATT_WAIT_BAR() asm volatile("s_waitcnt vmcnt(0) lgkmcnt(0)\n\ts_barrier" ::: "memory")
__device__ __forceinline__ float max3f(float a, float b, float c) { float r; asm volatile("v_max3_f32 %0, %1, %2, %3" : "=v"(r) : "v"(a), "v"(b), "v"(c)); return r; }
__device__ __forceinline__ float max2f(float a, float b) { float r; asm volatile("v_max_f32_e32 %0, %1, %2" : "=v"(r) : "v"(a), "v"(b)); return r; }
__device__ __forceinline__ float fadd_s(float a, float b) { float r; asm volatile("v_add_f32_e32 %0, %1, %2" : "=v"(r) : "v"(a), "v"(b)); return r; }

__device__ __forceinline__ void write_o(const Args& A, const f32x16& o0, const f32x16& o1, ALAS float* wsf, ALAS char* shm, int wid, int lane, int r32, int hi, long row0, int col0) {
    if (A.f8) {
        ALAS unsigned char* stg = (ALAS unsigned char*)(shm + L_OST) + wid * 4096;
#pragma unroll
        for (int r = 0; r < 16; ++r) { const int orow = crow(r, hi); const float rl = __builtin_amdgcn_rcpf(wsf[32 + orow]) * 8.0f;
            const int w = __builtin_amdgcn_cvt_pk_fp8_f32(__builtin_amdgcn_fmed3f(o0[r] * rl, -448.f, 448.f), __builtin_amdgcn_fmed3f(o1[r] * rl, -448.f, 448.f), 0, false);
            stg[orow * 64 + r32] = (unsigned char)(w & 0xff); stg[orow * 64 + 32 + r32] = (unsigned char)((w >> 8) & 0xff); }
        asm volatile("s_waitcnt lgkmcnt(0)" ::: "memory");
        unsigned char* Ow = (unsigned char*)A.AO + row0 * 1024 + col0;
#pragma unroll
        for (int i = 0; i < 2; ++i) { const int row = i * 16 + (lane >> 2), ch = lane & 3; const u32x4 v = *(ALAS const u32x4*)(stg + row * 64 + ch * 16); *(u32x4*)(Ow + (long)row * 1024 + ch * 16) = v; }
    } else {
        ALAS bf16* stg = (ALAS bf16*)(shm + L_OST) + wid * 2048;
#pragma unroll
        for (int r = 0; r < 16; ++r) { const int orow = crow(r, hi); const float rl = __builtin_amdgcn_rcpf(wsf[32 + orow]);
            stg[orow * 64 + r32] = (bf16)(cvtpk(o0[r] * rl, 0.f) & 0xffffu); stg[orow * 64 + 32 + r32] = (bf16)(cvtpk(o1[r] * rl, 0.f) & 0xffffu); }
        asm volatile("s_waitcnt lgkmcnt(0)" ::: "memory");
        bf16* Ow = A.AO + row0 * 1024 + col0;
#pragma unroll
        for (int i = 0; i < 4; ++i) { const int row = i * 8 + (lane >> 3), ch = lane & 7; const u32x4 v = *(ALAS const u32x4*)(stg + row * 64 + ch * 8); *(u32x4*)(Ow + (long)row * 1024 + ch * 8) = v; }
    }
}

template <bool CHUNK>
__device__ __forceinline__ void attn_unit(const Args& A, int b, int h, int qb, ALAS char* shm, const int tidb) {
    constexpr int NDK = CHUNK ? 4 : 6, KSLOT = NDK * 2048;
    constexpr float THR = 8.0f;
    int tid_l; asm volatile("v_mbcnt_lo_u32_b32 %0, -1, 0\n\tv_mbcnt_hi_u32_b32 %0, -1, %0" : "=v"(tid_l)); tid_l += tidb;
    const int tid = tid_l, lane = tid & 63, r32 = lane & 31, hi = lane >> 5;
    const int wid = __builtin_amdgcn_readfirstlane(tid >> 6);
    const long rowbase = (long)b * SEQ; const int q0 = qb * 256;
    const unsigned lds0 = (unsigned)(size_t)shm;
    ALAS float* wsf = (ALAS float*)(shm + L_WS) + wid * 64;
    ALAS float* bt = (ALAS float*)(shm + L_BIAS);
    const bf16* ksrc = (CHUNK ? A.KB : A.KN) + (rowbase + lane) * 512 + h * 64 + wid * 8;
    const bf16* krsrc = A.KR + (rowbase + lane) * 32 + (wid & 3) * 8;
    const bf16* vsrc = (CHUNK ? A.VB : A.V) + (rowbase + 16 * (wid & 3) + (lane >> 2)) * 512 + h * 64 + (wid >> 2) * 32 + (lane & 3) * 8;
    const unsigned kdst = lds0 + L_K + wid * 1024, krdst = lds0 + L_K + (8 + (wid & 3)) * 1024, vdst = lds0 + L_V + wid * 1024;
#define ATT_ISSUE_K(t, s) do { glds16(ksrc + (long)(t) * 64 * 512, (unsigned)__builtin_amdgcn_readfirstlane(kdst + (s) * KSLOT)); \
        if (!CHUNK && wid < 4) glds16(krsrc + (long)(t) * 64 * 32, (unsigned)__builtin_amdgcn_readfirstlane(krdst + (s) * KSLOT)); } while (0)
#define ATT_ISSUE_V(t, s) glds16(vsrc + (long)(t) * 64 * 512, (unsigned)__builtin_amdgcn_readfirstlane(vdst + (s) * VSLOT))
    const int t_end = 4 * qb + 4, t_begin = CHUNK ? (4 * qb - 8 > 0 ? 4 * qb - 8 : 0) : 0;
    const int cw = 4 * qb + (wid >> 1);
    const int vis_lo = CHUNK ? (cw - 8 > 0 ? cw - 8 : 0) : 0;
    if (CHUNK) { if (tid < 257) bt[tid] = A.bias[h * 257 + tid] * LOG2E; }
    ATT_ISSUE_K(t_begin, 0); ATT_ISSUE_V(t_begin, 0); ATT_ISSUE_K(t_begin + 1, 1);
    const bf16* Qw = CHUNK ? A.QB + (rowbase + q0 + wid * 32 + r32) * 512 + h * 64 + hi * 8 : A.Q + (rowbase + q0 + wid * 32 + r32) * 768 + h * 96 + hi * 8;
    bf16x8 qr[NDK];
#pragma unroll
    for (int d0 = 0; d0 < NDK; ++d0) qr[d0] = *(const bf16x8*)(Qw + d0 * 16);
    float mhat = 0.f, lsum = 0.f; f32x16 o0 = {}, o1 = {}; bool first = true;
    const int vbo = ((lane >> 4) & 1) * 32 + (lane & 3) * 8 + (4 * hi + ((lane & 15) >> 2)) * 64;
    ALAS const char* Kfr = shm + L_K + hi * 1024 + r32 * 16;
#define ATT_QK(C0, C1, t, slot) do { float cinit = -mhat; if (CHUNK) { if ((t) < cw - 2) cinit += bt[256]; } \
        _Pragma("unroll") for (int r = 0; r < 16; ++r) { C0[r] = cinit; C1[r] = cinit; } \
        ALAS const char* Ks_ = Kfr + (slot) * KSLOT; \
        _Pragma("unroll") for (int d0 = 0; d0 < NDK; ++d0) { const bf16x8 a0 = *(ALAS const bf16x8*)(Ks_ + d0 * 2048), a1 = *(ALAS const bf16x8*)(Ks_ + d0 * 2048 + 512); \
            C0 = __builtin_amdgcn_mfma_f32_32x32x16_bf16(a0, qr[d0], C0, 0, 0, 0); C1 = __builtin_amdgcn_mfma_f32_32x32x16_bf16(a1, qr[d0], C1, 0, 0, 0); } } while (0)
    ATT_WAIT_BAR();
    f32x16 c0, c1;
    if (t_begin >= vis_lo) ATT_QK(c0, c1, t_begin, 0);
    int ks = 0, vs = 0;
    for (int t = t_begin; t < t_end; ++t) {
        const int ks1 = ks == 2 ? 0 : ks + 1, ks2 = ks1 == 2 ? 0 : ks1 + 1;
        if (t + 2 < t_end) ATT_ISSUE_K(t + 2, ks2);
        if (t + 1 < t_end) ATT_ISSUE_V(t + 1, vs ^ 1);
        const bool vis = (t >= vis_lo && t <= cw), visn = (t + 1 >= vis_lo && t + 1 <= cw);
        if (vis) {
            if (CHUNK) { if (t >= cw - 2) {
                const int dq = 64 * (cw - t) + 32 * (wid & 1) + r32 + 128;
#pragma unroll
                for (int r = 0; r < 16; ++r) { int i0 = dq - crow(r, hi), i1 = i0 - 32; i0 = i0 < 0 ? 0 : (i0 > 256 ? 256 : i0); i1 = i1 < 0 ? 0 : (i1 > 256 ? 256 : i1); c0[r] += bt[i0]; c1[r] += bt[i1]; }
            } }
            float rmp[4];
#pragma unroll
            for (int j = 0; j < 4; ++j) rmp[j] = fmaxf(fmaxf(c0[j], c1[j]), fmaxf(c0[4 + j], c1[4 + j]));
#pragma unroll
            for (int j = 0; j < 4; ++j) rmp[j] = fmaxf(rmp[j], fmaxf(fmaxf(c0[8 + j], c1[8 + j]), fmaxf(c0[12 + j], c1[12 + j])));
            float rm = xhalf_max(fmaxf(fmaxf(rmp[0], rmp[1]), fmaxf(rmp[2], rmp[3])));
            if (first) { first = false; mhat = rm;
#pragma unroll
                for (int r = 0; r < 16; ++r) { c0[r] -= rm; c1[r] -= rm; }
            } else if (__any(rm > THR)) {
                const float dl = fmaxf(rm, 0.f); mhat += dl;
#pragma unroll
                for (int r = 0; r < 16; ++r) { c0[r] -= dl; c1[r] -= dl; }
                const float f = __builtin_amdgcn_exp2f(-dl); lsum *= f;
                if (hi == 0) wsf[r32] = f;
                asm volatile("s_waitcnt lgkmcnt(0)" ::: "memory");
#pragma unroll
                for (int r = 0; r < 16; ++r) { const float fr_ = wsf[crow(r, hi)]; o0[r] *= fr_; o1[r] *= fr_; }
            }
        }
        f32x16 n0, n1;
        if (vis && visn) {
            ALAS const char* Ks_ = Kfr + ks1 * KSLOT;
            bf16x8 ka = *(ALAS const bf16x8*)(Ks_), kb = *(ALAS const bf16x8*)(Ks_ + 512);
            float cinit = -mhat; if (CHUNK) { if (t + 1 < cw - 2) cinit += bt[256]; }
#pragma unroll
            for (int r = 0; r < 16; ++r) { n0[r] = cinit; n1[r] = cinit; }
            __builtin_amdgcn_sched_barrier(0);
            constexpr int NM = 2 * NDK;
#pragma unroll
            for (int d0 = 0; d0 < NDK; ++d0) {
                bf16x8 na = ka, nb = kb;
                if (d0 + 1 < NDK) { na = *(ALAS const bf16x8*)(Ks_ + (d0 + 1) * 2048); nb = *(ALAS const bf16x8*)(Ks_ + (d0 + 1) * 2048 + 512); }
                n0 = __builtin_amdgcn_mfma_f32_32x32x16_bf16(ka, qr[d0], n0, 0, 0, 0);
#pragma unroll
                for (int e = 0; e < 32; ++e) if (e * NM / 32 == 2 * d0) { if (e < 16) c0[e] = __builtin_amdgcn_exp2f(c0[e]); else c1[e - 16] = __builtin_amdgcn_exp2f(c1[e - 16]); }
                __builtin_amdgcn_sched_barrier(0);
                n1 = __builtin_amdgcn_mfma_f32_32x32x16_bf16(kb, qr[d0], n1, 0, 0, 0);
#pragma unroll
                for (int e = 0; e < 32; ++e) if (e * NM / 32 == 2 * d0 + 1) { if (e < 16) c0[e] = __builtin_amdgcn_exp2f(c0[e]); else c1[e - 16] = __builtin_amdgcn_exp2f(c1[e - 16]); }
                __builtin_amdgcn_sched_barrier(0);
                ka = na; kb = nb;
            }
            ALAS const char* vb = shm + L_V + vs * VSLOT + vbo;
            s16x4 vl[8], vh[8];
#pragma unroll
            for (int kk = 0; kk < 4; ++kk) { vl[kk] = vtr(vb + kk * 1024); vh[kk] = vtr(vb + kk * 1024 + 512); vl[4 + kk] = vtr(vb + 4096 + kk * 1024); vh[4 + kk] = vtr(vb + 4096 + kk * 1024 + 512); }
            float sacc4[4];
#pragma unroll
            for (int kk = 0; kk < 4; ++kk) {
                u32x4 pw;
                if (kk < 2) { pw = (u32x4){cvtpk(c0[8 * kk], c0[8 * kk + 1]), cvtpk(c0[8 * kk + 2], c0[8 * kk + 3]), cvtpk(c0[8 * kk + 4], c0[8 * kk + 5]), cvtpk(c0[8 * kk + 6], c0[8 * kk + 7])};
                    sacc4[kk] = ((c0[8 * kk] + c0[8 * kk + 1]) + (c0[8 * kk + 2] + c0[8 * kk + 3])) + ((c0[8 * kk + 4] + c0[8 * kk + 5]) + (c0[8 * kk + 6] + c0[8 * kk + 7])); }
                else { const int k2 = kk - 2; pw = (u32x4){cvtpk(c1[8 * k2], c1[8 * k2 + 1]), cvtpk(c1[8 * k2 + 2], c1[8 * k2 + 3]), cvtpk(c1[8 * k2 + 4], c1[8 * k2 + 5]), cvtpk(c1[8 * k2 + 6], c1[8 * k2 + 7])};
                    sacc4[kk] = ((c1[8 * k2] + c1[8 * k2 + 1]) + (c1[8 * k2 + 2] + c1[8 * k2 + 3])) + ((c1[8 * k2 + 4] + c1[8 * k2 + 5]) + (c1[8 * k2 + 6] + c1[8 * k2 + 7])); }
                const bf16x8 v0 = (bf16x8){vl[kk][0], vl[kk][1], vl[kk][2], vl[kk][3], vh[kk][0], vh[kk][1], vh[kk][2], vh[kk][3]}, v1 = (bf16x8){vl[4 + kk][0], vl[4 + kk][1], vl[4 + kk][2], vl[4 + kk][3], vh[4 + kk][0], vh[4 + kk][1], vh[4 + kk][2], vh[4 + kk][3]};
                o0 = __builtin_amdgcn_mfma_f32_32x32x16_bf16(__builtin_bit_cast(bf16x8, pw), v0, o0, 0, 0, 0);
                o1 = __builtin_amdgcn_mfma_f32_32x32x16_bf16(__builtin_bit_cast(bf16x8, pw), v1, o1, 0, 0, 0);
                __builtin_amdgcn_sched_barrier(0);
            }
            lsum += (sacc4[0] + sacc4[1]) + (sacc4[2] + sacc4[3]);
        } else {
        if (visn) ATT_QK(n0, n1, t + 1, ks1);
        if (vis) {
            float sacc = 0.f;
#pragma unroll
            for (int r = 0; r < 16; ++r) { c0[r] = __builtin_amdgcn_exp2f(c0[r]); c1[r] = __builtin_amdgcn_exp2f(c1[r]); sacc += c0[r] + c1[r]; }
            lsum += sacc;
            u32x4 pw[4];
#pragma unroll
            for (int k = 0; k < 2; ++k) {
                pw[k]     = (u32x4){cvtpk(c0[8 * k], c0[8 * k + 1]), cvtpk(c0[8 * k + 2], c0[8 * k + 3]), cvtpk(c0[8 * k + 4], c0[8 * k + 5]), cvtpk(c0[8 * k + 6], c0[8 * k + 7])};
                pw[2 + k] = (u32x4){cvtpk(c1[8 * k], c1[8 * k + 1]), cvtpk(c1[8 * k + 2], c1[8 * k + 3]), cvtpk(c1[8 * k + 4], c1[8 * k + 5]), cvtpk(c1[8 * k + 6], c1[8 * k + 7])};
            }
            ALAS const char* vb = shm + L_V + vs * VSLOT + vbo;
#pragma unroll
            for (int kk = 0; kk < 4; ++kk) {
                const s16x4 l0 = vtr(vb + kk * 1024), h0 = vtr(vb + kk * 1024 + 512), l1 = vtr(vb + 4096 + kk * 1024), h1 = vtr(vb + 4096 + kk * 1024 + 512);
                const bf16x8 v0 = (bf16x8){l0[0], l0[1], l0[2], l0[3], h0[0], h0[1], h0[2], h0[3]}, v1 = (bf16x8){l1[0], l1[1], l1[2], l1[3], h1[0], h1[1], h1[2], h1[3]};
                o0 = __builtin_amdgcn_mfma_f32_32x32x16_bf16(__builtin_bit_cast(bf16x8, pw[kk]), v0, o0, 0, 0, 0);
                o1 = __builtin_amdgcn_mfma_f32_32x32x16_bf16(__builtin_bit_cast(bf16x8, pw[kk]), v1, o1, 0, 0, 0);
            }
        }
        }
        if (visn) { c0 = n0; c1 = n1; }
        ks = ks1; vs ^= 1;
        ATT_WAIT_BAR();
    }
    const float lt = xhalf_sum(lsum);
    if (hi == 0) wsf[32 + r32] = lt;
    asm volatile("s_waitcnt lgkmcnt(0)" ::: "memory");
    write_o(A, o0, o1, wsf, shm, wid, lane, r32, hi, rowbase + q0 + wid * 32, (CHUNK ? 512 : 0) + h * 64);
    asm volatile("s_waitcnt lgkmcnt(0)\n\ts_barrier" ::: "memory");
#undef ATT_ISSUE_K
#undef ATT_ISSUE_V
#undef ATT_QK
}

__device__ __forceinline__ bool mla_unit_fast(const Args& A, int b, int h, int qb, ALAS char* shm, const int tidb) {
    constexpr int NDK = 6, KSLOT = NDK * 2048;
    constexpr float THR = 8.0f;
    int tid_l; asm volatile("v_mbcnt_lo_u32_b32 %0, -1, 0\n\tv_mbcnt_hi_u32_b32 %0, -1, %0" : "=v"(tid_l)); tid_l += tidb;
    const int tid = tid_l, lane = tid & 63, r32 = lane & 31, hi = lane >> 5;
    const int wid = __builtin_amdgcn_readfirstlane(tid >> 6);
    const long rowbase = (long)b * SEQ; const int q0 = qb * 256;
    const unsigned lds0 = (unsigned)(size_t)shm;
    ALAS float* wsf = (ALAS float*)(shm + L_WS) + wid * 64;
    ALAS int* bailw = (ALAS int*)(shm + L_BIAS);
    const bf16* ksrc = A.KN + (rowbase + lane) * 512 + h * 64 + wid * 8;
    const bf16* krsrc = A.KR + (rowbase + lane) * 32 + (wid & 3) * 8;
    const bf16* vsrc = A.V + (rowbase + 16 * (wid & 3) + (lane >> 2)) * 512 + h * 64 + (wid >> 2) * 32 + (lane & 3) * 8;
    const unsigned kdst = lds0 + L_K + wid * 1024, krdst = lds0 + L_K + (8 + (wid & 3)) * 1024, vdst = lds0 + L_V + wid * 1024;
#define MF_ISSUE_K(t, s) do { glds16(ksrc + (long)(t) * 64 * 512, (unsigned)__builtin_amdgcn_readfirstlane(kdst + (s) * KSLOT)); \
        if (wid < 4) glds16(krsrc + (long)(t) * 64 * 32, (unsigned)__builtin_amdgcn_readfirstlane(krdst + (s) * KSLOT)); } while (0)
#define MF_ISSUE_V(t, s) glds16(vsrc + (long)(t) * 64 * 512, (unsigned)__builtin_amdgcn_readfirstlane(vdst + (s) * VSLOT))
    const int t_end = 4 * qb + 4;
    const int cw = 4 * qb + (wid >> 1);
    if (tid == 0) bailw[0] = 0;
    MF_ISSUE_K(0, 0); MF_ISSUE_V(0, 0); MF_ISSUE_K(1, 1);
    const bf16* Qw = A.Q + (rowbase + q0 + wid * 32 + r32) * 768 + h * 96 + hi * 8;
    bf16x8 qr[NDK];
#pragma unroll
    for (int d0 = 0; d0 < NDK; ++d0) qr[d0] = *(const bf16x8*)(Qw + d0 * 16);
    float lsum = 0.f; f32x16 o0 = {}, o1 = {};
    const int vbo = ((lane >> 4) & 1) * 32 + (lane & 3) * 8 + (4 * hi + ((lane & 15) >> 2)) * 64;
    ALAS const char* Kfr = shm + L_K + hi * 1024 + r32 * 16;
#define MF_ROWMAX(C0, C1) ({ float rmp_[4]; _Pragma("unroll") for (int j = 0; j < 4; ++j) { rmp_[j] = max3f(C0[j], C1[j], C0[4 + j]); rmp_[j] = max3f(rmp_[j], C1[4 + j], C0[8 + j]); rmp_[j] = max3f(rmp_[j], C1[8 + j], C0[12 + j]); rmp_[j] = max2f(rmp_[j], C1[12 + j]); } \
        xhalf_max(max2f(max3f(rmp_[0], rmp_[1], rmp_[2]), rmp_[3])); })
    ATT_WAIT_BAR();
    f32x16 cs[2][2];
    { f32x16 z0 = {}, z1 = {}; ALAS const char* Ks_ = Kfr;
#pragma unroll
      for (int d0 = 0; d0 < NDK; ++d0) { const bf16x8 a0 = *(ALAS const bf16x8*)(Ks_ + d0 * 2048), a1 = *(ALAS const bf16x8*)(Ks_ + d0 * 2048 + 512);
          z0 = __builtin_amdgcn_mfma_f32_32x32x16_bf16(a0, qr[d0], z0, 0, 0, 0); z1 = __builtin_amdgcn_mfma_f32_32x32x16_bf16(a1, qr[d0], z1, 0, 0, 0); }
      asm volatile("s_nop 15\n\ts_nop 7" : "+v"(z0), "+v"(z1));
      cs[0][0] = z0; cs[0][1] = z1; }
    const float mhat = MF_ROWMAX(cs[0][0], cs[0][1]);
#pragma unroll
    for (int r = 0; r < 16; ++r) { cs[0][0][r] -= mhat; cs[0][1][r] -= mhat; }
    f32x16 negm;
#pragma unroll
    for (int r = 0; r < 16; ++r) negm[r] = -mhat;
    bool bailed = false; int ks = 0, vs = 0;
    for (int t2 = 0; t2 < t_end; t2 += 2) {
#pragma unroll
        for (int p = 0; p < 2; ++p) {
            const int t = t2 + p; f32x16 &C0 = cs[p][0], &C1 = cs[p][1], &N0 = cs[p ^ 1][0], &N1 = cs[p ^ 1][1];
            const bool vis = !bailed && t <= cw;
            const int ks1 = ks == 2 ? 0 : ks + 1, ks2 = ks1 == 2 ? 0 : ks1 + 1;
            if (t + 2 < t_end) MF_ISSUE_K(t + 2, ks2);
            if (t + 1 < t_end) MF_ISSUE_V(t + 1, vs ^ 1);
            if (vis) {
                {
                    ALAS const char* Ks_ = Kfr + ks1 * KSLOT;
                    bf16x8 ka = *(ALAS const bf16x8*)(Ks_), kb = *(ALAS const bf16x8*)(Ks_ + 512);
                    constexpr int NM = 2 * NDK;
#pragma unroll
                    for (int d0 = 0; d0 < NDK; ++d0) {
                        bf16x8 na = ka, nb = kb;
                        if (d0 + 1 < NDK) { na = *(ALAS const bf16x8*)(Ks_ + (d0 + 1) * 2048); nb = *(ALAS const bf16x8*)(Ks_ + (d0 + 1) * 2048 + 512); }
                        N0 = __builtin_amdgcn_mfma_f32_32x32x16_bf16(ka, qr[d0], d0 == 0 ? negm : N0, 0, 0, 0);
#pragma unroll
                        for (int e = 0; e < 32; ++e) if (e * NM / 32 == 2 * d0) { if (e < 16) C0[e] = __builtin_amdgcn_exp2f(C0[e]); else C1[e - 16] = __builtin_amdgcn_exp2f(C1[e - 16]); }
                        __builtin_amdgcn_sched_barrier(0);
                        N1 = __builtin_amdgcn_mfma_f32_32x32x16_bf16(kb, qr[d0], d0 == 0 ? negm : N1, 0, 0, 0);
#pragma unroll
                        for (int e = 0; e < 32; ++e) if (e * NM / 32 == 2 * d0 + 1) { if (e < 16) C0[e] = __builtin_amdgcn_exp2f(C0[e]); else C1[e - 16] = __builtin_amdgcn_exp2f(C1[e - 16]); }
                        __builtin_amdgcn_sched_barrier(0);
                        ka = na; kb = nb;
                    }
                }
                ALAS const char* vb_ = shm + L_V + vs * VSLOT + vbo; s16x4 vl_[8], vh_[8];
#pragma unroll
                for (int kk = 0; kk < 4; ++kk) { vl_[kk] = vtr(vb_ + kk * 1024); vh_[kk] = vtr(vb_ + kk * 1024 + 512); vl_[4 + kk] = vtr(vb_ + 4096 + kk * 1024); vh_[4 + kk] = vtr(vb_ + 4096 + kk * 1024 + 512); }
                float sa_[4];
#pragma unroll
                for (int kk = 0; kk < 4; ++kk) { const f32x16& cc_ = (kk < 2) ? C0 : C1; const int k8_ = 8 * (kk & 1);
                    const u32x4 pw_ = (u32x4){cvtpk(cc_[k8_], cc_[k8_ + 1]), cvtpk(cc_[k8_ + 2], cc_[k8_ + 3]), cvtpk(cc_[k8_ + 4], cc_[k8_ + 5]), cvtpk(cc_[k8_ + 6], cc_[k8_ + 7])};
                    sa_[kk] = fadd_s(fadd_s(fadd_s(cc_[k8_], cc_[k8_ + 1]), fadd_s(cc_[k8_ + 2], cc_[k8_ + 3])), fadd_s(fadd_s(cc_[k8_ + 4], cc_[k8_ + 5]), fadd_s(cc_[k8_ + 6], cc_[k8_ + 7])));
                    const bf16x8 v0_ = (bf16x8){vl_[kk][0], vl_[kk][1], vl_[kk][2], vl_[kk][3], vh_[kk][0], vh_[kk][1], vh_[kk][2], vh_[kk][3]}, v1_ = (bf16x8){vl_[4 + kk][0], vl_[4 + kk][1], vl_[4 + kk][2], vl_[4 + kk][3], vh_[4 + kk][0], vh_[4 + kk][1], vh_[4 + kk][2], vh_[4 + kk][3]};
                    o0 = __builtin_amdgcn_mfma_f32_32x32x16_bf16(__builtin_bit_cast(bf16x8, pw_), v0_, o0, 0, 0, 0); o1 = __builtin_amdgcn_mfma_f32_32x32x16_bf16(__builtin_bit_cast(bf16x8, pw_), v1_, o1, 0, 0, 0);
                    __builtin_amdgcn_sched_barrier(0); }
                lsum = fadd_s(lsum, fadd_s(fadd_s(sa_[0], sa_[1]), fadd_s(sa_[2], sa_[3])));
            }
            ks = ks1; vs ^= 1;
            ATT_WAIT_BAR();
        }
    }
    const float lt = xhalf_sum(lsum);
    if (__any(!(lt > 1.0e-30f && lt < 1.0e30f))) bailed = true;
    if (bailed && lane == 0) bailw[0] = 1;
    if (hi == 0) wsf[32 + r32] = lt;
    asm volatile("s_waitcnt lgkmcnt(0)" ::: "memory");
    write_o(A, o0, o1, wsf, shm, wid, lane, r32, hi, rowbase + q0 + wid * 32, h * 64);
    asm volatile("s_waitcnt lgkmcnt(0)\n\ts_barrier" ::: "memory");
    const int redo = __builtin_amdgcn_readfirstlane(bailw[0]);
    asm volatile("s_waitcnt lgkmcnt(0)\n\ts_barrier" ::: "memory");
    return redo != 0;
#undef MF_ISSUE_K
#undef MF_ISSUE_V
#undef MF_ROWMAX
}
typedef int v8i __attribute__((ext_vector_type(8)));
__device__ __forceinline__ void mfma8_new(f32x16& d, const v8i& ka, const v8i& qb, const f32x16& c, int sa, int sb) {
    asm volatile("v_mfma_scale_f32_32x32x64_f8f6f4 %0, %1, %2, %3, %4, %5 op_sel_hi:[0,0,0]" : "=&v"(d) : "v"(ka), "v"(qb), "v"(c), "v"(sa), "v"(sb)); }
__device__ __forceinline__ void mfma8_acc(f32x16& d, const v8i& ka, const v8i& qb, int sa, int sb) {
    asm volatile("v_mfma_scale_f32_32x32x64_f8f6f4 %0, %1, %2, %0, %3, %4 op_sel_hi:[0,0,0]" : "+v"(d) : "v"(ka), "v"(qb), "v"(sa), "v"(sb)); }
__device__ __forceinline__ bool mla_unit_fast8(const Args& A, int b, int h, int qb, ALAS char* shm, const int tidb) {
    constexpr int KSLOT = 8192;
    constexpr float THR = 8.0f;
    int tid_l; asm volatile("v_mbcnt_lo_u32_b32 %0, -1, 0\n\tv_mbcnt_hi_u32_b32 %0, -1, %0" : "=v"(tid_l)); tid_l += tidb;
    const int tid = tid_l, lane = tid & 63, r32 = lane & 31, hi = lane >> 5;
    const int wid = __builtin_amdgcn_readfirstlane(tid >> 6);
    const long rowbase = (long)b * SEQ; const int q0 = qb * 256;
    const unsigned lds0 = (unsigned)(size_t)shm;
    ALAS float* wsf = (ALAS float*)(shm + L_WS) + wid * 64;
    ALAS int* bailw = (ALAS int*)(shm + L_BIAS);
    const int m_ = wid >> 2, kh_ = (wid >> 1) & 1, j_ = wid & 1;
    const long krow_ = rowbase + 32 * kh_ + r32;
    const unsigned char* ks8 = m_ == 0 ? A.KN8 + krow_ * 512 + h * 64 + 32 * hi + 16 * j_ : (hi == 0 ? A.KR8 + krow_ * 32 + 16 * j_ : A.ZERO + r32 * 16);
    const long kst8 = m_ == 0 ? 64 * 512 : (hi == 0 ? 64 * 32 : 0);
    const bf16* vsrc = A.V + (rowbase + 16 * (wid & 3) + (lane >> 2)) * 512 + h * 64 + (wid >> 2) * 32 + (lane & 3) * 8;
    const unsigned kdst = lds0 + L_K + wid * 1024, vdst = lds0 + L_V + wid * 1024;
#define MF_ISSUE_K(t, s) glds16(ks8 + (long)(t) * kst8, (unsigned)__builtin_amdgcn_readfirstlane(kdst + (s) * KSLOT))
#define MF_ISSUE_V(t, s) glds16(vsrc + (long)(t) * 64 * 512, (unsigned)__builtin_amdgcn_readfirstlane(vdst + (s) * VSLOT))
    const int t_end = 4 * qb + 4;
    const int cw = 4 * qb + (wid >> 1);
    if (tid == 0) bailw[0] = 0;
    MF_ISSUE_K(0, 0); MF_ISSUE_V(0, 0); MF_ISSUE_K(1, 1);
    const unsigned char* Q8w = A.Q8 + (rowbase + q0 + wid * 32 + r32) * 768 + h * 96;
    const unsigned char* Q8r = hi == 0 ? Q8w + 64 : A.ZERO;
    v8i qf0, qf1;
    { const u32x4 a0 = *(const u32x4*)(Q8w + 32 * hi), a1 = *(const u32x4*)(Q8w + 32 * hi + 16), b0 = *(const u32x4*)(Q8r), b1 = *(const u32x4*)(Q8r + 16);
      qf0 = (v8i){(int)a0.x, (int)a0.y, (int)a0.z, (int)a0.w, (int)a1.x, (int)a1.y, (int)a1.z, (int)a1.w}; qf1 = (v8i){(int)b0.x, (int)b0.y, (int)b0.z, (int)b0.w, (int)b1.x, (int)b1.y, (int)b1.z, (int)b1.w}; }
    const int sa8 = 0x7c7c7c7c, sb8 = 0x7b7b7b7b;
    float lsum = 0.f; f32x16 o0 = {}, o1 = {};
    const int vbo = ((lane >> 4) & 1) * 32 + (lane & 3) * 8 + (4 * hi + ((lane & 15) >> 2)) * 64;
    ALAS const char* Kfr = shm + L_K + lane * 16;
#define M8_KFRAG(dst, base, m, kh) do { const u32x4 lo_ = *(ALAS const u32x4*)((base) + (((m) * 2 + (kh)) * 2) * 1024), hi_ = *(ALAS const u32x4*)((base) + (((m) * 2 + (kh)) * 2 + 1) * 1024); \
        dst = (v8i){(int)lo_.x, (int)lo_.y, (int)lo_.z, (int)lo_.w, (int)hi_.x, (int)hi_.y, (int)hi_.z, (int)hi_.w}; } while (0)
#define MF_ROWMAX(C0, C1) ({ float rmp_[4]; _Pragma("unroll") for (int j = 0; j < 4; ++j) { rmp_[j] = max3f(C0[j], C1[j], C0[4 + j]); rmp_[j] = max3f(rmp_[j], C1[4 + j], C0[8 + j]); rmp_[j] = max3f(rmp_[j], C1[8 + j], C0[12 + j]); rmp_[j] = max2f(rmp_[j], C1[12 + j]); } \
        xhalf_max(max2f(max3f(rmp_[0], rmp_[1], rmp_[2]), rmp_[3])); })
    ATT_WAIT_BAR();
    f32x16 cs[2][2];
    { f32x16 z0 = {}, z1 = {}; ALAS const char* Ks_ = Kfr;
      v8i k00, k01, k10, k11; M8_KFRAG(k00, Ks_, 0, 0); M8_KFRAG(k01, Ks_, 0, 1); M8_KFRAG(k10, Ks_, 1, 0); M8_KFRAG(k11, Ks_, 1, 1);
      mfma8_acc(z0, k00, qf0, sa8, sb8); mfma8_acc(z1, k01, qf0, sa8, sb8); mfma8_acc(z0, k10, qf1, sa8, sb8); mfma8_acc(z1, k11, qf1, sa8, sb8);
      asm volatile("s_nop 15\n\ts_nop 7" : "+v"(z0), "+v"(z1));
      cs[0][0] = z0; cs[0][1] = z1; }
    const float mhat = MF_ROWMAX(cs[0][0], cs[0][1]);
#pragma unroll
    for (int r = 0; r < 16; ++r) { cs[0][0][r] -= mhat; cs[0][1][r] -= mhat; }
    f32x16 negm;
#pragma unroll
    for (int r = 0; r < 16; ++r) negm[r] = -mhat;
    bool bailed = false; int ks = 0, vs = 0;
    for (int t2 = 0; t2 < t_end; t2 += 2) {
#pragma unroll
        for (int p = 0; p < 2; ++p) {
            const int t = t2 + p; f32x16 &C0 = cs[p][0], &C1 = cs[p][1], &N0 = cs[p ^ 1][0], &N1 = cs[p ^ 1][1];
            const bool vis = !bailed && t <= cw;
            const int ks1 = ks == 2 ? 0 : ks + 1, ks2 = ks1 == 2 ? 0 : ks1 + 1;
            if (t + 2 < t_end) MF_ISSUE_K(t + 2, ks2);
            if (t + 1 < t_end) MF_ISSUE_V(t + 1, vs ^ 1);
            if (vis) {
                {
                    ALAS const char* Ks_ = Kfr + ks1 * KSLOT;
                    v8i kfa, kfb; M8_KFRAG(kfa, Ks_, 0, 0);
                    M8_KFRAG(kfb, Ks_, 0, 1);
                    mfma8_new(N0, kfa, qf0, negm, sa8, sb8);
#pragma unroll
                    for (int e = 0; e < 8; ++e) C0[e] = __builtin_amdgcn_exp2f(C0[e]);
                    __builtin_amdgcn_sched_barrier(0);
                    M8_KFRAG(kfa, Ks_, 1, 0);
                    mfma8_new(N1, kfb, qf0, negm, sa8, sb8);
#pragma unroll
                    for (int e = 8; e < 16; ++e) C0[e] = __builtin_amdgcn_exp2f(C0[e]);
                    __builtin_amdgcn_sched_barrier(0);
                    M8_KFRAG(kfb, Ks_, 1, 1);
                    mfma8_acc(N0, kfa, qf1, sa8, sb8);
#pragma unroll
                    for (int e = 0; e < 8; ++e) C1[e] = __builtin_amdgcn_exp2f(C1[e]);
                    __builtin_amdgcn_sched_barrier(0);
                    mfma8_acc(N1, kfb, qf1, sa8, sb8);
#pragma unroll
                    for (int e = 8; e < 16; ++e) C1[e] = __builtin_amdgcn_exp2f(C1[e]);
                    __builtin_amdgcn_sched_barrier(0);
                }
                ALAS const char* vb_ = shm + L_V + vs * VSLOT + vbo; s16x4 vl_[8], vh_[8];
#pragma unroll
                for (int kk = 0; kk < 4; ++kk) { vl_[kk] = vtr(vb_ + kk * 1024); vh_[kk] = vtr(vb_ + kk * 1024 + 512); vl_[4 + kk] = vtr(vb_ + 4096 + kk * 1024); vh_[4 + kk] = vtr(vb_ + 4096 + kk * 1024 + 512); }
                float sa_[4];
#pragma unroll
                for (int kk = 0; kk < 4; ++kk) { const f32x16& cc_ = (kk < 2) ? C0 : C1; const int k8_ = 8 * (kk & 1);
                    const u32x4 pw_ = (u32x4){cvtpk(cc_[k8_], cc_[k8_ + 1]), cvtpk(cc_[k8_ + 2], cc_[k8_ + 3]), cvtpk(cc_[k8_ + 4], cc_[k8_ + 5]), cvtpk(cc_[k8_ + 6], cc_[k8_ + 7])};
                    sa_[kk] = fadd_s(fadd_s(fadd_s(cc_[k8_], cc_[k8_ + 1]), fadd_s(cc_[k8_ + 2], cc_[k8_ + 3])), fadd_s(fadd_s(cc_[k8_ + 4], cc_[k8_ + 5]), fadd_s(cc_[k8_ + 6], cc_[k8_ + 7])));
                    const bf16x8 v0_ = (bf16x8){vl_[kk][0], vl_[kk][1], vl_[kk][2], vl_[kk][3], vh_[kk][0], vh_[kk][1], vh_[kk][2], vh_[kk][3]}, v1_ = (bf16x8){vl_[4 + kk][0], vl_[4 + kk][1], vl_[4 + kk][2], vl_[4 + kk][3], vh_[4 + kk][0], vh_[4 + kk][1], vh_[4 + kk][2], vh_[4 + kk][3]};
                    o0 = __builtin_amdgcn_mfma_f32_32x32x16_bf16(__builtin_bit_cast(bf16x8, pw_), v0_, o0, 0, 0, 0); o1 = __builtin_amdgcn_mfma_f32_32x32x16_bf16(__builtin_bit_cast(bf16x8, pw_), v1_, o1, 0, 0, 0);
                    __builtin_amdgcn_sched_barrier(0); }
                lsum = fadd_s(lsum, fadd_s(fadd_s(sa_[0], sa_[1]), fadd_s(sa_[2], sa_[3])));
            }
            ks = ks1; vs ^= 1;
            ATT_WAIT_BAR();
        }
    }
    const float lt = xhalf_sum(lsum);
    if (__any(!(lt > 1.0e-30f && lt < 1.0e30f))) bailed = true;
    if (bailed && lane == 0) bailw[0] = 1;
    if (hi == 0) wsf[32 + r32] = lt;
    asm volatile("s_waitcnt lgkmcnt(0)" ::: "memory");
    write_o(A, o0, o1, wsf, shm, wid, lane, r32, hi, rowbase + q0 + wid * 32, h * 64);
    asm volatile("s_waitcnt lgkmcnt(0)\n\ts_barrier" ::: "memory");
    const int redo = __builtin_amdgcn_readfirstlane(bailw[0]);
    asm volatile("s_waitcnt lgkmcnt(0)\n\ts_barrier" ::: "memory");
    return redo != 0;
#undef MF_ISSUE_K
#undef MF_ISSUE_V
#undef MF_ROWMAX
#undef M8_KFRAG
}
__device__ __forceinline__ bool chunk_unit_fast(const Args& A, int b, int h, int qb, ALAS char* shm, const int tidb) {
    constexpr int NDK = 4, KSLOT = NDK * 2048;
    constexpr float THR = 8.0f;
    int tid_l; asm volatile("v_mbcnt_lo_u32_b32 %0, -1, 0\n\tv_mbcnt_hi_u32_b32 %0, -1, %0" : "=v"(tid_l)); tid_l += tidb;
    const int tid = tid_l, lane = tid & 63, r32 = lane & 31, hi = lane >> 5;
    const int wid = __builtin_amdgcn_readfirstlane(tid >> 6);
    const long rowbase = (long)b * SEQ; const int q0 = qb * 256;
    const unsigned lds0 = (unsigned)(size_t)shm;
    ALAS float* wsf = (ALAS float*)(shm + L_WS) + wid * 64;
    ALAS float* bt = (ALAS float*)(shm + L_BIAS);
    ALAS int* bailw = (ALAS int*)(shm + L_BIAS) + 300;
    const bf16* ksrc = A.KB + (rowbase + lane) * 512 + h * 64 + wid * 8;
    const bf16* vsrc = A.VB + (rowbase + 16 * (wid & 3) + (lane >> 2)) * 512 + h * 64 + (wid >> 2) * 32 + (lane & 3) * 8;
    const unsigned kdst = lds0 + L_K + wid * 1024, vdst = lds0 + L_V + wid * 1024;
#define CF_ISSUE_K(t, s) glds16(ksrc + (long)(t) * 64 * 512, (unsigned)__builtin_amdgcn_readfirstlane(kdst + (s) * KSLOT))
#define CF_ISSUE_V(t, s) glds16(vsrc + (long)(t) * 64 * 512, (unsigned)__builtin_amdgcn_readfirstlane(vdst + (s) * VSLOT))
    const int t_end = 4 * qb + 4, t_begin = 4 * qb - 8 > 0 ? 4 * qb - 8 : 0;
    const int cw = 4 * qb + (wid >> 1);
    const int vis_lo = cw - 8 > 0 ? cw - 8 : 0;
    if (tid == 0) bailw[0] = 0;
    if (tid < 257) bt[tid] = (A.bias[h * 257 + tid] - A.bias[h * 257 + 256]) * LOG2E;
    CF_ISSUE_K(t_begin, 0); CF_ISSUE_V(t_begin, 0); CF_ISSUE_K(t_begin + 1, 1);
    const bf16* Qw = A.QB + (rowbase + q0 + wid * 32 + r32) * 512 + h * 64 + hi * 8;
    bf16x8 qr[NDK];
#pragma unroll
    for (int d0 = 0; d0 < NDK; ++d0) qr[d0] = *(const bf16x8*)(Qw + d0 * 16);
    float lsum = 0.f; f32x16 o0 = {}, o1 = {};
    const int vbo = ((lane >> 4) & 1) * 32 + (lane & 3) * 8 + (4 * hi + ((lane & 15) >> 2)) * 64;
    ALAS const char* Kfr = shm + L_K + hi * 1024 + r32 * 16;
#define CF_ROWMAX(C0, C1) ({ float rmp_[4]; _Pragma("unroll") for (int j = 0; j < 4; ++j) { rmp_[j] = max3f(C0[j], C1[j], C0[4 + j]); rmp_[j] = max3f(rmp_[j], C1[4 + j], C0[8 + j]); rmp_[j] = max3f(rmp_[j], C1[8 + j], C0[12 + j]); rmp_[j] = max2f(rmp_[j], C1[12 + j]); } \
        xhalf_max(max2f(max3f(rmp_[0], rmp_[1], rmp_[2]), rmp_[3])); })
#define CF_BIAS(C0, C1, tt) do { const int dq_ = 64 * (cw - (tt)) + 32 * (wid & 1) + r32 + 128; \
        _Pragma("unroll") for (int r = 0; r < 16; ++r) { int i0 = dq_ - crow(r, hi), i1 = i0 - 32; i0 = i0 < 0 ? 0 : (i0 > 256 ? 256 : i0); i1 = i1 < 0 ? 0 : (i1 > 256 ? 256 : i1); C0[r] += bt[i0]; C1[r] += bt[i1]; } } while (0)
    f32x16 cs[2][2], negm;
    ATT_WAIT_BAR();
    { f32x16 z0 = {}, z1 = {};
#pragma unroll
      for (int d0 = 0; d0 < NDK; ++d0) { const bf16x8 a0 = *(ALAS const bf16x8*)(Kfr + d0 * 2048), a1 = *(ALAS const bf16x8*)(Kfr + d0 * 2048 + 512);
          z0 = __builtin_amdgcn_mfma_f32_32x32x16_bf16(a0, qr[d0], z0, 0, 0, 0); z1 = __builtin_amdgcn_mfma_f32_32x32x16_bf16(a1, qr[d0], z1, 0, 0, 0); }
      asm volatile("s_nop 15\n\ts_nop 7" : "+v"(z0), "+v"(z1));
      if (vis_lo == t_begin && t_begin >= cw - 2) CF_BIAS(z0, z1, t_begin);
      const float mhat = CF_ROWMAX(z0, z1);
#pragma unroll
      for (int r = 0; r < 16; ++r) { z0[r] -= mhat; z1[r] -= mhat; negm[r] = -mhat; }
      cs[0][0] = z0; cs[0][1] = z1; cs[1][0] = z0; cs[1][1] = z1; }
    bool bailed = false; int ks = 0, vs = 0;
    for (int t2 = t_begin; t2 < t_end; t2 += 2) {
#pragma unroll
        for (int p = 0; p < 2; ++p) {
            const int t = t2 + p; f32x16 &C0 = cs[p][0], &C1 = cs[p][1], &N0 = cs[p ^ 1][0], &N1 = cs[p ^ 1][1];
            if (t >= vis_lo && t > t_begin && t <= cw) { if (t >= cw - 2) CF_BIAS(C0, C1, t); }
            const bool vis = !bailed && t >= vis_lo && t <= cw;
            const int ks1 = ks == 2 ? 0 : ks + 1, ks2 = ks1 == 2 ? 0 : ks1 + 1;
            if (t + 2 < t_end) CF_ISSUE_K(t + 2, ks2);
            if (t + 1 < t_end) CF_ISSUE_V(t + 1, vs ^ 1);
            if (vis) {
                {
                    ALAS const char* Ks_ = Kfr + ks1 * KSLOT;
                    bf16x8 ka = *(ALAS const bf16x8*)(Ks_), kb = *(ALAS const bf16x8*)(Ks_ + 512);
                    constexpr int NM = 2 * NDK;
#pragma unroll
                    for (int d0 = 0; d0 < NDK; ++d0) {
                        bf16x8 na = ka, nb = kb;
                        if (d0 + 1 < NDK) { na = *(ALAS const bf16x8*)(Ks_ + (d0 + 1) * 2048); nb = *(ALAS const bf16x8*)(Ks_ + (d0 + 1) * 2048 + 512); }
                        N0 = __builtin_amdgcn_mfma_f32_32x32x16_bf16(ka, qr[d0], d0 == 0 ? negm : N0, 0, 0, 0);
#pragma unroll
                        for (int e = 0; e < 32; ++e) if (e * NM / 32 == 2 * d0) { if (e < 16) C0[e] = __builtin_amdgcn_exp2f(C0[e]); else C1[e - 16] = __builtin_amdgcn_exp2f(C1[e - 16]); }
                        __builtin_amdgcn_sched_barrier(0);
                        N1 = __builtin_amdgcn_mfma_f32_32x32x16_bf16(kb, qr[d0], d0 == 0 ? negm : N1, 0, 0, 0);
#pragma unroll
                        for (int e = 0; e < 32; ++e) if (e * NM / 32 == 2 * d0 + 1) { if (e < 16) C0[e] = __builtin_amdgcn_exp2f(C0[e]); else C1[e - 16] = __builtin_amdgcn_exp2f(C1[e - 16]); }
                        __builtin_amdgcn_sched_barrier(0);
                        ka = na; kb = nb;
                    }
                }
                ALAS const char* vb_ = shm + L_V + vs * VSLOT + vbo; s16x4 vl_[8], vh_[8];
#pragma unroll
                for (int kk = 0; kk < 4; ++kk) { vl_[kk] = vtr(vb_ + kk * 1024); vh_[kk] = vtr(vb_ + kk * 1024 + 512); vl_[4 + kk] = vtr(vb_ + 4096 + kk * 1024); vh_[4 + kk] = vtr(vb_ + 4096 + kk * 1024 + 512); }
                float sa_[4];
#pragma unroll
                for (int kk = 0; kk < 4; ++kk) { const f32x16& cc_ = (kk < 2) ? C0 : C1; const int k8_ = 8 * (kk & 1);
                    const u32x4 pw_ = (u32x4){cvtpk(cc_[k8_], cc_[k8_ + 1]), cvtpk(cc_[k8_ + 2], cc_[k8_ + 3]), cvtpk(cc_[k8_ + 4], cc_[k8_ + 5]), cvtpk(cc_[k8_ + 6], cc_[k8_ + 7])};
                    sa_[kk] = fadd_s(fadd_s(fadd_s(cc_[k8_], cc_[k8_ + 1]), fadd_s(cc_[k8_ + 2], cc_[k8_ + 3])), fadd_s(fadd_s(cc_[k8_ + 4], cc_[k8_ + 5]), fadd_s(cc_[k8_ + 6], cc_[k8_ + 7])));
                    const bf16x8 v0_ = (bf16x8){vl_[kk][0], vl_[kk][1], vl_[kk][2], vl_[kk][3], vh_[kk][0], vh_[kk][1], vh_[kk][2], vh_[kk][3]}, v1_ = (bf16x8){vl_[4 + kk][0], vl_[4 + kk][1], vl_[4 + kk][2], vl_[4 + kk][3], vh_[4 + kk][0], vh_[4 + kk][1], vh_[4 + kk][2], vh_[4 + kk][3]};
                    o0 = __builtin_amdgcn_mfma_f32_32x32x16_bf16(__builtin_bit_cast(bf16x8, pw_), v0_, o0, 0, 0, 0); o1 = __builtin_amdgcn_mfma_f32_32x32x16_bf16(__builtin_bit_cast(bf16x8, pw_), v1_, o1, 0, 0, 0);
                    __builtin_amdgcn_sched_barrier(0); }
                lsum = fadd_s(lsum, fadd_s(fadd_s(sa_[0], sa_[1]), fadd_s(sa_[2], sa_[3])));
            } else if (!bailed && t + 1 == vis_lo) {
                ALAS const char* Kq_ = Kfr + ks1 * KSLOT;
#pragma unroll
                for (int d0 = 0; d0 < NDK; ++d0) { const bf16x8 a0 = *(ALAS const bf16x8*)(Kq_ + d0 * 2048), a1 = *(ALAS const bf16x8*)(Kq_ + d0 * 2048 + 512);
                    N0 = __builtin_amdgcn_mfma_f32_32x32x16_bf16(a0, qr[d0], d0 == 0 ? negm : N0, 0, 0, 0); N1 = __builtin_amdgcn_mfma_f32_32x32x16_bf16(a1, qr[d0], d0 == 0 ? negm : N1, 0, 0, 0); }
            }
            ks = ks1; vs ^= 1;
            ATT_WAIT_BAR();
        }
    }
    const float lt = xhalf_sum(lsum);
    if (__any(!(lt > 1.0e-30f && lt < 1.0e30f))) bailed = true;
    if (bailed && lane == 0) bailw[0] = 1;
    if (hi == 0) wsf[32 + r32] = lt;
    asm volatile("s_waitcnt lgkmcnt(0)" ::: "memory");
    write_o(A, o0, o1, wsf, shm, wid, lane, r32, hi, rowbase + q0 + wid * 32, 512 + h * 64);
    asm volatile("s_waitcnt lgkmcnt(0)\n\ts_barrier" ::: "memory");
    const int redo = __builtin_amdgcn_readfirstlane(bailw[0]);
    asm volatile("s_waitcnt lgkmcnt(0)\n\ts_barrier" ::: "memory");
    return redo != 0;
#undef CF_ISSUE_K
#undef CF_ISSUE_V
#undef CF_ROWMAX
#undef CF_BIAS
}
__device__ __forceinline__ bool chunk_unit_fast8(const Args& A, int b, int h, int qb, ALAS char* shm, const int tidb) {
    constexpr int KSLOT = 4096;
    constexpr float THR = 8.0f;
    int tid_l; asm volatile("v_mbcnt_lo_u32_b32 %0, -1, 0\n\tv_mbcnt_hi_u32_b32 %0, -1, %0" : "=v"(tid_l)); tid_l += tidb;
    const int tid = tid_l, lane = tid & 63, r32 = lane & 31, hi = lane >> 5;
    const int wid = __builtin_amdgcn_readfirstlane(tid >> 6);
    const long rowbase = (long)b * SEQ; const int q0 = qb * 256;
    const unsigned lds0 = (unsigned)(size_t)shm;
    ALAS float* wsf = (ALAS float*)(shm + L_WS) + wid * 64;
    ALAS float* bt = (ALAS float*)(shm + L_BIAS);
    ALAS int* bailw = (ALAS int*)(shm + L_BIAS) + 300;
    const unsigned char* ks8 = A.KB8 + (rowbase + 32 * ((wid >> 1) & 1) + r32) * 512 + h * 64 + 32 * hi + 16 * (wid & 1);
    const bf16* vsrc = A.VB + (rowbase + 16 * (wid & 3) + (lane >> 2)) * 512 + h * 64 + (wid >> 2) * 32 + (lane & 3) * 8;
    const unsigned kdst = lds0 + L_K + wid * 1024, vdst = lds0 + L_V + wid * 1024;
#define CF_ISSUE_K(t, s) do { if (wid < 4) glds16(ks8 + (long)(t) * 64 * 512, (unsigned)__builtin_amdgcn_readfirstlane(kdst + (s) * KSLOT)); } while (0)
#define CF_ISSUE_V(t, s) glds16(vsrc + (long)(t) * 64 * 512, (unsigned)__builtin_amdgcn_readfirstlane(vdst + (s) * VSLOT))
    const int t_end = 4 * qb + 4, t_begin = 4 * qb - 8 > 0 ? 4 * qb - 8 : 0;
    const int cw = 4 * qb + (wid >> 1);
    const int vis_lo = cw - 8 > 0 ? cw - 8 : 0;
    if (tid == 0) bailw[0] = 0;
    if (tid < 257) bt[tid] = (A.bias[h * 257 + tid] - A.bias[h * 257 + 256]) * LOG2E;
    CF_ISSUE_K(t_begin, 0); CF_ISSUE_V(t_begin, 0); CF_ISSUE_K(t_begin + 1, 1);
    const unsigned char* Q8w = A.QB8 + (rowbase + q0 + wid * 32 + r32) * 512 + h * 64 + 32 * hi;
    v8i qf;
    { const u32x4 a0 = *(const u32x4*)(Q8w), a1 = *(const u32x4*)(Q8w + 16); qf = (v8i){(int)a0.x, (int)a0.y, (int)a0.z, (int)a0.w, (int)a1.x, (int)a1.y, (int)a1.z, (int)a1.w}; }
    const int sa8 = 0x7c7c7c7c, sb8 = 0x7b7b7b7b;
    float lsum = 0.f; f32x16 o0 = {}, o1 = {};
    const int vbo = ((lane >> 4) & 1) * 32 + (lane & 3) * 8 + (4 * hi + ((lane & 15) >> 2)) * 64;
    ALAS const char* Kfr = shm + L_K + lane * 16;
#define C8_KFRAG(dst, base, kh) do { const u32x4 lo_ = *(ALAS const u32x4*)((base) + ((kh) * 2) * 1024), hi_ = *(ALAS const u32x4*)((base) + ((kh) * 2 + 1) * 1024); \
        dst = (v8i){(int)lo_.x, (int)lo_.y, (int)lo_.z, (int)lo_.w, (int)hi_.x, (int)hi_.y, (int)hi_.z, (int)hi_.w}; } while (0)
#define CF_ROWMAX(C0, C1) ({ float rmp_[4]; _Pragma("unroll") for (int j = 0; j < 4; ++j) { rmp_[j] = max3f(C0[j], C1[j], C0[4 + j]); rmp_[j] = max3f(rmp_[j], C1[4 + j], C0[8 + j]); rmp_[j] = max3f(rmp_[j], C1[8 + j], C0[12 + j]); rmp_[j] = max2f(rmp_[j], C1[12 + j]); } \
        xhalf_max(max2f(max3f(rmp_[0], rmp_[1], rmp_[2]), rmp_[3])); })
#define CF_BIAS(C0, C1, tt) do { const int dq_ = 64 * (cw - (tt)) + 32 * (wid & 1) + r32 + 128; \
        _Pragma("unroll") for (int r = 0; r < 16; ++r) { int i0 = dq_ - crow(r, hi), i1 = i0 - 32; i0 = i0 < 0 ? 0 : (i0 > 256 ? 256 : i0); i1 = i1 < 0 ? 0 : (i1 > 256 ? 256 : i1); C0[r] += bt[i0]; C1[r] += bt[i1]; } } while (0)
    f32x16 cs[2][2], negm;
    ATT_WAIT_BAR();
    { f32x16 z0 = {}, z1 = {};
      { v8i k0_, k1_; C8_KFRAG(k0_, Kfr, 0); C8_KFRAG(k1_, Kfr, 1); mfma8_acc(z0, k0_, qf, sa8, sb8); mfma8_acc(z1, k1_, qf, sa8, sb8); }
      asm volatile("s_nop 15\n\ts_nop 7" : "+v"(z0), "+v"(z1));
      if (vis_lo == t_begin && t_begin >= cw - 2) CF_BIAS(z0, z1, t_begin);
      const float mhat = CF_ROWMAX(z0, z1);
#pragma unroll
      for (int r = 0; r < 16; ++r) { z0[r] -= mhat; z1[r] -= mhat; negm[r] = -mhat; }
      cs[0][0] = z0; cs[0][1] = z1; cs[1][0] = z0; cs[1][1] = z1; }
    bool bailed = false; int ks = 0, vs = 0;
    for (int t2 = t_begin; t2 < t_end; t2 += 2) {
#pragma unroll
        for (int p = 0; p < 2; ++p) {
            const int t = t2 + p; f32x16 &C0 = cs[p][0], &C1 = cs[p][1], &N0 = cs[p ^ 1][0], &N1 = cs[p ^ 1][1];
            if (t >= vis_lo && t > t_begin && t <= cw) { if (t >= cw - 2) CF_BIAS(C0, C1, t); }
            const bool vis = !bailed && t >= vis_lo && t <= cw;
            const int ks1 = ks == 2 ? 0 : ks + 1, ks2 = ks1 == 2 ? 0 : ks1 + 1;
            if (t + 2 < t_end) CF_ISSUE_K(t + 2, ks2);
            if (t + 1 < t_end) CF_ISSUE_V(t + 1, vs ^ 1);
            if (vis) {
                {
                    ALAS const char* Ks_ = Kfr + ks1 * KSLOT;
                    v8i kfa, kfb; C8_KFRAG(kfa, Ks_, 0); C8_KFRAG(kfb, Ks_, 1);
                    mfma8_new(N0, kfa, qf, negm, sa8, sb8);
#pragma unroll
                    for (int e = 0; e < 16; ++e) C0[e] = __builtin_amdgcn_exp2f(C0[e]);
                    __builtin_amdgcn_sched_barrier(0);
                    mfma8_new(N1, kfb, qf, negm, sa8, sb8);
#pragma unroll
                    for (int e = 0; e < 16; ++e) C1[e] = __builtin_amdgcn_exp2f(C1[e]);
                    __builtin_amdgcn_sched_barrier(0);
                }
                ALAS const char* vb_ = shm + L_V + vs * VSLOT + vbo; s16x4 vl_[8], vh_[8];
#pragma unroll
                for (int kk = 0; kk < 4; ++kk) { vl_[kk] = vtr(vb_ + kk * 1024); vh_[kk] = vtr(vb_ + kk * 1024 + 512); vl_[4 + kk] = vtr(vb_ + 4096 + kk * 1024); vh_[4 + kk] = vtr(vb_ + 4096 + kk * 1024 + 512); }
                float sa_[4];
#pragma unroll
                for (int kk = 0; kk < 4; ++kk) { const f32x16& cc_ = (kk < 2) ? C0 : C1; const int k8_ = 8 * (kk & 1);
                    const u32x4 pw_ = (u32x4){cvtpk(cc_[k8_], cc_[k8_ + 1]), cvtpk(cc_[k8_ + 2], cc_[k8_ + 3]), cvtpk(cc_[k8_ + 4], cc_[k8_ + 5]), cvtpk(cc_[k8_ + 6], cc_[k8_ + 7])};
                    sa_[kk] = fadd_s(fadd_s(fadd_s(cc_[k8_], cc_[k8_ + 1]), fadd_s(cc_[k8_ + 2], cc_[k8_ + 3])), fadd_s(fadd_s(cc_[k8_ + 4], cc_[k8_ + 5]), fadd_s(cc_[k8_ + 6], cc_[k8_ + 7])));
                    const bf16x8 v0_ = (bf16x8){vl_[kk][0], vl_[kk][1], vl_[kk][2], vl_[kk][3], vh_[kk][0], vh_[kk][1], vh_[kk][2], vh_[kk][3]}, v1_ = (bf16x8){vl_[4 + kk][0], vl_[4 + kk][1], vl_[4 + kk][2], vl_[4 + kk][3], vh_[4 + kk][0], vh_[4 + kk][1], vh_[4 + kk][2], vh_[4 + kk][3]};
                    o0 = __builtin_amdgcn_mfma_f32_32x32x16_bf16(__builtin_bit_cast(bf16x8, pw_), v0_, o0, 0, 0, 0); o1 = __builtin_amdgcn_mfma_f32_32x32x16_bf16(__builtin_bit_cast(bf16x8, pw_), v1_, o1, 0, 0, 0);
                    __builtin_amdgcn_sched_barrier(0); }
                lsum = fadd_s(lsum, fadd_s(fadd_s(sa_[0], sa_[1]), fadd_s(sa_[2], sa_[3])));
            } else if (!bailed && t + 1 == vis_lo) {
                ALAS const char* Kq_ = Kfr + ks1 * KSLOT;
                v8i k0_, k1_; C8_KFRAG(k0_, Kq_, 0); C8_KFRAG(k1_, Kq_, 1); mfma8_new(N0, k0_, qf, negm, sa8, sb8); mfma8_new(N1, k1_, qf, negm, sa8, sb8);
            }
            ks = ks1; vs ^= 1;
            ATT_WAIT_BAR();
        }
    }
    const float lt = xhalf_sum(lsum);
    if (__any(!(lt > 1.0e-30f && lt < 1.0e30f))) bailed = true;
    if (bailed && lane == 0) bailw[0] = 1;
    if (hi == 0) wsf[32 + r32] = lt;
    asm volatile("s_waitcnt lgkmcnt(0)" ::: "memory");
    write_o(A, o0, o1, wsf, shm, wid, lane, r32, hi, rowbase + q0 + wid * 32, 512 + h * 64);
    asm volatile("s_waitcnt lgkmcnt(0)\n\ts_barrier" ::: "memory");
    const int redo = __builtin_amdgcn_readfirstlane(bailw[0]);
    asm volatile("s_waitcnt lgkmcnt(0)\n\ts_barrier" ::: "memory");
    return redo != 0;
#undef CF_ISSUE_K
#undef C8_KFRAG
#undef CF_ISSUE_V
#undef CF_ROWMAX
#undef CF_BIAS
}
template <bool CHUNK>
__device__ __forceinline__ void attn_phase(const Args& A, int vcu, int G, ALAS char* shm, const int tidb) {
    if (G == 256) {
        for (int i = 0; i < 4; ++i) {
            int bh, qb;
            if (CHUNK) { const int u = vcu * 4 + i; bh = u >> 5; qb = u & 31; }
            else { const int s = vcu & 7; bh = vcu >> 3; qb = (i == 0) ? s : (i == 1) ? 15 - s : (i == 2) ? 16 + s : 31 - s; }
            if (CHUNK) { if (A.qk8 ? chunk_unit_fast8(A, bh >> 3, bh & 7, qb, shm, tidb) : chunk_unit_fast(A, bh >> 3, bh & 7, qb, shm, tidb)) attn_unit<CHUNK>(A, bh >> 3, bh & 7, qb, shm, tidb); }
            else if (A.qk8 ? mla_unit_fast8(A, bh >> 3, bh & 7, qb, shm, tidb) : mla_unit_fast(A, bh >> 3, bh & 7, qb, shm, tidb)) attn_unit<CHUNK>(A, bh >> 3, bh & 7, qb, shm, tidb);
        }
    } else {
        for (int u = vcu; u < 1024; u += G) attn_unit<CHUNK>(A, u >> 8, (u >> 5) & 7, u & 31, shm, tidb);
    }
}

#undef ATT_WAIT_BAR
}
#define GAS __attribute__((address_space(1)))
#define LAS __attribute__((address_space(3)))
typedef unsigned short bf16;
typedef unsigned v4u __attribute__((ext_vector_type(4)));
typedef float f32x4 __attribute__((ext_vector_type(4)));
typedef short bf16x8 __attribute__((ext_vector_type(8)));
typedef GAS unsigned gu32;
typedef GAS unsigned long long gu64;
#define RLX_AGENT __ATOMIC_RELAXED, __HIP_MEMORY_SCOPE_AGENT
#define LDS_WAIT() asm volatile("s_waitcnt lgkmcnt(0)" ::: "memory")
#define VM_WAIT() asm volatile("s_waitcnt vmcnt(0)" ::: "memory")
__device__ __forceinline__ unsigned long long rt() { return __builtin_amdgcn_s_memrealtime(); }
__device__ __forceinline__ unsigned f2bf(float f) { unsigned u = __builtin_bit_cast(unsigned, f); return (u + 0x7fffu + ((u >> 16) & 1u)) >> 16; }
__device__ __forceinline__ unsigned pk2(float lo, float hi) { return f2bf(lo) | (f2bf(hi) << 16); }

#define XB_TMO      128
#define XB_XCNT(j)  (256  + 64 * (j))
#define XB_XSUB(j)  (1280 + 64 * (j))
#define XB_XGEN(j)  (2304 + 64 * (j))
#define XB_TOP      3328
#define XB_TOPGEN   3392
#define XCD_BAR_WORDS 3456
#define XB_SPIN_CAP (1u << 18)

__device__ __forceinline__ unsigned xb_ld(unsigned* p)              { return __hip_atomic_load(p, __ATOMIC_RELAXED, __HIP_MEMORY_SCOPE_AGENT); }
__device__ __forceinline__ unsigned xb_add(unsigned* p, unsigned v) { return __hip_atomic_fetch_add(p, v, __ATOMIC_RELAXED, __HIP_MEMORY_SCOPE_AGENT); }
__device__ __forceinline__ unsigned xb_xcc_id() { return (unsigned)__builtin_amdgcn_s_getreg((3 << 11) | 20) & 0xFu; }
#define XB_SPIN(cond, bar) do { unsigned _sp = 0; while (cond) { __builtin_amdgcn_s_sleep(1); \
    if ((++_sp & 255u) == 0u) { if (xb_ld(&(bar)[XB_TMO])) break; if (_sp > XB_SPIN_CAP) { atomicAdd(&(bar)[XB_TMO], 1u); break; } } } } while (0)

struct XcdBarrier {
    unsigned* bar; unsigned x;
    volatile LAS unsigned* st;
};

__device__ __forceinline__ XcdBarrier xcd_barrier_post(unsigned* bar, volatile LAS unsigned* st, const bool t0  ) {
    XcdBarrier b; b.bar = bar; b.x = xb_xcc_id(); b.st = st;
    if (t0) (void)xb_add(&bar[XB_XCNT(b.x)], 1u);
    return b;
}
__device__ __forceinline__ void xcd_barrier_complete(unsigned* bar, unsigned x, unsigned& nloc, unsigned& nx) {
    const unsigned G = gridDim.x * gridDim.y * gridDim.z;
    unsigned sum, cnt, mine, sp = 0u;
    for (;;) {
        sum = 0u; cnt = 0u; mine = 0u;
#pragma unroll
        for (unsigned j = 0; j < 16; ++j) { const unsigned c = xb_ld(&bar[XB_XCNT(j)]); sum += c; cnt += (c > 0u) ? 1u : 0u; mine = (j == x) ? c : mine; }
        if (sum == G) break;
        __builtin_amdgcn_s_sleep(1);
        if ((++sp & 255u) == 0u) { if (xb_ld(&bar[XB_TMO])) break; if (sp > XB_SPIN_CAP) { atomicAdd(&bar[XB_TMO], 1u); break; } }
    }
    nloc = mine > 0u ? mine : 1u; nx = cnt > 0u ? cnt : 1u;
}

template <bool CENSUS> __device__ __forceinline__ void xcd_barrier(const XcdBarrier& b, const bool t0  ) {
    asm volatile("s_waitcnt vmcnt(0)" ::: "memory");
    __syncthreads();
    if (t0) {
        unsigned* bar = b.bar;
        __builtin_amdgcn_s_waitcnt(0);
        unsigned nloc = b.st[0], nx = b.st[1];
        if (CENSUS) { if (nloc == 0u) { xcd_barrier_complete(bar, b.x, nloc, nx); b.st[0] = nloc; b.st[1] = nx; } }
        const unsigned old = xb_add(&bar[XB_XSUB(b.x)], 1u);
        const unsigned gen = old / nloc;
        if (old + 1u == (gen + 1u) * nloc) {
            __builtin_amdgcn_fence(__ATOMIC_RELEASE, "agent");
            asm volatile("s_waitcnt vmcnt(0)" ::: "memory");
            const unsigned og = xb_add(&bar[XB_TOP], 1u);
            const unsigned tg = og / nx;
            if (og + 1u == (tg + 1u) * nx) xb_add(&bar[XB_TOPGEN], 1u);
            else XB_SPIN(xb_ld(&bar[XB_TOPGEN]) == tg, bar);
            __builtin_amdgcn_fence(__ATOMIC_ACQUIRE, "agent");
            xb_add(&bar[XB_XGEN(b.x)], 1u);
            asm volatile("s_waitcnt vmcnt(0)" ::: "memory");
        } else {
            XB_SPIN(xb_ld(&bar[XB_XGEN(b.x)]) == gen, bar);
            __builtin_amdgcn_fence(__ATOMIC_ACQUIRE, "agent");
            asm volatile("s_waitcnt vmcnt(0)" ::: "memory");
        }
    }
    __syncthreads();
}
static_assert(att::L_END <= RING_BYTES && RSTAB_OFF + 8 * 1024 <= LDS_BYTES, "LDS map");
typedef unsigned v2u __attribute__((ext_vector_type(2)));
typedef int v4i __attribute__((ext_vector_type(4)));
#define SWZ_XOR(x) (((x) << 10) | 0x1F)
__device__ __forceinline__ float wave_sum(float v) {
    v += __int_as_float(__builtin_amdgcn_ds_swizzle(__float_as_int(v), SWZ_XOR(1))); v += __int_as_float(__builtin_amdgcn_ds_swizzle(__float_as_int(v), SWZ_XOR(2)));
    v += __int_as_float(__builtin_amdgcn_ds_swizzle(__float_as_int(v), SWZ_XOR(4))); v += __int_as_float(__builtin_amdgcn_ds_swizzle(__float_as_int(v), SWZ_XOR(8)));
    v += __int_as_float(__builtin_amdgcn_ds_swizzle(__float_as_int(v), SWZ_XOR(16)));
    auto rr = __builtin_amdgcn_permlane32_swap(__float_as_uint(v), __float_as_uint(v), false, false); return __uint_as_float(rr[0]) + __uint_as_float(rr[1]);
}
__device__ __forceinline__ int wave_sum_i(int v) {
    v += __builtin_amdgcn_ds_swizzle(v, SWZ_XOR(1)); v += __builtin_amdgcn_ds_swizzle(v, SWZ_XOR(2)); v += __builtin_amdgcn_ds_swizzle(v, SWZ_XOR(4)); v += __builtin_amdgcn_ds_swizzle(v, SWZ_XOR(8)); v += __builtin_amdgcn_ds_swizzle(v, SWZ_XOR(16));
    auto rr = __builtin_amdgcn_permlane32_swap((unsigned)v, (unsigned)v, false, false); return (int)(rr[0] + rr[1]);
}
enum { TM_ID = 0, TM_IN, TM_UQ, TM_UKV, TM_W1, TM_W3 };
__device__ __forceinline__ int rope_pos(int j) { return j < 16 ? 8 * (j >> 2) + (j & 3) : 8 * ((j - 16) >> 2) + 4 + (j & 3); }
__device__ __forceinline__ int tr_dest_row(int mode, int n0, int n) {
    if (mode == TM_IN) { const int gb = n0 < 672 ? n0 : n0 + 96; return gb + (n0 == 640 ? rope_pos(n) : n); }
    if (mode == TM_UQ) return n0 + ((((n0 >> 5) % 3) == 2) ? rope_pos(n) : n);
    if (mode == TM_UKV) { const int h = n0 >> 7, j0 = n0 & 127; return (j0 < 64 ? h * 64 + j0 : 512 + h * 64 + (j0 - 64)) + n; }
    if (mode == TM_W1) return (n0 >> 7) * 256 + (n0 & 127) + n;
    if (mode == TM_W3) return (n0 >> 7) * 256 + 128 + (n0 & 127) + n;
    return n0 + n;
}
struct TrJob { const float* W; int K, N; bf16* dst; const float* gain; int mode; int f8; };
__device__ __forceinline__ void tr_item(const TrJob& J, int item, LAS float* scr, int lane) {
    const int nblk = J.N / 32, kb = item / nblk, nb = item % nblk, k0 = 64 * kb, n0 = 32 * nb;
    float wv[32];
#pragma unroll
    for (int i = 0; i < 32; ++i) wv[i] = __builtin_nontemporal_load(J.W + (size_t)(k0 + 2 * i + (lane >> 5)) * J.N + n0 + (lane & 31));
#pragma unroll
    for (int i = 0; i < 32; ++i) scr[(2 * i + (lane >> 5)) * 33 + (lane & 31)] = wv[i];
    LDS_WAIT(); asm volatile("" ::: "memory");
    const int c = lane & 7; float g[8];
#pragma unroll
    for (int e = 0; e < 8; ++e) g[e] = J.gain ? J.gain[k0 + 8 * c + e] : 1.f;
#pragma unroll
    for (int j = 0; j < 4; ++j) { const int n = (lane >> 3) + 8 * j; const LAS float* s = scr + (8 * c) * 33 + n;
        if (J.f8) { int w0 = 0, w1 = 0;
            w0 = __builtin_amdgcn_cvt_pk_fp8_f32(s[0 * 33] * g[0] * 64.0f, s[1 * 33] * g[1] * 64.0f, w0, false); w0 = __builtin_amdgcn_cvt_pk_fp8_f32(s[2 * 33] * g[2] * 64.0f, s[3 * 33] * g[3] * 64.0f, w0, true);
            w1 = __builtin_amdgcn_cvt_pk_fp8_f32(s[4 * 33] * g[4] * 64.0f, s[5 * 33] * g[5] * 64.0f, w1, false); w1 = __builtin_amdgcn_cvt_pk_fp8_f32(s[6 * 33] * g[6] * 64.0f, s[7 * 33] * g[7] * 64.0f, w1, true);
            v2u o; o.x = (unsigned)w0; o.y = (unsigned)w1; *(GAS v2u*)((unsigned char*)J.dst + (size_t)tr_dest_row(J.mode, n0, n) * J.K + k0 + 8 * c) = o; }
        else { v4u o; o.x = pk2(s[0 * 33] * g[0], s[1 * 33] * g[1]); o.y = pk2(s[2 * 33] * g[2], s[3 * 33] * g[3]); o.z = pk2(s[4 * 33] * g[4], s[5 * 33] * g[5]); o.w = pk2(s[6 * 33] * g[6], s[7 * 33] * g[7]);
        *(GAS v4u*)(J.dst + (size_t)tr_dest_row(J.mode, n0, n) * J.K + k0 + 8 * c) = o; } }
    LDS_WAIT(); asm volatile("" ::: "memory");
}
__device__ __forceinline__ void tr_run(const TrJob& J, int& base, int gw, int NGW, LAS float* scr, int lane) {
    const int nitems = (J.K / 64) * (J.N / 32);
    int first = gw - (base % NGW); if (first < 0) first += NGW;
    for (int it = first; it < nitems; it += NGW) tr_item(J, it, scr, lane);
    base += nitems;
}
template <bool INIT, bool FINAL>
__device__ __forceinline__ void row_pass(const float* xin, float* xout, bf16* xb, float* ssx, const bf16* Y, const int* pos, const float* gfin, int gw, int NGW, int lane, unsigned char* xq = nullptr  ) {
    constexpr int U = 4;
    for (int t0 = gw; t0 < T_; t0 += U * NGW) {
        f32x4 v[U][4];
        if (INIT) {
#pragma unroll
            for (int u = 0; u < U; ++u) { const int t = t0 + u * NGW; if (t < T_) { const GAS f32x4* xr = (const GAS f32x4*)(xin + (size_t)t * D_) + lane;
#pragma unroll
                for (int j = 0; j < 4; ++j) v[u][j] = xr[64 * j]; } }
        } else {
            int p0[U], p1[U];
#pragma unroll
            for (int u = 0; u < U; ++u) { const int t = t0 + u * NGW; p0[u] = 0; p1[u] = 0; if (t < T_) { p0[u] = pos[2 * t]; p1[u] = pos[2 * t + 1]; } }
            v2u xw[U][4], aw[U][4], bw[U][4];
#pragma unroll
            for (int u = 0; u < U; ++u) { const int t = t0 + u * NGW; if (t < T_) {
                const GAS v2u* x0 = (const GAS v2u*)(xb + (size_t)t * D_) + lane;
                const GAS v2u* y0 = (const GAS v2u*)(Y + (size_t)p0[u] * D_) + lane; const GAS v2u* y1 = (const GAS v2u*)(Y + (size_t)p1[u] * D_) + lane;
#pragma unroll
                for (int j = 0; j < 4; ++j) { xw[u][j] = x0[64 * j]; aw[u][j] = y0[64 * j]; bw[u][j] = y1[64 * j]; } } }
#pragma unroll
            for (int u = 0; u < U; ++u)
#pragma unroll
                for (int j = 0; j < 4; ++j) { const v2u c = xw[u][j], a = aw[u][j], b = bw[u][j];
                    v[u][j].x = __uint_as_float(c.x << 16) + (__uint_as_float(a.x << 16) + __uint_as_float(b.x << 16)); v[u][j].y = __uint_as_float(c.x & 0xffff0000u) + (__uint_as_float(a.x & 0xffff0000u) + __uint_as_float(b.x & 0xffff0000u));
                    v[u][j].z = __uint_as_float(c.y << 16) + (__uint_as_float(a.y << 16) + __uint_as_float(b.y << 16)); v[u][j].w = __uint_as_float(c.y & 0xffff0000u) + (__uint_as_float(a.y & 0xffff0000u) + __uint_as_float(b.y & 0xffff0000u)); }
        }
#pragma unroll
        for (int u = 0; u < U; ++u) { const int t = t0 + u * NGW; if (t < T_) {
            float ss = 0.f;
#pragma unroll
            for (int j = 0; j < 4; ++j) ss += (v[u][j].x * v[u][j].x + v[u][j].y * v[u][j].y) + (v[u][j].z * v[u][j].z + v[u][j].w * v[u][j].w);
            ss = wave_sum(ss);
            if (FINAL) {
                GAS f32x4* xo = (GAS f32x4*)(xout + (size_t)t * D_) + lane;
                const float rs = 1.0f / sqrtf(ss * (1.0f / D_) + EPS_);
#pragma unroll
                for (int j = 0; j < 4; ++j) { const f32x4 g = ((const GAS f32x4*)gfin)[lane + 64 * j]; xo[64 * j] = v[u][j] * rs * g; }
            } else {
                GAS v2u* bo = (GAS v2u*)(xb + (size_t)t * D_) + lane;
#pragma unroll
                for (int j = 0; j < 4; ++j) { v2u w; w.x = pk2(v[u][j].x, v[u][j].y); w.y = pk2(v[u][j].z, v[u][j].w); bo[64 * j] = w; }
                if (xq) { GAS unsigned* qo = (GAS unsigned*)(xq + (size_t)t * D_) + lane;
#pragma unroll
                    for (int j = 0; j < 4; ++j) { int w = 0;
                        w = __builtin_amdgcn_cvt_pk_fp8_f32(__builtin_amdgcn_fmed3f(v[u][j].x * 8.0f, -448.f, 448.f), __builtin_amdgcn_fmed3f(v[u][j].y * 8.0f, -448.f, 448.f), w, false);
                        w = __builtin_amdgcn_cvt_pk_fp8_f32(__builtin_amdgcn_fmed3f(v[u][j].z * 8.0f, -448.f, 448.f), __builtin_amdgcn_fmed3f(v[u][j].w * 8.0f, -448.f, 448.f), w, true); qo[64 * j] = (unsigned)w; } }
                if (lane < 16) ssx[(size_t)t * 16 + lane] = lane == 0 ? ss : 0.f;
            } } }
    }
}
__device__ __forceinline__ void moe_route1(LAS unsigned char* lds, const bf16* x, const float* ssx, const float* wr, const float* g, int* tok_e, float* tok_g, float* tok_rs, int* counts, int bx, int G, int tid, int wave, int lane) {
    LAS float* wrgT = (LAS float*)lds;
    LAS int* hist = (LAS int*)(lds + 32768);
    for (int idx = tid; idx < 8192; idx += 512) { const int k = idx >> 3, e = idx & 7; wrgT[e * 1024 + k] = wr[idx] * g[k]; }
    __syncthreads();
    for (int ch = bx; ch < T_ / 128; ch += G) {
        if (tid < 8) hist[tid] = 0;
        __syncthreads();
        for (int i = 0; i < 16; ++i) {
            const int t = ch * 128 + wave * 16 + i;
            const GAS v2u* xr = (const GAS v2u*)(x + (size_t)t * D_) + lane;
            f32x4 xv[4];
#pragma unroll
            for (int j = 0; j < 4; ++j) { const v2u c = xr[64 * j]; xv[j] = (f32x4){__uint_as_float(c.x << 16), __uint_as_float(c.x & 0xffff0000u), __uint_as_float(c.y << 16), __uint_as_float(c.y & 0xffff0000u)}; }
            float lg[8];
#pragma unroll
            for (int e = 0; e < 8; ++e) { float a = 0.f;
#pragma unroll
                for (int j = 0; j < 4; ++j) { const f32x4 w = *(const LAS f32x4*)(wrgT + e * 1024 + 256 * j + 4 * lane); a += (xv[j].x * w.x + xv[j].y * w.y) + (xv[j].z * w.z + xv[j].w * w.w); }
                lg[e] = wave_sum(a); }
            const float ssp = lane < 16 ? ssx[(size_t)t * 16 + lane] : 0.f;
            const float rs = 1.0f / sqrtf(wave_sum(ssp) * (1.0f / D_) + EPS_);
#pragma unroll
            for (int e = 0; e < 8; ++e) lg[e] *= rs;
            int e0 = 0; float b0 = lg[0];
#pragma unroll
            for (int e = 1; e < 8; ++e) if (lg[e] > b0) { b0 = lg[e]; e0 = e; }
            int e1 = -1; float b1 = -3.0e38f;
#pragma unroll
            for (int e = 0; e < 8; ++e) if (e != e0 && (e1 < 0 || lg[e] > b1)) { b1 = lg[e]; e1 = e; }
            const float g0 = 1.0f / (1.0f + __builtin_amdgcn_exp2f((b1 - b0) * LOG2E_)), g1 = 1.0f - g0;
            if (lane == 0) { tok_e[t] = e0 | (e1 << 8); tok_g[2 * t] = g0; tok_g[2 * t + 1] = g1; tok_rs[t] = rs; atomicAdd((int*)&hist[e0], 1); atomicAdd((int*)&hist[e1], 1); }
        }
        __syncthreads();
        if (tid < 8) counts[ch * 8 + tid] = hist[tid];
        __syncthreads();
    }
}
__device__ __forceinline__ void moe_route2(LAS unsigned char* lds, const bf16* xb, bf16* xs, const int* tok_e, const float* tok_g, const float* tok_rs, const int* counts, int* pos, float* rowg, float* rowrs, int* meta,
                                           int bx, int G, int tid, int wave, int lane, bool f8) {
    LAS int* lcnt = (LAS int*)lds; LAS int* ltot = lcnt + 2048; LAS int* lbef = ltot + 8; LAS int* ldest = lbef + 8;
    for (int ch = bx; ch < T_ / 128; ch += G) {
        { const v4i v = ((const v4i*)counts)[tid]; ((LAS v4i*)lcnt)[tid] = v; }
        __syncthreads();
        { const int e = wave; int tot = 0, bef = 0;
#pragma unroll
          for (int i = 0; i < 4; ++i) { const int c2 = lane + 64 * i; const int v = lcnt[c2 * 8 + e]; tot += v; bef += (c2 < ch) ? v : 0; }
          tot = wave_sum_i(tot); bef = wave_sum_i(bef); if (lane == 0) { ltot[e] = tot; lbef[e] = bef; } }
        __syncthreads();
        int pst[8], pen[8]; { int run = 0;
#pragma unroll
            for (int e = 0; e < 8; ++e) { const int tt = ltot[e]; pst[e] = run; run += (tt + 255) & ~255; pen[e] = run; } }
        if (wave == 0) {
            int runc[8];
#pragma unroll
            for (int e = 0; e < 8; ++e) runc[e] = pst[e] + lbef[e];
#pragma unroll
            for (int half = 0; half < 2; ++half) {
                const int tl = half * 64 + lane, t = ch * 128 + tl; const int ee = tok_e[t]; const int e0 = ee & 255, e1 = ee >> 8;
                int d0 = 0, d1 = 0;
#pragma unroll
                for (int e = 0; e < 8; ++e) { const bool m0 = (e0 == e), m1 = (e1 == e); const unsigned long long mk = __ballot(m0 || m1);
                    const int rank = __popcll(mk & ((1ull << lane) - 1ull)); if (m0) d0 = runc[e] + rank; if (m1) d1 = runc[e] + rank; runc[e] += __popcll(mk); }
                ldest[2 * tl] = d0; ldest[2 * tl + 1] = d1; pos[2 * t] = d0; pos[2 * t + 1] = d1;
                const float g0 = tok_g[2 * t], g1 = tok_g[2 * t + 1], rs = tok_rs[t];
                rowg[d0] = g0; rowg[d1] = g1; rowrs[d0] = rs; rowrs[d1] = rs;
            }
        }
        __syncthreads();
        if (f8) {
            for (int ab = wave; ab < 256; ab += 32) {
              v4u ra0[4], ra1[4]; float rsc[4];
#pragma unroll
              for (int u = 0; u < 4; ++u) { const int a = ab + 8 * u, t = ch * 128 + (a >> 1); rsc[u] = tok_rs[t] * 16.0f; const GAS v4u* s = (const GAS v4u*)(xb + (size_t)t * D_) + 2 * lane; ra0[u] = s[0]; ra1[u] = s[1]; }
#pragma unroll
              for (int u = 0; u < 4; ++u) { const int a = ab + 8 * u; const int d = ldest[a]; const float sc = rsc[u]; const v4u a0 = ra0[u], a1 = ra1[u];
                v4u o;
#define F8PK(w) ({ int r_ = 0; r_ = __builtin_amdgcn_cvt_pk_fp8_f32(__builtin_amdgcn_fmed3f(__uint_as_float((w).x << 16) * sc, -448.f, 448.f), __builtin_amdgcn_fmed3f(__uint_as_float((w).x & 0xffff0000u) * sc, -448.f, 448.f), r_, false); \
                   r_ = __builtin_amdgcn_cvt_pk_fp8_f32(__builtin_amdgcn_fmed3f(__uint_as_float((w).y << 16) * sc, -448.f, 448.f), __builtin_amdgcn_fmed3f(__uint_as_float((w).y & 0xffff0000u) * sc, -448.f, 448.f), r_, true); (unsigned)r_; })
                { v2u p; p.x = a0.x; p.y = a0.y; o.x = F8PK(p); p.x = a0.z; p.y = a0.w; o.y = F8PK(p); p.x = a1.x; p.y = a1.y; o.z = F8PK(p); p.x = a1.z; p.y = a1.w; o.w = F8PK(p); }
#undef F8PK
                *((GAS v4u*)((unsigned char*)xs + (size_t)d * D_) + lane) = o; } }
        } else {
        for (int a = wave; a < 256; a += 8) { const int t = ch * 128 + (a >> 1); const int d = ldest[a];
            const GAS v4u* s = (const GAS v4u*)(xb + (size_t)t * D_) + lane; GAS v4u* o = (GAS v4u*)(xs + (size_t)d * D_) + lane;
            const v4u a0 = s[0], a1 = s[64]; o[0] = a0; o[64] = a1; }
        }
        if (ch == 0) {
            int pv = 0, ps = 0, tt = 0, pe_ = 0;
#pragma unroll
            for (int e = 0; e < 8; ++e) { if (tid == e) pv = pen[e]; if (wave == e) { ps = pst[e]; pe_ = pen[e]; tt = ltot[e]; } }
            if (tid < 8) meta[tid] = pv;
            for (int r = ps + tt + lane; r < pe_; r += 64) { rowrs[r] = 0.f; rowg[r] = 0.f; }
        }
        __syncthreads();
    }
}

struct Params { const float* in[18]; float* out; unsigned char* ws; int ph_lo, ph_hi; };
typedef __attribute__((address_space(4))) Params KP;
constexpr int IT_FF = (D_ / 64) * (FF_ / 32), MOE_ITEMS = NEXP * 3 * IT_FF;
static_assert(IT_FF == (FF_ / 64) * (D_ / 32), "w1 / w3 / w2 have the same item count");
constexpr int FILL_IN = 6000, FILL_IN8 = 4000, FILL_UQ = 2000, FILL_MD = 16000;
constexpr int fill_in(int l) { return f8_in_layer(l) ? FILL_IN8 : FILL_IN; }
constexpr int fill_in_at(int l) { return (l & 1) == 0 ? (l < 2 ? 0 : FILL_MD) : fill_in_at(l - 1) + fill_in(l - 1) + FILL_UQ; }
constexpr int FA0 = fill_in_at(0), FA1 = fill_in_at(1), FA2 = fill_in_at(2), FA3 = fill_in_at(3), FN0 = fill_in(0), FN1 = fill_in(1), FN2 = fill_in(2), FN3 = fill_in(3);
constexpr int L1_DONE = fill_in_at(1) + fill_in(1) + FILL_UQ, L3_DONE = fill_in_at(3) + fill_in(3) + FILL_UQ;
static_assert(FILL_MD <= NEXP * 2 * IT_FF && L3_DONE <= MOE_ITEMS, "early ranges");
__device__ __forceinline__ void moe_job(const KP* kp, unsigned char* ws, int l, int g, TrJob& J, int& it) {
    const int mj = l >> 1, j = g / IT_FF; it = g % IT_FF;
    unsigned char* WM13 = ws + WS_WM; unsigned char* WM2 = WM13 + (size_t)NEXP * 2 * FF_ * D_ * 2; const int eb = f8_layer(l) ? 1 : 2;
    if (j < 2 * NEXP) { const int e = j >> 1;
        if ((j & 1) == 0) J = TrJob{kp->in[14] + (size_t)(mj * NEXP + e) * D_ * FF_, D_, FF_, (bf16*)(WM13 + (size_t)e * 2 * FF_ * D_ * eb), kp->in[9] + l * D_, TM_W1, (int)f8_layer(l)};
        else J = TrJob{kp->in[15] + (size_t)(mj * NEXP + e) * D_ * FF_, D_, FF_, (bf16*)(WM13 + (size_t)e * 2 * FF_ * D_ * eb), kp->in[9] + l * D_, TM_W3, (int)f8_layer(l)};
    } else { const int e = j - 2 * NEXP; J = TrJob{kp->in[16] + (size_t)(mj * NEXP + e) * FF_ * D_, FF_, D_, (bf16*)(WM2 + (size_t)e * FF_ * D_ * eb), nullptr, TM_ID, (int)f8_layer(l)}; }
}
__device__ __forceinline__ void moe_fill(const KP* kp, unsigned char* ws, int l, int a, int b, int nwg, int G, int c, int wave, LAS unsigned char* lds, int lane) {
    const int r = nwg % G; int P = G, pidx = c;
    if (r != 0) { P = G - r; pidx = c - r; }
    if (pidx >= 0) { LAS float* scr = (LAS float*)(lds + wave * 16384);
        for (int g = a + pidx * NWAVES + wave; g < b; g += P * NWAVES) { TrJob J; int it; moe_job(kp, ws, l, g, J, it); tr_item(J, it, scr, lane); } }
    __syncthreads();
}
__device__ __forceinline__ const KP* kargs() { const KP* p = (const KP*)__builtin_amdgcn_kernarg_segment_ptr(); asm volatile("" : "+s"(p)); return p; }
__global__ void __launch_bounds__(NWAVES * 64, 2) hybrid_fwd(Params P) {
    extern __shared__ __attribute__((aligned(16))) unsigned char lds_raw[];
    LAS unsigned char* lds = (LAS unsigned char*)lds_raw;
    const int wave_s = __builtin_amdgcn_readfirstlane((int)threadIdx.x >> 6);
#define LANE_NOW() ({ int l_; asm volatile("v_mbcnt_lo_u32_b32 %0, -1, 0\n\tv_mbcnt_hi_u32_b32 %0, -1, %0" : "=v"(l_)); l_; })
#define T0_NOW() (wave_s == 0 && LANE_NOW() == 0)
    { const int tid0 = wave_s * 64 + LANE_NOW();
      for (int u = tid0; u < (LDS_BYTES - LDSCTL_OFF) / 4; u += NWAVES * 64) ((LAS unsigned*)(lds + LDSCTL_OFF))[u] = 0u; }
    __syncthreads();
#define GEOM() int G_l = gridDim.x, bx_l = blockIdx.x; asm volatile("" : "+s"(G_l), "+s"(bx_l));   const int G = G_l, bx = bx_l, vcu = (G % 8 == 0) ? (bx % 8) * (G / 8) + bx / 8 : bx; const int wave = wave_s; const int gw = vcu * NWAVES + wave, NGW = G * NWAVES; (void)gw; (void)NGW; (void)vcu; (void)bx
#define BAROBJ() XcdBarrier bar; bar.bar = (unsigned*)(kargs()->ws + WS_CTL); bar.x = xb_xcc_id(); bar.st = (volatile LAS unsigned*)(lds + MISC_OFF) + 8
    { const KP* kp0 = kargs(); const int lo0 = kp0->ph_lo, hi0 = kp0->ph_hi;
      if (hi0 - lo0 > 1) { XcdBarrier b0 = xcd_barrier_post((unsigned*)(kp0->ws + WS_CTL), (volatile LAS unsigned*)(lds + MISC_OFF) + 8, T0_NOW());
        if (lo0 != 0) { if (T0_NOW()) { unsigned nloc, nx; xcd_barrier_complete(b0.bar, b0.x, nloc, nx); b0.st[0] = nloc; b0.st[1] = nx; } __syncthreads(); } } }
#ifndef PROBE_MASK
#define PROBE_MASK 0
#endif
#define REPS(bit) ((((PROBE_MASK) >> (bit)) & 1) ? 2 : 1)
#define RUN(k) (kargs()->ph_lo <= (k) && (k) < kargs()->ph_hi)
#ifdef PROBE_BAR2
#define SEAM(k) do { if (RUN(k) && RUN((k) + 1)) { BAROBJ(); xcd_barrier<false>(bar, T0_NOW()); xcd_barrier<false>(bar, T0_NOW()); } } while (0)
#else
#define SEAM(k) do { if (RUN(k) && RUN((k) + 1)) { BAROBJ(); xcd_barrier<false>(bar, T0_NOW()); } } while (0)
#endif
#define SEAM_FIRST(k) do { if (RUN(k) && RUN((k) + 1)) { BAROBJ(); xcd_barrier<true>(bar, T0_NOW()); } } while (0)
#define PHASE_ENV() const KP* kp = kargs(); unsigned char* ws = kp->ws; (void)ws; const int lane_p = LANE_NOW(); const int tid_p = wave_s * 64 + lane_p; (void)tid_p; (void)lane_p; GEOM(); \
    float* X = kp->out; bf16* XB = (bf16*)(ws + WS_XB); float* SSX = (float*)(ws + WS_SSX); float* SSQ = (float*)(ws + WS_SSQ); float* RCOS = (float*)(ws + WS_RCOS); float* RSIN = (float*)(ws + WS_RSIN); \
    LAS float* rstab = (LAS float*)(lds + RSTAB_OFF); (void)X; (void)XB; (void)SSX; (void)SSQ; (void)RCOS; (void)RSIN; (void)rstab
#define ATT_PTRS() bf16 *CQ = (bf16*)(ws + WS_CQ), *CKV = (bf16*)(ws + WS_CKV), *KR = (bf16*)(ws + WS_KR), *QBb = (bf16*)(ws + WS_QB), *KBb = (bf16*)(ws + WS_KB), *VBb = (bf16*)(ws + WS_VB), \
         *Qm = (bf16*)(ws + WS_Q), *KN = (bf16*)(ws + WS_KN), *Vm = (bf16*)(ws + WS_V), *AO = (bf16*)(ws + WS_AO); (void)CQ; (void)CKV; (void)KR; (void)QBb; (void)KBb; (void)VBb; (void)Qm; (void)KN; (void)Vm; (void)AO
#define MOE_PTRS() bf16 *HM = (bf16*)(ws + WS_HM), *XS = (bf16*)(ws + WS_XS); int* TOKE = (int*)(ws + WS_TOKE); float* TOKG = (float*)(ws + WS_TOKG); float* TOKRS = (float*)(ws + WS_TOKRS); int* POS = (int*)(ws + WS_POS); \
    int* CNT = (int*)(ws + WS_CNT); int* META = (int*)(ws + WS_META); float* ROWG = (float*)(ws + WS_ROWG); float* ROWRS = (float*)(ws + WS_ROWRS); bf16* WM13 = (bf16*)(ws + WS_WM); bf16* WM2 = WM13 + (size_t)NEXP * 2 * FF_ * D_; \
    (void)HM; (void)XS; (void)TOKE; (void)TOKG; (void)TOKRS; (void)POS; (void)CNT; (void)META; (void)ROWG; (void)ROWRS; (void)WM13; (void)WM2
#define WATT_PTRS() const bf16* WIN = (const bf16*)(ws + WS_WATT + (size_t)l * WATT_L); const bf16* WUQ = WIN + (size_t)IN_PAD * D_; const bf16* WUKV = WUQ + 768 * QL_; const bf16* WOUT = WUKV + 1024 * KVL_; (void)WIN; (void)WUQ; (void)WUKV; (void)WOUT

    if (RUN(0)) for (int rep_ = 0; rep_ < REPS(9); ++rep_) {
        PHASE_ENV();
        LAS float* scr = (LAS float*)(lds + wave * 16384);
        int base = 0;
        for (int j = 0; j < 22; ++j) {
            TrJob J;
            if (j < 16) { const int l = j >> 2, k = j & 3; bf16* wl = (bf16*)(ws + WS_WATT + (size_t)l * WATT_L);
                if (k == 0) J = TrJob{kp->in[2] + (size_t)l * D_ * IN_DIM, D_, IN_DIM, wl, kp->in[1] + l * D_, TM_IN, (int)f8_in_layer(l)};
                else if (k == 1) J = TrJob{kp->in[4] + (size_t)l * QL_ * 768, QL_, 768, wl + (size_t)IN_PAD * D_, kp->in[3] + l * QL_, TM_UQ, 0};
                else if (k == 2) J = TrJob{kp->in[6] + (size_t)l * KVL_ * 1024, KVL_, 1024, wl + (size_t)IN_PAD * D_ + 768 * QL_, kp->in[5] + l * KVL_, TM_UKV, 0};
                else J = TrJob{kp->in[8] + (size_t)l * D_ * D_, D_, D_, wl + (size_t)IN_PAD * D_ + 768 * QL_ + 1024 * KVL_, nullptr, TM_ID, (int)f8_out_layer(l)};
            } else { const int dl = (j - 16) / 3, k = (j - 16) % 3; bf16* wl = (bf16*)(ws + WS_WD + (size_t)dl * WD_L);
                if (k == 0) J = TrJob{kp->in[10] + (size_t)dl * D_ * FF_, D_, FF_, wl, kp->in[9] + (2 * dl) * D_, TM_W1, (int)f8_up_layer(2 * dl)};
                else if (k == 1) J = TrJob{kp->in[11] + (size_t)dl * D_ * FF_, D_, FF_, wl, kp->in[9] + (2 * dl) * D_, TM_W3, (int)f8_up_layer(2 * dl)};
                else J = TrJob{kp->in[12] + (size_t)dl * FF_ * D_, FF_, D_, wl + (size_t)2 * FF_ * D_, nullptr, TM_ID, (int)f8_layer(2 * dl)};
            }
            tr_run(J, base, gw, NGW, scr, lane_p);
        }
        for (int r = gw; r < DEPTH_ * 96; r += NGW) {
            const v4u z = {0u, 0u, 0u, 0u};
            if (f8_in_layer(r / 96)) { GAS v4u* o = (GAS v4u*)((unsigned char*)(ws + WS_WATT + (size_t)(r / 96) * WATT_L) + (size_t)(672 + r % 96) * D_) + lane_p; o[0] = z; }
            else { GAS v4u* o = (GAS v4u*)((bf16*)(ws + WS_WATT + (size_t)(r / 96) * WATT_L) + (size_t)(672 + r % 96) * D_) + lane_p; o[0] = z; o[64] = z; } }
        for (int idx = gw * 64 + lane_p; idx < 8192 * 16; idx += NGW * 64) {
            const int pos = idx >> 4, j = idx & 15, j4 = j & 3, jq = j >> 2;
            const double c4 = j4 == 0 ? 1.0 : j4 == 1 ? 0.5623413251903491 : j4 == 2 ? 0.31622776601683794 : 0.17782794100389228;
            const double p10 = jq == 0 ? 1.0 : jq == 1 ? 0.1 : jq == 2 ? 0.01 : 0.001;
            double a = (double)pos * (c4 * p10) * 0.15915494309189535; a -= __builtin_floor(a);
            const float rv = (float)a; RCOS[idx] = __builtin_amdgcn_cosf(rv); RSIN[idx] = __builtin_amdgcn_sinf(rv);
        }
        if (gw == 0) { const v4u z = {0u, 0u, 0u, 0u}; ((GAS v4u*)(ws + WS_ZERO))[lane_p] = z; }
        row_pass<true, false>(kp->in[0], nullptr, XB, SSX, nullptr, nullptr, nullptr, gw, NGW, lane_p, f8_in_layer(0) ? ws + WS_XQ2 : nullptr);
    }
    SEAM_FIRST(0);
    int step = 1;
    for (int l = 0; l < DEPTH_; ++l) {
        if (RUN(step)) for (int rep_ = 0; rep_ < REPS(0); ++rep_) {
            PHASE_ENV(); ATT_PTRS(); WATT_PTRS();
            pg8::Gemm g{XB, WIN, T_, IN_PAD, D_}; pg8::StaticOrder S; S.init(T_, IN_PAD, G, bx);
            pg8::EpiIn E{ws, 0.125f * LOG2E_, rstab, (int)f8_qk_layer(l)};
            if ((F8_IN_LAYERS) != 0 && f8_in_layer(l)) { pg8::Gemm g8{(const bf16*)(ws + ((l & 1) ? WS_XS : WS_XQ2)), WIN, T_, IN_PAD, D_};
                pg8::gemm_phase<pg8::EpiIn, pg8::StaticOrder, true, true, true>(lds, g8, S, E, wave_s * 64); }
            else pg8::gemm_phase<pg8::EpiIn, pg8::StaticOrder, true, true>(lds, g, S, E, wave_s * 64);
            { const int ml = l < 2 ? 1 : 3, a0 = l == 0 ? FA0 : l == 1 ? FA1 : l == 2 ? FA2 : FA3, n0 = l == 0 ? FN0 : l == 1 ? FN1 : l == 2 ? FN2 : FN3; moe_fill(kp, ws, ml, a0, a0 + n0, (T_ / 256) * (IN_PAD / 256), G, bx, wave, lds, lane_p); }
        }
        SEAM(step); ++step;
        if (RUN(step)) {
            for (int rep_ = 0; rep_ < REPS(1); ++rep_) { PHASE_ENV(); ATT_PTRS(); WATT_PTRS();
              pg8::Gemm g{CQ, WUQ, T_, 768, QL_}; pg8::StaticOrder S; S.init(T_, 768, G, bx);
              pg8::EpiQ E{ws, 0.10206207261596575f * LOG2E_, rstab, (int)f8_qk_layer(l)};
              pg8::gemm_phase<pg8::EpiQ, pg8::StaticOrder, true, true>(lds, g, S, E, wave_s * 64);
              { const int ml = l < 2 ? 1 : 3, a0 = l == 0 ? FA0 + FN0 : l == 1 ? FA1 + FN1 : l == 2 ? FA2 + FN2 : FA3 + FN3; moe_fill(kp, ws, ml, a0, a0 + FILL_UQ, (T_ / 256) * (768 / 256), G, bx, wave, lds, lane_p); } }
            for (int rep_ = 0; rep_ < REPS(1); ++rep_) { PHASE_ENV(); ATT_PTRS(); WATT_PTRS();
              pg8::Gemm g{CKV, WUKV, T_, 1024, KVL_}; pg8::StaticOrder S; S.init(T_, 1024, G, bx);
              pg8::EpiKV E{ws, rstab, (int)f8_qk_layer(l)};
              pg8::gemm_phase<pg8::EpiKV, pg8::StaticOrder, true, true>(lds, g, S, E, wave_s * 64); }
        }
        SEAM(step); ++step;
        if (RUN(step)) {
            for (int rep_ = 0; rep_ < REPS(2); ++rep_) { PHASE_ENV(); ATT_PTRS();
              const att::Args A{Qm, KN, KR, Vm, QBb, KBb, VBb, AO, kp->in[7] + (size_t)l * 8 * 257, (int)f8_out_layer(l), ws + WS_Q8, ws + WS_KN8, ws + WS_KR8, ws + WS_ZERO, (int)f8_qk_layer(l), ws + WS_QB8, ws + WS_KB8};
              att::attn_phase<false>(A, vcu, G, (LAS char*)lds, wave_s * 64); }
            for (int rep_ = 0; rep_ < REPS(3); ++rep_) { PHASE_ENV(); ATT_PTRS();
              const att::Args A{Qm, KN, KR, Vm, QBb, KBb, VBb, AO, kp->in[7] + (size_t)l * 8 * 257, (int)f8_out_layer(l), ws + WS_Q8, ws + WS_KN8, ws + WS_KR8, ws + WS_ZERO, (int)f8_qk_layer(l), ws + WS_QB8, ws + WS_KB8};
              att::attn_phase<true>(A, vcu, G, (LAS char*)lds, wave_s * 64); }
        }
        SEAM(step); ++step;
        if (RUN(step)) for (int rep_ = 0; rep_ < REPS(10); ++rep_) {
            PHASE_ENV(); ATT_PTRS(); WATT_PTRS();
            pg8::Gemm g{AO, WOUT, T_, D_, D_}; pg8::StaticOrder S; S.init(T_, D_, G, bx);
            if ((F8_OUT_LAYERS) != 0 && f8_out_layer(l)) {
                if ((F8_UP_LAYERS) != 0 && f8_up_layer(l)) { pg8::EpiResQ E{ws, rep_ + 1 < REPS(10)}; pg8::gemm_phase<pg8::EpiResQ, pg8::StaticOrder, true, true, true>(lds, g, S, E, wave_s * 64); }
                else { pg8::EpiRes E{ws, rep_ + 1 < REPS(10)}; pg8::gemm_phase<pg8::EpiRes, pg8::StaticOrder, true, true, true>(lds, g, S, E, wave_s * 64); } }
            else if ((F8_UP_LAYERS) != 0 && f8_up_layer(l)) { pg8::EpiResQ E{ws, rep_ + 1 < REPS(10)}; pg8::gemm_phase<pg8::EpiResQ, pg8::StaticOrder, true, true>(lds, g, S, E, wave_s * 64); }
            else { pg8::EpiRes E{ws, rep_ + 1 < REPS(10)}; pg8::gemm_phase<pg8::EpiRes, pg8::StaticOrder, true, true>(lds, g, S, E, wave_s * 64); }
        }
        SEAM(step); ++step;
        if ((l & 1) == 0) {
            if (RUN(step)) for (int rep_ = 0; rep_ < REPS(4); ++rep_) {
                PHASE_ENV(); MOE_PTRS();
                const bf16* W13 = (const bf16*)(ws + WS_WD + (size_t)(l >> 1) * WD_L);
                pg8::Gemm g{XB, W13, T_, 2 * FF_, D_}; pg8::StaticOrder S; S.init(T_, 2 * FF_, G, bx);
#ifdef PROBE_NULLEPI
                if (rep_ + 1 < REPS(4)) { pg8::EpiNull E{ws}; pg8::gemm_phase<pg8::EpiNull, pg8::StaticOrder, true, true>(lds, g, S, E, wave_s * 64); } else
#endif
                if ((F8_UP_LAYERS) != 0 && f8_up_layer(l)) { pg8::Gemm g8{XS, W13, T_, 2 * FF_, D_}; pg8::EpiGLU<false, true> E{ws, rstab}; pg8::gemm_phase<pg8::EpiGLU<false, true>, pg8::StaticOrder, true, true, true>(lds, g8, S, E, wave_s * 64); }
                else                 if (F8_DENSE_ANY && (F8_DENSE_ALL || f8_layer(l))) { pg8::EpiGLU<false, true> E{ws, rstab}; pg8::gemm_phase<pg8::EpiGLU<false, true>, pg8::StaticOrder, true, true>(lds, g, S, E, wave_s * 64); }
                else if (!F8_DENSE_ALL) { pg8::EpiGLU<false, false> E{ws, rstab}; pg8::gemm_phase<pg8::EpiGLU<false, false>, pg8::StaticOrder, true, true>(lds, g, S, E, wave_s * 64); }
            }
            SEAM(step); ++step;
            if (RUN(step)) for (int rep_ = 0; rep_ < REPS(11); ++rep_) {
                PHASE_ENV(); MOE_PTRS();
                const bf16* W2 = (const bf16*)(ws + WS_WD + (size_t)(l >> 1) * WD_L) + (size_t)2 * FF_ * D_;
                pg8::Gemm g{HM, W2, T_, D_, FF_}; pg8::StaticOrder S; S.init(T_, D_, G, bx);
                pg8::EpiRes E{ws, rep_ + 1 < REPS(11)};
                if ((F8_IN_LAYERS) != 0 && f8_in_layer(l + 1) && f8_layer(l)) { pg8::EpiResQ EQ{ws, rep_ + 1 < REPS(11)}; pg8::gemm_phase<pg8::EpiResQ, pg8::StaticOrder, true, true, true>(lds, g, S, EQ, wave_s * 64); }
                else if (F8_DENSE_ANY && (F8_DENSE_ALL || f8_layer(l))) pg8::gemm_phase<pg8::EpiRes, pg8::StaticOrder, true, true, true>(lds, g, S, E, wave_s * 64);
                else if ((F8_IN_LAYERS) != 0 && f8_in_layer(l + 1)) { pg8::EpiResQ EQ{ws, rep_ + 1 < REPS(11)}; pg8::gemm_phase<pg8::EpiResQ, pg8::StaticOrder, true, true, false>(lds, g, S, EQ, wave_s * 64); }
                else if (!F8_DENSE_ALL) pg8::gemm_phase<pg8::EpiRes, pg8::StaticOrder, true, true, false>(lds, g, S, E, wave_s * 64);
            }
            SEAM(step); ++step;
        } else {
            const int mj = l >> 1;
            if (RUN(step)) for (int rep_ = 0; rep_ < REPS(5); ++rep_) {
                PHASE_ENV(); MOE_PTRS();
                moe_route1(lds, XB, SSX, kp->in[13] + (size_t)mj * D_ * NEXP, kp->in[9] + l * D_, TOKE, TOKG, TOKRS, CNT, bx, G, tid_p, wave, lane_p);
                __syncthreads();
                LAS float* scr = (LAS float*)(lds + wave * 16384);
                for (int g = (l == 1 ? L1_DONE : L3_DONE) + gw; g < MOE_ITEMS; g += NGW) { TrJob J; int it; moe_job(kp, ws, l, g, J, it); tr_item(J, it, scr, lane_p); }
                __syncthreads();
            }
            SEAM(step); ++step;
            if (RUN(step)) for (int rep_ = 0; rep_ < REPS(6); ++rep_) { PHASE_ENV(); MOE_PTRS(); moe_route2(lds, XB, XS, TOKE, TOKG, TOKRS, CNT, POS, ROWG, ROWRS, META, bx, G, tid_p, wave, lane_p, f8_layer(l)); }
            SEAM(step); ++step;
            if (RUN(step)) for (int rep_ = 0; rep_ < REPS(7); ++rep_) {
                PHASE_ENV(); MOE_PTRS();
                pg8::MoeOrder S;
#pragma unroll
                for (int e = 0; e < 8; ++e) S.pe[e] = __builtin_amdgcn_readfirstlane(META[e]);
                const int mrows = S.pe[7];
                S.estride = (size_t)2 * FF_ * D_ * (f8_layer(l) ? 1 : 2); S.so.init(mrows, 2 * FF_, G, bx);
                pg8::Gemm g{XS, WM13, mrows, 2 * FF_, D_, 0x79797979, 0x7b7b7b7b};
                if (F8_MOE_ANY && (F8_MOE_ALL || f8_layer(l))) { pg8::EpiGLU<true, true, true> E{ws, rstab}; pg8::gemm_phase<pg8::EpiGLU<true, true, true>, pg8::MoeOrder, true, true, true>(lds, g, S, E, wave_s * 64); }
                else if (!F8_MOE_ALL) { pg8::EpiGLU<true, false> E{ws, rstab}; pg8::gemm_phase<pg8::EpiGLU<true, false>, pg8::MoeOrder, true, true>(lds, g, S, E, wave_s * 64); }
            }
            SEAM(step); ++step;
            if (RUN(step)) for (int rep_ = 0; rep_ < REPS(8); ++rep_) {
                PHASE_ENV(); MOE_PTRS();
                pg8::MoeOrder S;
#pragma unroll
                for (int e = 0; e < 8; ++e) S.pe[e] = __builtin_amdgcn_readfirstlane(META[e]);
                const int mrows = S.pe[7];
                S.estride = (size_t)FF_ * D_ * (f8_layer(l) ? 1 : 2); S.so.init(mrows, D_, G, bx);
                pg8::Gemm g{HM, WM2, mrows, D_, FF_};
                pg8::EpiY E{ws, rstab};
                if (F8_MOE_ANY && (F8_MOE_ALL || f8_layer(l))) pg8::gemm_phase<pg8::EpiY, pg8::MoeOrder, true, true, true>(lds, g, S, E, wave_s * 64);
                else if (!F8_MOE_ALL) pg8::gemm_phase<pg8::EpiY, pg8::MoeOrder, true, true, false>(lds, g, S, E, wave_s * 64);
                if (l == 1) moe_fill(kp, ws, 3, 0, FILL_MD, (mrows / 256) * (D_ / 256), G, bx, wave, lds, lane_p);
            }
            SEAM(step); ++step;
            if (RUN(step)) {
                PHASE_ENV(); MOE_PTRS();
                if (l == DEPTH_ - 1) row_pass<false, true>(nullptr, X, XB, SSX, XS, POS, kp->in[17], gw, NGW, lane_p);
                else row_pass<false, false>(nullptr, nullptr, XB, SSX, XS, POS, nullptr, gw, NGW, lane_p, f8_in_layer(l + 1) ? ws + WS_XQ2 : nullptr);
            }
            SEAM(step); ++step;
        }
    }
#undef RUN
#undef SEAM
#undef SEAM_FIRST
#undef GEOM
#undef BAROBJ
#undef LANE_NOW
#undef T0_NOW
}

extern "C" void kernel_launch(void* const* d_in, const int* in_sizes, int n_in, void* d_out, int out_size, void* d_ws, size_t ws_size, hipStream_t stream) {
    static int grid = 0;
    if (grid == 0) {
        if (n_in != 18 || in_sizes[0] != T_ * D_ || out_size != T_ * D_ || ws_size < WS_END) { fprintf(stderr, "kernel_launch: unexpected shapes / workspace (n_in %d, ws %zu, need %zu); nothing launched\n", n_in, ws_size, (size_t)WS_END); grid = -1; return; }
        int dev = 0, cus = 0;
        if (hipGetDevice(&dev) != hipSuccess || hipDeviceGetAttribute(&cus, hipDeviceAttributeMultiprocessorCount, dev) != hipSuccess) { grid = -1; return; }
        if (hipFuncSetAttribute((const void*)hybrid_fwd, hipFuncAttributeMaxDynamicSharedMemorySize, LDS_BYTES) != hipSuccess) { fprintf(stderr, "kernel_launch: hipFuncSetAttribute failed\n"); grid = -1; return; }
        int per_cu = 0;
        if (hipOccupancyMaxActiveBlocksPerMultiprocessor(&per_cu, (const void*)hybrid_fwd, NWAVES * 64, LDS_BYTES) != hipSuccess || per_cu < 1) fprintf(stderr, "kernel_launch: occupancy query reports %d blocks per CU\n", per_cu);
        (void)hipGetLastError();
        grid = cus;
    }
    if (grid < 0) return;
    (void)hipMemsetAsync((char*)d_ws + WS_CTL, 0, CTL_ZERO_BYTES, stream);
    Params p{};
    for (int i = 0; i < 18; ++i) p.in[i] = (const float*)d_in[i];
    p.out = (float*)d_out; p.ws = (unsigned char*)d_ws;
#if MK_ONE_LAUNCH
    p.ph_lo = 0; p.ph_hi = NSTEPS;
    hipLaunchKernelGGL(hybrid_fwd, dim3(grid), dim3(NWAVES * 64), LDS_BYTES, stream, p);
#else
    for (int s = 0; s < NSTEPS; ++s) { p.ph_lo = s; p.ph_hi = s + 1; hipLaunchKernelGGL(hybrid_fwd, dim3(grid), dim3(NWAVES * 64), LDS_BYTES, stream, p); }
#endif
}
```

```cpp
#include <hip/hip_runtime.h>
#include <cstdio>
#include <cstdint>
constexpr int NWAVES = 8;
constexpr int T_ = 32768, D_ = 1024, DEPTH_ = 4, IN_DIM = 2208, IN_PAD = 2304, FF_ = 3584, NEXP = 8, QL_ = 384, KVL_ = 256;
constexpr int MAXROWS = 2 * T_ + NEXP * 256;
constexpr float EPS_ = 1e-6f, LOG2E_ = 1.4426950408889634f;
#ifndef MK_ONE_LAUNCH
#define MK_ONE_LAUNCH 1
#endif
#ifndef F8_LAYERS
#define F8_LAYERS 0xE
#endif
constexpr bool f8_layer(int l) { return ((F8_LAYERS) >> l) & 1; }
#ifndef F8_UP_LAYERS
#define F8_UP_LAYERS 0x4
#endif
constexpr bool f8_up_layer(int l) { return ((F8_UP_LAYERS) >> l) & 1; }
#ifndef F8_QK_LAYERS
#define F8_QK_LAYERS 0xF
#endif
constexpr bool f8_qk_layer(int l) { return l >= 0 && l < 4 && (((F8_QK_LAYERS) >> l) & 1); }
#ifndef F8_OUT_LAYERS
#define F8_OUT_LAYERS 0xC
#endif
constexpr bool f8_out_layer(int l) { return l >= 0 && l < 4 && (((F8_OUT_LAYERS) >> l) & 1); }
#ifndef F8_IN_LAYERS
#define F8_IN_LAYERS 0xC
#endif
constexpr bool f8_in_layer(int l) { return l >= 0 && l < 4 && (((F8_IN_LAYERS) >> l) & 1); }
static_assert(((F8_UP_LAYERS) & ~(F8_LAYERS) & 0xF) == 0 && ((F8_UP_LAYERS) & 0xA) == 0, "fp8 up-projection: dense layers whose down-projection is fp8");
constexpr bool F8_DENSE_ANY = (F8_LAYERS & 0x5) != 0, F8_DENSE_ALL = (F8_LAYERS & 0x5) == 0x5, F8_MOE_ANY = (F8_LAYERS & 0xA) != 0, F8_MOE_ALL = (F8_LAYERS & 0xA) == 0xA;
constexpr int NSTEPS = 31;
constexpr size_t MiB = 1u << 20;
constexpr size_t WS_CTL = 0, CTL_ZERO_BYTES = 65536;
constexpr size_t WS_RCOS = 1 * MiB, WS_RSIN = WS_RCOS + 512 * 1024;
constexpr size_t WS_SSX = 2 * MiB;
constexpr size_t WS_SSQ = 4 * MiB;
constexpr size_t WS_TOKE = 7 * MiB, WS_TOKG = WS_TOKE + 128 * 1024, WS_TOKRS = WS_TOKG + 256 * 1024, WS_POS = WS_TOKRS + 128 * 1024,
                 WS_CNT = WS_POS + 256 * 1024, WS_META = WS_CNT + 8192, WS_ROWG = 8 * MiB, WS_ROWRS = WS_ROWG + 512 * 1024;
constexpr size_t WATT_L = (size_t)(IN_PAD * D_ + 768 * QL_ + 1024 * KVL_ + D_ * D_) * 2;
constexpr size_t WS_WATT = 10 * MiB;
constexpr size_t WD_L = (size_t)3 * D_ * FF_ * 2;
constexpr size_t WS_WD = 41 * MiB;
constexpr size_t WS_WM = 83 * MiB;
constexpr size_t WS_XQ2 = WS_WM + 56 * MiB;
static_assert((F8_IN_LAYERS) == 0 || F8_MOE_ALL, "WS_XQ2 overlays the bf16 half of the MoE W13 buffer");
constexpr size_t WS_XB = 251 * MiB;
constexpr size_t WS_XS = 315 * MiB;
constexpr size_t WS_HM = 447 * MiB;
constexpr size_t WS_CQ = WS_HM, WS_CKV = WS_CQ + 24 * MiB, WS_KR = WS_CKV + 16 * MiB, WS_QB = WS_KR + 2 * MiB, WS_KB = WS_QB + 32 * MiB, WS_VB = WS_KB + 32 * MiB,
                 WS_Q = WS_VB + 32 * MiB, WS_KN = WS_Q + 48 * MiB, WS_V = WS_KN + 32 * MiB, WS_AO = WS_V + 32 * MiB;
constexpr size_t WS_Q8 = WS_AO + 64 * MiB, WS_KN8 = WS_Q8 + 24 * MiB, WS_KR8 = WS_KN8 + 16 * MiB, WS_ZERO = WS_KR8 + 1 * MiB;
constexpr size_t WS_END = WS_HM + (size_t)MAXROWS * FF_ * 2;
static_assert(WS_ZERO + 1024 <= WS_END && WS_Q8 >= WS_HM + (size_t)MAXROWS * FF_ && WS_Q8 >= WS_HM + (size_t)T_ * FF_ * 2 && ((F8_QK_LAYERS) == 0 || F8_MOE_ALL), "fp8 attention copies sit above the FFN hidden rows");
static_assert(WS_AO + 64 * MiB <= WS_END && WS_WATT + 4 * WATT_L <= WS_WD && WS_WD + 2 * WD_L <= WS_WM && WS_WM + 8 * WD_L <= WS_XB && WS_XS + (size_t)MAXROWS * D_ * 2 <= WS_HM, "d_ws map");
constexpr int RING_BYTES = 131072, LDSCTL_OFF = RING_BYTES, MISC_OFF = LDSCTL_OFF + 320, RSTAB_OFF = LDSCTL_OFF + 1024, LDS_BYTES = 147456;

namespace pg8 {
#define PG8_LAS __attribute__((address_space(3)))
typedef unsigned short bf16_t;
typedef short bf16x8 __attribute__((ext_vector_type(8)));
typedef float f32x4 __attribute__((ext_vector_type(4)));
typedef unsigned u32x4 __attribute__((ext_vector_type(4)));
typedef int v4i32 __attribute__((ext_vector_type(4)));
typedef int v8i32 __attribute__((ext_vector_type(8)));
typedef unsigned u32x2 __attribute__((ext_vector_type(2)));
constexpr int BM = 256, BK = 64, HALF = 128, HTB = HALF * BK * 2  , STAGE_BYTES = 8 * HTB, NXCD = 8, WGM = 8;

__host__ __device__ __forceinline__ int lds_byte(int r, int c) { const int st = (r >> 4) * 2 + (c >> 5), rr = r & 15, cc = c & 31, ob = rr * 64 + cc * 2; return st * 1024 + (ob ^ (((ob >> 9) & 1) << 5)); }
__host__ __device__ __forceinline__ void stage_rc(int b, int& R, int& C) { const int st = b / 1024, sb = b % 1024, swz = sb ^ (((sb >> 9) & 1) << 5); R = (st >> 1) * 16 + swz / 64; C = (st & 1) * 32 + (swz % 64) / 2; }
__host__ __device__ __forceinline__ int perm32(int rho) { const int n = rho >> 4, i = rho & 15; return 8 * (i >> 2) + 4 * n + (i & 3); }

struct Unit { int pm, pn; };
struct Gemm { const bf16_t* A; const bf16_t* Bt; int M, N, K; int scw = 0x79797979, sch = 0x7c7c7c7c; };

struct StaticOrder {
    int nM, nN, nwg, G, c;
    __host__ __device__ void init(int M, int N, int G_, int c_) { nM = M / BM; nN = N / BM; nwg = nM * nN; G = G_; c = c_; }
    __host__ __device__ bool next(int i, Unit& u) const {
        const long L = (long)i * G + c; if (L >= nwg) return false;
        int wgid = (int)L; { const int q = nwg / NXCD, r = nwg % NXCD, xcd = wgid % NXCD, off = wgid / NXCD; wgid = (xcd < r ? xcd * (q + 1) : r * (q + 1) + (xcd - r) * q) + off; }
        const int nig = WGM * nN, gid = wgid / nig, fm = gid * WGM, gsz = (nM - fm) < WGM ? (nM - fm) : WGM;
        u.pm = fm + ((wgid % nig) % gsz); u.pn = (wgid % nig) / gsz; return true;
    }
    __device__ __forceinline__ size_t boff(const Unit&) const { return 0; }
    __device__ __forceinline__ void a_ready(const Unit&) const {}
    __device__ __forceinline__ void done(const Unit&) const {}
};

__device__ __forceinline__ unsigned cvt_pk_bf16(float lo, float hi) { unsigned r; asm volatile("v_cvt_pk_bf16_f32 %0, %1, %2" : "=v"(r) : "v"(lo), "v"(hi)); return r; }
typedef float f32x2 __attribute__((ext_vector_type(2)));
__device__ __forceinline__ u32x4 pack8(const f32x4 a, const f32x4 b) { u32x4 w; w.x = cvt_pk_bf16(a[0], a[1]); w.y = cvt_pk_bf16(a[2], a[3]); w.z = cvt_pk_bf16(b[0], b[1]); w.w = cvt_pk_bf16(b[2], b[3]); return w; }
__device__ __forceinline__ float sumsq4(const f32x4 v) { return (v[0] * v[0] + v[1] * v[1]) + (v[2] * v[2] + v[3] * v[3]); }
__device__ __forceinline__ float xor16_add(float v) { return v + __int_as_float(__builtin_amdgcn_ds_swizzle(__float_as_int(v), 0x401F)); }
__device__ __forceinline__ float xor32_add(float v) { auto rr = __builtin_amdgcn_permlane32_swap(__float_as_uint(v), __float_as_uint(v), false, false); return __uint_as_float(rr[0]) + __uint_as_float(rr[1]); }
__device__ __forceinline__ float silu_f(float x) { return x * __builtin_amdgcn_rcpf(1.0f + __builtin_amdgcn_exp2f(-1.4426950409f * x)); }
template <int NP4, int PITCH, int OFF>
__device__ __forceinline__ void rs_table(const float* part, int rowbase, int wr, int lane, float inv_dim, PG8_LAS float* t) {
    f32x4 s[2][NP4];
#pragma unroll
    for (int ai = 0; ai < 2; ++ai) { const f32x4* p = (const f32x4*)(part + (size_t)(rowbase + ai * 128 + wr * 64 + lane) * PITCH + OFF);
#pragma unroll
        for (int j = 0; j < NP4; ++j) s[ai][j] = p[j]; }
#pragma unroll
    for (int ai = 0; ai < 2; ++ai) { f32x4 a = s[ai][0];
#pragma unroll
        for (int j = 1; j < NP4; ++j) a += s[ai][j];
        t[ai * 64 + lane] = __builtin_amdgcn_rsqf(((a[0] + a[1]) + (a[2] + a[3])) * inv_dim + 1e-6f); }
    asm volatile("s_waitcnt lgkmcnt(0)" ::: "memory");
}
constexpr int DM = 1024, FFN = 3584, SEQ_ = 8192;

__device__ __forceinline__ f32x4 bf2f_lo(const u32x4 w, int h) { const unsigned a = h ? w.z : w.x, b = h ? w.w : w.y; return (f32x4){__uint_as_float(a << 16), __uint_as_float(a & 0xffff0000u), __uint_as_float(b << 16), __uint_as_float(b & 0xffff0000u)}; }
struct EpiRes {
    static constexpr bool PERM = true, AFTER_DRAIN = false, PREFETCH = false;
    unsigned char* ws; bool dummy;
    __device__ __forceinline__ void operator()(const f32x4 (&acc)[2][2][4][2], const Unit& u, int wr, int wc, int fr, int fq) const {
        bf16_t* xb = (bf16_t*)(ws + (dummy ? WS_XS : WS_XB)); float* ssx = (float*)(ws + (dummy ? WS_SSQ : WS_SSX));
        const int row0 = u.pm * BM + wr * 64 + fr, col0 = u.pn * BM + wc * 32 + 8 * fq;
        u32x4 old[2][4][2];
#pragma unroll
        for (int ai = 0; ai < 2; ++ai)
#pragma unroll
            for (int m = 0; m < 4; ++m)
#pragma unroll
                for (int bj = 0; bj < 2; ++bj) old[ai][m][bj] = *(const u32x4*)(xb + (size_t)(row0 + ai * HALF + m * 16) * DM + col0 + bj * HALF);
#pragma unroll
        for (int ai = 0; ai < 2; ++ai)
#pragma unroll
            for (int m = 0; m < 4; ++m) {
                const int row = row0 + ai * HALF + m * 16; float ss = 0.f;
#pragma unroll
                for (int bj = 0; bj < 2; ++bj) {
                    const f32x4 v0 = bf2f_lo(old[ai][m][bj], 0) + acc[ai][bj][m][0], v1 = bf2f_lo(old[ai][m][bj], 1) + acc[ai][bj][m][1];
                    ss += sumsq4(v0) + sumsq4(v1);
                    *(u32x4*)(xb + (size_t)row * DM + col0 + bj * HALF) = pack8(v0, v1);
                }
                ss = xor32_add(xor16_add(ss));
                if (fq == 0) ssx[(size_t)row * 16 + u.pn * 4 + wc] = ss;
            }
    }
};
__device__ __forceinline__ unsigned pack4_fp8_x16(const f32x4 v) { int w = 0; w = __builtin_amdgcn_cvt_pk_fp8_f32(__builtin_amdgcn_fmed3f(v[0] * 16.0f, -448.0f, 448.0f), __builtin_amdgcn_fmed3f(v[1] * 16.0f, -448.0f, 448.0f), w, false);
    w = __builtin_amdgcn_cvt_pk_fp8_f32(__builtin_amdgcn_fmed3f(v[2] * 16.0f, -448.0f, 448.0f), __builtin_amdgcn_fmed3f(v[3] * 16.0f, -448.0f, 448.0f), w, true); return (unsigned)w; }
__device__ __forceinline__ unsigned pack4_fp8_x8(const f32x4 v) { int w = 0; w = __builtin_amdgcn_cvt_pk_fp8_f32(__builtin_amdgcn_fmed3f(v[0] * 8.0f, -448.0f, 448.0f), __builtin_amdgcn_fmed3f(v[1] * 8.0f, -448.0f, 448.0f), w, false);
    w = __builtin_amdgcn_cvt_pk_fp8_f32(__builtin_amdgcn_fmed3f(v[2] * 8.0f, -448.0f, 448.0f), __builtin_amdgcn_fmed3f(v[3] * 8.0f, -448.0f, 448.0f), w, true); return (unsigned)w; }
struct EpiResQ {
    static constexpr bool PERM = true, AFTER_DRAIN = false, PREFETCH = false;
    unsigned char* ws; bool dummy;
    __device__ __forceinline__ void operator()(const f32x4 (&acc)[2][2][4][2], const Unit& u, int wr, int wc, int fr, int fq) const {
        bf16_t* xb = (bf16_t*)(ws + (dummy ? WS_XS : WS_XB)); float* ssx = (float*)(ws + (dummy ? WS_SSQ : WS_SSX)); unsigned char* xq = ws + WS_XS + (dummy ? (size_t)64 * 1024 * 1024 : 0);
        const int row0 = u.pm * BM + wr * 64 + fr, col0 = u.pn * BM + wc * 32 + 8 * fq;
#pragma unroll
        for (int ai = 0; ai < 2; ++ai) {
            u32x4 old[4][2];
#pragma unroll
            for (int m = 0; m < 4; ++m)
#pragma unroll
                for (int bj = 0; bj < 2; ++bj) old[m][bj] = *(const u32x4*)(xb + (size_t)(row0 + ai * HALF + m * 16) * DM + col0 + bj * HALF);
#pragma unroll
            for (int m = 0; m < 4; ++m) {
                const int row = row0 + ai * HALF + m * 16; float ss = 0.f;
#pragma unroll
                for (int bj = 0; bj < 2; ++bj) {
                    const f32x4 v0 = bf2f_lo(old[m][bj], 0) + acc[ai][bj][m][0], v1 = bf2f_lo(old[m][bj], 1) + acc[ai][bj][m][1];
                    ss += sumsq4(v0) + sumsq4(v1);
                    *(u32x4*)(xb + (size_t)row * DM + col0 + bj * HALF) = pack8(v0, v1);
                    { u32x2 w8; w8.x = pack4_fp8_x8(v0); w8.y = pack4_fp8_x8(v1); *(u32x2*)(xq + (size_t)row * DM + col0 + bj * HALF) = w8; }
                }
                ss = xor32_add(xor16_add(ss));
                if (fq == 0) ssx[(size_t)row * 16 + u.pn * 4 + wc] = ss;
            }
        }
    }
};
__device__ __forceinline__ unsigned pack4_fp8(const f32x4 v) { int w = 0; w = __builtin_amdgcn_cvt_pk_fp8_f32(__builtin_amdgcn_fmed3f(v[0] * 8.0f, -448.0f, 448.0f), __builtin_amdgcn_fmed3f(v[1] * 8.0f, -448.0f, 448.0f), w, false);
    w = __builtin_amdgcn_cvt_pk_fp8_f32(__builtin_amdgcn_fmed3f(v[2] * 8.0f, -448.0f, 448.0f), __builtin_amdgcn_fmed3f(v[3] * 8.0f, -448.0f, 448.0f), w, true); return (unsigned)w; }
template <bool MOE, bool F8OUT = true, bool NORS = false> struct EpiGLU {
    static constexpr bool PERM = true, AFTER_DRAIN = false, PREFETCH = false;
    unsigned char* ws; PG8_LAS float* tab;
    __device__ __forceinline__ void operator()(const f32x4 (&acc)[2][2][4][2], const Unit& u, int wr, int wc, int fr, int fq) const {
        const int lane = fq * 16 + fr, wid = wr * 4 + wc; float rs[2][4];
        bf16_t* h = (bf16_t*)(ws + WS_HM); const float* part = (const float*)(ws + (MOE ? WS_ROWRS : WS_SSX));
        if (NORS) {
            asm volatile("s_waitcnt vmcnt(0)" ::: "memory");
#pragma unroll
            for (int ai = 0; ai < 2; ++ai)
#pragma unroll
                for (int m = 0; m < 4; ++m) rs[ai][m] = 1.0f;
        } else if (MOE) {
#pragma unroll
            for (int ai = 0; ai < 2; ++ai)
#pragma unroll
                for (int m = 0; m < 4; ++m) rs[ai][m] = part[u.pm * BM + ai * HALF + wr * 64 + m * 16 + fr];
        } else {
            PG8_LAS float* t = tab + wid * 128; rs_table<4, 16, 0>(part, u.pm * BM, wr, lane, 1.0f / DM, t);
#pragma unroll
            for (int ai = 0; ai < 2; ++ai)
#pragma unroll
                for (int m = 0; m < 4; ++m) rs[ai][m] = t[ai * 64 + m * 16 + fr];
        }
        const int row0 = u.pm * BM + wr * 64 + fr, col0 = u.pn * HALF + wc * 32 + 8 * fq;
#pragma unroll
        for (int ai = 0; ai < 2; ++ai)
#pragma unroll
            for (int m = 0; m < 4; ++m) {
                const float r = rs[ai][m]; f32x4 o[2];
#pragma unroll
                for (int n = 0; n < 2; ++n) { const f32x4 a = acc[ai][0][m][n] * r, b = acc[ai][1][m][n] * r;
                    o[n] = (f32x4){silu_f(a[0]) * b[0], silu_f(a[1]) * b[1], silu_f(a[2]) * b[2], silu_f(a[3]) * b[3]}; }
                if (F8OUT) { u32x2 w; w.x = pack4_fp8(o[0]); w.y = pack4_fp8(o[1]); *(u32x2*)((unsigned char*)h + (size_t)(row0 + ai * HALF + m * 16) * FFN + col0) = w; }
                else *(u32x4*)(h + (size_t)(row0 + ai * HALF + m * 16) * FFN + col0) = pack8(o[0], o[1]);
            }
    }
};
struct EpiY {
    static constexpr bool PERM = true, AFTER_DRAIN = false, PREFETCH = true;
    unsigned char* ws; PG8_LAS float* tab;
    __device__ __forceinline__ void prefetch(const Unit& u, int wid, int lane) const {
        const float* rowg = (const float*)(ws + WS_ROWG);
        __builtin_amdgcn_global_load_lds((const unsigned*)(rowg + (size_t)u.pm * BM + lane * 4), (PG8_LAS unsigned*)(tab + wid * 256), 16, 0, 0);
    }
    __device__ __forceinline__ void operator()(const f32x4 (&acc)[2][2][4][2], const Unit& u, int wr, int wc, int fr, int fq) const {
        bf16_t* y = (bf16_t*)(ws + WS_XS); const PG8_LAS float* t = tab + (wr * 4 + wc) * 256;
        const int row0 = u.pm * BM + wr * 64 + fr, col0 = u.pn * BM + wc * 32 + 8 * fq;
#pragma unroll
        for (int ai = 0; ai < 2; ++ai)
#pragma unroll
            for (int m = 0; m < 4; ++m) { const int row = row0 + ai * HALF + m * 16; const float g = t[ai * HALF + wr * 64 + m * 16 + fr];
#pragma unroll
                for (int bj = 0; bj < 2; ++bj) *(u32x4*)(y + (size_t)row * DM + col0 + bj * HALF) = pack8(acc[ai][bj][m][0] * g, acc[ai][bj][m][1] * g); }
    }
};
__device__ __forceinline__ void rope8(f32x4& v0, f32x4& v1, const float* rcos, const float* rsin, int pos, int fq) {
    const f32x4 c = *(const f32x4*)(rcos + pos * 16 + 4 * fq), s = *(const f32x4*)(rsin + pos * 16 + 4 * fq);
    const f32x4 o0 = v0 * c - v1 * s, o1 = v0 * s + v1 * c; v0 = o0; v1 = o1;
}
struct EpiIn {
    static constexpr bool PERM = true, AFTER_DRAIN = false, PREFETCH = false;
    unsigned char* ws; float qbscale; PG8_LAS float* tab; int f8qk = 0;
    __device__ __forceinline__ void operator()(const f32x4 (&acc)[2][2][4][2], const Unit& u, int wr, int wc, int fr, int fq) const {
        const int lane = fq * 16 + fr, wid = wr * 4 + wc;
        const float* ssx = (const float*)(ws + WS_SSX); float* ssq = (float*)(ws + WS_SSQ); const float* rcos = (const float*)(ws + WS_RCOS); const float* rsin = (const float*)(ws + WS_RSIN);
        bf16_t *cq = (bf16_t*)(ws + WS_CQ), *ckv = (bf16_t*)(ws + WS_CKV), *kr = (bf16_t*)(ws + WS_KR), *qb = (bf16_t*)(ws + WS_QB), *kb = (bf16_t*)(ws + WS_KB), *vb = (bf16_t*)(ws + WS_VB);
        PG8_LAS float* t = tab + wid * 128; rs_table<4, 16, 0>(ssx, u.pm * BM, wr, lane, 1.0f / DM, t);
        const int row0 = u.pm * BM + wr * 64 + fr;
#pragma unroll
        for (int bj = 0; bj < 2; ++bj) {
            const int colg = u.pn * BM + bj * HALF + wc * 32;
            if (colg >= 672 && colg < 768) continue;
            bf16_t* dst; int pitch, kind = 0, sidx = 0; float sc = 1.f;
            if (colg < 384) { dst = cq + colg; pitch = 384; kind = 1; sidx = colg >> 5; }
            else if (colg < 640) { dst = ckv + (colg - 384); pitch = 256; kind = 1; sidx = colg >> 5; }
            else if (colg < 672) { dst = kr; pitch = 32; kind = 2; }
            else if (colg < 1280) { dst = qb + (colg - 768); pitch = 512; sc = qbscale; }
            else if (colg < 1792) { dst = kb + (colg - 1280); pitch = 512; }
            else { dst = vb + (colg - 1792); pitch = 512; }
#pragma unroll
            for (int ai = 0; ai < 2; ++ai)
#pragma unroll
                for (int m = 0; m < 4; ++m) {
                    const int row = row0 + ai * HALF + m * 16; const float r = t[ai * 64 + m * 16 + fr] * sc;
                    f32x4 v0 = acc[ai][bj][m][0] * r, v1 = acc[ai][bj][m][1] * r;
                    if (kind == 2) rope8(v0, v1, rcos, rsin, row & (SEQ_ - 1), fq);
                    *(u32x4*)(dst + (size_t)row * pitch + 8 * fq) = pack8(v0, v1);
                    if (kind == 2 && f8qk) { u32x2 w8; w8.x = pack4_fp8_x8(v0); w8.y = pack4_fp8_x8(v1); *(u32x2*)(ws + WS_KR8 + (size_t)row * 32 + 8 * fq) = w8; }
                    if (kind == 1) { float ss = sumsq4(v0) + sumsq4(v1); ss = xor32_add(xor16_add(ss)); if (fq == 0) ssq[(size_t)row * 20 + sidx] = ss; }
                }
        }
    }
};
struct EpiQ {
    static constexpr bool PERM = true, AFTER_DRAIN = false, PREFETCH = false;
    unsigned char* ws; float qscale; PG8_LAS float* tab; int f8qk = 0;
    __device__ __forceinline__ void operator()(const f32x4 (&acc)[2][2][4][2], const Unit& u, int wr, int wc, int fr, int fq) const {
        const int lane = fq * 16 + fr, wid = wr * 4 + wc;
        const float* ssq = (const float*)(ws + WS_SSQ); bf16_t* q = (bf16_t*)(ws + WS_Q); const float* rcos = (const float*)(ws + WS_RCOS); const float* rsin = (const float*)(ws + WS_RSIN);
        PG8_LAS float* t = tab + wid * 128; rs_table<3, 20, 0>(ssq, u.pm * BM, wr, lane, 1.0f / 384.0f, t);
        const int row0 = u.pm * BM + wr * 64 + fr;
#pragma unroll
        for (int bj = 0; bj < 2; ++bj) {
            const int colg = u.pn * BM + bj * HALF + wc * 32; const bool rope = ((colg >> 5) % 3) == 2;
#pragma unroll
            for (int ai = 0; ai < 2; ++ai)
#pragma unroll
                for (int m = 0; m < 4; ++m) {
                    const int row = row0 + ai * HALF + m * 16; const float r = t[ai * 64 + m * 16 + fr] * qscale;
                    f32x4 v0 = acc[ai][bj][m][0] * r, v1 = acc[ai][bj][m][1] * r;
                    if (rope) rope8(v0, v1, rcos, rsin, row & (SEQ_ - 1), fq);
                    if (!f8qk) *(u32x4*)(q + (size_t)row * 768 + colg + 8 * fq) = pack8(v0, v1);
                    if (f8qk) { u32x2 w8; w8.x = pack4_fp8_x16(v0); w8.y = pack4_fp8_x16(v1); *(u32x2*)(ws + WS_Q8 + (size_t)row * 768 + colg + 8 * fq) = w8; }
                }
        }
    }
};
struct EpiKV {
    static constexpr bool PERM = true, AFTER_DRAIN = false, PREFETCH = false;
    unsigned char* ws; PG8_LAS float* tab; int f8qk = 0;
    __device__ __forceinline__ void operator()(const f32x4 (&acc)[2][2][4][2], const Unit& u, int wr, int wc, int fr, int fq) const {
        const int lane = fq * 16 + fr, wid = wr * 4 + wc;
        const float* ssq = (const float*)(ws + WS_SSQ); bf16_t* kn = (bf16_t*)(ws + WS_KN); bf16_t* v = (bf16_t*)(ws + WS_V);
        PG8_LAS float* t = tab + wid * 128; rs_table<2, 20, 12>(ssq, u.pm * BM, wr, lane, 1.0f / 256.0f, t);
        const int row0 = u.pm * BM + wr * 64 + fr;
#pragma unroll
        for (int bj = 0; bj < 2; ++bj) {
            const int colg = u.pn * BM + bj * HALF + wc * 32; bf16_t* dst = colg < 512 ? kn + colg : v + (colg - 512);
#pragma unroll
            for (int ai = 0; ai < 2; ++ai)
#pragma unroll
                for (int m = 0; m < 4; ++m) {
                    const int row = row0 + ai * HALF + m * 16; const float r = t[ai * 64 + m * 16 + fr];
                    if (!(f8qk && colg < 512)) *(u32x4*)(dst + (size_t)row * 512 + 8 * fq) = pack8(acc[ai][bj][m][0] * r, acc[ai][bj][m][1] * r);
                    if (f8qk && colg < 512) { u32x2 w8; w8.x = pack4_fp8_x8(acc[ai][bj][m][0] * r); w8.y = pack4_fp8_x8(acc[ai][bj][m][1] * r); *(u32x2*)(ws + WS_KN8 + (size_t)row * 512 + colg + 8 * fq) = w8; }
                }
        }
    }
};
struct EpiNull {
    static constexpr bool PERM = true, AFTER_DRAIN = false, PREFETCH = false;
    unsigned char* ws;
    __device__ __forceinline__ void operator()(const f32x4 (&acc)[2][2][4][2], const Unit& u, int wr, int wc, int fr, int fq) const {
        float s = 0.f;
#pragma unroll
        for (int ai = 0; ai < 2; ++ai)
#pragma unroll
            for (int bj = 0; bj < 2; ++bj)
#pragma unroll
                for (int m = 0; m < 4; ++m)
#pragma unroll
                    for (int n = 0; n < 2; ++n) s += acc[ai][bj][m][n][0] + acc[ai][bj][m][n][3];
        if (s == 123456.789f) *(float*)(ws + WS_SSQ) = s;
    }
};
struct MoeOrder {
    StaticOrder so; int pe[8]; size_t estride;
    __device__ __forceinline__ bool next(int i, Unit& u) const { return so.next(i, u); }
    __device__ __forceinline__ size_t boff(const Unit& u) const { int e = 0;
#pragma unroll
        for (int j = 0; j < 7; ++j) e += (u.pm * BM >= pe[j]) ? 1 : 0;
        return (size_t)e * estride; }
    __device__ __forceinline__ void a_ready(const Unit&) const {}
    __device__ __forceinline__ void done(const Unit&) const {}
};
template <class Epi, class Sched, bool ALIGN_EPI = false, bool SP2 = false, bool F8 = false>
__device__ __forceinline__ void gemm_phase(PG8_LAS unsigned char* lds, const Gemm g, const Sched& S, const Epi& E, const int tidb  ) {
    int tid_l; asm volatile("v_mbcnt_lo_u32_b32 %0, -1, 0\n\tv_mbcnt_hi_u32_b32 %0, -1, %0" : "=v"(tid_l)); tid_l += tidb;
    const int tid = tid_l, wid = __builtin_amdgcn_readfirstlane(tid >> 6), lane = tid & 63, wr = wid >> 2, wc = wid & 3, fr = lane & 15, fq = lane >> 4;
    int K_l = g.K; asm volatile("" : "+s"(K_l));
    constexpr int ES = F8 ? 1 : 2;
    const int K = K_l, nt = K * ES / (BK * 2);
    unsigned voffA[2], voffB[2];
#pragma unroll
    for (int i = 0; i < 2; ++i) { int R, C; stage_rc(tid * 16 + i * 8192, R, C); const int Rb = Epi::PERM ? ((R & ~31) + perm32(R & 31)) : R;
        voffA[i] = (unsigned)(R * K) * ES + C * 2u; voffB[i] = (unsigned)(Rb * K) * ES + C * 2u; }
    const size_t kstep = (size_t)(BK * 2);
    const size_t hstep = (size_t)HALF * K * ES;
    const size_t tstep = 2 * hstep;
    const unsigned ldsw = (unsigned)wid * 1024u;
    const int aoff = lds_byte(wr * 64 + fr, fq * 8), boff = lds_byte(wc * 32 + fr, fq * 8);
#define PG8_SA(b, h) (((b) * 2 + (h)) * HTB)
#define PG8_SB(b, h) ((4 + (b) * 2 + (h)) * HTB)
#define PG8_STAGE(bufoff, gbase, voff) do { _Pragma("unroll") for (int _i = 0; _i < 2; ++_i) \
        __builtin_amdgcn_global_load_lds((const unsigned*)((const char*)(gbase) + (voff)[_i]), (PG8_LAS unsigned*)(lds + (bufoff) + ldsw + _i * 8192), 16, 0, 0); } while (0)
#define PG8_LDA(dst, b, h) do { if constexpr (F8) { _Pragma("unroll") for (int m = 0; m < 4; ++m) _Pragma("unroll") for (int k = 0; k < 2; ++k) { const v4i32 t_ = *(const PG8_LAS v4i32*)(lds + PG8_SA(b, h) + aoff + m * 2048 + k * 1024); dst##8[m][4 * k] = t_[0]; dst##8[m][4 * k + 1] = t_[1]; dst##8[m][4 * k + 2] = t_[2]; dst##8[m][4 * k + 3] = t_[3]; } } else { _Pragma("unroll") for (int m = 0; m < 4; ++m) _Pragma("unroll") for (int k = 0; k < 2; ++k) dst[m][k] = *(const PG8_LAS bf16x8*)(lds + PG8_SA(b, h) + aoff + m * 2048 + k * 1024); } } while (0)
#define PG8_LDB(dst, b, h) do { if constexpr (F8) { _Pragma("unroll") for (int n = 0; n < 2; ++n) _Pragma("unroll") for (int k = 0; k < 2; ++k) { const v4i32 t_ = *(const PG8_LAS v4i32*)(lds + PG8_SB(b, h) + boff + n * 2048 + k * 1024); dst##8[n][4 * k] = t_[0]; dst##8[n][4 * k + 1] = t_[1]; dst##8[n][4 * k + 2] = t_[2]; dst##8[n][4 * k + 3] = t_[3]; } } else { _Pragma("unroll") for (int n = 0; n < 2; ++n) _Pragma("unroll") for (int k = 0; k < 2; ++k) dst[n][k] = *(const PG8_LAS bf16x8*)(lds + PG8_SB(b, h) + boff + n * 2048 + k * 1024); } } while (0)
#define PG8_MMA(ai, bj, At, Bt) do { __builtin_amdgcn_s_setprio(1); if constexpr (F8) { _Pragma("unroll") for (int m = 0; m < 4; ++m) _Pragma("unroll") for (int n = 0; n < 2; ++n) \
        asm volatile("v_mfma_scale_f32_16x16x128_f8f6f4 %0, %1, %2, %0, %3, %4 op_sel_hi:[0,0,0]" : "+v"(acc[ai][bj][m][n]) : "v"(Bt##8[n]), "v"(At##8[m]), "v"(sc_w), "v"(sc_h)); } else { \
        _Pragma("unroll") for (int m = 0; m < 4; ++m) _Pragma("unroll") for (int n = 0; n < 2; ++n) _Pragma("unroll") for (int k = 0; k < 2; ++k) \
        acc[ai][bj][m][n] = __builtin_amdgcn_mfma_f32_16x16x32_bf16(Bt[n][k], At[m][k], acc[ai][bj][m][n], 0, 0, 0); } __builtin_amdgcn_s_setprio(0); } while (0)
#define PG8_WAIT_V(n) asm volatile("s_waitcnt vmcnt(" #n ")" ::: "memory")
#define PG8_WAIT_L(n) asm volatile("s_waitcnt lgkmcnt(" #n ")" ::: "memory")
#define PG8_BAR __builtin_amdgcn_s_barrier()
#define PG8_SCHED __builtin_amdgcn_sched_barrier(0)
    Unit cur, nxt; int ui = 0;
    if (!S.next(0, cur)) return;
    f32x4 acc[2][2][4][2];
#pragma unroll
    for (int a = 0; a < 2; ++a)
#pragma unroll
        for (int b = 0; b < 2; ++b)
#pragma unroll
            for (int m = 0; m < 4; ++m)
#pragma unroll
                for (int n = 0; n < 2; ++n) acc[a][b][m][n] = (f32x4){0.f, 0.f, 0.f, 0.f};
    bf16x8 At[4][2], B0[2][2], B1[2][2];
    const int sc_w = g.scw, sc_h = g.sch;
    v8i32 At8[4], B08[2], B18[2];
    const char* cA = (const char*)g.A + (size_t)cur.pm * tstep; const char* cB = (const char*)g.Bt + S.boff(cur) + (size_t)cur.pn * tstep;
    S.a_ready(cur);
    if constexpr (SP2) {
        PG8_STAGE(PG8_SB(0, 0), cB, voffB); PG8_STAGE(PG8_SB(0, 1), cB + hstep, voffB); PG8_STAGE(PG8_SA(0, 0), cA, voffA); PG8_STAGE(PG8_SA(0, 1), cA + hstep, voffA);
        if (wr == 1) PG8_BAR;
        PG8_WAIT_V(2); PG8_BAR;
        PG8_STAGE(PG8_SB(1, 0), cB + kstep, voffB); PG8_STAGE(PG8_SA(1, 0), cA + kstep, voffA); PG8_STAGE(PG8_SB(1, 1), cB + hstep + kstep, voffB);
        PG8_WAIT_V(6); PG8_BAR;
    } else {
        PG8_STAGE(PG8_SB(0, 0), cB, voffB); PG8_STAGE(PG8_SA(0, 0), cA, voffA); PG8_STAGE(PG8_SB(0, 1), cB + hstep, voffB); PG8_STAGE(PG8_SA(0, 1), cA + hstep, voffA);
        if (wr == 1) PG8_BAR;
        PG8_WAIT_V(4); PG8_BAR;
        PG8_STAGE(PG8_SB(1, 0), cB + kstep, voffB); PG8_STAGE(PG8_SA(1, 0), cA + kstep, voffA); PG8_STAGE(PG8_SB(1, 1), cB + hstep + kstep, voffB);
        PG8_WAIT_V(6); PG8_BAR;
    }
    for (;;) {
        const bool has_next = S.next(ui + 1, nxt);
        const char* nA = has_next ? (const char*)g.A + (size_t)nxt.pm * tstep : cA; const char* nB = has_next ? (const char*)g.Bt + S.boff(nxt) + (size_t)nxt.pn * tstep : cB;
        for (int t = 0; t < nt; t += 2) {
            const bool last = (t == nt - 2);
            if constexpr (Epi::PREFETCH) { if (t == 0) E.prefetch(cur, wid, lane); }
            const char* a1 = cA + (size_t)(t + 1) * kstep;
            const char* a2 = last ? nA : cA + (size_t)(t + 2) * kstep; const char* b2 = last ? nB : cB + (size_t)(t + 2) * kstep;
            const char* a3 = a2 + kstep; const char* b3 = b2 + kstep;
            if (last && has_next) S.a_ready(nxt);
            if constexpr (SP2) {
            PG8_LDB(B0, 0, 0); PG8_LDB(B1, 0, 1); PG8_SCHED; PG8_LDA(At, 0, 0); PG8_STAGE(PG8_SA(1, 1), a1 + hstep, voffA);
            PG8_WAIT_V(8); PG8_WAIT_L(0); PG8_BAR; PG8_MMA(0, 0, At, B0); PG8_MMA(0, 1, At, B1); PG8_BAR; PG8_SCHED;
            PG8_LDA(At, 0, 1); PG8_STAGE(PG8_SB(0, 0), b2, voffB); PG8_STAGE(PG8_SB(0, 1), b2 + hstep, voffB); PG8_STAGE(PG8_SA(0, 0), a2, voffA);
            PG8_WAIT_V(8); PG8_WAIT_L(0); PG8_BAR; PG8_MMA(1, 0, At, B0); PG8_MMA(1, 1, At, B1); PG8_BAR; PG8_SCHED;
            PG8_LDB(B0, 1, 0); PG8_LDB(B1, 1, 1); PG8_SCHED; PG8_LDA(At, 1, 0); PG8_STAGE(PG8_SA(0, 1), a2 + hstep, voffA);
            PG8_WAIT_V(8); PG8_WAIT_L(0); PG8_BAR; PG8_MMA(0, 0, At, B0); PG8_MMA(0, 1, At, B1); PG8_BAR; PG8_SCHED;
            PG8_LDA(At, 1, 1); PG8_STAGE(PG8_SB(1, 0), b3, voffB); PG8_STAGE(PG8_SB(1, 1), b3 + hstep, voffB); PG8_STAGE(PG8_SA(1, 0), a3, voffA);
            PG8_WAIT_V(8); PG8_WAIT_L(0); PG8_BAR; PG8_MMA(1, 0, At, B0); PG8_MMA(1, 1, At, B1); PG8_BAR; PG8_SCHED;
            } else {
            PG8_LDB(B0, 0, 0); PG8_SCHED; PG8_LDA(At, 0, 0); PG8_STAGE(PG8_SA(1, 1), a1 + hstep, voffA);
            PG8_WAIT_L(8); PG8_BAR; PG8_WAIT_L(0); PG8_MMA(0, 0, At, B0); PG8_BAR; PG8_SCHED;
            PG8_LDB(B1, 0, 1); PG8_STAGE(PG8_SB(0, 0), b2, voffB);
            PG8_BAR; PG8_WAIT_L(0); PG8_MMA(0, 1, At, B1); PG8_BAR;
            PG8_LDA(At, 0, 1); PG8_STAGE(PG8_SA(0, 0), a2, voffA);
            PG8_BAR; PG8_WAIT_L(0); PG8_MMA(1, 0, At, B0); PG8_BAR; PG8_SCHED;
            PG8_STAGE(PG8_SB(0, 1), b2 + hstep, voffB);
            PG8_WAIT_V(6); PG8_BAR; PG8_MMA(1, 1, At, B1); PG8_BAR;
            PG8_LDB(B0, 1, 0); PG8_SCHED; PG8_LDA(At, 1, 0); PG8_STAGE(PG8_SA(0, 1), a2 + hstep, voffA);
            PG8_WAIT_L(8); PG8_BAR; PG8_WAIT_L(0); PG8_MMA(0, 0, At, B0); PG8_BAR; PG8_SCHED;
            PG8_LDB(B1, 1, 1); PG8_STAGE(PG8_SB(1, 0), b3, voffB);
            PG8_BAR; PG8_WAIT_L(0); PG8_MMA(0, 1, At, B1); PG8_BAR;
            PG8_LDA(At, 1, 1); PG8_STAGE(PG8_SA(1, 0), a3, voffA);
            PG8_BAR; PG8_WAIT_L(0); PG8_MMA(1, 0, At, B0); PG8_BAR; PG8_SCHED;
            PG8_STAGE(PG8_SB(1, 1), b3 + hstep, voffB);
            PG8_WAIT_V(6); PG8_BAR; PG8_MMA(1, 1, At, B1); PG8_BAR;
            }
        }
        if constexpr (ALIGN_EPI) { if (wr == 0) PG8_BAR; }
        if constexpr (F8) asm volatile("s_nop 15\n\ts_nop 15" ::: "memory");
        if constexpr (!Epi::AFTER_DRAIN) { E(acc, cur, wr, wc, fr, fq); S.done(cur); }
        if (!has_next) break;
#pragma unroll
        for (int a = 0; a < 2; ++a)
#pragma unroll
            for (int b = 0; b < 2; ++b)
#pragma unroll
                for (int m = 0; m < 4; ++m)
#pragma unroll
                    for (int n = 0; n < 2; ++n) acc[a][b][m][n] = (f32x4){0.f, 0.f, 0.f, 0.f};
        cur = nxt; cA = nA; cB = nB; ++ui;
        if constexpr (ALIGN_EPI) { if (wr == 1) PG8_BAR; }
    }
    PG8_WAIT_V(0);
    if constexpr (!ALIGN_EPI) { if (wr == 0) PG8_BAR; }
    PG8_BAR;
    if constexpr (Epi::AFTER_DRAIN) { E.fused(acc, cur, wr, wc, fr, fq, lds, wid, lane); S.done(cur); }
#undef PG8_SA
#undef PG8_SB
#undef PG8_STAGE
#undef PG8_LDA
#undef PG8_LDB
#undef PG8_MMA
#undef PG8_WAIT_V
#undef PG8_WAIT_L
#undef PG8_BAR
#undef PG8_SCHED
}
}
namespace att {
#define ALAS __attribute__((address_space(3)))
using bf16 = unsigned short;
using bf16x8 = __attribute__((ext_vector_type(8))) short;
using s16x4 = __attribute__((ext_vector_type(4))) short;
using f32x16 = __attribute__((ext_vector_type(16))) float;
using u32x4 = __attribute__((ext_vector_type(4))) unsigned;
typedef unsigned v2u32 __attribute__((ext_vector_type(2)));
typedef short v4i16_t __attribute__((ext_vector_type(4)));
typedef float f32x2_t __attribute__((ext_vector_type(2))); typedef __bf16 bf16x2_t __attribute__((ext_vector_type(2)));
constexpr int SEQ = 8192;
constexpr int KSLOT_MAX = 12288, VSLOT = 8192;
constexpr int L_K = 0, L_V = 3 * KSLOT_MAX, L_WS = L_V + 2 * VSLOT, L_OST = L_WS + 8 * 256, L_BIAS = L_OST + 8 * 4096, L_END = L_BIAS + 1280;
constexpr float LOG2E = 1.4426950408889634f;
struct Args { const bf16* Q; const bf16* KN; const bf16* KR; const bf16* V; const bf16* QB; const bf16* KB; const bf16* VB; bf16* AO; const float* bias; int f8; const unsigned char* Q8; const unsigned char* KN8; const unsigned char* KR8; const unsigned char* ZERO; int qk8; };

__device__ __forceinline__ int crow(int r, int hi) { return (r & 3) + 8 * (r >> 2) + 4 * hi; }
__device__ __forceinline__ void glds16(const void* gsrc, unsigned lds_dst) { unsigned keep;
    asm volatile("s_mov_b32 %0, m0\n\ts_mov_b32 m0, %2\n\ts_nop 0\n\tglobal_load_lds_dwordx4 %1, off\n\ts_mov_b32 m0, %0" : "=&s"(keep) : "v"(gsrc), "s"(lds_dst) : "memory"); }
__device__ __forceinline__ unsigned cvtpk(float lo, float hi) { f32x2_t v = {lo, hi}; bf16x2_t b = __builtin_convertvector(v, bf16x2_t); return __builtin_bit_cast(unsigned, b); }
__device__ __forceinline__ s16x4 vtr(ALAS const char* p) { return __builtin_bit_cast(s16x4, __builtin_amdgcn_ds_read_tr16_b64_v4i16((ALAS v4i16_t*)p)); }
__device__ __forceinline__ float xhalf_max(float m) { auto rr = __builtin_amdgcn_permlane32_swap(__float_as_uint(m), __float_as_uint(m), false, false); return fmaxf(__uint_as_float(rr[0]), __uint_as_float(rr[1])); }
__device__ __forceinline__ float xhalf_sum(float m) { auto rr = __builtin_amdgcn_permlane32_swap(__float_as_uint(m), __float_as_uint(m), false, false); return __uint_as_float(rr[0]) + __uint_as_float(rr[1]); }
#define ATT_WAIT_BAR() asm volatile("s_waitcnt vmcnt(0) lgkmcnt(0)\n\ts_barrier" ::: "memory")
__device__ __forceinline__ float max3f(float a, float b, float c) { float r; asm volatile("v_max3_f32 %0, %1, %2, %3" : "=v"(r) : "v"(a), "v"(b), "v"(c)); return r; }
__device__ __forceinline__ float max2f(float a, float b) { float r; asm volatile("v_max_f32_e32 %0, %1, %2" : "=v"(r) : "v"(a), "v"(b)); return r; }
__device__ __forceinline__ float fadd_s(float a, float b) { float r; asm volatile("v_add_f32_e32 %0, %1, %2" : "=v"(r) : "v"(a), "v"(b)); return r; }

__device__ __forceinline__ void write_o(const Args& A, const f32x16& o0, const f32x16& o1, ALAS float* wsf, ALAS char* shm, int wid, int lane, int r32, int hi, long row0, int col0) {
    if (A.f8) {
        ALAS unsigned char* stg = (ALAS unsigned char*)(shm + L_OST) + wid * 4096;
#pragma unroll
        for (int r = 0; r < 16; ++r) { const int orow = crow(r, hi); const float rl = __builtin_amdgcn_rcpf(wsf[32 + orow]) * 8.0f;
            const int w = __builtin_amdgcn_cvt_pk_fp8_f32(__builtin_amdgcn_fmed3f(o0[r] * rl, -448.f, 448.f), __builtin_amdgcn_fmed3f(o1[r] * rl, -448.f, 448.f), 0, false);
            stg[orow * 64 + r32] = (unsigned char)(w & 0xff); stg[orow * 64 + 32 + r32] = (unsigned char)((w >> 8) & 0xff); }
        asm volatile("s_waitcnt lgkmcnt(0)" ::: "memory");
        unsigned char* Ow = (unsigned char*)A.AO + row0 * 1024 + col0;
#pragma unroll
        for (int i = 0; i < 2; ++i) { const int row = i * 16 + (lane >> 2), ch = lane & 3; const u32x4 v = *(ALAS const u32x4*)(stg + row * 64 + ch * 16); *(u32x4*)(Ow + (long)row * 1024 + ch * 16) = v; }
    } else {
        ALAS bf16* stg = (ALAS bf16*)(shm + L_OST) + wid * 2048;
#pragma unroll
        for (int r = 0; r < 16; ++r) { const int orow = crow(r, hi); const float rl = __builtin_amdgcn_rcpf(wsf[32 + orow]);
            stg[orow * 64 + r32] = (bf16)(cvtpk(o0[r] * rl, 0.f) & 0xffffu); stg[orow * 64 + 32 + r32] = (bf16)(cvtpk(o1[r] * rl, 0.f) & 0xffffu); }
        asm volatile("s_waitcnt lgkmcnt(0)" ::: "memory");
        bf16* Ow = A.AO + row0 * 1024 + col0;
#pragma unroll
        for (int i = 0; i < 4; ++i) { const int row = i * 8 + (lane >> 3), ch = lane & 7; const u32x4 v = *(ALAS const u32x4*)(stg + row * 64 + ch * 8); *(u32x4*)(Ow + (long)row * 1024 + ch * 8) = v; }
    }
}

template <bool CHUNK>
__device__ __forceinline__ void attn_unit(const Args& A, int b, int h, int qb, ALAS char* shm, const int tidb) {
    constexpr int NDK = CHUNK ? 4 : 6, KSLOT = NDK * 2048;
    constexpr float THR = 8.0f;
    int tid_l; asm volatile("v_mbcnt_lo_u32_b32 %0, -1, 0\n\tv_mbcnt_hi_u32_b32 %0, -1, %0" : "=v"(tid_l)); tid_l += tidb;
    const int tid = tid_l, lane = tid & 63, r32 = lane & 31, hi = lane >> 5;
    const int wid = __builtin_amdgcn_readfirstlane(tid >> 6);
    const long rowbase = (long)b * SEQ; const int q0 = qb * 256;
    const unsigned lds0 = (unsigned)(size_t)shm;
    ALAS float* wsf = (ALAS float*)(shm + L_WS) + wid * 64;
    ALAS float* bt = (ALAS float*)(shm + L_BIAS);
    const bf16* ksrc = (CHUNK ? A.KB : A.KN) + (rowbase + lane) * 512 + h * 64 + wid * 8;
    const bf16* krsrc = A.KR + (rowbase + lane) * 32 + (wid & 3) * 8;
    const bf16* vsrc = (CHUNK ? A.VB : A.V) + (rowbase + 16 * (wid & 3) + (lane >> 2)) * 512 + h * 64 + (wid >> 2) * 32 + (lane & 3) * 8;
    const unsigned kdst = lds0 + L_K + wid * 1024, krdst = lds0 + L_K + (8 + (wid & 3)) * 1024, vdst = lds0 + L_V + wid * 1024;
#define ATT_ISSUE_K(t, s) do { glds16(ksrc + (long)(t) * 64 * 512, (unsigned)__builtin_amdgcn_readfirstlane(kdst + (s) * KSLOT)); \
        if (!CHUNK && wid < 4) glds16(krsrc + (long)(t) * 64 * 32, (unsigned)__builtin_amdgcn_readfirstlane(krdst + (s) * KSLOT)); } while (0)
#define ATT_ISSUE_V(t, s) glds16(vsrc + (long)(t) * 64 * 512, (unsigned)__builtin_amdgcn_readfirstlane(vdst + (s) * VSLOT))
    const int t_end = 4 * qb + 4, t_begin = CHUNK ? (4 * qb - 8 > 0 ? 4 * qb - 8 : 0) : 0;
    const int cw = 4 * qb + (wid >> 1);
    const int vis_lo = CHUNK ? (cw - 8 > 0 ? cw - 8 : 0) : 0;
    if (CHUNK) { if (tid < 257) bt[tid] = A.bias[h * 257 + tid] * LOG2E; }
    ATT_ISSUE_K(t_begin, 0); ATT_ISSUE_V(t_begin, 0); ATT_ISSUE_K(t_begin + 1, 1);
    const bf16* Qw = CHUNK ? A.QB + (rowbase + q0 + wid * 32 + r32) * 512 + h * 64 + hi * 8 : A.Q + (rowbase + q0 + wid * 32 + r32) * 768 + h * 96 + hi * 8;
    bf16x8 qr[NDK];
#pragma unroll
    for (int d0 = 0; d0 < NDK; ++d0) qr[d0] = *(const bf16x8*)(Qw + d0 * 16);
    float mhat = 0.f, lsum = 0.f; f32x16 o0 = {}, o1 = {}; bool first = true;
    const int vbo = ((lane >> 4) & 1) * 32 + (lane & 3) * 8 + (4 * hi + ((lane & 15) >> 2)) * 64;
    ALAS const char* Kfr = shm + L_K + hi * 1024 + r32 * 16;
#define ATT_QK(C0, C1, t, slot) do { float cinit = -mhat; if (CHUNK) { if ((t) < cw - 2) cinit += bt[256]; } \
        _Pragma("unroll") for (int r = 0; r < 16; ++r) { C0[r] = cinit; C1[r] = cinit; } \
        ALAS const char* Ks_ = Kfr + (slot) * KSLOT; \
        _Pragma("unroll") for (int d0 = 0; d0 < NDK; ++d0) { const bf16x8 a0 = *(ALAS const bf16x8*)(Ks_ + d0 * 2048), a1 = *(ALAS const bf16x8*)(Ks_ + d0 * 2048 + 512); \
            C0 = __builtin_amdgcn_mfma_f32_32x32x16_bf16(a0, qr[d0], C0, 0, 0, 0); C1 = __builtin_amdgcn_mfma_f32_32x32x16_bf16(a1, qr[d0], C1, 0, 0, 0); } } while (0)
    ATT_WAIT_BAR();
    f32x16 c0, c1;
    if (t_begin >= vis_lo) ATT_QK(c0, c1, t_begin, 0);
    int ks = 0, vs = 0;
    for (int t = t_begin; t < t_end; ++t) {
        const int ks1 = ks == 2 ? 0 : ks + 1, ks2 = ks1 == 2 ? 0 : ks1 + 1;
        if (t + 2 < t_end) ATT_ISSUE_K(t + 2, ks2);
        if (t + 1 < t_end) ATT_ISSUE_V(t + 1, vs ^ 1);
        const bool vis = (t >= vis_lo && t <= cw), visn = (t + 1 >= vis_lo && t + 1 <= cw);
        if (vis) {
            if (CHUNK) { if (t >= cw - 2) {
                const int dq = 64 * (cw - t) + 32 * (wid & 1) + r32 + 128;
#pragma unroll
                for (int r = 0; r < 16; ++r) { int i0 = dq - crow(r, hi), i1 = i0 - 32; i0 = i0 < 0 ? 0 : (i0 > 256 ? 256 : i0); i1 = i1 < 0 ? 0 : (i1 > 256 ? 256 : i1); c0[r] += bt[i0]; c1[r] += bt[i1]; }
            } }
            float rmp[4];
#pragma unroll
            for (int j = 0; j < 4; ++j) rmp[j] = fmaxf(fmaxf(c0[j], c1[j]), fmaxf(c0[4 + j], c1[4 + j]));
#pragma unroll
            for (int j = 0; j < 4; ++j) rmp[j] = fmaxf(rmp[j], fmaxf(fmaxf(c0[8 + j], c1[8 + j]), fmaxf(c0[12 + j], c1[12 + j])));
            float rm = xhalf_max(fmaxf(fmaxf(rmp[0], rmp[1]), fmaxf(rmp[2], rmp[3])));
            if (first) { first = false; mhat = rm;
#pragma unroll
                for (int r = 0; r < 16; ++r) { c0[r] -= rm; c1[r] -= rm; }
            } else if (__any(rm > THR)) {
                const float dl = fmaxf(rm, 0.f); mhat += dl;
#pragma unroll
                for (int r = 0; r < 16; ++r) { c0[r] -= dl; c1[r] -= dl; }
                const float f = __builtin_amdgcn_exp2f(-dl); lsum *= f;
                if (hi == 0) wsf[r32] = f;
                asm volatile("s_waitcnt lgkmcnt(0)" ::: "memory");
#pragma unroll
                for (int r = 0; r < 16; ++r) { const float fr_ = wsf[crow(r, hi)]; o0[r] *= fr_; o1[r] *= fr_; }
            }
        }
        f32x16 n0, n1;
        if (vis && visn) {
            ALAS const char* Ks_ = Kfr + ks1 * KSLOT;
            bf16x8 ka = *(ALAS const bf16x8*)(Ks_), kb = *(ALAS const bf16x8*)(Ks_ + 512);
            float cinit = -mhat; if (CHUNK) { if (t + 1 < cw - 2) cinit += bt[256]; }
#pragma unroll
            for (int r = 0; r < 16; ++r) { n0[r] = cinit; n1[r] = cinit; }
            __builtin_amdgcn_sched_barrier(0);
            constexpr int NM = 2 * NDK;
#pragma unroll
            for (int d0 = 0; d0 < NDK; ++d0) {
                bf16x8 na = ka, nb = kb;
                if (d0 + 1 < NDK) { na = *(ALAS const bf16x8*)(Ks_ + (d0 + 1) * 2048); nb = *(ALAS const bf16x8*)(Ks_ + (d0 + 1) * 2048 + 512); }
                n0 = __builtin_amdgcn_mfma_f32_32x32x16_bf16(ka, qr[d0], n0, 0, 0, 0);
#pragma unroll
                for (int e = 0; e < 32; ++e) if (e * NM / 32 == 2 * d0) { if (e < 16) c0[e] = __builtin_amdgcn_exp2f(c0[e]); else c1[e - 16] = __builtin_amdgcn_exp2f(c1[e - 16]); }
                __builtin_amdgcn_sched_barrier(0);
                n1 = __builtin_amdgcn_mfma_f32_32x32x16_bf16(kb, qr[d0], n1, 0, 0, 0);
#pragma unroll
                for (int e = 0; e < 32; ++e) if (e * NM / 32 == 2 * d0 + 1) { if (e < 16) c0[e] = __builtin_amdgcn_exp2f(c0[e]); else c1[e - 16] = __builtin_amdgcn_exp2f(c1[e - 16]); }
                __builtin_amdgcn_sched_barrier(0);
                ka = na; kb = nb;
            }
            ALAS const char* vb = shm + L_V + vs * VSLOT + vbo;
            s16x4 vl[8], vh[8];
#pragma unroll
            for (int kk = 0; kk < 4; ++kk) { vl[kk] = vtr(vb + kk * 1024); vh[kk] = vtr(vb + kk * 1024 + 512); vl[4 + kk] = vtr(vb + 4096 + kk * 1024); vh[4 + kk] = vtr(vb + 4096 + kk * 1024 + 512); }
            float sacc4[4];
#pragma unroll
            for (int kk = 0; kk < 4; ++kk) {
                u32x4 pw;
                if (kk < 2) { pw = (u32x4){cvtpk(c0[8 * kk], c0[8 * kk + 1]), cvtpk(c0[8 * kk + 2], c0[8 * kk + 3]), cvtpk(c0[8 * kk + 4], c0[8 * kk + 5]), cvtpk(c0[8 * kk + 6], c0[8 * kk + 7])};
                    sacc4[kk] = ((c0[8 * kk] + c0[8 * kk + 1]) + (c0[8 * kk + 2] + c0[8 * kk + 3])) + ((c0[8 * kk + 4] + c0[8 * kk + 5]) + (c0[8 * kk + 6] + c0[8 * kk + 7])); }
                else { const int k2 = kk - 2; pw = (u32x4){cvtpk(c1[8 * k2], c1[8 * k2 + 1]), cvtpk(c1[8 * k2 + 2], c1[8 * k2 + 3]), cvtpk(c1[8 * k2 + 4], c1[8 * k2 + 5]), cvtpk(c1[8 * k2 + 6], c1[8 * k2 + 7])};
                    sacc4[kk] = ((c1[8 * k2] + c1[8 * k2 + 1]) + (c1[8 * k2 + 2] + c1[8 * k2 + 3])) + ((c1[8 * k2 + 4] + c1[8 * k2 + 5]) + (c1[8 * k2 + 6] + c1[8 * k2 + 7])); }
                const bf16x8 v0 = (bf16x8){vl[kk][0], vl[kk][1], vl[kk][2], vl[kk][3], vh[kk][0], vh[kk][1], vh[kk][2], vh[kk][3]}, v1 = (bf16x8){vl[4 + kk][0], vl[4 + kk][1], vl[4 + kk][2], vl[4 + kk][3], vh[4 + kk][0], vh[4 + kk][1], vh[4 + kk][2], vh[4 + kk][3]};
                o0 = __builtin_amdgcn_mfma_f32_32x32x16_bf16(__builtin_bit_cast(bf16x8, pw), v0, o0, 0, 0, 0);
                o1 = __builtin_amdgcn_mfma_f32_32x32x16_bf16(__builtin_bit_cast(bf16x8, pw), v1, o1, 0, 0, 0);
                __builtin_amdgcn_sched_barrier(0);
            }
            lsum += (sacc4[0] + sacc4[1]) + (sacc4[2] + sacc4[3]);
        } else {
        if (visn) ATT_QK(n0, n1, t + 1, ks1);
        if (vis) {
            float sacc = 0.f;
#pragma unroll
            for (int r = 0; r < 16; ++r) { c0[r] = __builtin_amdgcn_exp2f(c0[r]); c1[r] = __builtin_amdgcn_exp2f(c1[r]); sacc += c0[r] + c1[r]; }
            lsum += sacc;
            u32x4 pw[4];
#pragma unroll
            for (int k = 0; k < 2; ++k) {
                pw[k]     = (u32x4){cvtpk(c0[8 * k], c0[8 * k + 1]), cvtpk(c0[8 * k + 2], c0[8 * k + 3]), cvtpk(c0[8 * k + 4], c0[8 * k + 5]), cvtpk(c0[8 * k + 6], c0[8 * k + 7])};
                pw[2 + k] = (u32x4){cvtpk(c1[8 * k], c1[8 * k + 1]), cvtpk(c1[8 * k + 2], c1[8 * k + 3]), cvtpk(c1[8 * k + 4], c1[8 * k + 5]), cvtpk(c1[8 * k + 6], c1[8 * k + 7])};
            }
            ALAS const char* vb = shm + L_V + vs * VSLOT + vbo;
#pragma unroll
            for (int kk = 0; kk < 4; ++kk) {
                const s16x4 l0 = vtr(vb + kk * 1024), h0 = vtr(vb + kk * 1024 + 512), l1 = vtr(vb + 4096 + kk * 1024), h1 = vtr(vb + 4096 + kk * 1024 + 512);
                const bf16x8 v0 = (bf16x8){l0[0], l0[1], l0[2], l0[3], h0[0], h0[1], h0[2], h0[3]}, v1 = (bf16x8){l1[0], l1[1], l1[2], l1[3], h1[0], h1[1], h1[2], h1[3]};
                o0 = __builtin_amdgcn_mfma_f32_32x32x16_bf16(__builtin_bit_cast(bf16x8, pw[kk]), v0, o0, 0, 0, 0);
                o1 = __builtin_amdgcn_mfma_f32_32x32x16_bf16(__builtin_bit_cast(bf16x8, pw[kk]), v1, o1, 0, 0, 0);
            }
        }
        }
        if (visn) { c0 = n0; c1 = n1; }
        ks = ks1; vs ^= 1;
        ATT_WAIT_BAR();
    }
    const float lt = xhalf_sum(lsum);
    if (hi == 0) wsf[32 + r32] = lt;
    asm volatile("s_waitcnt lgkmcnt(0)" ::: "memory");
    write_o(A, o0, o1, wsf, shm, wid, lane, r32, hi, rowbase + q0 + wid * 32, (CHUNK ? 512 : 0) + h * 64);
    asm volatile("s_waitcnt lgkmcnt(0)\n\ts_barrier" ::: "memory");
#undef ATT_ISSUE_K
#undef ATT_ISSUE_V
#undef ATT_QK
}

__device__ __forceinline__ bf16x8 cvt8_fp8_bf16(const v2u32 w, const float sc) {
    const f32x2_t a = __builtin_amdgcn_cvt_pk_f32_fp8((int)w.x, false), b2 = __builtin_amdgcn_cvt_pk_f32_fp8((int)w.x, true), c = __builtin_amdgcn_cvt_pk_f32_fp8((int)w.y, false), d = __builtin_amdgcn_cvt_pk_f32_fp8((int)w.y, true);
    const u32x4 r = {cvtpk(a[0] * sc, a[1] * sc), cvtpk(b2[0] * sc, b2[1] * sc), cvtpk(c[0] * sc, c[1] * sc), cvtpk(d[0] * sc, d[1] * sc)}; return __builtin_bit_cast(bf16x8, r); }
__device__ __forceinline__ bf16x8 kfrag8(ALAS const char* slot, const int d0, const int kh, const int r32, const int hi) {
    const int m = d0 < 4 ? 0 : 1, dd = d0 < 4 ? d0 : d0 - 4;
    return cvt8_fp8_bf16(*(ALAS const v2u32*)(slot + ((m * 2 + kh) * 2 + (dd & 1)) * 1024 + ((dd >> 1) * 32 + r32) * 16 + 8 * hi), 1.0f); }
__device__ __forceinline__ void attn_unit8(const Args& A, int b, int h, int qb, ALAS char* shm, const int tidb) {
    constexpr bool CHUNK = false;
    constexpr int NDK = 6, KSLOT = 8192;
    constexpr float THR = 8.0f;
    int tid_l; asm volatile("v_mbcnt_lo_u32_b32 %0, -1, 0\n\tv_mbcnt_hi_u32_b32 %0, -1, %0" : "=v"(tid_l)); tid_l += tidb;
    const int tid = tid_l, lane = tid & 63, r32 = lane & 31, hi = lane >> 5;
    const int wid = __builtin_amdgcn_readfirstlane(tid >> 6);
    const long rowbase = (long)b * SEQ; const int q0 = qb * 256;
    const unsigned lds0 = (unsigned)(size_t)shm;
    ALAS float* wsf = (ALAS float*)(shm + L_WS) + wid * 64;
    ALAS float* bt = (ALAS float*)(shm + L_BIAS);
    const int m_ = wid >> 2, kh_ = (wid >> 1) & 1, j_ = wid & 1;
    const long krow_ = rowbase + 32 * kh_ + r32;
    const unsigned char* ks8 = m_ == 0 ? A.KN8 + krow_ * 512 + h * 64 + 32 * hi + 16 * j_ : (hi == 0 ? A.KR8 + krow_ * 32 + 16 * j_ : A.ZERO + r32 * 16);
    const long kst8 = m_ == 0 ? 64 * 512 : (hi == 0 ? 64 * 32 : 0);
    const bf16* vsrc = (CHUNK ? A.VB : A.V) + (rowbase + 16 * (wid & 3) + (lane >> 2)) * 512 + h * 64 + (wid >> 2) * 32 + (lane & 3) * 8;
    const unsigned kdst = lds0 + L_K + wid * 1024, krdst = lds0 + L_K + (8 + (wid & 3)) * 1024, vdst = lds0 + L_V + wid * 1024;
#define ATT_ISSUE_K(t, s) glds16(ks8 + (long)(t) * kst8, (unsigned)__builtin_amdgcn_readfirstlane(kdst + (s) * KSLOT))
#define ATT_ISSUE_V(t, s) glds16(vsrc + (long)(t) * 64 * 512, (unsigned)__builtin_amdgcn_readfirstlane(vdst + (s) * VSLOT))
    const int t_end = 4 * qb + 4, t_begin = CHUNK ? (4 * qb - 8 > 0 ? 4 * qb - 8 : 0) : 0;
    const int cw = 4 * qb + (wid >> 1);
    const int vis_lo = CHUNK ? (cw - 8 > 0 ? cw - 8 : 0) : 0;
    if (CHUNK) { if (tid < 257) bt[tid] = A.bias[h * 257 + tid] * LOG2E; }
    ATT_ISSUE_K(t_begin, 0); ATT_ISSUE_V(t_begin, 0); ATT_ISSUE_K(t_begin + 1, 1);
    const bf16* Qw = CHUNK ? A.QB + (rowbase + q0 + wid * 32 + r32) * 512 + h * 64 + hi * 8 : A.Q + (rowbase + q0 + wid * 32 + r32) * 768 + h * 96 + hi * 8;
    const unsigned char* Q8w = A.Q8 + (rowbase + q0 + wid * 32 + r32) * 768 + h * 96 + 8 * hi; (void)Qw;
    bf16x8 qr[NDK];
#pragma unroll
    for (int d0 = 0; d0 < NDK; ++d0) qr[d0] = cvt8_fp8_bf16(*(const v2u32*)(Q8w + 16 * d0), 1.0f / 128.0f);
    float mhat = 0.f, lsum = 0.f; f32x16 o0 = {}, o1 = {}; bool first = true;
    const int vbo = ((lane >> 4) & 1) * 32 + (lane & 3) * 8 + (4 * hi + ((lane & 15) >> 2)) * 64;
    ALAS const char* Kfr = shm + L_K;
#define ATT_QK(C0, C1, t, slot) do { float cinit = -mhat; if (CHUNK) { if ((t) < cw - 2) cinit += bt[256]; } \
        _Pragma("unroll") for (int r = 0; r < 16; ++r) { C0[r] = cinit; C1[r] = cinit; } \
        ALAS const char* Ks_ = Kfr + (slot) * KSLOT; \
        _Pragma("unroll") for (int d0 = 0; d0 < NDK; ++d0) { const bf16x8 a0 = kfrag8(Ks_, d0, 0, r32, hi), a1 = kfrag8(Ks_, d0, 1, r32, hi); \
            C0 = __builtin_amdgcn_mfma_f32_32x32x16_bf16(a0, qr[d0], C0, 0, 0, 0); C1 = __builtin_amdgcn_mfma_f32_32x32x16_bf16(a1, qr[d0], C1, 0, 0, 0); } } while (0)
    ATT_WAIT_BAR();
    f32x16 c0, c1;
    if (t_begin >= vis_lo) ATT_QK(c0, c1, t_begin, 0);
    int ks = 0, vs = 0;
    for (int t = t_begin; t < t_end; ++t) {
        const int ks1 = ks == 2 ? 0 : ks + 1, ks2 = ks1 == 2 ? 0 : ks1 + 1;
        if (t + 2 < t_end) ATT_ISSUE_K(t + 2, ks2);
        if (t + 1 < t_end) ATT_ISSUE_V(t + 1, vs ^ 1);
        const bool vis = (t >= vis_lo && t <= cw), visn = (t + 1 >= vis_lo && t + 1 <= cw);
        if (vis) {
            if (CHUNK) { if (t >= cw - 2) {
                const int dq = 64 * (cw - t) + 32 * (wid & 1) + r32 + 128;
#pragma unroll
                for (int r = 0; r < 16; ++r) { int i0 = dq - crow(r, hi), i1 = i0 - 32; i0 = i0 < 0 ? 0 : (i0 > 256 ? 256 : i0); i1 = i1 < 0 ? 0 : (i1 > 256 ? 256 : i1); c0[r] += bt[i0]; c1[r] += bt[i1]; }
            } }
            float rmp[4];
#pragma unroll
            for (int j = 0; j < 4; ++j) rmp[j] = fmaxf(fmaxf(c0[j], c1[j]), fmaxf(c0[4 + j], c1[4 + j]));
#pragma unroll
            for (int j = 0; j < 4; ++j) rmp[j] = fmaxf(rmp[j], fmaxf(fmaxf(c0[8 + j], c1[8 + j]), fmaxf(c0[12 + j], c1[12 + j])));
            float rm = xhalf_max(fmaxf(fmaxf(rmp[0], rmp[1]), fmaxf(rmp[2], rmp[3])));
            if (first) { first = false; mhat = rm;
#pragma unroll
                for (int r = 0; r < 16; ++r) { c0[r] -= rm; c1[r] -= rm; }
            } else if (__any(rm > THR)) {
                const float dl = fmaxf(rm, 0.f); mhat += dl;
#pragma unroll
                for (int r = 0; r < 16; ++r) { c0[r] -= dl; c1[r] -= dl; }
                const float f = __builtin_amdgcn_exp2f(-dl); lsum *= f;
                if (hi == 0) wsf[r32] = f;
                asm volatile("s_waitcnt lgkmcnt(0)" ::: "memory");
#pragma unroll
                for (int r = 0; r < 16; ++r) { const float fr_ = wsf[crow(r, hi)]; o0[r] *= fr_; o1[r] *= fr_; }
            }
        }
        f32x16 n0, n1;
        if (vis && visn) {
            ALAS const char* Ks_ = Kfr + ks1 * KSLOT;
            bf16x8 ka = kfrag8(Ks_, 0, 0, r32, hi), kb = kfrag8(Ks_, 0, 1, r32, hi);
            float cinit = -mhat; if (CHUNK) { if (t + 1 < cw - 2) cinit += bt[256]; }
#pragma unroll
            for (int r = 0; r < 16; ++r) { n0[r] = cinit; n1[r] = cinit; }
            __builtin_amdgcn_sched_barrier(0);
            constexpr int NM = 2 * NDK;
#pragma unroll
            for (int d0 = 0; d0 < NDK; ++d0) {
                bf16x8 na = ka, nb = kb;
                if (d0 + 1 < NDK) { na = kfrag8(Ks_, d0 + 1, 0, r32, hi); nb = kfrag8(Ks_, d0 + 1, 1, r32, hi); }
                n0 = __builtin_amdgcn_mfma_f32_32x32x16_bf16(ka, qr[d0], n0, 0, 0, 0);
#pragma unroll
                for (int e = 0; e < 32; ++e) if (e * NM / 32 == 2 * d0) { if (e < 16) c0[e] = __builtin_amdgcn_exp2f(c0[e]); else c1[e - 16] = __builtin_amdgcn_exp2f(c1[e - 16]); }
                __builtin_amdgcn_sched_barrier(0);
                n1 = __builtin_amdgcn_mfma_f32_32x32x16_bf16(kb, qr[d0], n1, 0, 0, 0);
#pragma unroll
                for (int e = 0; e < 32; ++e) if (e * NM / 32 == 2 * d0 + 1) { if (e < 16) c0[e] = __builtin_amdgcn_exp2f(c0[e]); else c1[e - 16] = __builtin_amdgcn_exp2f(c1[e - 16]); }
                __builtin_amdgcn_sched_barrier(0);
                ka = na; kb = nb;
            }
            ALAS const char* vb = shm + L_V + vs * VSLOT + vbo;
            s16x4 vl[8], vh[8];
#pragma unroll
            for (int kk = 0; kk < 4; ++kk) { vl[kk] = vtr(vb + kk * 1024); vh[kk] = vtr(vb + kk * 1024 + 512); vl[4 + kk] = vtr(vb + 4096 + kk * 1024); vh[4 + kk] = vtr(vb + 4096 + kk * 1024 + 512); }
            float sacc4[4];
#pragma unroll
            for (int kk = 0; kk < 4; ++kk) {
                u32x4 pw;
                if (kk < 2) { pw = (u32x4){cvtpk(c0[8 * kk], c0[8 * kk + 1]), cvtpk(c0[8 * kk + 2], c0[8 * kk + 3]), cvtpk(c0[8 * kk + 4], c0[8 * kk + 5]), cvtpk(c0[8 * kk + 6], c0[8 * kk + 7])};
                    sacc4[kk] = ((c0[8 * kk] + c0[8 * kk + 1]) + (c0[8 * kk + 2] + c0[8 * kk + 3])) + ((c0[8 * kk + 4] + c0[8 * kk + 5]) + (c0[8 * kk + 6] + c0[8 * kk + 7])); }
                else { const int k2 = kk - 2; pw = (u32x4){cvtpk(c1[8 * k2], c1[8 * k2 + 1]), cvtpk(c1[8 * k2 + 2], c1[8 * k2 + 3]), cvtpk(c1[8 * k2 + 4], c1[8 * k2 + 5]), cvtpk(c1[8 * k2 + 6], c1[8 * k2 + 7])};
                    sacc4[kk] = ((c1[8 * k2] + c1[8 * k2 + 1]) + (c1[8 * k2 + 2] + c1[8 * k2 + 3])) + ((c1[8 * k2 + 4] + c1[8 * k2 + 5]) + (c1[8 * k2 + 6] + c1[8 * k2 + 7])); }
                const bf16x8 v0 = (bf16x8){vl[kk][0], vl[kk][1], vl[kk][2], vl[kk][3], vh[kk][0], vh[kk][1], vh[kk][2], vh[kk][3]}, v1 = (bf16x8){vl[4 + kk][0], vl[4 + kk][1], vl[4 + kk][2], vl[4 + kk][3], vh[4 + kk][0], vh[4 + kk][1], vh[4 + kk][2], vh[4 + kk][3]};
                o0 = __builtin_amdgcn_mfma_f32_32x32x16_bf16(__builtin_bit_cast(bf16x8, pw), v0, o0, 0, 0, 0);
                o1 = __builtin_amdgcn_mfma_f32_32x32x16_bf16(__builtin_bit_cast(bf16x8, pw), v1, o1, 0, 0, 0);
                __builtin_amdgcn_sched_barrier(0);
            }
            lsum += (sacc4[0] + sacc4[1]) + (sacc4[2] + sacc4[3]);
        } else {
        if (visn) ATT_QK(n0, n1, t + 1, ks1);
        if (vis) {
            float sacc = 0.f;
#pragma unroll
            for (int r = 0; r < 16; ++r) { c0[r] = __builtin_amdgcn_exp2f(c0[r]); c1[r] = __builtin_amdgcn_exp2f(c1[r]); sacc += c0[r] + c1[r]; }
            lsum += sacc;
            u32x4 pw[4];
#pragma unroll
            for (int k = 0; k < 2; ++k) {
                pw[k]     = (u32x4){cvtpk(c0[8 * k], c0[8 * k + 1]), cvtpk(c0[8 * k + 2], c0[8 * k + 3]), cvtpk(c0[8 * k + 4], c0[8 * k + 5]), cvtpk(c0[8 * k + 6], c0[8 * k + 7])};
                pw[2 + k] = (u32x4){cvtpk(c1[8 * k], c1[8 * k + 1]), cvtpk(c1[8 * k + 2], c1[8 * k + 3]), cvtpk(c1[8 * k + 4], c1[8 * k + 5]), cvtpk(c1[8 * k + 6], c1[8 * k + 7])};
            }
            ALAS const char* vb = shm + L_V + vs * VSLOT + vbo;
#pragma unroll
            for (int kk = 0; kk < 4; ++kk) {
                const s16x4 l0 = vtr(vb + kk * 1024), h0 = vtr(vb + kk * 1024 + 512), l1 = vtr(vb + 4096 + kk * 1024), h1 = vtr(vb + 4096 + kk * 1024 + 512);
                const bf16x8 v0 = (bf16x8){l0[0], l0[1], l0[2], l0[3], h0[0], h0[1], h0[2], h0[3]}, v1 = (bf16x8){l1[0], l1[1], l1[2], l1[3], h1[0], h1[1], h1[2], h1[3]};
                o0 = __builtin_amdgcn_mfma_f32_32x32x16_bf16(__builtin_bit_cast(bf16x8, pw[kk]), v0, o0, 0, 0, 0);
                o1 = __builtin_amdgcn_mfma_f32_32x32x16_bf16(__builtin_bit_cast(bf16x8, pw[kk]), v1, o1, 0, 0, 0);
            }
        }
        }
        if (visn) { c0 = n0; c1 = n1; }
        ks = ks1; vs ^= 1;
        ATT_WAIT_BAR();
    }
    const float lt = xhalf_sum(lsum);
    if (hi == 0) wsf[32 + r32] = lt;
    asm volatile("s_waitcnt lgkmcnt(0)" ::: "memory");
    write_o(A, o0, o1, wsf, shm, wid, lane, r32, hi, rowbase + q0 + wid * 32, (CHUNK ? 512 : 0) + h * 64);
    asm volatile("s_waitcnt lgkmcnt(0)\n\ts_barrier" ::: "memory");
#undef ATT_ISSUE_K
#undef ATT_ISSUE_V
#undef ATT_QK
}

__device__ __forceinline__ bool mla_unit_fast(const Args& A, int b, int h, int qb, ALAS char* shm, const int tidb) {
    constexpr int NDK = 6, KSLOT = NDK * 2048;
    constexpr float THR = 8.0f;
    int tid_l; asm volatile("v_mbcnt_lo_u32_b32 %0, -1, 0\n\tv_mbcnt_hi_u32_b32 %0, -1, %0" : "=v"(tid_l)); tid_l += tidb;
    const int tid = tid_l, lane = tid & 63, r32 = lane & 31, hi = lane >> 5;
    const int wid = __builtin_amdgcn_readfirstlane(tid >> 6);
    const long rowbase = (long)b * SEQ; const int q0 = qb * 256;
    const unsigned lds0 = (unsigned)(size_t)shm;
    ALAS float* wsf = (ALAS float*)(shm + L_WS) + wid * 64;
    ALAS int* bailw = (ALAS int*)(shm + L_BIAS);
    const bf16* ksrc = A.KN + (rowbase + lane) * 512 + h * 64 + wid * 8;
    const bf16* krsrc = A.KR + (rowbase + lane) * 32 + (wid & 3) * 8;
    const bf16* vsrc = A.V + (rowbase + 16 * (wid & 3) + (lane >> 2)) * 512 + h * 64 + (wid >> 2) * 32 + (lane & 3) * 8;
    const unsigned kdst = lds0 + L_K + wid * 1024, krdst = lds0 + L_K + (8 + (wid & 3)) * 1024, vdst = lds0 + L_V + wid * 1024;
#define MF_ISSUE_K(t, s) do { glds16(ksrc + (long)(t) * 64 * 512, (unsigned)__builtin_amdgcn_readfirstlane(kdst + (s) * KSLOT)); \
        if (wid < 4) glds16(krsrc + (long)(t) * 64 * 32, (unsigned)__builtin_amdgcn_readfirstlane(krdst + (s) * KSLOT)); } while (0)
#define MF_ISSUE_V(t, s) glds16(vsrc + (long)(t) * 64 * 512, (unsigned)__builtin_amdgcn_readfirstlane(vdst + (s) * VSLOT))
    const int t_end = 4 * qb + 4;
    const int cw = 4 * qb + (wid >> 1);
    if (tid == 0) bailw[0] = 0;
    MF_ISSUE_K(0, 0); MF_ISSUE_V(0, 0); MF_ISSUE_K(1, 1);
    const bf16* Qw = A.Q + (rowbase + q0 + wid * 32 + r32) * 768 + h * 96 + hi * 8;
    bf16x8 qr[NDK];
#pragma unroll
    for (int d0 = 0; d0 < NDK; ++d0) qr[d0] = *(const bf16x8*)(Qw + d0 * 16);
    float lsum = 0.f; f32x16 o0 = {}, o1 = {};
    const int vbo = ((lane >> 4) & 1) * 32 + (lane & 3) * 8 + (4 * hi + ((lane & 15) >> 2)) * 64;
    ALAS const char* Kfr = shm + L_K + hi * 1024 + r32 * 16;
#define MF_ROWMAX(C0, C1) ({ float rmp_[4]; _Pragma("unroll") for (int j = 0; j < 4; ++j) { rmp_[j] = max3f(C0[j], C1[j], C0[4 + j]); rmp_[j] = max3f(rmp_[j], C1[4 + j], C0[8 + j]); rmp_[j] = max3f(rmp_[j], C1[8 + j], C0[12 + j]); rmp_[j] = max2f(rmp_[j], C1[12 + j]); } \
        xhalf_max(max2f(max3f(rmp_[0], rmp_[1], rmp_[2]), rmp_[3])); })
    ATT_WAIT_BAR();
    f32x16 cs[2][2];
    { f32x16 z0 = {}, z1 = {}; ALAS const char* Ks_ = Kfr;
#pragma unroll
      for (int d0 = 0; d0 < NDK; ++d0) { const bf16x8 a0 = *(ALAS const bf16x8*)(Ks_ + d0 * 2048), a1 = *(ALAS const bf16x8*)(Ks_ + d0 * 2048 + 512);
          z0 = __builtin_amdgcn_mfma_f32_32x32x16_bf16(a0, qr[d0], z0, 0, 0, 0); z1 = __builtin_amdgcn_mfma_f32_32x32x16_bf16(a1, qr[d0], z1, 0, 0, 0); }
      asm volatile("s_nop 15\n\ts_nop 7" : "+v"(z0), "+v"(z1));
      cs[0][0] = z0; cs[0][1] = z1; }
    const float mhat = MF_ROWMAX(cs[0][0], cs[0][1]);
#pragma unroll
    for (int r = 0; r < 16; ++r) { cs[0][0][r] -= mhat; cs[0][1][r] -= mhat; }
    f32x16 negm;
#pragma unroll
    for (int r = 0; r < 16; ++r) negm[r] = -mhat;
    bool bailed = false; int ks = 0, vs = 0;
    for (int t2 = 0; t2 < t_end; t2 += 2) {
#pragma unroll
        for (int p = 0; p < 2; ++p) {
            const int t = t2 + p; f32x16 &C0 = cs[p][0], &C1 = cs[p][1], &N0 = cs[p ^ 1][0], &N1 = cs[p ^ 1][1];
            const bool vis = !bailed && t <= cw;
            const int ks1 = ks == 2 ? 0 : ks + 1, ks2 = ks1 == 2 ? 0 : ks1 + 1;
            if (t + 2 < t_end) MF_ISSUE_K(t + 2, ks2);
            if (t + 1 < t_end) MF_ISSUE_V(t + 1, vs ^ 1);
            if (vis) {
                {
                    ALAS const char* Ks_ = Kfr + ks1 * KSLOT;
                    bf16x8 ka = *(ALAS const bf16x8*)(Ks_), kb = *(ALAS const bf16x8*)(Ks_ + 512);
                    constexpr int NM = 2 * NDK;
#pragma unroll
                    for (int d0 = 0; d0 < NDK; ++d0) {
                        bf16x8 na = ka, nb = kb;
                        if (d0 + 1 < NDK) { na = *(ALAS const bf16x8*)(Ks_ + (d0 + 1) * 2048); nb = *(ALAS const bf16x8*)(Ks_ + (d0 + 1) * 2048 + 512); }
                        N0 = __builtin_amdgcn_mfma_f32_32x32x16_bf16(ka, qr[d0], d0 == 0 ? negm : N0, 0, 0, 0);
#pragma unroll
                        for (int e = 0; e < 32; ++e) if (e * NM / 32 == 2 * d0) { if (e < 16) C0[e] = __builtin_amdgcn_exp2f(C0[e]); else C1[e - 16] = __builtin_amdgcn_exp2f(C1[e - 16]); }
                        __builtin_amdgcn_sched_barrier(0);
                        N1 = __builtin_amdgcn_mfma_f32_32x32x16_bf16(kb, qr[d0], d0 == 0 ? negm : N1, 0, 0, 0);
#pragma unroll
                        for (int e = 0; e < 32; ++e) if (e * NM / 32 == 2 * d0 + 1) { if (e < 16) C0[e] = __builtin_amdgcn_exp2f(C0[e]); else C1[e - 16] = __builtin_amdgcn_exp2f(C1[e - 16]); }
                        __builtin_amdgcn_sched_barrier(0);
                        ka = na; kb = nb;
                    }
                }
                ALAS const char* vb_ = shm + L_V + vs * VSLOT + vbo; s16x4 vl_[8], vh_[8];
#pragma unroll
                for (int kk = 0; kk < 4; ++kk) { vl_[kk] = vtr(vb_ + kk * 1024); vh_[kk] = vtr(vb_ + kk * 1024 + 512); vl_[4 + kk] = vtr(vb_ + 4096 + kk * 1024); vh_[4 + kk] = vtr(vb_ + 4096 + kk * 1024 + 512); }
                float sa_[4];
#pragma unroll
                for (int kk = 0; kk < 4; ++kk) { const f32x16& cc_ = (kk < 2) ? C0 : C1; const int k8_ = 8 * (kk & 1);
                    const u32x4 pw_ = (u32x4){cvtpk(cc_[k8_], cc_[k8_ + 1]), cvtpk(cc_[k8_ + 2], cc_[k8_ + 3]), cvtpk(cc_[k8_ + 4], cc_[k8_ + 5]), cvtpk(cc_[k8_ + 6], cc_[k8_ + 7])};
                    sa_[kk] = fadd_s(fadd_s(fadd_s(cc_[k8_], cc_[k8_ + 1]), fadd_s(cc_[k8_ + 2], cc_[k8_ + 3])), fadd_s(fadd_s(cc_[k8_ + 4], cc_[k8_ + 5]), fadd_s(cc_[k8_ + 6], cc_[k8_ + 7])));
                    const bf16x8 v0_ = (bf16x8){vl_[kk][0], vl_[kk][1], vl_[kk][2], vl_[kk][3], vh_[kk][0], vh_[kk][1], vh_[kk][2], vh_[kk][3]}, v1_ = (bf16x8){vl_[4 + kk][0], vl_[4 + kk][1], vl_[4 + kk][2], vl_[4 + kk][3], vh_[4 + kk][0], vh_[4 + kk][1], vh_[4 + kk][2], vh_[4 + kk][3]};
                    o0 = __builtin_amdgcn_mfma_f32_32x32x16_bf16(__builtin_bit_cast(bf16x8, pw_), v0_, o0, 0, 0, 0); o1 = __builtin_amdgcn_mfma_f32_32x32x16_bf16(__builtin_bit_cast(bf16x8, pw_), v1_, o1, 0, 0, 0);
                    __builtin_amdgcn_sched_barrier(0); }
                lsum = fadd_s(lsum, fadd_s(fadd_s(sa_[0], sa_[1]), fadd_s(sa_[2], sa_[3])));
            }
            ks = ks1; vs ^= 1;
            ATT_WAIT_BAR();
        }
    }
    const float lt = xhalf_sum(lsum);
    if (__any(!(lt > 1.0e-30f && lt < 1.0e30f))) bailed = true;
    if (bailed && lane == 0) bailw[0] = 1;
    if (hi == 0) wsf[32 + r32] = lt;
    asm volatile("s_waitcnt lgkmcnt(0)" ::: "memory");
    write_o(A, o0, o1, wsf, shm, wid, lane, r32, hi, rowbase + q0 + wid * 32, h * 64);
    asm volatile("s_waitcnt lgkmcnt(0)\n\ts_barrier" ::: "memory");
    const int redo = __builtin_amdgcn_readfirstlane(bailw[0]);
    asm volatile("s_waitcnt lgkmcnt(0)\n\ts_barrier" ::: "memory");
    return redo != 0;
#undef MF_ISSUE_K
#undef MF_ISSUE_V
#undef MF_ROWMAX
}
typedef int v8i __attribute__((ext_vector_type(8)));
__device__ __forceinline__ void mfma8_new(f32x16& d, const v8i& ka, const v8i& qb, const f32x16& c, int sa, int sb) {
    asm volatile("v_mfma_scale_f32_32x32x64_f8f6f4 %0, %1, %2, %3, %4, %5 op_sel_hi:[0,0,0]" : "=&v"(d) : "v"(ka), "v"(qb), "v"(c), "v"(sa), "v"(sb)); }
__device__ __forceinline__ void mfma8_acc(f32x16& d, const v8i& ka, const v8i& qb, int sa, int sb) {
    asm volatile("v_mfma_scale_f32_32x32x64_f8f6f4 %0, %1, %2, %0, %3, %4 op_sel_hi:[0,0,0]" : "+v"(d) : "v"(ka), "v"(qb), "v"(sa), "v"(sb)); }
__device__ __forceinline__ bool mla_unit_fast8(const Args& A, int b, int h, int qb, ALAS char* shm, const int tidb) {
    constexpr int KSLOT = 8192;
    constexpr float THR = 8.0f;
    int tid_l; asm volatile("v_mbcnt_lo_u32_b32 %0, -1, 0\n\tv_mbcnt_hi_u32_b32 %0, -1, %0" : "=v"(tid_l)); tid_l += tidb;
    const int tid = tid_l, lane = tid & 63, r32 = lane & 31, hi = lane >> 5;
    const int wid = __builtin_amdgcn_readfirstlane(tid >> 6);
    const long rowbase = (long)b * SEQ; const int q0 = qb * 256;
    const unsigned lds0 = (unsigned)(size_t)shm;
    ALAS float* wsf = (ALAS float*)(shm + L_WS) + wid * 64;
    ALAS int* bailw = (ALAS int*)(shm + L_BIAS);
    const int m_ = wid >> 2, kh_ = (wid >> 1) & 1, j_ = wid & 1;
    const long krow_ = rowbase + 32 * kh_ + r32;
    const unsigned char* ks8 = m_ == 0 ? A.KN8 + krow_ * 512 + h * 64 + 32 * hi + 16 * j_ : (hi == 0 ? A.KR8 + krow_ * 32 + 16 * j_ : A.ZERO + r32 * 16);
    const long kst8 = m_ == 0 ? 64 * 512 : (hi == 0 ? 64 * 32 : 0);
    const bf16* vsrc = A.V + (rowbase + 16 * (wid & 3) + (lane >> 2)) * 512 + h * 64 + (wid >> 2) * 32 + (lane & 3) * 8;
    const unsigned kdst = lds0 + L_K + wid * 1024, vdst = lds0 + L_V + wid * 1024;
#define MF_ISSUE_K(t, s) glds16(ks8 + (long)(t) * kst8, (unsigned)__builtin_amdgcn_readfirstlane(kdst + (s) * KSLOT))
#define MF_ISSUE_V(t, s) glds16(vsrc + (long)(t) * 64 * 512, (unsigned)__builtin_amdgcn_readfirstlane(vdst + (s) * VSLOT))
    const int t_end = 4 * qb + 4;
    const int cw = 4 * qb + (wid >> 1);
    if (tid == 0) bailw[0] = 0;
    MF_ISSUE_K(0, 0); MF_ISSUE_V(0, 0); MF_ISSUE_K(1, 1);
    const unsigned char* Q8w = A.Q8 + (rowbase + q0 + wid * 32 + r32) * 768 + h * 96;
    const unsigned char* Q8r = hi == 0 ? Q8w + 64 : A.ZERO;
    v8i qf0, qf1;
    { const u32x4 a0 = *(const u32x4*)(Q8w + 32 * hi), a1 = *(const u32x4*)(Q8w + 32 * hi + 16), b0 = *(const u32x4*)(Q8r), b1 = *(const u32x4*)(Q8r + 16);
      qf0 = (v8i){(int)a0.x, (int)a0.y, (int)a0.z, (int)a0.w, (int)a1.x, (int)a1.y, (int)a1.z, (int)a1.w}; qf1 = (v8i){(int)b0.x, (int)b0.y, (int)b0.z, (int)b0.w, (int)b1.x, (int)b1.y, (int)b1.z, (int)b1.w}; }
    const int sa8 = 0x7c7c7c7c, sb8 = 0x7b7b7b7b;
    float lsum = 0.f; f32x16 o0 = {}, o1 = {};
    const int vbo = ((lane >> 4) & 1) * 32 + (lane & 3) * 8 + (4 * hi + ((lane & 15) >> 2)) * 64;
    ALAS const char* Kfr = shm + L_K + lane * 16;
#define M8_KFRAG(dst, base, m, kh) do { const u32x4 lo_ = *(ALAS const u32x4*)((base) + (((m) * 2 + (kh)) * 2) * 1024), hi_ = *(ALAS const u32x4*)((base) + (((m) * 2 + (kh)) * 2 + 1) * 1024); \
        dst = (v8i){(int)lo_.x, (int)lo_.y, (int)lo_.z, (int)lo_.w, (int)hi_.x, (int)hi_.y, (int)hi_.z, (int)hi_.w}; } while (0)
#define MF_ROWMAX(C0, C1) ({ float rmp_[4]; _Pragma("unroll") for (int j = 0; j < 4; ++j) { rmp_[j] = max3f(C0[j], C1[j], C0[4 + j]); rmp_[j] = max3f(rmp_[j], C1[4 + j], C0[8 + j]); rmp_[j] = max3f(rmp_[j], C1[8 + j], C0[12 + j]); rmp_[j] = max2f(rmp_[j], C1[12 + j]); } \
        xhalf_max(max2f(max3f(rmp_[0], rmp_[1], rmp_[2]), rmp_[3])); })
    ATT_WAIT_BAR();
    f32x16 cs[2][2];
    { f32x16 z0 = {}, z1 = {}; ALAS const char* Ks_ = Kfr;
      v8i k00, k01, k10, k11; M8_KFRAG(k00, Ks_, 0, 0); M8_KFRAG(k01, Ks_, 0, 1); M8_KFRAG(k10, Ks_, 1, 0); M8_KFRAG(k11, Ks_, 1, 1);
      mfma8_acc(z0, k00, qf0, sa8, sb8); mfma8_acc(z1, k01, qf0, sa8, sb8); mfma8_acc(z0, k10, qf1, sa8, sb8); mfma8_acc(z1, k11, qf1, sa8, sb8);
      asm volatile("s_nop 15\n\ts_nop 7" : "+v"(z0), "+v"(z1));
      cs[0][0] = z0; cs[0][1] = z1; }
    const float mhat = MF_ROWMAX(cs[0][0], cs[0][1]);
#pragma unroll
    for (int r = 0; r < 16; ++r) { cs[0][0][r] -= mhat; cs[0][1][r] -= mhat; }
    f32x16 negm;
#pragma unroll
    for (int r = 0; r < 16; ++r) negm[r] = -mhat;
    bool bailed = false; int ks = 0, vs = 0;
    for (int t2 = 0; t2 < t_end; t2 += 2) {
#pragma unroll
        for (int p = 0; p < 2; ++p) {
            const int t = t2 + p; f32x16 &C0 = cs[p][0], &C1 = cs[p][1], &N0 = cs[p ^ 1][0], &N1 = cs[p ^ 1][1];
            const bool vis = !bailed && t <= cw;
            const int ks1 = ks == 2 ? 0 : ks + 1, ks2 = ks1 == 2 ? 0 : ks1 + 1;
            if (t + 2 < t_end) MF_ISSUE_K(t + 2, ks2);
            if (t + 1 < t_end) MF_ISSUE_V(t + 1, vs ^ 1);
            if (vis) {
                {
                    ALAS const char* Ks_ = Kfr + ks1 * KSLOT;
                    v8i kfa, kfb; M8_KFRAG(kfa, Ks_, 0, 0);
                    M8_KFRAG(kfb, Ks_, 0, 1);
                    mfma8_new(N0, kfa, qf0, negm, sa8, sb8);
#pragma unroll
                    for (int e = 0; e < 8; ++e) C0[e] = __builtin_amdgcn_exp2f(C0[e]);
                    __builtin_amdgcn_sched_barrier(0);
                    M8_KFRAG(kfa, Ks_, 1, 0);
                    mfma8_new(N1, kfb, qf0, negm, sa8, sb8);
#pragma unroll
                    for (int e = 8; e < 16; ++e) C0[e] = __builtin_amdgcn_exp2f(C0[e]);
                    __builtin_amdgcn_sched_barrier(0);
                    M8_KFRAG(kfb, Ks_, 1, 1);
                    mfma8_acc(N0, kfa, qf1, sa8, sb8);
#pragma unroll
                    for (int e = 0; e < 8; ++e) C1[e] = __builtin_amdgcn_exp2f(C1[e]);
                    __builtin_amdgcn_sched_barrier(0);
                    mfma8_acc(N1, kfb, qf1, sa8, sb8);
#pragma unroll
                    for (int e = 8; e < 16; ++e) C1[e] = __builtin_amdgcn_exp2f(C1[e]);
                    __builtin_amdgcn_sched_barrier(0);
                }
                ALAS const char* vb_ = shm + L_V + vs * VSLOT + vbo; s16x4 vl_[8], vh_[8];
#pragma unroll
                for (int kk = 0; kk < 4; ++kk) { vl_[kk] = vtr(vb_ + kk * 1024); vh_[kk] = vtr(vb_ + kk * 1024 + 512); vl_[4 + kk] = vtr(vb_ + 4096 + kk * 1024); vh_[4 + kk] = vtr(vb_ + 4096 + kk * 1024 + 512); }
                float sa_[4];
#pragma unroll
                for (int kk = 0; kk < 4; ++kk) { const f32x16& cc_ = (kk < 2) ? C0 : C1; const int k8_ = 8 * (kk & 1);
                    const u32x4 pw_ = (u32x4){cvtpk(cc_[k8_], cc_[k8_ + 1]), cvtpk(cc_[k8_ + 2], cc_[k8_ + 3]), cvtpk(cc_[k8_ + 4], cc_[k8_ + 5]), cvtpk(cc_[k8_ + 6], cc_[k8_ + 7])};
                    sa_[kk] = fadd_s(fadd_s(fadd_s(cc_[k8_], cc_[k8_ + 1]), fadd_s(cc_[k8_ + 2], cc_[k8_ + 3])), fadd_s(fadd_s(cc_[k8_ + 4], cc_[k8_ + 5]), fadd_s(cc_[k8_ + 6], cc_[k8_ + 7])));
                    const bf16x8 v0_ = (bf16x8){vl_[kk][0], vl_[kk][1], vl_[kk][2], vl_[kk][3], vh_[kk][0], vh_[kk][1], vh_[kk][2], vh_[kk][3]}, v1_ = (bf16x8){vl_[4 + kk][0], vl_[4 + kk][1], vl_[4 + kk][2], vl_[4 + kk][3], vh_[4 + kk][0], vh_[4 + kk][1], vh_[4 + kk][2], vh_[4 + kk][3]};
                    o0 = __builtin_amdgcn_mfma_f32_32x32x16_bf16(__builtin_bit_cast(bf16x8, pw_), v0_, o0, 0, 0, 0); o1 = __builtin_amdgcn_mfma_f32_32x32x16_bf16(__builtin_bit_cast(bf16x8, pw_), v1_, o1, 0, 0, 0);
                    __builtin_amdgcn_sched_barrier(0); }
                lsum = fadd_s(lsum, fadd_s(fadd_s(sa_[0], sa_[1]), fadd_s(sa_[2], sa_[3])));
            }
            ks = ks1; vs ^= 1;
            ATT_WAIT_BAR();
        }
    }
    const float lt = xhalf_sum(lsum);
    if (__any(!(lt > 1.0e-30f && lt < 1.0e30f))) bailed = true;
    if (bailed && lane == 0) bailw[0] = 1;
    if (hi == 0) wsf[32 + r32] = lt;
    asm volatile("s_waitcnt lgkmcnt(0)" ::: "memory");
    write_o(A, o0, o1, wsf, shm, wid, lane, r32, hi, rowbase + q0 + wid * 32, h * 64);
    asm volatile("s_waitcnt lgkmcnt(0)\n\ts_barrier" ::: "memory");
    const int redo = __builtin_amdgcn_readfirstlane(bailw[0]);
    asm volatile("s_waitcnt lgkmcnt(0)\n\ts_barrier" ::: "memory");
    return redo != 0;
#undef MF_ISSUE_K
#undef MF_ISSUE_V
#undef MF_ROWMAX
#undef M8_KFRAG
}
__device__ __forceinline__ bool chunk_unit_fast(const Args& A, int b, int h, int qb, ALAS char* shm, const int tidb) {
    constexpr int NDK = 4, KSLOT = NDK * 2048;
    constexpr float THR = 8.0f;
    int tid_l; asm volatile("v_mbcnt_lo_u32_b32 %0, -1, 0\n\tv_mbcnt_hi_u32_b32 %0, -1, %0" : "=v"(tid_l)); tid_l += tidb;
    const int tid = tid_l, lane = tid & 63, r32 = lane & 31, hi = lane >> 5;
    const int wid = __builtin_amdgcn_readfirstlane(tid >> 6);
    const long rowbase = (long)b * SEQ; const int q0 = qb * 256;
    const unsigned lds0 = (unsigned)(size_t)shm;
    ALAS float* wsf = (ALAS float*)(shm + L_WS) + wid * 64;
    ALAS float* bt = (ALAS float*)(shm + L_BIAS);
    ALAS int* bailw = (ALAS int*)(shm + L_BIAS) + 300;
    const bf16* ksrc = A.KB + (rowbase + lane) * 512 + h * 64 + wid * 8;
    const bf16* vsrc = A.VB + (rowbase + 16 * (wid & 3) + (lane >> 2)) * 512 + h * 64 + (wid >> 2) * 32 + (lane & 3) * 8;
    const unsigned kdst = lds0 + L_K + wid * 1024, vdst = lds0 + L_V + wid * 1024;
#define CF_ISSUE_K(t, s) glds16(ksrc + (long)(t) * 64 * 512, (unsigned)__builtin_amdgcn_readfirstlane(kdst + (s) * KSLOT))
#define CF_ISSUE_V(t, s) glds16(vsrc + (long)(t) * 64 * 512, (unsigned)__builtin_amdgcn_readfirstlane(vdst + (s) * VSLOT))
    const int t_end = 4 * qb + 4, t_begin = 4 * qb - 8 > 0 ? 4 * qb - 8 : 0;
    const int cw = 4 * qb + (wid >> 1);
    const int vis_lo = cw - 8 > 0 ? cw - 8 : 0;
    if (tid == 0) bailw[0] = 0;
    if (tid < 257) bt[tid] = (A.bias[h * 257 + tid] - A.bias[h * 257 + 256]) * LOG2E;
    CF_ISSUE_K(t_begin, 0); CF_ISSUE_V(t_begin, 0); CF_ISSUE_K(t_begin + 1, 1);
    const bf16* Qw = A.QB + (rowbase + q0 + wid * 32 + r32) * 512 + h * 64 + hi * 8;
    bf16x8 qr[NDK];
#pragma unroll
    for (int d0 = 0; d0 < NDK; ++d0) qr[d0] = *(const bf16x8*)(Qw + d0 * 16);
    float lsum = 0.f; f32x16 o0 = {}, o1 = {};
    const int vbo = ((lane >> 4) & 1) * 32 + (lane & 3) * 8 + (4 * hi + ((lane & 15) >> 2)) * 64;
    ALAS const char* Kfr = shm + L_K + hi * 1024 + r32 * 16;
#define CF_ROWMAX(C0, C1) ({ float rmp_[4]; _Pragma("unroll") for (int j = 0; j < 4; ++j) { rmp_[j] = max3f(C0[j], C1[j], C0[4 + j]); rmp_[j] = max3f(rmp_[j], C1[4 + j], C0[8 + j]); rmp_[j] = max3f(rmp_[j], C1[8 + j], C0[12 + j]); rmp_[j] = max2f(rmp_[j], C1[12 + j]); } \
        xhalf_max(max2f(max3f(rmp_[0], rmp_[1], rmp_[2]), rmp_[3])); })
#define CF_BIAS(C0, C1, tt) do { const int dq_ = 64 * (cw - (tt)) + 32 * (wid & 1) + r32 + 128; \
        _Pragma("unroll") for (int r = 0; r < 16; ++r) { int i0 = dq_ - crow(r, hi), i1 = i0 - 32; i0 = i0 < 0 ? 0 : (i0 > 256 ? 256 : i0); i1 = i1 < 0 ? 0 : (i1 > 256 ? 256 : i1); C0[r] += bt[i0]; C1[r] += bt[i1]; } } while (0)
    f32x16 cs[2][2], negm;
    ATT_WAIT_BAR();
    { f32x16 z0 = {}, z1 = {};
#pragma unroll
      for (int d0 = 0; d0 < NDK; ++d0) { const bf16x8 a0 = *(ALAS const bf16x8*)(Kfr + d0 * 2048), a1 = *(ALAS const bf16x8*)(Kfr + d0 * 2048 + 512);
          z0 = __builtin_amdgcn_mfma_f32_32x32x16_bf16(a0, qr[d0], z0, 0, 0, 0); z1 = __builtin_amdgcn_mfma_f32_32x32x16_bf16(a1, qr[d0], z1, 0, 0, 0); }
      asm volatile("s_nop 15\n\ts_nop 7" : "+v"(z0), "+v"(z1));
      if (vis_lo == t_begin && t_begin >= cw - 2) CF_BIAS(z0, z1, t_begin);
      const float mhat = CF_ROWMAX(z0, z1);
#pragma unroll
      for (int r = 0; r < 16; ++r) { z0[r] -= mhat; z1[r] -= mhat; negm[r] = -mhat; }
      cs[0][0] = z0; cs[0][1] = z1; cs[1][0] = z0; cs[1][1] = z1; }
    bool bailed = false; int ks = 0, vs = 0;
    for (int t2 = t_begin; t2 < t_end; t2 += 2) {
#pragma unroll
        for (int p = 0; p < 2; ++p) {
            const int t = t2 + p; f32x16 &C0 = cs[p][0], &C1 = cs[p][1], &N0 = cs[p ^ 1][0], &N1 = cs[p ^ 1][1];
            if (t >= vis_lo && t > t_begin && t <= cw) { if (t >= cw - 2) CF_BIAS(C0, C1, t); }
            const bool vis = !bailed && t >= vis_lo && t <= cw;
            const int ks1 = ks == 2 ? 0 : ks + 1, ks2 = ks1 == 2 ? 0 : ks1 + 1;
            if (t + 2 < t_end) CF_ISSUE_K(t + 2, ks2);
            if (t + 1 < t_end) CF_ISSUE_V(t + 1, vs ^ 1);
            if (vis) {
                {
                    ALAS const char* Ks_ = Kfr + ks1 * KSLOT;
                    bf16x8 ka = *(ALAS const bf16x8*)(Ks_), kb = *(ALAS const bf16x8*)(Ks_ + 512);
                    constexpr int NM = 2 * NDK;
#pragma unroll
                    for (int d0 = 0; d0 < NDK; ++d0) {
                        bf16x8 na = ka, nb = kb;
                        if (d0 + 1 < NDK) { na = *(ALAS const bf16x8*)(Ks_ + (d0 + 1) * 2048); nb = *(ALAS const bf16x8*)(Ks_ + (d0 + 1) * 2048 + 512); }
                        N0 = __builtin_amdgcn_mfma_f32_32x32x16_bf16(ka, qr[d0], d0 == 0 ? negm : N0, 0, 0, 0);
#pragma unroll
                        for (int e = 0; e < 32; ++e) if (e * NM / 32 == 2 * d0) { if (e < 16) C0[e] = __builtin_amdgcn_exp2f(C0[e]); else C1[e - 16] = __builtin_amdgcn_exp2f(C1[e - 16]); }
                        __builtin_amdgcn_sched_barrier(0);
                        N1 = __builtin_amdgcn_mfma_f32_32x32x16_bf16(kb, qr[d0], d0 == 0 ? negm : N1, 0, 0, 0);
#pragma unroll
                        for (int e = 0; e < 32; ++e) if (e * NM / 32 == 2 * d0 + 1) { if (e < 16) C0[e] = __builtin_amdgcn_exp2f(C0[e]); else C1[e - 16] = __builtin_amdgcn_exp2f(C1[e - 16]); }
                        __builtin_amdgcn_sched_barrier(0);
                        ka = na; kb = nb;
                    }
                }
                ALAS const char* vb_ = shm + L_V + vs * VSLOT + vbo; s16x4 vl_[8], vh_[8];
#pragma unroll
                for (int kk = 0; kk < 4; ++kk) { vl_[kk] = vtr(vb_ + kk * 1024); vh_[kk] = vtr(vb_ + kk * 1024 + 512); vl_[4 + kk] = vtr(vb_ + 4096 + kk * 1024); vh_[4 + kk] = vtr(vb_ + 4096 + kk * 1024 + 512); }
                float sa_[4];
#pragma unroll
                for (int kk = 0; kk < 4; ++kk) { const f32x16& cc_ = (kk < 2) ? C0 : C1; const int k8_ = 8 * (kk & 1);
                    const u32x4 pw_ = (u32x4){cvtpk(cc_[k8_], cc_[k8_ + 1]), cvtpk(cc_[k8_ + 2], cc_[k8_ + 3]), cvtpk(cc_[k8_ + 4], cc_[k8_ + 5]), cvtpk(cc_[k8_ + 6], cc_[k8_ + 7])};
                    sa_[kk] = fadd_s(fadd_s(fadd_s(cc_[k8_], cc_[k8_ + 1]), fadd_s(cc_[k8_ + 2], cc_[k8_ + 3])), fadd_s(fadd_s(cc_[k8_ + 4], cc_[k8_ + 5]), fadd_s(cc_[k8_ + 6], cc_[k8_ + 7])));
                    const bf16x8 v0_ = (bf16x8){vl_[kk][0], vl_[kk][1], vl_[kk][2], vl_[kk][3], vh_[kk][0], vh_[kk][1], vh_[kk][2], vh_[kk][3]}, v1_ = (bf16x8){vl_[4 + kk][0], vl_[4 + kk][1], vl_[4 + kk][2], vl_[4 + kk][3], vh_[4 + kk][0], vh_[4 + kk][1], vh_[4 + kk][2], vh_[4 + kk][3]};
                    o0 = __builtin_amdgcn_mfma_f32_32x32x16_bf16(__builtin_bit_cast(bf16x8, pw_), v0_, o0, 0, 0, 0); o1 = __builtin_amdgcn_mfma_f32_32x32x16_bf16(__builtin_bit_cast(bf16x8, pw_), v1_, o1, 0, 0, 0);
                    __builtin_amdgcn_sched_barrier(0); }
                lsum = fadd_s(lsum, fadd_s(fadd_s(sa_[0], sa_[1]), fadd_s(sa_[2], sa_[3])));
            } else if (!bailed && t + 1 == vis_lo) {
                ALAS const char* Kq_ = Kfr + ks1 * KSLOT;
#pragma unroll
                for (int d0 = 0; d0 < NDK; ++d0) { const bf16x8 a0 = *(ALAS const bf16x8*)(Kq_ + d0 * 2048), a1 = *(ALAS const bf16x8*)(Kq_ + d0 * 2048 + 512);
                    N0 = __builtin_amdgcn_mfma_f32_32x32x16_bf16(a0, qr[d0], d0 == 0 ? negm : N0, 0, 0, 0); N1 = __builtin_amdgcn_mfma_f32_32x32x16_bf16(a1, qr[d0], d0 == 0 ? negm : N1, 0, 0, 0); }
            }
            ks = ks1; vs ^= 1;
            ATT_WAIT_BAR();
        }
    }
    const float lt = xhalf_sum(lsum);
    if (__any(!(lt > 1.0e-30f && lt < 1.0e30f))) bailed = true;
    if (bailed && lane == 0) bailw[0] = 1;
    if (hi == 0) wsf[32 + r32] = lt;
    asm volatile("s_waitcnt lgkmcnt(0)" ::: "memory");
    write_o(A, o0, o1, wsf, shm, wid, lane, r32, hi, rowbase + q0 + wid * 32, 512 + h * 64);
    asm volatile("s_waitcnt lgkmcnt(0)\n\ts_barrier" ::: "memory");
    const int redo = __builtin_amdgcn_readfirstlane(bailw[0]);
    asm volatile("s_waitcnt lgkmcnt(0)\n\ts_barrier" ::: "memory");
    return redo != 0;
#undef CF_ISSUE_K
#undef CF_ISSUE_V
#undef CF_ROWMAX
#undef CF_BIAS
}
template <bool CHUNK>
__device__ __forceinline__ void attn_phase(const Args& A, int vcu, int G, ALAS char* shm, const int tidb) {
    if (G == 256) {
        for (int i = 0; i < 4; ++i) {
            int bh, qb;
            if (CHUNK) { const int u = vcu * 4 + i; bh = u >> 5; qb = u & 31; }
            else { const int s = vcu & 7; bh = vcu >> 3; qb = (i == 0) ? s : (i == 1) ? 15 - s : (i == 2) ? 16 + s : 31 - s; }
            if (CHUNK) { if (chunk_unit_fast(A, bh >> 3, bh & 7, qb, shm, tidb)) attn_unit<CHUNK>(A, bh >> 3, bh & 7, qb, shm, tidb); }
            else if (A.qk8) { if (mla_unit_fast8(A, bh >> 3, bh & 7, qb, shm, tidb)) attn_unit8(A, bh >> 3, bh & 7, qb, shm, tidb); }
            else if (mla_unit_fast(A, bh >> 3, bh & 7, qb, shm, tidb)) attn_unit<CHUNK>(A, bh >> 3, bh & 7, qb, shm, tidb);
        }
    } else {
        for (int u = vcu; u < 1024; u += G) { if (!CHUNK && A.qk8) attn_unit8(A, u >> 8, (u >> 5) & 7, u & 31, shm, tidb); else attn_unit<CHUNK>(A, u >> 8, (u >> 5) & 7, u & 31, shm, tidb); }
    }
}

#undef ATT_WAIT_BAR
}
#define GAS __attribute__((address_space(1)))
#define LAS __attribute__((address_space(3)))
typedef unsigned short bf16;
typedef unsigned v4u __attribute__((ext_vector_type(4)));
typedef float f32x4 __attribute__((ext_vector_type(4)));
typedef short bf16x8 __attribute__((ext_vector_type(8)));
typedef GAS unsigned gu32;
typedef GAS unsigned long long gu64;
#define RLX_AGENT __ATOMIC_RELAXED, __HIP_MEMORY_SCOPE_AGENT
#define LDS_WAIT() asm volatile("s_waitcnt lgkmcnt(0)" ::: "memory")
#define VM_WAIT() asm volatile("s_waitcnt vmcnt(0)" ::: "memory")
__device__ __forceinline__ unsigned long long rt() { return __builtin_amdgcn_s_memrealtime(); }
__device__ __forceinline__ unsigned f2bf(float f) { unsigned u = __builtin_bit_cast(unsigned, f); return (u + 0x7fffu + ((u >> 16) & 1u)) >> 16; }
__device__ __forceinline__ unsigned pk2(float lo, float hi) { return f2bf(lo) | (f2bf(hi) << 16); }

#define XB_TMO      128
#define XB_XCNT(j)  (256  + 64 * (j))
#define XB_XSUB(j)  (1280 + 64 * (j))
#define XB_XGEN(j)  (2304 + 64 * (j))
#define XB_TOP      3328
#define XB_TOPGEN   3392
#define XCD_BAR_WORDS 3456
#define XB_SPIN_CAP (1u << 18)

__device__ __forceinline__ unsigned xb_ld(unsigned* p)              { return __hip_atomic_load(p, __ATOMIC_RELAXED, __HIP_MEMORY_SCOPE_AGENT); }
__device__ __forceinline__ unsigned xb_add(unsigned* p, unsigned v) { return __hip_atomic_fetch_add(p, v, __ATOMIC_RELAXED, __HIP_MEMORY_SCOPE_AGENT); }
__device__ __forceinline__ unsigned xb_xcc_id() { return (unsigned)__builtin_amdgcn_s_getreg((3 << 11) | 20) & 0xFu; }
#define XB_SPIN(cond, bar) do { unsigned _sp = 0; while (cond) { __builtin_amdgcn_s_sleep(1); \
    if ((++_sp & 255u) == 0u) { if (xb_ld(&(bar)[XB_TMO])) break; if (_sp > XB_SPIN_CAP) { atomicAdd(&(bar)[XB_TMO], 1u); break; } } } } while (0)

struct XcdBarrier {
    unsigned* bar; unsigned x;
    volatile LAS unsigned* st;
};

__device__ __forceinline__ XcdBarrier xcd_barrier_post(unsigned* bar, volatile LAS unsigned* st, const bool t0  ) {
    XcdBarrier b; b.bar = bar; b.x = xb_xcc_id(); b.st = st;
    if (t0) (void)xb_add(&bar[XB_XCNT(b.x)], 1u);
    return b;
}
__device__ __forceinline__ void xcd_barrier_complete(unsigned* bar, unsigned x, unsigned& nloc, unsigned& nx) {
    const unsigned G = gridDim.x * gridDim.y * gridDim.z;
    unsigned sum, cnt, mine, sp = 0u;
    for (;;) {
        sum = 0u; cnt = 0u; mine = 0u;
#pragma unroll
        for (unsigned j = 0; j < 16; ++j) { const unsigned c = xb_ld(&bar[XB_XCNT(j)]); sum += c; cnt += (c > 0u) ? 1u : 0u; mine = (j == x) ? c : mine; }
        if (sum == G) break;
        __builtin_amdgcn_s_sleep(1);
        if ((++sp & 255u) == 0u) { if (xb_ld(&bar[XB_TMO])) break; if (sp > XB_SPIN_CAP) { atomicAdd(&bar[XB_TMO], 1u); break; } }
    }
    nloc = mine > 0u ? mine : 1u; nx = cnt > 0u ? cnt : 1u;
}

template <bool CENSUS> __device__ __forceinline__ void xcd_barrier(const XcdBarrier& b, const bool t0  ) {
    asm volatile("s_waitcnt vmcnt(0)" ::: "memory");
    __syncthreads();
    if (t0) {
        unsigned* bar = b.bar;
        __builtin_amdgcn_s_waitcnt(0);
        unsigned nloc = b.st[0], nx = b.st[1];
        if (CENSUS) { if (nloc == 0u) { xcd_barrier_complete(bar, b.x, nloc, nx); b.st[0] = nloc; b.st[1] = nx; } }
        const unsigned old = xb_add(&bar[XB_XSUB(b.x)], 1u);
        const unsigned gen = old / nloc;
        if (old + 1u == (gen + 1u) * nloc) {
            __builtin_amdgcn_fence(__ATOMIC_RELEASE, "agent");
            asm volatile("s_waitcnt vmcnt(0)" ::: "memory");
            const unsigned og = xb_add(&bar[XB_TOP], 1u);
            const unsigned tg = og / nx;
            if (og + 1u == (tg + 1u) * nx) xb_add(&bar[XB_TOPGEN], 1u);
            else XB_SPIN(xb_ld(&bar[XB_TOPGEN]) == tg, bar);
            __builtin_amdgcn_fence(__ATOMIC_ACQUIRE, "agent");
            xb_add(&bar[XB_XGEN(b.x)], 1u);
            asm volatile("s_waitcnt vmcnt(0)" ::: "memory");
        } else {
            XB_SPIN(xb_ld(&bar[XB_XGEN(b.x)]) == gen, bar);
            __builtin_amdgcn_fence(__ATOMIC_ACQUIRE, "agent");
            asm volatile("s_waitcnt vmcnt(0)" ::: "memory");
        }
    }
    __syncthreads();
}
static_assert(att::L_END <= RING_BYTES && RSTAB_OFF + 8 * 1024 <= LDS_BYTES, "LDS map");
typedef unsigned v2u __attribute__((ext_vector_type(2)));
typedef int v4i __attribute__((ext_vector_type(4)));
#define SWZ_XOR(x) (((x) << 10) | 0x1F)
__device__ __forceinline__ float wave_sum(float v) {
    v += __int_as_float(__builtin_amdgcn_ds_swizzle(__float_as_int(v), SWZ_XOR(1))); v += __int_as_float(__builtin_amdgcn_ds_swizzle(__float_as_int(v), SWZ_XOR(2)));
    v += __int_as_float(__builtin_amdgcn_ds_swizzle(__float_as_int(v), SWZ_XOR(4))); v += __int_as_float(__builtin_amdgcn_ds_swizzle(__float_as_int(v), SWZ_XOR(8)));
    v += __int_as_float(__builtin_amdgcn_ds_swizzle(__float_as_int(v), SWZ_XOR(16)));
    auto rr = __builtin_amdgcn_permlane32_swap(__float_as_uint(v), __float_as_uint(v), false, false); return __uint_as_float(rr[0]) + __uint_as_float(rr[1]);
}
__device__ __forceinline__ int wave_sum_i(int v) {
    v += __builtin_amdgcn_ds_swizzle(v, SWZ_XOR(1)); v += __builtin_amdgcn_ds_swizzle(v, SWZ_XOR(2)); v += __builtin_amdgcn_ds_swizzle(v, SWZ_XOR(4)); v += __builtin_amdgcn_ds_swizzle(v, SWZ_XOR(8)); v += __builtin_amdgcn_ds_swizzle(v, SWZ_XOR(16));
    auto rr = __builtin_amdgcn_permlane32_swap((unsigned)v, (unsigned)v, false, false); return (int)(rr[0] + rr[1]);
}
enum { TM_ID = 0, TM_IN, TM_UQ, TM_UKV, TM_W1, TM_W3 };
__device__ __forceinline__ int rope_pos(int j) { return j < 16 ? 8 * (j >> 2) + (j & 3) : 8 * ((j - 16) >> 2) + 4 + (j & 3); }
__device__ __forceinline__ int tr_dest_row(int mode, int n0, int n) {
    if (mode == TM_IN) { const int gb = n0 < 672 ? n0 : n0 + 96; return gb + (n0 == 640 ? rope_pos(n) : n); }
    if (mode == TM_UQ) return n0 + ((((n0 >> 5) % 3) == 2) ? rope_pos(n) : n);
    if (mode == TM_UKV) { const int h = n0 >> 7, j0 = n0 & 127; return (j0 < 64 ? h * 64 + j0 : 512 + h * 64 + (j0 - 64)) + n; }
    if (mode == TM_W1) return (n0 >> 7) * 256 + (n0 & 127) + n;
    if (mode == TM_W3) return (n0 >> 7) * 256 + 128 + (n0 & 127) + n;
    return n0 + n;
}
struct TrJob { const float* W; int K, N; bf16* dst; const float* gain; int mode; int f8; };
__device__ __forceinline__ void tr_item(const TrJob& J, int item, LAS float* scr, int lane) {
    const int nblk = J.N / 32, kb = item / nblk, nb = item % nblk, k0 = 64 * kb, n0 = 32 * nb;
    float wv[32];
#pragma unroll
    for (int i = 0; i < 32; ++i) wv[i] = __builtin_nontemporal_load(J.W + (size_t)(k0 + 2 * i + (lane >> 5)) * J.N + n0 + (lane & 31));
#pragma unroll
    for (int i = 0; i < 32; ++i) scr[(2 * i + (lane >> 5)) * 33 + (lane & 31)] = wv[i];
    LDS_WAIT(); asm volatile("" ::: "memory");
    const int c = lane & 7; float g[8];
#pragma unroll
    for (int e = 0; e < 8; ++e) g[e] = J.gain ? J.gain[k0 + 8 * c + e] : 1.f;
#pragma unroll
    for (int j = 0; j < 4; ++j) { const int n = (lane >> 3) + 8 * j; const LAS float* s = scr + (8 * c) * 33 + n;
        if (J.f8) { int w0 = 0, w1 = 0;
            w0 = __builtin_amdgcn_cvt_pk_fp8_f32(s[0 * 33] * g[0] * 64.0f, s[1 * 33] * g[1] * 64.0f, w0, false); w0 = __builtin_amdgcn_cvt_pk_fp8_f32(s[2 * 33] * g[2] * 64.0f, s[3 * 33] * g[3] * 64.0f, w0, true);
            w1 = __builtin_amdgcn_cvt_pk_fp8_f32(s[4 * 33] * g[4] * 64.0f, s[5 * 33] * g[5] * 64.0f, w1, false); w1 = __builtin_amdgcn_cvt_pk_fp8_f32(s[6 * 33] * g[6] * 64.0f, s[7 * 33] * g[7] * 64.0f, w1, true);
            v2u o; o.x = (unsigned)w0; o.y = (unsigned)w1; *(GAS v2u*)((unsigned char*)J.dst + (size_t)tr_dest_row(J.mode, n0, n) * J.K + k0 + 8 * c) = o; }
        else { v4u o; o.x = pk2(s[0 * 33] * g[0], s[1 * 33] * g[1]); o.y = pk2(s[2 * 33] * g[2], s[3 * 33] * g[3]); o.z = pk2(s[4 * 33] * g[4], s[5 * 33] * g[5]); o.w = pk2(s[6 * 33] * g[6], s[7 * 33] * g[7]);
        *(GAS v4u*)(J.dst + (size_t)tr_dest_row(J.mode, n0, n) * J.K + k0 + 8 * c) = o; } }
    LDS_WAIT(); asm volatile("" ::: "memory");
}
__device__ __forceinline__ void tr_run(const TrJob& J, int& base, int gw, int NGW, LAS float* scr, int lane) {
    const int nitems = (J.K / 64) * (J.N / 32);
    int first = gw - (base % NGW); if (first < 0) first += NGW;
    for (int it = first; it < nitems; it += NGW) tr_item(J, it, scr, lane);
    base += nitems;
}
template <bool INIT, bool FINAL>
__device__ __forceinline__ void row_pass(const float* xin, float* xout, bf16* xb, float* ssx, const bf16* Y, const int* pos, const float* gfin, int gw, int NGW, int lane, unsigned char* xq = nullptr  ) {
    constexpr int U = 4;
    for (int t0 = gw; t0 < T_; t0 += U * NGW) {
        f32x4 v[U][4];
        if (INIT) {
#pragma unroll
            for (int u = 0; u < U; ++u) { const int t = t0 + u * NGW; if (t < T_) { const GAS f32x4* xr = (const GAS f32x4*)(xin + (size_t)t * D_) + lane;
#pragma unroll
                for (int j = 0; j < 4; ++j) v[u][j] = xr[64 * j]; } }
        } else {
            int p0[U], p1[U];
#pragma unroll
            for (int u = 0; u < U; ++u) { const int t = t0 + u * NGW; p0[u] = 0; p1[u] = 0; if (t < T_) { p0[u] = pos[2 * t]; p1[u] = pos[2 * t + 1]; } }
            v2u xw[U][4], aw[U][4], bw[U][4];
#pragma unroll
            for (int u = 0; u < U; ++u) { const int t = t0 + u * NGW; if (t < T_) {
                const GAS v2u* x0 = (const GAS v2u*)(xb + (size_t)t * D_) + lane;
                const GAS v2u* y0 = (const GAS v2u*)(Y + (size_t)p0[u] * D_) + lane; const GAS v2u* y1 = (const GAS v2u*)(Y + (size_t)p1[u] * D_) + lane;
#pragma unroll
                for (int j = 0; j < 4; ++j) { xw[u][j] = x0[64 * j]; aw[u][j] = y0[64 * j]; bw[u][j] = y1[64 * j]; } } }
#pragma unroll
            for (int u = 0; u < U; ++u)
#pragma unroll
                for (int j = 0; j < 4; ++j) { const v2u c = xw[u][j], a = aw[u][j], b = bw[u][j];
                    v[u][j].x = __uint_as_float(c.x << 16) + (__uint_as_float(a.x << 16) + __uint_as_float(b.x << 16)); v[u][j].y = __uint_as_float(c.x & 0xffff0000u) + (__uint_as_float(a.x & 0xffff0000u) + __uint_as_float(b.x & 0xffff0000u));
                    v[u][j].z = __uint_as_float(c.y << 16) + (__uint_as_float(a.y << 16) + __uint_as_float(b.y << 16)); v[u][j].w = __uint_as_float(c.y & 0xffff0000u) + (__uint_as_float(a.y & 0xffff0000u) + __uint_as_float(b.y & 0xffff0000u)); }
        }
#pragma unroll
        for (int u = 0; u < U; ++u) { const int t = t0 + u * NGW; if (t < T_) {
            float ss = 0.f;
#pragma unroll
            for (int j = 0; j < 4; ++j) ss += (v[u][j].x * v[u][j].x + v[u][j].y * v[u][j].y) + (v[u][j].z * v[u][j].z + v[u][j].w * v[u][j].w);
            ss = wave_sum(ss);
            if (FINAL) {
                GAS f32x4* xo = (GAS f32x4*)(xout + (size_t)t * D_) + lane;
                const float rs = 1.0f / sqrtf(ss * (1.0f / D_) + EPS_);
#pragma unroll
                for (int j = 0; j < 4; ++j) { const f32x4 g = ((const GAS f32x4*)gfin)[lane + 64 * j]; xo[64 * j] = v[u][j] * rs * g; }
            } else {
                GAS v2u* bo = (GAS v2u*)(xb + (size_t)t * D_) + lane;
#pragma unroll
                for (int j = 0; j < 4; ++j) { v2u w; w.x = pk2(v[u][j].x, v[u][j].y); w.y = pk2(v[u][j].z, v[u][j].w); bo[64 * j] = w; }
                if (xq) { GAS unsigned* qo = (GAS unsigned*)(xq + (size_t)t * D_) + lane;
#pragma unroll
                    for (int j = 0; j < 4; ++j) { int w = 0;
                        w = __builtin_amdgcn_cvt_pk_fp8_f32(__builtin_amdgcn_fmed3f(v[u][j].x * 8.0f, -448.f, 448.f), __builtin_amdgcn_fmed3f(v[u][j].y * 8.0f, -448.f, 448.f), w, false);
                        w = __builtin_amdgcn_cvt_pk_fp8_f32(__builtin_amdgcn_fmed3f(v[u][j].z * 8.0f, -448.f, 448.f), __builtin_amdgcn_fmed3f(v[u][j].w * 8.0f, -448.f, 448.f), w, true); qo[64 * j] = (unsigned)w; } }
                if (lane < 16) ssx[(size_t)t * 16 + lane] = lane == 0 ? ss : 0.f;
            } } }
    }
}
__device__ __forceinline__ void moe_route1(LAS unsigned char* lds, const bf16* x, const float* ssx, const float* wr, const float* g, int* tok_e, float* tok_g, float* tok_rs, int* counts, int bx, int G, int tid, int wave, int lane) {
    LAS float* wrgT = (LAS float*)lds;
    LAS int* hist = (LAS int*)(lds + 32768);
    for (int idx = tid; idx < 8192; idx += 512) { const int k = idx >> 3, e = idx & 7; wrgT[e * 1024 + k] = wr[idx] * g[k]; }
    __syncthreads();
    for (int ch = bx; ch < T_ / 128; ch += G) {
        if (tid < 8) hist[tid] = 0;
        __syncthreads();
        for (int i = 0; i < 16; ++i) {
            const int t = ch * 128 + wave * 16 + i;
            const GAS v2u* xr = (const GAS v2u*)(x + (size_t)t * D_) + lane;
            f32x4 xv[4];
#pragma unroll
            for (int j = 0; j < 4; ++j) { const v2u c = xr[64 * j]; xv[j] = (f32x4){__uint_as_float(c.x << 16), __uint_as_float(c.x & 0xffff0000u), __uint_as_float(c.y << 16), __uint_as_float(c.y & 0xffff0000u)}; }
            float lg[8];
#pragma unroll
            for (int e = 0; e < 8; ++e) { float a = 0.f;
#pragma unroll
                for (int j = 0; j < 4; ++j) { const f32x4 w = *(const LAS f32x4*)(wrgT + e * 1024 + 256 * j + 4 * lane); a += (xv[j].x * w.x + xv[j].y * w.y) + (xv[j].z * w.z + xv[j].w * w.w); }
                lg[e] = wave_sum(a); }
            const float ssp = lane < 16 ? ssx[(size_t)t * 16 + lane] : 0.f;
            const float rs = 1.0f / sqrtf(wave_sum(ssp) * (1.0f / D_) + EPS_);
#pragma unroll
            for (int e = 0; e < 8; ++e) lg[e] *= rs;
            int e0 = 0; float b0 = lg[0];
#pragma unroll
            for (int e = 1; e < 8; ++e) if (lg[e] > b0) { b0 = lg[e]; e0 = e; }
            int e1 = -1; float b1 = -3.0e38f;
#pragma unroll
            for (int e = 0; e < 8; ++e) if (e != e0 && (e1 < 0 || lg[e] > b1)) { b1 = lg[e]; e1 = e; }
            const float g0 = 1.0f / (1.0f + __builtin_amdgcn_exp2f((b1 - b0) * LOG2E_)), g1 = 1.0f - g0;
            if (lane == 0) { tok_e[t] = e0 | (e1 << 8); tok_g[2 * t] = g0; tok_g[2 * t + 1] = g1; tok_rs[t] = rs; atomicAdd((int*)&hist[e0], 1); atomicAdd((int*)&hist[e1], 1); }
        }
        __syncthreads();
        if (tid < 8) counts[ch * 8 + tid] = hist[tid];
        __syncthreads();
    }
}
__device__ __forceinline__ void moe_route2(LAS unsigned char* lds, const bf16* xb, bf16* xs, const int* tok_e, const float* tok_g, const float* tok_rs, const int* counts, int* pos, float* rowg, float* rowrs, int* meta,
                                           int bx, int G, int tid, int wave, int lane, bool f8) {
    LAS int* lcnt = (LAS int*)lds; LAS int* ltot = lcnt + 2048; LAS int* lbef = ltot + 8; LAS int* ldest = lbef + 8;
    for (int ch = bx; ch < T_ / 128; ch += G) {
        { const v4i v = ((const v4i*)counts)[tid]; ((LAS v4i*)lcnt)[tid] = v; }
        __syncthreads();
        { const int e = wave; int tot = 0, bef = 0;
#pragma unroll
          for (int i = 0; i < 4; ++i) { const int c2 = lane + 64 * i; const int v = lcnt[c2 * 8 + e]; tot += v; bef += (c2 < ch) ? v : 0; }
          tot = wave_sum_i(tot); bef = wave_sum_i(bef); if (lane == 0) { ltot[e] = tot; lbef[e] = bef; } }
        __syncthreads();
        int pst[8], pen[8]; { int run = 0;
#pragma unroll
            for (int e = 0; e < 8; ++e) { const int tt = ltot[e]; pst[e] = run; run += (tt + 255) & ~255; pen[e] = run; } }
        if (wave == 0) {
            int runc[8];
#pragma unroll
            for (int e = 0; e < 8; ++e) runc[e] = pst[e] + lbef[e];
#pragma unroll
            for (int half = 0; half < 2; ++half) {
                const int tl = half * 64 + lane, t = ch * 128 + tl; const int ee = tok_e[t]; const int e0 = ee & 255, e1 = ee >> 8;
                int d0 = 0, d1 = 0;
#pragma unroll
                for (int e = 0; e < 8; ++e) { const bool m0 = (e0 == e), m1 = (e1 == e); const unsigned long long mk = __ballot(m0 || m1);
                    const int rank = __popcll(mk & ((1ull << lane) - 1ull)); if (m0) d0 = runc[e] + rank; if (m1) d1 = runc[e] + rank; runc[e] += __popcll(mk); }
                ldest[2 * tl] = d0; ldest[2 * tl + 1] = d1; pos[2 * t] = d0; pos[2 * t + 1] = d1;
                const float g0 = tok_g[2 * t], g1 = tok_g[2 * t + 1], rs = tok_rs[t];
                rowg[d0] = g0; rowg[d1] = g1; rowrs[d0] = rs; rowrs[d1] = rs;
            }
        }
        __syncthreads();
        if (f8) {
            for (int ab = wave; ab < 256; ab += 32) {
              v4u ra0[4], ra1[4]; float rsc[4];
#pragma unroll
              for (int u = 0; u < 4; ++u) { const int a = ab + 8 * u, t = ch * 128 + (a >> 1); rsc[u] = tok_rs[t] * 16.0f; const GAS v4u* s = (const GAS v4u*)(xb + (size_t)t * D_) + 2 * lane; ra0[u] = s[0]; ra1[u] = s[1]; }
#pragma unroll
              for (int u = 0; u < 4; ++u) { const int a = ab + 8 * u; const int d = ldest[a]; const float sc = rsc[u]; const v4u a0 = ra0[u], a1 = ra1[u];
                v4u o;
#define F8PK(w) ({ int r_ = 0; r_ = __builtin_amdgcn_cvt_pk_fp8_f32(__builtin_amdgcn_fmed3f(__uint_as_float((w).x << 16) * sc, -448.f, 448.f), __builtin_amdgcn_fmed3f(__uint_as_float((w).x & 0xffff0000u) * sc, -448.f, 448.f), r_, false); \
                   r_ = __builtin_amdgcn_cvt_pk_fp8_f32(__builtin_amdgcn_fmed3f(__uint_as_float((w).y << 16) * sc, -448.f, 448.f), __builtin_amdgcn_fmed3f(__uint_as_float((w).y & 0xffff0000u) * sc, -448.f, 448.f), r_, true); (unsigned)r_; })
                { v2u p; p.x = a0.x; p.y = a0.y; o.x = F8PK(p); p.x = a0.z; p.y = a0.w; o.y = F8PK(p); p.x = a1.x; p.y = a1.y; o.z = F8PK(p); p.x = a1.z; p.y = a1.w; o.w = F8PK(p); }
#undef F8PK
                *((GAS v4u*)((unsigned char*)xs + (size_t)d * D_) + lane) = o; } }
        } else {
        for (int a = wave; a < 256; a += 8) { const int t = ch * 128 + (a >> 1); const int d = ldest[a];
            const GAS v4u* s = (const GAS v4u*)(xb + (size_t)t * D_) + lane; GAS v4u* o = (GAS v4u*)(xs + (size_t)d * D_) + lane;
            const v4u a0 = s[0], a1 = s[64]; o[0] = a0; o[64] = a1; }
        }
        if (ch == 0) {
            int pv = 0, ps = 0, tt = 0, pe_ = 0;
#pragma unroll
            for (int e = 0; e < 8; ++e) { if (tid == e) pv = pen[e]; if (wave == e) { ps = pst[e]; pe_ = pen[e]; tt = ltot[e]; } }
            if (tid < 8) meta[tid] = pv;
            for (int r = ps + tt + lane; r < pe_; r += 64) { rowrs[r] = 0.f; rowg[r] = 0.f; }
        }
        __syncthreads();
    }
}

struct Params { const float* in[18]; float* out; unsigned char* ws; int ph_lo, ph_hi; };
typedef __attribute__((address_space(4))) Params KP;
constexpr int IT_FF = (D_ / 64) * (FF_ / 32), MOE_ITEMS = NEXP * 3 * IT_FF;
static_assert(IT_FF == (FF_ / 64) * (D_ / 32), "w1 / w3 / w2 have the same item count");
constexpr int FILL_IN = 6000, FILL_IN8 = 4000, FILL_UQ = 2000, FILL_MD = 16000;
constexpr int fill_in(int l) { return f8_in_layer(l) ? FILL_IN8 : FILL_IN; }
constexpr int fill_in_at(int l) { return (l & 1) == 0 ? (l < 2 ? 0 : FILL_MD) : fill_in_at(l - 1) + fill_in(l - 1) + FILL_UQ; }
constexpr int FA0 = fill_in_at(0), FA1 = fill_in_at(1), FA2 = fill_in_at(2), FA3 = fill_in_at(3), FN0 = fill_in(0), FN1 = fill_in(1), FN2 = fill_in(2), FN3 = fill_in(3);
constexpr int L1_DONE = fill_in_at(1) + fill_in(1) + FILL_UQ, L3_DONE = fill_in_at(3) + fill_in(3) + FILL_UQ;
static_assert(FILL_MD <= NEXP * 2 * IT_FF && L3_DONE <= MOE_ITEMS, "early ranges");
__device__ __forceinline__ void moe_job(const KP* kp, unsigned char* ws, int l, int g, TrJob& J, int& it) {
    const int mj = l >> 1, j = g / IT_FF; it = g % IT_FF;
    unsigned char* WM13 = ws + WS_WM; unsigned char* WM2 = WM13 + (size_t)NEXP * 2 * FF_ * D_ * 2; const int eb = f8_layer(l) ? 1 : 2;
    if (j < 2 * NEXP) { const int e = j >> 1;
        if ((j & 1) == 0) J = TrJob{kp->in[14] + (size_t)(mj * NEXP + e) * D_ * FF_, D_, FF_, (bf16*)(WM13 + (size_t)e * 2 * FF_ * D_ * eb), kp->in[9] + l * D_, TM_W1, (int)f8_layer(l)};
        else J = TrJob{kp->in[15] + (size_t)(mj * NEXP + e) * D_ * FF_, D_, FF_, (bf16*)(WM13 + (size_t)e * 2 * FF_ * D_ * eb), kp->in[9] + l * D_, TM_W3, (int)f8_layer(l)};
    } else { const int e = j - 2 * NEXP; J = TrJob{kp->in[16] + (size_t)(mj * NEXP + e) * FF_ * D_, FF_, D_, (bf16*)(WM2 + (size_t)e * FF_ * D_ * eb), nullptr, TM_ID, (int)f8_layer(l)}; }
}
__device__ __forceinline__ void moe_fill(const KP* kp, unsigned char* ws, int l, int a, int b, int nwg, int G, int c, int wave, LAS unsigned char* lds, int lane) {
    const int r = nwg % G; int P = G, pidx = c;
    if (r != 0) { P = G - r; pidx = c - r; }
    if (pidx >= 0) { LAS float* scr = (LAS float*)(lds + wave * 16384);
        for (int g = a + pidx * NWAVES + wave; g < b; g += P * NWAVES) { TrJob J; int it; moe_job(kp, ws, l, g, J, it); tr_item(J, it, scr, lane); } }
    __syncthreads();
}
__device__ __forceinline__ const KP* kargs() { const KP* p = (const KP*)__builtin_amdgcn_kernarg_segment_ptr(); asm volatile("" : "+s"(p)); return p; }
__global__ void __launch_bounds__(NWAVES * 64, 2) hybrid_fwd(Params P) {
    extern __shared__ __attribute__((aligned(16))) unsigned char lds_raw[];
    LAS unsigned char* lds = (LAS unsigned char*)lds_raw;
    const int wave_s = __builtin_amdgcn_readfirstlane((int)threadIdx.x >> 6);
#define LANE_NOW() ({ int l_; asm volatile("v_mbcnt_lo_u32_b32 %0, -1, 0\n\tv_mbcnt_hi_u32_b32 %0, -1, %0" : "=v"(l_)); l_; })
#define T0_NOW() (wave_s == 0 && LANE_NOW() == 0)
    { const int tid0 = wave_s * 64 + LANE_NOW();
      for (int u = tid0; u < (LDS_BYTES - LDSCTL_OFF) / 4; u += NWAVES * 64) ((LAS unsigned*)(lds + LDSCTL_OFF))[u] = 0u; }
    __syncthreads();
#define GEOM() int G_l = gridDim.x, bx_l = blockIdx.x; asm volatile("" : "+s"(G_l), "+s"(bx_l));   const int G = G_l, bx = bx_l, vcu = (G % 8 == 0) ? (bx % 8) * (G / 8) + bx / 8 : bx; const int wave = wave_s; const int gw = vcu * NWAVES + wave, NGW = G * NWAVES; (void)gw; (void)NGW; (void)vcu; (void)bx
#define BAROBJ() XcdBarrier bar; bar.bar = (unsigned*)(kargs()->ws + WS_CTL); bar.x = xb_xcc_id(); bar.st = (volatile LAS unsigned*)(lds + MISC_OFF) + 8
    { const KP* kp0 = kargs(); const int lo0 = kp0->ph_lo, hi0 = kp0->ph_hi;
      if (hi0 - lo0 > 1) { XcdBarrier b0 = xcd_barrier_post((unsigned*)(kp0->ws + WS_CTL), (volatile LAS unsigned*)(lds + MISC_OFF) + 8, T0_NOW());
        if (lo0 != 0) { if (T0_NOW()) { unsigned nloc, nx; xcd_barrier_complete(b0.bar, b0.x, nloc, nx); b0.st[0] = nloc; b0.st[1] = nx; } __syncthreads(); } } }
#ifndef PROBE_MASK
#define PROBE_MASK 0
#endif
#define REPS(bit) ((((PROBE_MASK) >> (bit)) & 1) ? 2 : 1)
#define RUN(k) (kargs()->ph_lo <= (k) && (k) < kargs()->ph_hi)
#ifdef PROBE_BAR2
#define SEAM(k) do { if (RUN(k) && RUN((k) + 1)) { BAROBJ(); xcd_barrier<false>(bar, T0_NOW()); xcd_barrier<false>(bar, T0_NOW()); } } while (0)
#else
#define SEAM(k) do { if (RUN(k) && RUN((k) + 1)) { BAROBJ(); xcd_barrier<false>(bar, T0_NOW()); } } while (0)
#endif
#define SEAM_FIRST(k) do { if (RUN(k) && RUN((k) + 1)) { BAROBJ(); xcd_barrier<true>(bar, T0_NOW()); } } while (0)
#define PHASE_ENV() const KP* kp = kargs(); unsigned char* ws = kp->ws; (void)ws; const int lane_p = LANE_NOW(); const int tid_p = wave_s * 64 + lane_p; (void)tid_p; (void)lane_p; GEOM(); \
    float* X = kp->out; bf16* XB = (bf16*)(ws + WS_XB); float* SSX = (float*)(ws + WS_SSX); float* SSQ = (float*)(ws + WS_SSQ); float* RCOS = (float*)(ws + WS_RCOS); float* RSIN = (float*)(ws + WS_RSIN); \
    LAS float* rstab = (LAS float*)(lds + RSTAB_OFF); (void)X; (void)XB; (void)SSX; (void)SSQ; (void)RCOS; (void)RSIN; (void)rstab
#define ATT_PTRS() bf16 *CQ = (bf16*)(ws + WS_CQ), *CKV = (bf16*)(ws + WS_CKV), *KR = (bf16*)(ws + WS_KR), *QBb = (bf16*)(ws + WS_QB), *KBb = (bf16*)(ws + WS_KB), *VBb = (bf16*)(ws + WS_VB), \
         *Qm = (bf16*)(ws + WS_Q), *KN = (bf16*)(ws + WS_KN), *Vm = (bf16*)(ws + WS_V), *AO = (bf16*)(ws + WS_AO); (void)CQ; (void)CKV; (void)KR; (void)QBb; (void)KBb; (void)VBb; (void)Qm; (void)KN; (void)Vm; (void)AO
#define MOE_PTRS() bf16 *HM = (bf16*)(ws + WS_HM), *XS = (bf16*)(ws + WS_XS); int* TOKE = (int*)(ws + WS_TOKE); float* TOKG = (float*)(ws + WS_TOKG); float* TOKRS = (float*)(ws + WS_TOKRS); int* POS = (int*)(ws + WS_POS); \
    int* CNT = (int*)(ws + WS_CNT); int* META = (int*)(ws + WS_META); float* ROWG = (float*)(ws + WS_ROWG); float* ROWRS = (float*)(ws + WS_ROWRS); bf16* WM13 = (bf16*)(ws + WS_WM); bf16* WM2 = WM13 + (size_t)NEXP * 2 * FF_ * D_; \
    (void)HM; (void)XS; (void)TOKE; (void)TOKG; (void)TOKRS; (void)POS; (void)CNT; (void)META; (void)ROWG; (void)ROWRS; (void)WM13; (void)WM2
#define WATT_PTRS() const bf16* WIN = (const bf16*)(ws + WS_WATT + (size_t)l * WATT_L); const bf16* WUQ = WIN + (size_t)IN_PAD * D_; const bf16* WUKV = WUQ + 768 * QL_; const bf16* WOUT = WUKV + 1024 * KVL_; (void)WIN; (void)WUQ; (void)WUKV; (void)WOUT

    if (RUN(0)) for (int rep_ = 0; rep_ < REPS(9); ++rep_) {
        PHASE_ENV();
        LAS float* scr = (LAS float*)(lds + wave * 16384);
        int base = 0;
        for (int j = 0; j < 22; ++j) {
            TrJob J;
            if (j < 16) { const int l = j >> 2, k = j & 3; bf16* wl = (bf16*)(ws + WS_WATT + (size_t)l * WATT_L);
                if (k == 0) J = TrJob{kp->in[2] + (size_t)l * D_ * IN_DIM, D_, IN_DIM, wl, kp->in[1] + l * D_, TM_IN, (int)f8_in_layer(l)};
                else if (k == 1) J = TrJob{kp->in[4] + (size_t)l * QL_ * 768, QL_, 768, wl + (size_t)IN_PAD * D_, kp->in[3] + l * QL_, TM_UQ, 0};
                else if (k == 2) J = TrJob{kp->in[6] + (size_t)l * KVL_ * 1024, KVL_, 1024, wl + (size_t)IN_PAD * D_ + 768 * QL_, kp->in[5] + l * KVL_, TM_UKV, 0};
                else J = TrJob{kp->in[8] + (size_t)l * D_ * D_, D_, D_, wl + (size_t)IN_PAD * D_ + 768 * QL_ + 1024 * KVL_, nullptr, TM_ID, (int)f8_out_layer(l)};
            } else { const int dl = (j - 16) / 3, k = (j - 16) % 3; bf16* wl = (bf16*)(ws + WS_WD + (size_t)dl * WD_L);
                if (k == 0) J = TrJob{kp->in[10] + (size_t)dl * D_ * FF_, D_, FF_, wl, kp->in[9] + (2 * dl) * D_, TM_W1, (int)f8_up_layer(2 * dl)};
                else if (k == 1) J = TrJob{kp->in[11] + (size_t)dl * D_ * FF_, D_, FF_, wl, kp->in[9] + (2 * dl) * D_, TM_W3, (int)f8_up_layer(2 * dl)};
                else J = TrJob{kp->in[12] + (size_t)dl * FF_ * D_, FF_, D_, wl + (size_t)2 * FF_ * D_, nullptr, TM_ID, (int)f8_layer(2 * dl)};
            }
            tr_run(J, base, gw, NGW, scr, lane_p);
        }
        for (int r = gw; r < DEPTH_ * 96; r += NGW) {
            const v4u z = {0u, 0u, 0u, 0u};
            if (f8_in_layer(r / 96)) { GAS v4u* o = (GAS v4u*)((unsigned char*)(ws + WS_WATT + (size_t)(r / 96) * WATT_L) + (size_t)(672 + r % 96) * D_) + lane_p; o[0] = z; }
            else { GAS v4u* o = (GAS v4u*)((bf16*)(ws + WS_WATT + (size_t)(r / 96) * WATT_L) + (size_t)(672 + r % 96) * D_) + lane_p; o[0] = z; o[64] = z; } }
        for (int idx = gw * 64 + lane_p; idx < 8192 * 16; idx += NGW * 64) {
            const int pos = idx >> 4, j = idx & 15, j4 = j & 3, jq = j >> 2;
            const double c4 = j4 == 0 ? 1.0 : j4 == 1 ? 0.5623413251903491 : j4 == 2 ? 0.31622776601683794 : 0.17782794100389228;
            const double p10 = jq == 0 ? 1.0 : jq == 1 ? 0.1 : jq == 2 ? 0.01 : 0.001;
            double a = (double)pos * (c4 * p10) * 0.15915494309189535; a -= __builtin_floor(a);
            const float rv = (float)a; RCOS[idx] = __builtin_amdgcn_cosf(rv); RSIN[idx] = __builtin_amdgcn_sinf(rv);
        }
        if (gw == 0) { const v4u z = {0u, 0u, 0u, 0u}; ((GAS v4u*)(ws + WS_ZERO))[lane_p] = z; }
        row_pass<true, false>(kp->in[0], nullptr, XB, SSX, nullptr, nullptr, nullptr, gw, NGW, lane_p, f8_in_layer(0) ? ws + WS_XQ2 : nullptr);
    }
    SEAM_FIRST(0);
    int step = 1;
    for (int l = 0; l < DEPTH_; ++l) {
        if (RUN(step)) for (int rep_ = 0; rep_ < REPS(0); ++rep_) {
            PHASE_ENV(); ATT_PTRS(); WATT_PTRS();
            pg8::Gemm g{XB, WIN, T_, IN_PAD, D_}; pg8::StaticOrder S; S.init(T_, IN_PAD, G, bx);
            pg8::EpiIn E{ws, 0.125f * LOG2E_, rstab, (int)f8_qk_layer(l)};
            if ((F8_IN_LAYERS) != 0 && f8_in_layer(l)) { pg8::Gemm g8{(const bf16*)(ws + ((l & 1) ? WS_XS : WS_XQ2)), WIN, T_, IN_PAD, D_};
                pg8::gemm_phase<pg8::EpiIn, pg8::StaticOrder, true, true, true>(lds, g8, S, E, wave_s * 64); }
            else pg8::gemm_phase<pg8::EpiIn, pg8::StaticOrder, true, true>(lds, g, S, E, wave_s * 64);
            { const int ml = l < 2 ? 1 : 3, a0 = l == 0 ? FA0 : l == 1 ? FA1 : l == 2 ? FA2 : FA3, n0 = l == 0 ? FN0 : l == 1 ? FN1 : l == 2 ? FN2 : FN3; moe_fill(kp, ws, ml, a0, a0 + n0, (T_ / 256) * (IN_PAD / 256), G, bx, wave, lds, lane_p); }
        }
        SEAM(step); ++step;
        if (RUN(step)) {
            for (int rep_ = 0; rep_ < REPS(1); ++rep_) { PHASE_ENV(); ATT_PTRS(); WATT_PTRS();
              pg8::Gemm g{CQ, WUQ, T_, 768, QL_}; pg8::StaticOrder S; S.init(T_, 768, G, bx);
              pg8::EpiQ E{ws, 0.10206207261596575f * LOG2E_, rstab, (int)f8_qk_layer(l)};
              pg8::gemm_phase<pg8::EpiQ, pg8::StaticOrder, true, true>(lds, g, S, E, wave_s * 64);
              { const int ml = l < 2 ? 1 : 3, a0 = l == 0 ? FA0 + FN0 : l == 1 ? FA1 + FN1 : l == 2 ? FA2 + FN2 : FA3 + FN3; moe_fill(kp, ws, ml, a0, a0 + FILL_UQ, (T_ / 256) * (768 / 256), G, bx, wave, lds, lane_p); } }
            for (int rep_ = 0; rep_ < REPS(1); ++rep_) { PHASE_ENV(); ATT_PTRS(); WATT_PTRS();
              pg8::Gemm g{CKV, WUKV, T_, 1024, KVL_}; pg8::StaticOrder S; S.init(T_, 1024, G, bx);
              pg8::EpiKV E{ws, rstab, (int)f8_qk_layer(l)};
              pg8::gemm_phase<pg8::EpiKV, pg8::StaticOrder, true, true>(lds, g, S, E, wave_s * 64); }
        }
        SEAM(step); ++step;
        if (RUN(step)) {
            for (int rep_ = 0; rep_ < REPS(2); ++rep_) { PHASE_ENV(); ATT_PTRS();
              const att::Args A{Qm, KN, KR, Vm, QBb, KBb, VBb, AO, kp->in[7] + (size_t)l * 8 * 257, (int)f8_out_layer(l), ws + WS_Q8, ws + WS_KN8, ws + WS_KR8, ws + WS_ZERO, (int)f8_qk_layer(l)};
              att::attn_phase<false>(A, vcu, G, (LAS char*)lds, wave_s * 64); }
            for (int rep_ = 0; rep_ < REPS(3); ++rep_) { PHASE_ENV(); ATT_PTRS();
              const att::Args A{Qm, KN, KR, Vm, QBb, KBb, VBb, AO, kp->in[7] + (size_t)l * 8 * 257, (int)f8_out_layer(l), ws + WS_Q8, ws + WS_KN8, ws + WS_KR8, ws + WS_ZERO, (int)f8_qk_layer(l)};
              att::attn_phase<true>(A, vcu, G, (LAS char*)lds, wave_s * 64); }
        }
        SEAM(step); ++step;
        if (RUN(step)) for (int rep_ = 0; rep_ < REPS(10); ++rep_) {
            PHASE_ENV(); ATT_PTRS(); WATT_PTRS();
            pg8::Gemm g{AO, WOUT, T_, D_, D_}; pg8::StaticOrder S; S.init(T_, D_, G, bx);
            if ((F8_OUT_LAYERS) != 0 && f8_out_layer(l)) {
                if ((F8_UP_LAYERS) != 0 && f8_up_layer(l)) { pg8::EpiResQ E{ws, rep_ + 1 < REPS(10)}; pg8::gemm_phase<pg8::EpiResQ, pg8::StaticOrder, true, true, true>(lds, g, S, E, wave_s * 64); }
                else { pg8::EpiRes E{ws, rep_ + 1 < REPS(10)}; pg8::gemm_phase<pg8::EpiRes, pg8::StaticOrder, true, true, true>(lds, g, S, E, wave_s * 64); } }
            else if ((F8_UP_LAYERS) != 0 && f8_up_layer(l)) { pg8::EpiResQ E{ws, rep_ + 1 < REPS(10)}; pg8::gemm_phase<pg8::EpiResQ, pg8::StaticOrder, true, true>(lds, g, S, E, wave_s * 64); }
            else { pg8::EpiRes E{ws, rep_ + 1 < REPS(10)}; pg8::gemm_phase<pg8::EpiRes, pg8::StaticOrder, true, true>(lds, g, S, E, wave_s * 64); }
        }
        SEAM(step); ++step;
        if ((l & 1) == 0) {
            if (RUN(step)) for (int rep_ = 0; rep_ < REPS(4); ++rep_) {
                PHASE_ENV(); MOE_PTRS();
                const bf16* W13 = (const bf16*)(ws + WS_WD + (size_t)(l >> 1) * WD_L);
                pg8::Gemm g{XB, W13, T_, 2 * FF_, D_}; pg8::StaticOrder S; S.init(T_, 2 * FF_, G, bx);
#ifdef PROBE_NULLEPI
                if (rep_ + 1 < REPS(4)) { pg8::EpiNull E{ws}; pg8::gemm_phase<pg8::EpiNull, pg8::StaticOrder, true, true>(lds, g, S, E, wave_s * 64); } else
#endif
                if ((F8_UP_LAYERS) != 0 && f8_up_layer(l)) { pg8::Gemm g8{XS, W13, T_, 2 * FF_, D_}; pg8::EpiGLU<false, true> E{ws, rstab}; pg8::gemm_phase<pg8::EpiGLU<false, true>, pg8::StaticOrder, true, true, true>(lds, g8, S, E, wave_s * 64); }
                else                 if (F8_DENSE_ANY && (F8_DENSE_ALL || f8_layer(l))) { pg8::EpiGLU<false, true> E{ws, rstab}; pg8::gemm_phase<pg8::EpiGLU<false, true>, pg8::StaticOrder, true, true>(lds, g, S, E, wave_s * 64); }
                else if (!F8_DENSE_ALL) { pg8::EpiGLU<false, false> E{ws, rstab}; pg8::gemm_phase<pg8::EpiGLU<false, false>, pg8::StaticOrder, true, true>(lds, g, S, E, wave_s * 64); }
            }
            SEAM(step); ++step;
            if (RUN(step)) for (int rep_ = 0; rep_ < REPS(11); ++rep_) {
                PHASE_ENV(); MOE_PTRS();
                const bf16* W2 = (const bf16*)(ws + WS_WD + (size_t)(l >> 1) * WD_L) + (size_t)2 * FF_ * D_;
                pg8::Gemm g{HM, W2, T_, D_, FF_}; pg8::StaticOrder S; S.init(T_, D_, G, bx);
                pg8::EpiRes E{ws, rep_ + 1 < REPS(11)};
                if ((F8_IN_LAYERS) != 0 && f8_in_layer(l + 1) && f8_layer(l)) { pg8::EpiResQ EQ{ws, rep_ + 1 < REPS(11)}; pg8::gemm_phase<pg8::EpiResQ, pg8::StaticOrder, true, true, true>(lds, g, S, EQ, wave_s * 64); }
                else if (F8_DENSE_ANY && (F8_DENSE_ALL || f8_layer(l))) pg8::gemm_phase<pg8::EpiRes, pg8::StaticOrder, true, true, true>(lds, g, S, E, wave_s * 64);
                else if ((F8_IN_LAYERS) != 0 && f8_in_layer(l + 1)) { pg8::EpiResQ EQ{ws, rep_ + 1 < REPS(11)}; pg8::gemm_phase<pg8::EpiResQ, pg8::StaticOrder, true, true, false>(lds, g, S, EQ, wave_s * 64); }
                else if (!F8_DENSE_ALL) pg8::gemm_phase<pg8::EpiRes, pg8::StaticOrder, true, true, false>(lds, g, S, E, wave_s * 64);
            }
            SEAM(step); ++step;
        } else {
            const int mj = l >> 1;
            if (RUN(step)) for (int rep_ = 0; rep_ < REPS(5); ++rep_) {
                PHASE_ENV(); MOE_PTRS();
                moe_route1(lds, XB, SSX, kp->in[13] + (size_t)mj * D_ * NEXP, kp->in[9] + l * D_, TOKE, TOKG, TOKRS, CNT, bx, G, tid_p, wave, lane_p);
                __syncthreads();
                LAS float* scr = (LAS float*)(lds + wave * 16384);
                for (int g = (l == 1 ? L1_DONE : L3_DONE) + gw; g < MOE_ITEMS; g += NGW) { TrJob J; int it; moe_job(kp, ws, l, g, J, it); tr_item(J, it, scr, lane_p); }
                __syncthreads();
            }
            SEAM(step); ++step;
            if (RUN(step)) for (int rep_ = 0; rep_ < REPS(6); ++rep_) { PHASE_ENV(); MOE_PTRS(); moe_route2(lds, XB, XS, TOKE, TOKG, TOKRS, CNT, POS, ROWG, ROWRS, META, bx, G, tid_p, wave, lane_p, f8_layer(l)); }
            SEAM(step); ++step;
            if (RUN(step)) for (int rep_ = 0; rep_ < REPS(7); ++rep_) {
                PHASE_ENV(); MOE_PTRS();
                pg8::MoeOrder S;
#pragma unroll
                for (int e = 0; e < 8; ++e) S.pe[e] = __builtin_amdgcn_readfirstlane(META[e]);
                const int mrows = S.pe[7];
                S.estride = (size_t)2 * FF_ * D_ * (f8_layer(l) ? 1 : 2); S.so.init(mrows, 2 * FF_, G, bx);
                pg8::Gemm g{XS, WM13, mrows, 2 * FF_, D_, 0x79797979, 0x7b7b7b7b};
                if (F8_MOE_ANY && (F8_MOE_ALL || f8_layer(l))) { pg8::EpiGLU<true, true, true> E{ws, rstab}; pg8::gemm_phase<pg8::EpiGLU<true, true, true>, pg8::MoeOrder, true, true, true>(lds, g, S, E, wave_s * 64); }
                else if (!F8_MOE_ALL) { pg8::EpiGLU<true, false> E{ws, rstab}; pg8::gemm_phase<pg8::EpiGLU<true, false>, pg8::MoeOrder, true, true>(lds, g, S, E, wave_s * 64); }
            }
            SEAM(step); ++step;
            if (RUN(step)) for (int rep_ = 0; rep_ < REPS(8); ++rep_) {
                PHASE_ENV(); MOE_PTRS();
                pg8::MoeOrder S;
#pragma unroll
                for (int e = 0; e < 8; ++e) S.pe[e] = __builtin_amdgcn_readfirstlane(META[e]);
                const int mrows = S.pe[7];
                S.estride = (size_t)FF_ * D_ * (f8_layer(l) ? 1 : 2); S.so.init(mrows, D_, G, bx);
                pg8::Gemm g{HM, WM2, mrows, D_, FF_};
                pg8::EpiY E{ws, rstab};
                if (F8_MOE_ANY && (F8_MOE_ALL || f8_layer(l))) pg8::gemm_phase<pg8::EpiY, pg8::MoeOrder, true, true, true>(lds, g, S, E, wave_s * 64);
                else if (!F8_MOE_ALL) pg8::gemm_phase<pg8::EpiY, pg8::MoeOrder, true, true, false>(lds, g, S, E, wave_s * 64);
                if (l == 1) moe_fill(kp, ws, 3, 0, FILL_MD, (mrows / 256) * (D_ / 256), G, bx, wave, lds, lane_p);
            }
            SEAM(step); ++step;
            if (RUN(step)) {
                PHASE_ENV(); MOE_PTRS();
                if (l == DEPTH_ - 1) row_pass<false, true>(nullptr, X, XB, SSX, XS, POS, kp->in[17], gw, NGW, lane_p);
                else row_pass<false, false>(nullptr, nullptr, XB, SSX, XS, POS, nullptr, gw, NGW, lane_p, f8_in_layer(l + 1) ? ws + WS_XQ2 : nullptr);
            }
            SEAM(step); ++step;
        }
    }
#undef RUN
#undef SEAM
#undef SEAM_FIRST
#undef GEOM
#undef BAROBJ
#undef LANE_NOW
#undef T0_NOW
}

extern "C" void kernel_launch(void* const* d_in, const int* in_sizes, int n_in, void* d_out, int out_size, void* d_ws, size_t ws_size, hipStream_t stream) {
    static int grid = 0;
    if (grid == 0) {
        if (n_in != 18 || in_sizes[0] != T_ * D_ || out_size != T_ * D_ || ws_size < WS_END) { fprintf(stderr, "kernel_launch: unexpected shapes / workspace (n_in %d, ws %zu, need %zu); nothing launched\n", n_in, ws_size, (size_t)WS_END); grid = -1; return; }
        int dev = 0, cus = 0;
        if (hipGetDevice(&dev) != hipSuccess || hipDeviceGetAttribute(&cus, hipDeviceAttributeMultiprocessorCount, dev) != hipSuccess) { grid = -1; return; }
        if (hipFuncSetAttribute((const void*)hybrid_fwd, hipFuncAttributeMaxDynamicSharedMemorySize, LDS_BYTES) != hipSuccess) { fprintf(stderr, "kernel_launch: hipFuncSetAttribute failed\n"); grid = -1; return; }
        int per_cu = 0;
        if (hipOccupancyMaxActiveBlocksPerMultiprocessor(&per_cu, (const void*)hybrid_fwd, NWAVES * 64, LDS_BYTES) != hipSuccess || per_cu < 1) fprintf(stderr, "kernel_launch: occupancy query reports %d blocks per CU\n", per_cu);
        (void)hipGetLastError();
        grid = cus;
    }
    if (grid < 0) return;
    (void)hipMemsetAsync((char*)d_ws + WS_CTL, 0, CTL_ZERO_BYTES, stream);
    Params p{};
    for (int i = 0; i < 18; ++i) p.in[i] = (const float*)d_in[i];
    p.out = (float*)d_out; p.ws = (unsigned char*)d_ws;
#if MK_ONE_LAUNCH
    p.ph_lo = 0; p.ph_hi = NSTEPS;
    hipLaunchKernelGGL(hybrid_fwd, dim3(grid), dim3(NWAVES * 64), LDS_BYTES, stream, p);
#else
    for (int s = 0; s < NSTEPS; ++s) { p.ph_lo = s; p.ph_hi = s + 1; hipLaunchKernelGGL(hybrid_fwd, dim3(grid), dim3(NWAVES * 64), LDS_BYTES, stream, p); }
#endif
}
```

```cpp
#include <hip/hip_runtime.h>
#include <cstdio>
#include <cstdint>
constexpr int NWAVES = 8;
constexpr int T_ = 32768, D_ = 1024, DEPTH_ = 4, IN_DIM = 2208, IN_PAD = 2304, FF_ = 3584, NEXP = 8, QL_ = 384, KVL_ = 256;
constexpr int MAXROWS = 2 * T_ + NEXP * 256;
constexpr float EPS_ = 1e-6f, LOG2E_ = 1.4426950408889634f;
#ifndef MK_ONE_LAUNCH
#define MK_ONE_LAUNCH 1
#endif
#ifndef F8_LAYERS
#define F8_LAYERS 0xE
#endif
constexpr bool f8_layer(int l) { return ((F8_LAYERS) >> l) & 1; }
#ifndef F8_UP_LAYERS
#define F8_UP_LAYERS 0x4
#endif
constexpr bool f8_up_layer(int l) { return ((F8_UP_LAYERS) >> l) & 1; }
#ifndef F8_QK_LAYERS
#define F8_QK_LAYERS 0xF
#endif
constexpr bool f8_qk_layer(int l) { return l >= 0 && l < 4 && (((F8_QK_LAYERS) >> l) & 1); }
#ifndef F8_PV_LAYERS
#define F8_PV_LAYERS 0xC
#endif
constexpr bool f8_pv_layer(int l) { return l >= 0 && l < 4 && (((F8_PV_LAYERS) >> l) & 1); }
static_assert(((F8_PV_LAYERS) & ~(F8_QK_LAYERS) & 0xF) == 0, "8-bit P.V only where Q.K^T is fp8");
#ifndef F8_OUT_LAYERS
#define F8_OUT_LAYERS 0xC
#endif
constexpr bool f8_out_layer(int l) { return l >= 0 && l < 4 && (((F8_OUT_LAYERS) >> l) & 1); }
#ifndef F8_IN_LAYERS
#define F8_IN_LAYERS 0xC
#endif
constexpr bool f8_in_layer(int l) { return l >= 0 && l < 4 && (((F8_IN_LAYERS) >> l) & 1); }
static_assert(((F8_UP_LAYERS) & ~(F8_LAYERS) & 0xF) == 0 && ((F8_UP_LAYERS) & 0xA) == 0, "fp8 up-projection: dense layers whose down-projection is fp8");
constexpr bool F8_DENSE_ANY = (F8_LAYERS & 0x5) != 0, F8_DENSE_ALL = (F8_LAYERS & 0x5) == 0x5, F8_MOE_ANY = (F8_LAYERS & 0xA) != 0, F8_MOE_ALL = (F8_LAYERS & 0xA) == 0xA;
constexpr int NSTEPS = 31;
constexpr size_t MiB = 1u << 20;
constexpr size_t WS_CTL = 0, CTL_ZERO_BYTES = 65536;
constexpr size_t WS_RCOS = 1 * MiB, WS_RSIN = WS_RCOS + 512 * 1024;
constexpr size_t WS_SSX = 2 * MiB;
constexpr size_t WS_SSQ = 4 * MiB;
constexpr size_t WS_TOKE = 7 * MiB, WS_TOKG = WS_TOKE + 128 * 1024, WS_TOKRS = WS_TOKG + 256 * 1024, WS_POS = WS_TOKRS + 128 * 1024,
                 WS_CNT = WS_POS + 256 * 1024, WS_META = WS_CNT + 8192, WS_ROWG = 8 * MiB, WS_ROWRS = WS_ROWG + 512 * 1024;
constexpr size_t WATT_L = (size_t)(IN_PAD * D_ + 768 * QL_ + 1024 * KVL_ + D_ * D_) * 2;
constexpr size_t WS_WATT = 10 * MiB;
constexpr size_t WD_L = (size_t)3 * D_ * FF_ * 2;
constexpr size_t WS_WD = 41 * MiB;
constexpr size_t WS_WM = 83 * MiB;
constexpr size_t WS_XQ2 = WS_WM + 56 * MiB;
static_assert((F8_IN_LAYERS) == 0 || F8_MOE_ALL, "WS_XQ2 overlays the bf16 half of the MoE W13 buffer");
constexpr size_t WS_XB = 251 * MiB;
constexpr size_t WS_XS = 315 * MiB;
constexpr size_t WS_HM = 447 * MiB;
constexpr size_t WS_CQ = WS_HM, WS_CKV = WS_CQ + 24 * MiB, WS_KR = WS_CKV + 16 * MiB, WS_QB = WS_KR + 2 * MiB, WS_KB = WS_QB + 32 * MiB, WS_VB = WS_KB + 32 * MiB,
                 WS_Q = WS_VB + 32 * MiB, WS_KN = WS_Q + 48 * MiB, WS_V = WS_KN + 32 * MiB, WS_AO = WS_V + 32 * MiB;
constexpr size_t WS_Q8 = WS_AO + 64 * MiB, WS_KN8 = WS_Q8 + 24 * MiB, WS_KR8 = WS_KN8 + 16 * MiB, WS_ZERO = WS_KR8 + 1 * MiB, WS_V8T = WS_ZERO + 1 * MiB;
constexpr size_t WS_END = WS_HM + (size_t)MAXROWS * FF_ * 2;
static_assert(WS_V8T + 16 * MiB <= WS_END && WS_Q8 >= WS_HM + (size_t)MAXROWS * FF_ && WS_Q8 >= WS_HM + (size_t)T_ * FF_ * 2 && ((F8_QK_LAYERS) == 0 || F8_MOE_ALL), "fp8 attention copies sit above the FFN hidden rows");
static_assert(WS_AO + 64 * MiB <= WS_END && WS_WATT + 4 * WATT_L <= WS_WD && WS_WD + 2 * WD_L <= WS_WM && WS_WM + 8 * WD_L <= WS_XB && WS_XS + (size_t)MAXROWS * D_ * 2 <= WS_HM, "d_ws map");
constexpr int RING_BYTES = 131072, LDSCTL_OFF = RING_BYTES, MISC_OFF = LDSCTL_OFF + 320, RSTAB_OFF = LDSCTL_OFF + 1024, LDS_BYTES = 147456;

namespace pg8 {
#define PG8_LAS __attribute__((address_space(3)))
typedef unsigned short bf16_t;
typedef short bf16x8 __attribute__((ext_vector_type(8)));
typedef float f32x4 __attribute__((ext_vector_type(4)));
typedef unsigned u32x4 __attribute__((ext_vector_type(4)));
typedef int v4i32 __attribute__((ext_vector_type(4)));
typedef int v8i32 __attribute__((ext_vector_type(8)));
typedef unsigned u32x2 __attribute__((ext_vector_type(2)));
constexpr int BM = 256, BK = 64, HALF = 128, HTB = HALF * BK * 2  , STAGE_BYTES = 8 * HTB, NXCD = 8, WGM = 8;

__host__ __device__ __forceinline__ int lds_byte(int r, int c) { const int st = (r >> 4) * 2 + (c >> 5), rr = r & 15, cc = c & 31, ob = rr * 64 + cc * 2; return st * 1024 + (ob ^ (((ob >> 9) & 1) << 5)); }
__host__ __device__ __forceinline__ void stage_rc(int b, int& R, int& C) { const int st = b / 1024, sb = b % 1024, swz = sb ^ (((sb >> 9) & 1) << 5); R = (st >> 1) * 16 + swz / 64; C = (st & 1) * 32 + (swz % 64) / 2; }
__host__ __device__ __forceinline__ int perm32(int rho) { const int n = rho >> 4, i = rho & 15; return 8 * (i >> 2) + 4 * n + (i & 3); }

struct Unit { int pm, pn; };
struct Gemm { const bf16_t* A; const bf16_t* Bt; int M, N, K; int scw = 0x79797979, sch = 0x7c7c7c7c; };

struct StaticOrder {
    int nM, nN, nwg, G, c;
    __host__ __device__ void init(int M, int N, int G_, int c_) { nM = M / BM; nN = N / BM; nwg = nM * nN; G = G_; c = c_; }
    __host__ __device__ bool next(int i, Unit& u) const {
        const long L = (long)i * G + c; if (L >= nwg) return false;
        int wgid = (int)L; { const int q = nwg / NXCD, r = nwg % NXCD, xcd = wgid % NXCD, off = wgid / NXCD; wgid = (xcd < r ? xcd * (q + 1) : r * (q + 1) + (xcd - r) * q) + off; }
        const int nig = WGM * nN, gid = wgid / nig, fm = gid * WGM, gsz = (nM - fm) < WGM ? (nM - fm) : WGM;
        u.pm = fm + ((wgid % nig) % gsz); u.pn = (wgid % nig) / gsz; return true;
    }
    __device__ __forceinline__ size_t boff(const Unit&) const { return 0; }
    __device__ __forceinline__ void a_ready(const Unit&) const {}
    __device__ __forceinline__ void done(const Unit&) const {}
};

__device__ __forceinline__ unsigned cvt_pk_bf16(float lo, float hi) { unsigned r; asm volatile("v_cvt_pk_bf16_f32 %0, %1, %2" : "=v"(r) : "v"(lo), "v"(hi)); return r; }
typedef float f32x2 __attribute__((ext_vector_type(2)));
__device__ __forceinline__ u32x4 pack8(const f32x4 a, const f32x4 b) { u32x4 w; w.x = cvt_pk_bf16(a[0], a[1]); w.y = cvt_pk_bf16(a[2], a[3]); w.z = cvt_pk_bf16(b[0], b[1]); w.w = cvt_pk_bf16(b[2], b[3]); return w; }
__device__ __forceinline__ float sumsq4(const f32x4 v) { return (v[0] * v[0] + v[1] * v[1]) + (v[2] * v[2] + v[3] * v[3]); }
__device__ __forceinline__ float xor16_add(float v) { return v + __int_as_float(__builtin_amdgcn_ds_swizzle(__float_as_int(v), 0x401F)); }
__device__ __forceinline__ float xor32_add(float v) { auto rr = __builtin_amdgcn_permlane32_swap(__float_as_uint(v), __float_as_uint(v), false, false); return __uint_as_float(rr[0]) + __uint_as_float(rr[1]); }
__device__ __forceinline__ float silu_f(float x) { return x * __builtin_amdgcn_rcpf(1.0f + __builtin_amdgcn_exp2f(-1.4426950409f * x)); }
template <int NP4, int PITCH, int OFF>
__device__ __forceinline__ void rs_table(const float* part, int rowbase, int wr, int lane, float inv_dim, PG8_LAS float* t) {
    f32x4 s[2][NP4];
#pragma unroll
    for (int ai = 0; ai < 2; ++ai) { const f32x4* p = (const f32x4*)(part + (size_t)(rowbase + ai * 128 + wr * 64 + lane) * PITCH + OFF);
#pragma unroll
        for (int j = 0; j < NP4; ++j) s[ai][j] = p[j]; }
#pragma unroll
    for (int ai = 0; ai < 2; ++ai) { f32x4 a = s[ai][0];
#pragma unroll
        for (int j = 1; j < NP4; ++j) a += s[ai][j];
        t[ai * 64 + lane] = __builtin_amdgcn_rsqf(((a[0] + a[1]) + (a[2] + a[3])) * inv_dim + 1e-6f); }
    asm volatile("s_waitcnt lgkmcnt(0)" ::: "memory");
}
constexpr int DM = 1024, FFN = 3584, SEQ_ = 8192;

__device__ __forceinline__ f32x4 bf2f_lo(const u32x4 w, int h) { const unsigned a = h ? w.z : w.x, b = h ? w.w : w.y; return (f32x4){__uint_as_float(a << 16), __uint_as_float(a & 0xffff0000u), __uint_as_float(b << 16), __uint_as_float(b & 0xffff0000u)}; }
struct EpiRes {
    static constexpr bool PERM = true, AFTER_DRAIN = false, PREFETCH = false;
    unsigned char* ws; bool dummy;
    __device__ __forceinline__ void operator()(const f32x4 (&acc)[2][2][4][2], const Unit& u, int wr, int wc, int fr, int fq) const {
        bf16_t* xb = (bf16_t*)(ws + (dummy ? WS_XS : WS_XB)); float* ssx = (float*)(ws + (dummy ? WS_SSQ : WS_SSX));
        const int row0 = u.pm * BM + wr * 64 + fr, col0 = u.pn * BM + wc * 32 + 8 * fq;
        u32x4 old[2][4][2];
#pragma unroll
        for (int ai = 0; ai < 2; ++ai)
#pragma unroll
            for (int m = 0; m < 4; ++m)
#pragma unroll
                for (int bj = 0; bj < 2; ++bj) old[ai][m][bj] = *(const u32x4*)(xb + (size_t)(row0 + ai * HALF + m * 16) * DM + col0 + bj * HALF);
#pragma unroll
        for (int ai = 0; ai < 2; ++ai)
#pragma unroll
            for (int m = 0; m < 4; ++m) {
                const int row = row0 + ai * HALF + m * 16; float ss = 0.f;
#pragma unroll
                for (int bj = 0; bj < 2; ++bj) {
                    const f32x4 v0 = bf2f_lo(old[ai][m][bj], 0) + acc[ai][bj][m][0], v1 = bf2f_lo(old[ai][m][bj], 1) + acc[ai][bj][m][1];
                    ss += sumsq4(v0) + sumsq4(v1);
                    *(u32x4*)(xb + (size_t)row * DM + col0 + bj * HALF) = pack8(v0, v1);
                }
                ss = xor32_add(xor16_add(ss));
                if (fq == 0) ssx[(size_t)row * 16 + u.pn * 4 + wc] = ss;
            }
    }
};
__device__ __forceinline__ unsigned pack4_fp8_x16(const f32x4 v) { int w = 0; w = __builtin_amdgcn_cvt_pk_fp8_f32(__builtin_amdgcn_fmed3f(v[0] * 16.0f, -448.0f, 448.0f), __builtin_amdgcn_fmed3f(v[1] * 16.0f, -448.0f, 448.0f), w, false);
    w = __builtin_amdgcn_cvt_pk_fp8_f32(__builtin_amdgcn_fmed3f(v[2] * 16.0f, -448.0f, 448.0f), __builtin_amdgcn_fmed3f(v[3] * 16.0f, -448.0f, 448.0f), w, true); return (unsigned)w; }
__device__ __forceinline__ unsigned pack4_fp8_x8(const f32x4 v) { int w = 0; w = __builtin_amdgcn_cvt_pk_fp8_f32(__builtin_amdgcn_fmed3f(v[0] * 8.0f, -448.0f, 448.0f), __builtin_amdgcn_fmed3f(v[1] * 8.0f, -448.0f, 448.0f), w, false);
    w = __builtin_amdgcn_cvt_pk_fp8_f32(__builtin_amdgcn_fmed3f(v[2] * 8.0f, -448.0f, 448.0f), __builtin_amdgcn_fmed3f(v[3] * 8.0f, -448.0f, 448.0f), w, true); return (unsigned)w; }
struct EpiResQ {
    static constexpr bool PERM = true, AFTER_DRAIN = false, PREFETCH = false;
    unsigned char* ws; bool dummy;
    __device__ __forceinline__ void operator()(const f32x4 (&acc)[2][2][4][2], const Unit& u, int wr, int wc, int fr, int fq) const {
        bf16_t* xb = (bf16_t*)(ws + (dummy ? WS_XS : WS_XB)); float* ssx = (float*)(ws + (dummy ? WS_SSQ : WS_SSX)); unsigned char* xq = ws + WS_XS + (dummy ? (size_t)64 * 1024 * 1024 : 0);
        const int row0 = u.pm * BM + wr * 64 + fr, col0 = u.pn * BM + wc * 32 + 8 * fq;
#pragma unroll
        for (int ai = 0; ai < 2; ++ai) {
            u32x4 old[4][2];
#pragma unroll
            for (int m = 0; m < 4; ++m)
#pragma unroll
                for (int bj = 0; bj < 2; ++bj) old[m][bj] = *(const u32x4*)(xb + (size_t)(row0 + ai * HALF + m * 16) * DM + col0 + bj * HALF);
#pragma unroll
            for (int m = 0; m < 4; ++m) {
                const int row = row0 + ai * HALF + m * 16; float ss = 0.f;
#pragma unroll
                for (int bj = 0; bj < 2; ++bj) {
                    const f32x4 v0 = bf2f_lo(old[m][bj], 0) + acc[ai][bj][m][0], v1 = bf2f_lo(old[m][bj], 1) + acc[ai][bj][m][1];
                    ss += sumsq4(v0) + sumsq4(v1);
                    *(u32x4*)(xb + (size_t)row * DM + col0 + bj * HALF) = pack8(v0, v1);
                    { u32x2 w8; w8.x = pack4_fp8_x8(v0); w8.y = pack4_fp8_x8(v1); *(u32x2*)(xq + (size_t)row * DM + col0 + bj * HALF) = w8; }
                }
                ss = xor32_add(xor16_add(ss));
                if (fq == 0) ssx[(size_t)row * 16 + u.pn * 4 + wc] = ss;
            }
        }
    }
};
__device__ __forceinline__ unsigned pack4_fp8(const f32x4 v) { int w = 0; w = __builtin_amdgcn_cvt_pk_fp8_f32(__builtin_amdgcn_fmed3f(v[0] * 8.0f, -448.0f, 448.0f), __builtin_amdgcn_fmed3f(v[1] * 8.0f, -448.0f, 448.0f), w, false);
    w = __builtin_amdgcn_cvt_pk_fp8_f32(__builtin_amdgcn_fmed3f(v[2] * 8.0f, -448.0f, 448.0f), __builtin_amdgcn_fmed3f(v[3] * 8.0f, -448.0f, 448.0f), w, true); return (unsigned)w; }
template <bool MOE, bool F8OUT = true, bool NORS = false> struct EpiGLU {
    static constexpr bool PERM = true, AFTER_DRAIN = false, PREFETCH = false;
    unsigned char* ws; PG8_LAS float* tab;
    __device__ __forceinline__ void operator()(const f32x4 (&acc)[2][2][4][2], const Unit& u, int wr, int wc, int fr, int fq) const {
        const int lane = fq * 16 + fr, wid = wr * 4 + wc; float rs[2][4];
        bf16_t* h = (bf16_t*)(ws + WS_HM); const float* part = (const float*)(ws + (MOE ? WS_ROWRS : WS_SSX));
        if (NORS) {
            asm volatile("s_waitcnt vmcnt(0)" ::: "memory");
#pragma unroll
            for (int ai = 0; ai < 2; ++ai)
#pragma unroll
                for (int m = 0; m < 4; ++m) rs[ai][m] = 1.0f;
        } else if (MOE) {
#pragma unroll
            for (int ai = 0; ai < 2; ++ai)
#pragma unroll
                for (int m = 0; m < 4; ++m) rs[ai][m] = part[u.pm * BM + ai * HALF + wr * 64 + m * 16 + fr];
        } else {
            PG8_LAS float* t = tab + wid * 128; rs_table<4, 16, 0>(part, u.pm * BM, wr, lane, 1.0f / DM, t);
#pragma unroll
            for (int ai = 0; ai < 2; ++ai)
#pragma unroll
                for (int m = 0; m < 4; ++m) rs[ai][m] = t[ai * 64 + m * 16 + fr];
        }
        const int row0 = u.pm * BM + wr * 64 + fr, col0 = u.pn * HALF + wc * 32 + 8 * fq;
#pragma unroll
        for (int ai = 0; ai < 2; ++ai)
#pragma unroll
            for (int m = 0; m < 4; ++m) {
                const float r = rs[ai][m]; f32x4 o[2];
#pragma unroll
                for (int n = 0; n < 2; ++n) { const f32x4 a = acc[ai][0][m][n] * r, b = acc[ai][1][m][n] * r;
                    o[n] = (f32x4){silu_f(a[0]) * b[0], silu_f(a[1]) * b[1], silu_f(a[2]) * b[2], silu_f(a[3]) * b[3]}; }
                if (F8OUT) { u32x2 w; w.x = pack4_fp8(o[0]); w.y = pack4_fp8(o[1]); *(u32x2*)((unsigned char*)h + (size_t)(row0 + ai * HALF + m * 16) * FFN + col0) = w; }
                else *(u32x4*)(h + (size_t)(row0 + ai * HALF + m * 16) * FFN + col0) = pack8(o[0], o[1]);
            }
    }
};
struct EpiY {
    static constexpr bool PERM = true, AFTER_DRAIN = false, PREFETCH = true;
    unsigned char* ws; PG8_LAS float* tab;
    __device__ __forceinline__ void prefetch(const Unit& u, int wid, int lane) const {
        const float* rowg = (const float*)(ws + WS_ROWG);
        __builtin_amdgcn_global_load_lds((const unsigned*)(rowg + (size_t)u.pm * BM + lane * 4), (PG8_LAS unsigned*)(tab + wid * 256), 16, 0, 0);
    }
    __device__ __forceinline__ void operator()(const f32x4 (&acc)[2][2][4][2], const Unit& u, int wr, int wc, int fr, int fq) const {
        bf16_t* y = (bf16_t*)(ws + WS_XS); const PG8_LAS float* t = tab + (wr * 4 + wc) * 256;
        const int row0 = u.pm * BM + wr * 64 + fr, col0 = u.pn * BM + wc * 32 + 8 * fq;
#pragma unroll
        for (int ai = 0; ai < 2; ++ai)
#pragma unroll
            for (int m = 0; m < 4; ++m) { const int row = row0 + ai * HALF + m * 16; const float g = t[ai * HALF + wr * 64 + m * 16 + fr];
#pragma unroll
                for (int bj = 0; bj < 2; ++bj) *(u32x4*)(y + (size_t)row * DM + col0 + bj * HALF) = pack8(acc[ai][bj][m][0] * g, acc[ai][bj][m][1] * g); }
    }
};
__device__ __forceinline__ void rope8(f32x4& v0, f32x4& v1, const float* rcos, const float* rsin, int pos, int fq) {
    const f32x4 c = *(const f32x4*)(rcos + pos * 16 + 4 * fq), s = *(const f32x4*)(rsin + pos * 16 + 4 * fq);
    const f32x4 o0 = v0 * c - v1 * s, o1 = v0 * s + v1 * c; v0 = o0; v1 = o1;
}
struct EpiIn {
    static constexpr bool PERM = true, AFTER_DRAIN = false, PREFETCH = false;
    unsigned char* ws; float qbscale; PG8_LAS float* tab; int f8qk = 0;
    __device__ __forceinline__ void operator()(const f32x4 (&acc)[2][2][4][2], const Unit& u, int wr, int wc, int fr, int fq) const {
        const int lane = fq * 16 + fr, wid = wr * 4 + wc;
        const float* ssx = (const float*)(ws + WS_SSX); float* ssq = (float*)(ws + WS_SSQ); const float* rcos = (const float*)(ws + WS_RCOS); const float* rsin = (const float*)(ws + WS_RSIN);
        bf16_t *cq = (bf16_t*)(ws + WS_CQ), *ckv = (bf16_t*)(ws + WS_CKV), *kr = (bf16_t*)(ws + WS_KR), *qb = (bf16_t*)(ws + WS_QB), *kb = (bf16_t*)(ws + WS_KB), *vb = (bf16_t*)(ws + WS_VB);
        PG8_LAS float* t = tab + wid * 128; rs_table<4, 16, 0>(ssx, u.pm * BM, wr, lane, 1.0f / DM, t);
        const int row0 = u.pm * BM + wr * 64 + fr;
#pragma unroll
        for (int bj = 0; bj < 2; ++bj) {
            const int colg = u.pn * BM + bj * HALF + wc * 32;
            if (colg >= 672 && colg < 768) continue;
            bf16_t* dst; int pitch, kind = 0, sidx = 0; float sc = 1.f;
            if (colg < 384) { dst = cq + colg; pitch = 384; kind = 1; sidx = colg >> 5; }
            else if (colg < 640) { dst = ckv + (colg - 384); pitch = 256; kind = 1; sidx = colg >> 5; }
            else if (colg < 672) { dst = kr; pitch = 32; kind = 2; }
            else if (colg < 1280) { dst = qb + (colg - 768); pitch = 512; sc = qbscale; }
            else if (colg < 1792) { dst = kb + (colg - 1280); pitch = 512; }
            else { dst = vb + (colg - 1792); pitch = 512; }
#pragma unroll
            for (int ai = 0; ai < 2; ++ai)
#pragma unroll
                for (int m = 0; m < 4; ++m) {
                    const int row = row0 + ai * HALF + m * 16; const float r = t[ai * 64 + m * 16 + fr] * sc;
                    f32x4 v0 = acc[ai][bj][m][0] * r, v1 = acc[ai][bj][m][1] * r;
                    if (kind == 2) rope8(v0, v1, rcos, rsin, row & (SEQ_ - 1), fq);
                    *(u32x4*)(dst + (size_t)row * pitch + 8 * fq) = pack8(v0, v1);
                    if (kind == 2 && f8qk) { u32x2 w8; w8.x = pack4_fp8_x8(v0); w8.y = pack4_fp8_x8(v1); *(u32x2*)(ws + WS_KR8 + (size_t)row * 32 + 8 * fq) = w8; }
                    if (kind == 1) { float ss = sumsq4(v0) + sumsq4(v1); ss = xor32_add(xor16_add(ss)); if (fq == 0) ssq[(size_t)row * 20 + sidx] = ss; }
                }
        }
    }
};
struct EpiQ {
    static constexpr bool PERM = true, AFTER_DRAIN = false, PREFETCH = false;
    unsigned char* ws; float qscale; PG8_LAS float* tab; int f8qk = 0;
    __device__ __forceinline__ void operator()(const f32x4 (&acc)[2][2][4][2], const Unit& u, int wr, int wc, int fr, int fq) const {
        const int lane = fq * 16 + fr, wid = wr * 4 + wc;
        const float* ssq = (const float*)(ws + WS_SSQ); bf16_t* q = (bf16_t*)(ws + WS_Q); const float* rcos = (const float*)(ws + WS_RCOS); const float* rsin = (const float*)(ws + WS_RSIN);
        PG8_LAS float* t = tab + wid * 128; rs_table<3, 20, 0>(ssq, u.pm * BM, wr, lane, 1.0f / 384.0f, t);
        const int row0 = u.pm * BM + wr * 64 + fr;
#pragma unroll
        for (int bj = 0; bj < 2; ++bj) {
            const int colg = u.pn * BM + bj * HALF + wc * 32; const bool rope = ((colg >> 5) % 3) == 2;
#pragma unroll
            for (int ai = 0; ai < 2; ++ai)
#pragma unroll
                for (int m = 0; m < 4; ++m) {
                    const int row = row0 + ai * HALF + m * 16; const float r = t[ai * 64 + m * 16 + fr] * qscale;
                    f32x4 v0 = acc[ai][bj][m][0] * r, v1 = acc[ai][bj][m][1] * r;
                    if (rope) rope8(v0, v1, rcos, rsin, row & (SEQ_ - 1), fq);
                    if (!f8qk) *(u32x4*)(q + (size_t)row * 768 + colg + 8 * fq) = pack8(v0, v1);
                    if (f8qk) { u32x2 w8; w8.x = pack4_fp8_x16(v0); w8.y = pack4_fp8_x16(v1); *(u32x2*)(ws + WS_Q8 + (size_t)row * 768 + colg + 8 * fq) = w8; }
                }
        }
    }
};
struct EpiKV {
    static constexpr bool PERM = true, AFTER_DRAIN = false, PREFETCH = false;
    unsigned char* ws; PG8_LAS float* tab; int f8qk = 0, f8pv = 0;
    __device__ __forceinline__ void operator()(const f32x4 (&acc)[2][2][4][2], const Unit& u, int wr, int wc, int fr, int fq) const {
        const int lane = fq * 16 + fr, wid = wr * 4 + wc;
        const float* ssq = (const float*)(ws + WS_SSQ); bf16_t* kn = (bf16_t*)(ws + WS_KN); bf16_t* v = (bf16_t*)(ws + WS_V);
        PG8_LAS float* t = tab + wid * 128; rs_table<2, 20, 12>(ssq, u.pm * BM, wr, lane, 1.0f / 256.0f, t);
        const int row0 = u.pm * BM + wr * 64 + fr;
#pragma unroll
        for (int bj = 0; bj < 2; ++bj) {
            const int colg = u.pn * BM + bj * HALF + wc * 32; bf16_t* dst = colg < 512 ? kn + colg : v + (colg - 512);
#pragma unroll
            for (int ai = 0; ai < 2; ++ai)
#pragma unroll
                for (int m = 0; m < 4; ++m) {
                    const int row = row0 + ai * HALF + m * 16; const float r = t[ai * 64 + m * 16 + fr];
                    if (!(f8qk && colg < 512)) *(u32x4*)(dst + (size_t)row * 512 + 8 * fq) = pack8(acc[ai][bj][m][0] * r, acc[ai][bj][m][1] * r);
                    if (f8pv && colg >= 512) {
                        const int c0_ = colg - 512 + 8 * fq, bb_ = row >> 13, pos_ = row & (SEQ_ - 1), key_ = pos_ & 63, k32_ = key_ & 31;
                        unsigned char* p_ = ws + WS_V8T + ((((size_t)(bb_ * 8 + (c0_ >> 6)) * 128 + (pos_ >> 6)) * 64 + (c0_ & 63)) * 64) + 32 * ((k32_ >> 2) & 1) + 16 * (key_ >> 5) + (k32_ & 3) + 4 * (k32_ >> 3);
                        const unsigned w0_ = pack4_fp8_x8(acc[ai][bj][m][0] * r), w1_ = pack4_fp8_x8(acc[ai][bj][m][1] * r);
#pragma unroll
                        for (int e_ = 0; e_ < 4; ++e_) { p_[e_ * 64] = (unsigned char)((w0_ >> (8 * e_)) & 0xffu); p_[(4 + e_) * 64] = (unsigned char)((w1_ >> (8 * e_)) & 0xffu); }
                    }
                    if (f8qk && colg < 512) { u32x2 w8; w8.x = pack4_fp8_x8(acc[ai][bj][m][0] * r); w8.y = pack4_fp8_x8(acc[ai][bj][m][1] * r); *(u32x2*)(ws + WS_KN8 + (size_t)row * 512 + colg + 8 * fq) = w8; }
                }
        }
    }
};
struct EpiNull {
    static constexpr bool PERM = true, AFTER_DRAIN = false, PREFETCH = false;
    unsigned char* ws;
    __device__ __forceinline__ void operator()(const f32x4 (&acc)[2][2][4][2], const Unit& u, int wr, int wc, int fr, int fq) const {
        float s = 0.f;
#pragma unroll
        for (int ai = 0; ai < 2; ++ai)
#pragma unroll
            for (int bj = 0; bj < 2; ++bj)
#pragma unroll
                for (int m = 0; m < 4; ++m)
#pragma unroll
                    for (int n = 0; n < 2; ++n) s += acc[ai][bj][m][n][0] + acc[ai][bj][m][n][3];
        if (s == 123456.789f) *(float*)(ws + WS_SSQ) = s;
    }
};
struct MoeOrder {
    StaticOrder so; int pe[8]; size_t estride;
    __device__ __forceinline__ bool next(int i, Unit& u) const { return so.next(i, u); }
    __device__ __forceinline__ size_t boff(const Unit& u) const { int e = 0;
#pragma unroll
        for (int j = 0; j < 7; ++j) e += (u.pm * BM >= pe[j]) ? 1 : 0;
        return (size_t)e * estride; }
    __device__ __forceinline__ void a_ready(const Unit&) const {}
    __device__ __forceinline__ void done(const Unit&) const {}
};
template <class Epi, class Sched, bool ALIGN_EPI = false, bool SP2 = false, bool F8 = false>
__device__ __forceinline__ void gemm_phase(PG8_LAS unsigned char* lds, const Gemm g, const Sched& S, const Epi& E, const int tidb  ) {
    int tid_l; asm volatile("v_mbcnt_lo_u32_b32 %0, -1, 0\n\tv_mbcnt_hi_u32_b32 %0, -1, %0" : "=v"(tid_l)); tid_l += tidb;
    const int tid = tid_l, wid = __builtin_amdgcn_readfirstlane(tid >> 6), lane = tid & 63, wr = wid >> 2, wc = wid & 3, fr = lane & 15, fq = lane >> 4;
    int K_l = g.K; asm volatile("" : "+s"(K_l));
    constexpr int ES = F8 ? 1 : 2;
    const int K = K_l, nt = K * ES / (BK * 2);
    unsigned voffA[2], voffB[2];
#pragma unroll
    for (int i = 0; i < 2; ++i) { int R, C; stage_rc(tid * 16 + i * 8192, R, C); const int Rb = Epi::PERM ? ((R & ~31) + perm32(R & 31)) : R;
        voffA[i] = (unsigned)(R * K) * ES + C * 2u; voffB[i] = (unsigned)(Rb * K) * ES + C * 2u; }
    const size_t kstep = (size_t)(BK * 2);
    const size_t hstep = (size_t)HALF * K * ES;
    const size_t tstep = 2 * hstep;
    const unsigned ldsw = (unsigned)wid * 1024u;
    const int aoff = lds_byte(wr * 64 + fr, fq * 8), boff = lds_byte(wc * 32 + fr, fq * 8);
#define PG8_SA(b, h) (((b) * 2 + (h)) * HTB)
#define PG8_SB(b, h) ((4 + (b) * 2 + (h)) * HTB)
#define PG8_STAGE(bufoff, gbase, voff) do { _Pragma("unroll") for (int _i = 0; _i < 2; ++_i) \
        __builtin_amdgcn_global_load_lds((const unsigned*)((const char*)(gbase) + (voff)[_i]), (PG8_LAS unsigned*)(lds + (bufoff) + ldsw + _i * 8192), 16, 0, 0); } while (0)
#define PG8_LDA(dst, b, h) do { if constexpr (F8) { _Pragma("unroll") for (int m = 0; m < 4; ++m) _Pragma("unroll") for (int k = 0; k < 2; ++k) { const v4i32 t_ = *(const PG8_LAS v4i32*)(lds + PG8_SA(b, h) + aoff + m * 2048 + k * 1024); dst##8[m][4 * k] = t_[0]; dst##8[m][4 * k + 1] = t_[1]; dst##8[m][4 * k + 2] = t_[2]; dst##8[m][4 * k + 3] = t_[3]; } } else { _Pragma("unroll") for (int m = 0; m < 4; ++m) _Pragma("unroll") for (int k = 0; k < 2; ++k) dst[m][k] = *(const PG8_LAS bf16x8*)(lds + PG8_SA(b, h) + aoff + m * 2048 + k * 1024); } } while (0)
#define PG8_LDB(dst, b, h) do { if constexpr (F8) { _Pragma("unroll") for (int n = 0; n < 2; ++n) _Pragma("unroll") for (int k = 0; k < 2; ++k) { const v4i32 t_ = *(const PG8_LAS v4i32*)(lds + PG8_SB(b, h) + boff + n * 2048 + k * 1024); dst##8[n][4 * k] = t_[0]; dst##8[n][4 * k + 1] = t_[1]; dst##8[n][4 * k + 2] = t_[2]; dst##8[n][4 * k + 3] = t_[3]; } } else { _Pragma("unroll") for (int n = 0; n < 2; ++n) _Pragma("unroll") for (int k = 0; k < 2; ++k) dst[n][k] = *(const PG8_LAS bf16x8*)(lds + PG8_SB(b, h) + boff + n * 2048 + k * 1024); } } while (0)
#define PG8_MMA(ai, bj, At, Bt) do { __builtin_amdgcn_s_setprio(1); if constexpr (F8) { _Pragma("unroll") for (int m = 0; m < 4; ++m) _Pragma("unroll") for (int n = 0; n < 2; ++n) \
        asm volatile("v_mfma_scale_f32_16x16x128_f8f6f4 %0, %1, %2, %0, %3, %4 op_sel_hi:[0,0,0]" : "+v"(acc[ai][bj][m][n]) : "v"(Bt##8[n]), "v"(At##8[m]), "v"(sc_w), "v"(sc_h)); } else { \
        _Pragma("unroll") for (int m = 0; m < 4; ++m) _Pragma("unroll") for (int n = 0; n < 2; ++n) _Pragma("unroll") for (int k = 0; k < 2; ++k) \
        acc[ai][bj][m][n] = __builtin_amdgcn_mfma_f32_16x16x32_bf16(Bt[n][k], At[m][k], acc[ai][bj][m][n], 0, 0, 0); } __builtin_amdgcn_s_setprio(0); } while (0)
#define PG8_WAIT_V(n) asm volatile("s_waitcnt vmcnt(" #n ")" ::: "memory")
#define PG8_WAIT_L(n) asm volatile("s_waitcnt lgkmcnt(" #n ")" ::: "memory")
#define PG8_BAR __builtin_amdgcn_s_barrier()
#define PG8_SCHED __builtin_amdgcn_sched_barrier(0)
    Unit cur, nxt; int ui = 0;
    if (!S.next(0, cur)) return;
    f32x4 acc[2][2][4][2];
#pragma unroll
    for (int a = 0; a < 2; ++a)
#pragma unroll
        for (int b = 0; b < 2; ++b)
#pragma unroll
            for (int m = 0; m < 4; ++m)
#pragma unroll
                for (int n = 0; n < 2; ++n) acc[a][b][m][n] = (f32x4){0.f, 0.f, 0.f, 0.f};
    bf16x8 At[4][2], B0[2][2], B1[2][2];
    const int sc_w = g.scw, sc_h = g.sch;
    v8i32 At8[4], B08[2], B18[2];
    const char* cA = (const char*)g.A + (size_t)cur.pm * tstep; const char* cB = (const char*)g.Bt + S.boff(cur) + (size_t)cur.pn * tstep;
    S.a_ready(cur);
    if constexpr (SP2) {
        PG8_STAGE(PG8_SB(0, 0), cB, voffB); PG8_STAGE(PG8_SB(0, 1), cB + hstep, voffB); PG8_STAGE(PG8_SA(0, 0), cA, voffA); PG8_STAGE(PG8_SA(0, 1), cA + hstep, voffA);
        if (wr == 1) PG8_BAR;
        PG8_WAIT_V(2); PG8_BAR;
        PG8_STAGE(PG8_SB(1, 0), cB + kstep, voffB); PG8_STAGE(PG8_SA(1, 0), cA + kstep, voffA); PG8_STAGE(PG8_SB(1, 1), cB + hstep + kstep, voffB);
        PG8_WAIT_V(6); PG8_BAR;
    } else {
        PG8_STAGE(PG8_SB(0, 0), cB, voffB); PG8_STAGE(PG8_SA(0, 0), cA, voffA); PG8_STAGE(PG8_SB(0, 1), cB + hstep, voffB); PG8_STAGE(PG8_SA(0, 1), cA + hstep, voffA);
        if (wr == 1) PG8_BAR;
        PG8_WAIT_V(4); PG8_BAR;
        PG8_STAGE(PG8_SB(1, 0), cB + kstep, voffB); PG8_STAGE(PG8_SA(1, 0), cA + kstep, voffA); PG8_STAGE(PG8_SB(1, 1), cB + hstep + kstep, voffB);
        PG8_WAIT_V(6); PG8_BAR;
    }
    for (;;) {
        const bool has_next = S.next(ui + 1, nxt);
        const char* nA = has_next ? (const char*)g.A + (size_t)nxt.pm * tstep : cA; const char* nB = has_next ? (const char*)g.Bt + S.boff(nxt) + (size_t)nxt.pn * tstep : cB;
        for (int t = 0; t < nt; t += 2) {
            const bool last = (t == nt - 2);
            if constexpr (Epi::PREFETCH) { if (t == 0) E.prefetch(cur, wid, lane); }
            const char* a1 = cA + (size_t)(t + 1) * kstep;
            const char* a2 = last ? nA : cA + (size_t)(t + 2) * kstep; const char* b2 = last ? nB : cB + (size_t)(t + 2) * kstep;
            const char* a3 = a2 + kstep; const char* b3 = b2 + kstep;
            if (last && has_next) S.a_ready(nxt);
            if constexpr (SP2) {
            PG8_LDB(B0, 0, 0); PG8_LDB(B1, 0, 1); PG8_SCHED; PG8_LDA(At, 0, 0); PG8_STAGE(PG8_SA(1, 1), a1 + hstep, voffA);
            PG8_WAIT_V(8); PG8_WAIT_L(0); PG8_BAR; PG8_MMA(0, 0, At, B0); PG8_MMA(0, 1, At, B1); PG8_BAR; PG8_SCHED;
            PG8_LDA(At, 0, 1); PG8_STAGE(PG8_SB(0, 0), b2, voffB); PG8_STAGE(PG8_SB(0, 1), b2 + hstep, voffB); PG8_STAGE(PG8_SA(0, 0), a2, voffA);
            PG8_WAIT_V(8); PG8_WAIT_L(0); PG8_BAR; PG8_MMA(1, 0, At, B0); PG8_MMA(1, 1, At, B1); PG8_BAR; PG8_SCHED;
            PG8_LDB(B0, 1, 0); PG8_LDB(B1, 1, 1); PG8_SCHED; PG8_LDA(At, 1, 0); PG8_STAGE(PG8_SA(0, 1), a2 + hstep, voffA);
            PG8_WAIT_V(8); PG8_WAIT_L(0); PG8_BAR; PG8_MMA(0, 0, At, B0); PG8_MMA(0, 1, At, B1); PG8_BAR; PG8_SCHED;
            PG8_LDA(At, 1, 1); PG8_STAGE(PG8_SB(1, 0), b3, voffB); PG8_STAGE(PG8_SB(1, 1), b3 + hstep, voffB); PG8_STAGE(PG8_SA(1, 0), a3, voffA);
            PG8_WAIT_V(8); PG8_WAIT_L(0); PG8_BAR; PG8_MMA(1, 0, At, B0); PG8_MMA(1, 1, At, B1); PG8_BAR; PG8_SCHED;
            } else {
            PG8_LDB(B0, 0, 0); PG8_SCHED; PG8_LDA(At, 0, 0); PG8_STAGE(PG8_SA(1, 1), a1 + hstep, voffA);
            PG8_WAIT_L(8); PG8_BAR; PG8_WAIT_L(0); PG8_MMA(0, 0, At, B0); PG8_BAR; PG8_SCHED;
            PG8_LDB(B1, 0, 1); PG8_STAGE(PG8_SB(0, 0), b2, voffB);
            PG8_BAR; PG8_WAIT_L(0); PG8_MMA(0, 1, At, B1); PG8_BAR;
            PG8_LDA(At, 0, 1); PG8_STAGE(PG8_SA(0, 0), a2, voffA);
            PG8_BAR; PG8_WAIT_L(0); PG8_MMA(1, 0, At, B0); PG8_BAR; PG8_SCHED;
            PG8_STAGE(PG8_SB(0, 1), b2 + hstep, voffB);
            PG8_WAIT_V(6); PG8_BAR; PG8_MMA(1, 1, At, B1); PG8_BAR;
            PG8_LDB(B0, 1, 0); PG8_SCHED; PG8_LDA(At, 1, 0); PG8_STAGE(PG8_SA(0, 1), a2 + hstep, voffA);
            PG8_WAIT_L(8); PG8_BAR; PG8_WAIT_L(0); PG8_MMA(0, 0, At, B0); PG8_BAR; PG8_SCHED;
            PG8_LDB(B1, 1, 1); PG8_STAGE(PG8_SB(1, 0), b3, voffB);
            PG8_BAR; PG8_WAIT_L(0); PG8_MMA(0, 1, At, B1); PG8_BAR;
            PG8_LDA(At, 1, 1); PG8_STAGE(PG8_SA(1, 0), a3, voffA);
            PG8_BAR; PG8_WAIT_L(0); PG8_MMA(1, 0, At, B0); PG8_BAR; PG8_SCHED;
            PG8_STAGE(PG8_SB(1, 1), b3 + hstep, voffB);
            PG8_WAIT_V(6); PG8_BAR; PG8_MMA(1, 1, At, B1); PG8_BAR;
            }
        }
        if constexpr (ALIGN_EPI) { if (wr == 0) PG8_BAR; }
        if constexpr (F8) asm volatile("s_nop 15\n\ts_nop 15" ::: "memory");
        if constexpr (!Epi::AFTER_DRAIN) { E(acc, cur, wr, wc, fr, fq); S.done(cur); }
        if (!has_next) break;
#pragma unroll
        for (int a = 0; a < 2; ++a)
#pragma unroll
            for (int b = 0; b < 2; ++b)
#pragma unroll
                for (int m = 0; m < 4; ++m)
#pragma unroll
                    for (int n = 0; n < 2; ++n) acc[a][b][m][n] = (f32x4){0.f, 0.f, 0.f, 0.f};
        cur = nxt; cA = nA; cB = nB; ++ui;
        if constexpr (ALIGN_EPI) { if (wr == 1) PG8_BAR; }
    }
    PG8_WAIT_V(0);
    if constexpr (!ALIGN_EPI) { if (wr == 0) PG8_BAR; }
    PG8_BAR;
    if constexpr (Epi::AFTER_DRAIN) { E.fused(acc, cur, wr, wc, fr, fq, lds, wid, lane); S.done(cur); }
#undef PG8_SA
#undef PG8_SB
#undef PG8_STAGE
#undef PG8_LDA
#undef PG8_LDB
#undef PG8_MMA
#undef PG8_WAIT_V
#undef PG8_WAIT_L
#undef PG8_BAR
#undef PG8_SCHED
}
}
namespace att {
#define ALAS __attribute__((address_space(3)))
using bf16 = unsigned short;
using bf16x8 = __attribute__((ext_vector_type(8))) short;
using s16x4 = __attribute__((ext_vector_type(4))) short;
using f32x16 = __attribute__((ext_vector_type(16))) float;
using u32x4 = __attribute__((ext_vector_type(4))) unsigned;
typedef unsigned v2u32 __attribute__((ext_vector_type(2)));
typedef short v4i16_t __attribute__((ext_vector_type(4)));
typedef float f32x2_t __attribute__((ext_vector_type(2))); typedef __bf16 bf16x2_t __attribute__((ext_vector_type(2)));
constexpr int SEQ = 8192;
constexpr int KSLOT_MAX = 12288, VSLOT = 8192;
constexpr int L_K = 0, L_V = 3 * KSLOT_MAX, L_WS = L_V + 2 * VSLOT, L_OST = L_WS + 8 * 256, L_BIAS = L_OST + 8 * 4096, L_END = L_BIAS + 1280;
constexpr float LOG2E = 1.4426950408889634f;
struct Args { const bf16* Q; const bf16* KN; const bf16* KR; const bf16* V; const bf16* QB; const bf16* KB; const bf16* VB; bf16* AO; const float* bias; int f8; const unsigned char* Q8; const unsigned char* KN8; const unsigned char* KR8; const unsigned char* ZERO; int qk8; const unsigned char* V8T; int pv8; };

__device__ __forceinline__ int crow(int r, int hi) { return (r & 3) + 8 * (r >> 2) + 4 * hi; }
__device__ __forceinline__ void glds16(const void* gsrc, unsigned lds_dst) { unsigned keep;
    asm volatile("s_mov_b32 %0, m0\n\ts_mov_b32 m0, %2\n\ts_nop 0\n\tglobal_load_lds_dwordx4 %1, off\n\ts_mov_b32 m0, %0" : "=&s"(keep) : "v"(gsrc), "s"(lds_dst) : "memory"); }
__device__ __forceinline__ unsigned cvtpk(float lo, float hi) { f32x2_t v = {lo, hi}; bf16x2_t b = __builtin_convertvector(v, bf16x2_t); return __builtin_bit_cast(unsigned, b); }
__device__ __forceinline__ s16x4 vtr(ALAS const char* p) { return __builtin_bit_cast(s16x4, __builtin_amdgcn_ds_read_tr16_b64_v4i16((ALAS v4i16_t*)p)); }
__device__ __forceinline__ float xhalf_max(float m) { auto rr = __builtin_amdgcn_permlane32_swap(__float_as_uint(m), __float_as_uint(m), false, false); return fmaxf(__uint_as_float(rr[0]), __uint_as_float(rr[1])); }
__device__ __forceinline__ float xhalf_sum(float m) { auto rr = __builtin_amdgcn_permlane32_swap(__float_as_uint(m), __float_as_uint(m), false, false); return __uint_as_float(rr[0]) + __uint_as_float(rr[1]); }
#define ATT_WAIT_BAR() asm volatile("s_waitcnt vmcnt(0) lgkmcnt(0)\n\ts_barrier" ::: "memory")
__device__ __forceinline__ float max3f(float a, float b, float c) { float r; asm volatile("v_max3_f32 %0, %1, %2, %3" : "=v"(r) : "v"(a), "v"(b), "v"(c)); return r; }
__device__ __forceinline__ float max2f(float a, float b) { float r; asm volatile("v_max_f32_e32 %0, %1, %2" : "=v"(r) : "v"(a), "v"(b)); return r; }
__device__ __forceinline__ float fadd_s(float a, float b) { float r; asm volatile("v_add_f32_e32 %0, %1, %2" : "=v"(r) : "v"(a), "v"(b)); return r; }

__device__ __forceinline__ void write_o(const Args& A, const f32x16& o0, const f32x16& o1, ALAS float* wsf, ALAS char* shm, int wid, int lane, int r32, int hi, long row0, int col0) {
    if (A.f8) {
        ALAS unsigned char* stg = (ALAS unsigned char*)(shm + L_OST) + wid * 4096;
#pragma unroll
        for (int r = 0; r < 16; ++r) { const int orow = crow(r, hi); const float rl = __builtin_amdgcn_rcpf(wsf[32 + orow]) * 8.0f;
            const int w = __builtin_amdgcn_cvt_pk_fp8_f32(__builtin_amdgcn_fmed3f(o0[r] * rl, -448.f, 448.f), __builtin_amdgcn_fmed3f(o1[r] * rl, -448.f, 448.f), 0, false);
            stg[orow * 64 + r32] = (unsigned char)(w & 0xff); stg[orow * 64 + 32 + r32] = (unsigned char)((w >> 8) & 0xff); }
        asm volatile("s_waitcnt lgkmcnt(0)" ::: "memory");
        unsigned char* Ow = (unsigned char*)A.AO + row0 * 1024 + col0;
#pragma unroll
        for (int i = 0; i < 2; ++i) { const int row = i * 16 + (lane >> 2), ch = lane & 3; const u32x4 v = *(ALAS const u32x4*)(stg + row * 64 + ch * 16); *(u32x4*)(Ow + (long)row * 1024 + ch * 16) = v; }
    } else {
        ALAS bf16* stg = (ALAS bf16*)(shm + L_OST) + wid * 2048;
#pragma unroll
        for (int r = 0; r < 16; ++r) { const int orow = crow(r, hi); const float rl = __builtin_amdgcn_rcpf(wsf[32 + orow]);
            stg[orow * 64 + r32] = (bf16)(cvtpk(o0[r] * rl, 0.f) & 0xffffu); stg[orow * 64 + 32 + r32] = (bf16)(cvtpk(o1[r] * rl, 0.f) & 0xffffu); }
        asm volatile("s_waitcnt lgkmcnt(0)" ::: "memory");
        bf16* Ow = A.AO + row0 * 1024 + col0;
#pragma unroll
        for (int i = 0; i < 4; ++i) { const int row = i * 8 + (lane >> 3), ch = lane & 7; const u32x4 v = *(ALAS const u32x4*)(stg + row * 64 + ch * 8); *(u32x4*)(Ow + (long)row * 1024 + ch * 8) = v; }
    }
}

template <bool CHUNK>
__device__ __forceinline__ void attn_unit(const Args& A, int b, int h, int qb, ALAS char* shm, const int tidb) {
    constexpr int NDK = CHUNK ? 4 : 6, KSLOT = NDK * 2048;
    constexpr float THR = 8.0f;
    int tid_l; asm volatile("v_mbcnt_lo_u32_b32 %0, -1, 0\n\tv_mbcnt_hi_u32_b32 %0, -1, %0" : "=v"(tid_l)); tid_l += tidb;
    const int tid = tid_l, lane = tid & 63, r32 = lane & 31, hi = lane >> 5;
    const int wid = __builtin_amdgcn_readfirstlane(tid >> 6);
    const long rowbase = (long)b * SEQ; const int q0 = qb * 256;
    const unsigned lds0 = (unsigned)(size_t)shm;
    ALAS float* wsf = (ALAS float*)(shm + L_WS) + wid * 64;
    ALAS float* bt = (ALAS float*)(shm + L_BIAS);
    const bf16* ksrc = (CHUNK ? A.KB : A.KN) + (rowbase + lane) * 512 + h * 64 + wid * 8;
    const bf16* krsrc = A.KR + (rowbase + lane) * 32 + (wid & 3) * 8;
    const bf16* vsrc = (CHUNK ? A.VB : A.V) + (rowbase + 16 * (wid & 3) + (lane >> 2)) * 512 + h * 64 + (wid >> 2) * 32 + (lane & 3) * 8;
    const unsigned kdst = lds0 + L_K + wid * 1024, krdst = lds0 + L_K + (8 + (wid & 3)) * 1024, vdst = lds0 + L_V + wid * 1024;
#define ATT_ISSUE_K(t, s) do { glds16(ksrc + (long)(t) * 64 * 512, (unsigned)__builtin_amdgcn_readfirstlane(kdst + (s) * KSLOT)); \
        if (!CHUNK && wid < 4) glds16(krsrc + (long)(t) * 64 * 32, (unsigned)__builtin_amdgcn_readfirstlane(krdst + (s) * KSLOT)); } while (0)
#define ATT_ISSUE_V(t, s) glds16(vsrc + (long)(t) * 64 * 512, (unsigned)__builtin_amdgcn_readfirstlane(vdst + (s) * VSLOT))
    const int t_end = 4 * qb + 4, t_begin = CHUNK ? (4 * qb - 8 > 0 ? 4 * qb - 8 : 0) : 0;
    const int cw = 4 * qb + (wid >> 1);
    const int vis_lo = CHUNK ? (cw - 8 > 0 ? cw - 8 : 0) : 0;
    if (CHUNK) { if (tid < 257) bt[tid] = A.bias[h * 257 + tid] * LOG2E; }
    ATT_ISSUE_K(t_begin, 0); ATT_ISSUE_V(t_begin, 0); ATT_ISSUE_K(t_begin + 1, 1);
    const bf16* Qw = CHUNK ? A.QB + (rowbase + q0 + wid * 32 + r32) * 512 + h * 64 + hi * 8 : A.Q + (rowbase + q0 + wid * 32 + r32) * 768 + h * 96 + hi * 8;
    bf16x8 qr[NDK];
#pragma unroll
    for (int d0 = 0; d0 < NDK; ++d0) qr[d0] = *(const bf16x8*)(Qw + d0 * 16);
    float mhat = 0.f, lsum = 0.f; f32x16 o0 = {}, o1 = {}; bool first = true;
    const int vbo = ((lane >> 4) & 1) * 32 + (lane & 3) * 8 + (4 * hi + ((lane & 15) >> 2)) * 64;
    ALAS const char* Kfr = shm + L_K + hi * 1024 + r32 * 16;
#define ATT_QK(C0, C1, t, slot) do { float cinit = -mhat; if (CHUNK) { if ((t) < cw - 2) cinit += bt[256]; } \
        _Pragma("unroll") for (int r = 0; r < 16; ++r) { C0[r] = cinit; C1[r] = cinit; } \
        ALAS const char* Ks_ = Kfr + (slot) * KSLOT; \
        _Pragma("unroll") for (int d0 = 0; d0 < NDK; ++d0) { const bf16x8 a0 = *(ALAS const bf16x8*)(Ks_ + d0 * 2048), a1 = *(ALAS const bf16x8*)(Ks_ + d0 * 2048 + 512); \
            C0 = __builtin_amdgcn_mfma_f32_32x32x16_bf16(a0, qr[d0], C0, 0, 0, 0); C1 = __builtin_amdgcn_mfma_f32_32x32x16_bf16(a1, qr[d0], C1, 0, 0, 0); } } while (0)
    ATT_WAIT_BAR();
    f32x16 c0, c1;
    if (t_begin >= vis_lo) ATT_QK(c0, c1, t_begin, 0);
    int ks = 0, vs = 0;
    for (int t = t_begin; t < t_end; ++t) {
        const int ks1 = ks == 2 ? 0 : ks + 1, ks2 = ks1 == 2 ? 0 : ks1 + 1;
        if (t + 2 < t_end) ATT_ISSUE_K(t + 2, ks2);
        if (t + 1 < t_end) ATT_ISSUE_V(t + 1, vs ^ 1);
        const bool vis = (t >= vis_lo && t <= cw), visn = (t + 1 >= vis_lo && t + 1 <= cw);
        if (vis) {
            if (CHUNK) { if (t >= cw - 2) {
                const int dq = 64 * (cw - t) + 32 * (wid & 1) + r32 + 128;
#pragma unroll
                for (int r = 0; r < 16; ++r) { int i0 = dq - crow(r, hi), i1 = i0 - 32; i0 = i0 < 0 ? 0 : (i0 > 256 ? 256 : i0); i1 = i1 < 0 ? 0 : (i1 > 256 ? 256 : i1); c0[r] += bt[i0]; c1[r] += bt[i1]; }
            } }
            float rmp[4];
#pragma unroll
            for (int j = 0; j < 4; ++j) rmp[j] = fmaxf(fmaxf(c0[j], c1[j]), fmaxf(c0[4 + j], c1[4 + j]));
#pragma unroll
            for (int j = 0; j < 4; ++j) rmp[j] = fmaxf(rmp[j], fmaxf(fmaxf(c0[8 + j], c1[8 + j]), fmaxf(c0[12 + j], c1[12 + j])));
            float rm = xhalf_max(fmaxf(fmaxf(rmp[0], rmp[1]), fmaxf(rmp[2], rmp[3])));
            if (first) { first = false; mhat = rm;
#pragma unroll
                for (int r = 0; r < 16; ++r) { c0[r] -= rm; c1[r] -= rm; }
            } else if (__any(rm > THR)) {
                const float dl = fmaxf(rm, 0.f); mhat += dl;
#pragma unroll
                for (int r = 0; r < 16; ++r) { c0[r] -= dl; c1[r] -= dl; }
                const float f = __builtin_amdgcn_exp2f(-dl); lsum *= f;
                if (hi == 0) wsf[r32] = f;
                asm volatile("s_waitcnt lgkmcnt(0)" ::: "memory");
#pragma unroll
                for (int r = 0; r < 16; ++r) { const float fr_ = wsf[crow(r, hi)]; o0[r] *= fr_; o1[r] *= fr_; }
            }
        }
        f32x16 n0, n1;
        if (vis && visn) {
            ALAS const char* Ks_ = Kfr + ks1 * KSLOT;
            bf16x8 ka = *(ALAS const bf16x8*)(Ks_), kb = *(ALAS const bf16x8*)(Ks_ + 512);
            float cinit = -mhat; if (CHUNK) { if (t + 1 < cw - 2) cinit += bt[256]; }
#pragma unroll
            for (int r = 0; r < 16; ++r) { n0[r] = cinit; n1[r] = cinit; }
            __builtin_amdgcn_sched_barrier(0);
            constexpr int NM = 2 * NDK;
#pragma unroll
            for (int d0 = 0; d0 < NDK; ++d0) {
                bf16x8 na = ka, nb = kb;
                if (d0 + 1 < NDK) { na = *(ALAS const bf16x8*)(Ks_ + (d0 + 1) * 2048); nb = *(ALAS const bf16x8*)(Ks_ + (d0 + 1) * 2048 + 512); }
                n0 = __builtin_amdgcn_mfma_f32_32x32x16_bf16(ka, qr[d0], n0, 0, 0, 0);
#pragma unroll
                for (int e = 0; e < 32; ++e) if (e * NM / 32 == 2 * d0) { if (e < 16) c0[e] = __builtin_amdgcn_exp2f(c0[e]); else c1[e - 16] = __builtin_amdgcn_exp2f(c1[e - 16]); }
                __builtin_amdgcn_sched_barrier(0);
                n1 = __builtin_amdgcn_mfma_f32_32x32x16_bf16(kb, qr[d0], n1, 0, 0, 0);
#pragma unroll
                for (int e = 0; e < 32; ++e) if (e * NM / 32 == 2 * d0 + 1) { if (e < 16) c0[e] = __builtin_amdgcn_exp2f(c0[e]); else c1[e - 16] = __builtin_amdgcn_exp2f(c1[e - 16]); }
                __builtin_amdgcn_sched_barrier(0);
                ka = na; kb = nb;
            }
            ALAS const char* vb = shm + L_V + vs * VSLOT + vbo;
            s16x4 vl[8], vh[8];
#pragma unroll
            for (int kk = 0; kk < 4; ++kk) { vl[kk] = vtr(vb + kk * 1024); vh[kk] = vtr(vb + kk * 1024 + 512); vl[4 + kk] = vtr(vb + 4096 + kk * 1024); vh[4 + kk] = vtr(vb + 4096 + kk * 1024 + 512); }
            float sacc4[4];
#pragma unroll
            for (int kk = 0; kk < 4; ++kk) {
                u32x4 pw;
                if (kk < 2) { pw = (u32x4){cvtpk(c0[8 * kk], c0[8 * kk + 1]), cvtpk(c0[8 * kk + 2], c0[8 * kk + 3]), cvtpk(c0[8 * kk + 4], c0[8 * kk + 5]), cvtpk(c0[8 * kk + 6], c0[8 * kk + 7])};
                    sacc4[kk] = ((c0[8 * kk] + c0[8 * kk + 1]) + (c0[8 * kk + 2] + c0[8 * kk + 3])) + ((c0[8 * kk + 4] + c0[8 * kk + 5]) + (c0[8 * kk + 6] + c0[8 * kk + 7])); }
                else { const int k2 = kk - 2; pw = (u32x4){cvtpk(c1[8 * k2], c1[8 * k2 + 1]), cvtpk(c1[8 * k2 + 2], c1[8 * k2 + 3]), cvtpk(c1[8 * k2 + 4], c1[8 * k2 + 5]), cvtpk(c1[8 * k2 + 6], c1[8 * k2 + 7])};
                    sacc4[kk] = ((c1[8 * k2] + c1[8 * k2 + 1]) + (c1[8 * k2 + 2] + c1[8 * k2 + 3])) + ((c1[8 * k2 + 4] + c1[8 * k2 + 5]) + (c1[8 * k2 + 6] + c1[8 * k2 + 7])); }
                const bf16x8 v0 = (bf16x8){vl[kk][0], vl[kk][1], vl[kk][2], vl[kk][3], vh[kk][0], vh[kk][1], vh[kk][2], vh[kk][3]}, v1 = (bf16x8){vl[4 + kk][0], vl[4 + kk][1], vl[4 + kk][2], vl[4 + kk][3], vh[4 + kk][0], vh[4 + kk][1], vh[4 + kk][2], vh[4 + kk][3]};
                o0 = __builtin_amdgcn_mfma_f32_32x32x16_bf16(__builtin_bit_cast(bf16x8, pw), v0, o0, 0, 0, 0);
                o1 = __builtin_amdgcn_mfma_f32_32x32x16_bf16(__builtin_bit_cast(bf16x8, pw), v1, o1, 0, 0, 0);
                __builtin_amdgcn_sched_barrier(0);
            }
            lsum += (sacc4[0] + sacc4[1]) + (sacc4[2] + sacc4[3]);
        } else {
        if (visn) ATT_QK(n0, n1, t + 1, ks1);
        if (vis) {
            float sacc = 0.f;
#pragma unroll
            for (int r = 0; r < 16; ++r) { c0[r] = __builtin_amdgcn_exp2f(c0[r]); c1[r] = __builtin_amdgcn_exp2f(c1[r]); sacc += c0[r] + c1[r]; }
            lsum += sacc;
            u32x4 pw[4];
#pragma unroll
            for (int k = 0; k < 2; ++k) {
                pw[k]     = (u32x4){cvtpk(c0[8 * k], c0[8 * k + 1]), cvtpk(c0[8 * k + 2], c0[8 * k + 3]), cvtpk(c0[8 * k + 4], c0[8 * k + 5]), cvtpk(c0[8 * k + 6], c0[8 * k + 7])};
                pw[2 + k] = (u32x4){cvtpk(c1[8 * k], c1[8 * k + 1]), cvtpk(c1[8 * k + 2], c1[8 * k + 3]), cvtpk(c1[8 * k + 4], c1[8 * k + 5]), cvtpk(c1[8 * k + 6], c1[8 * k + 7])};
            }
            ALAS const char* vb = shm + L_V + vs * VSLOT + vbo;
#pragma unroll
            for (int kk = 0; kk < 4; ++kk) {
                const s16x4 l0 = vtr(vb + kk * 1024), h0 = vtr(vb + kk * 1024 + 512), l1 = vtr(vb + 4096 + kk * 1024), h1 = vtr(vb + 4096 + kk * 1024 + 512);
                const bf16x8 v0 = (bf16x8){l0[0], l0[1], l0[2], l0[3], h0[0], h0[1], h0[2], h0[3]}, v1 = (bf16x8){l1[0], l1[1], l1[2], l1[3], h1[0], h1[1], h1[2], h1[3]};
                o0 = __builtin_amdgcn_mfma_f32_32x32x16_bf16(__builtin_bit_cast(bf16x8, pw[kk]), v0, o0, 0, 0, 0);
                o1 = __builtin_amdgcn_mfma_f32_32x32x16_bf16(__builtin_bit_cast(bf16x8, pw[kk]), v1, o1, 0, 0, 0);
            }
        }
        }
        if (visn) { c0 = n0; c1 = n1; }
        ks = ks1; vs ^= 1;
        ATT_WAIT_BAR();
    }
    const float lt = xhalf_sum(lsum);
    if (hi == 0) wsf[32 + r32] = lt;
    asm volatile("s_waitcnt lgkmcnt(0)" ::: "memory");
    write_o(A, o0, o1, wsf, shm, wid, lane, r32, hi, rowbase + q0 + wid * 32, (CHUNK ? 512 : 0) + h * 64);
    asm volatile("s_waitcnt lgkmcnt(0)\n\ts_barrier" ::: "memory");
#undef ATT_ISSUE_K
#undef ATT_ISSUE_V
#undef ATT_QK
}

__device__ __forceinline__ bf16x8 cvt8_fp8_bf16(const v2u32 w, const float sc) {
    const f32x2_t a = __builtin_amdgcn_cvt_pk_f32_fp8((int)w.x, false), b2 = __builtin_amdgcn_cvt_pk_f32_fp8((int)w.x, true), c = __builtin_amdgcn_cvt_pk_f32_fp8((int)w.y, false), d = __builtin_amdgcn_cvt_pk_f32_fp8((int)w.y, true);
    const u32x4 r = {cvtpk(a[0] * sc, a[1] * sc), cvtpk(b2[0] * sc, b2[1] * sc), cvtpk(c[0] * sc, c[1] * sc), cvtpk(d[0] * sc, d[1] * sc)}; return __builtin_bit_cast(bf16x8, r); }
__device__ __forceinline__ bf16x8 kfrag8(ALAS const char* slot, const int d0, const int kh, const int r32, const int hi) {
    const int m = d0 < 4 ? 0 : 1, dd = d0 < 4 ? d0 : d0 - 4;
    return cvt8_fp8_bf16(*(ALAS const v2u32*)(slot + ((m * 2 + kh) * 2 + (dd & 1)) * 1024 + ((dd >> 1) * 32 + r32) * 16 + 8 * hi), 1.0f); }
__device__ __forceinline__ void attn_unit8(const Args& A, int b, int h, int qb, ALAS char* shm, const int tidb) {
    constexpr bool CHUNK = false;
    constexpr int NDK = 6, KSLOT = 8192;
    constexpr float THR = 8.0f;
    int tid_l; asm volatile("v_mbcnt_lo_u32_b32 %0, -1, 0\n\tv_mbcnt_hi_u32_b32 %0, -1, %0" : "=v"(tid_l)); tid_l += tidb;
    const int tid = tid_l, lane = tid & 63, r32 = lane & 31, hi = lane >> 5;
    const int wid = __builtin_amdgcn_readfirstlane(tid >> 6);
    const long rowbase = (long)b * SEQ; const int q0 = qb * 256;
    const unsigned lds0 = (unsigned)(size_t)shm;
    ALAS float* wsf = (ALAS float*)(shm + L_WS) + wid * 64;
    ALAS float* bt = (ALAS float*)(shm + L_BIAS);
    const int m_ = wid >> 2, kh_ = (wid >> 1) & 1, j_ = wid & 1;
    const long krow_ = rowbase + 32 * kh_ + r32;
    const unsigned char* ks8 = m_ == 0 ? A.KN8 + krow_ * 512 + h * 64 + 32 * hi + 16 * j_ : (hi == 0 ? A.KR8 + krow_ * 32 + 16 * j_ : A.ZERO + r32 * 16);
    const long kst8 = m_ == 0 ? 64 * 512 : (hi == 0 ? 64 * 32 : 0);
    const bf16* vsrc = (CHUNK ? A.VB : A.V) + (rowbase + 16 * (wid & 3) + (lane >> 2)) * 512 + h * 64 + (wid >> 2) * 32 + (lane & 3) * 8;
    const unsigned kdst = lds0 + L_K + wid * 1024, krdst = lds0 + L_K + (8 + (wid & 3)) * 1024, vdst = lds0 + L_V + wid * 1024;
#define ATT_ISSUE_K(t, s) glds16(ks8 + (long)(t) * kst8, (unsigned)__builtin_amdgcn_readfirstlane(kdst + (s) * KSLOT))
#define ATT_ISSUE_V(t, s) glds16(vsrc + (long)(t) * 64 * 512, (unsigned)__builtin_amdgcn_readfirstlane(vdst + (s) * VSLOT))
    const int t_end = 4 * qb + 4, t_begin = CHUNK ? (4 * qb - 8 > 0 ? 4 * qb - 8 : 0) : 0;
    const int cw = 4 * qb + (wid >> 1);
    const int vis_lo = CHUNK ? (cw - 8 > 0 ? cw - 8 : 0) : 0;
    if (CHUNK) { if (tid < 257) bt[tid] = A.bias[h * 257 + tid] * LOG2E; }
    ATT_ISSUE_K(t_begin, 0); ATT_ISSUE_V(t_begin, 0); ATT_ISSUE_K(t_begin + 1, 1);
    const bf16* Qw = CHUNK ? A.QB + (rowbase + q0 + wid * 32 + r32) * 512 + h * 64 + hi * 8 : A.Q + (rowbase + q0 + wid * 32 + r32) * 768 + h * 96 + hi * 8;
    const unsigned char* Q8w = A.Q8 + (rowbase + q0 + wid * 32 + r32) * 768 + h * 96 + 8 * hi; (void)Qw;
    bf16x8 qr[NDK];
#pragma unroll
    for (int d0 = 0; d0 < NDK; ++d0) qr[d0] = cvt8_fp8_bf16(*(const v2u32*)(Q8w + 16 * d0), 1.0f / 128.0f);
    float mhat = 0.f, lsum = 0.f; f32x16 o0 = {}, o1 = {}; bool first = true;
    const int vbo = ((lane >> 4) & 1) * 32 + (lane & 3) * 8 + (4 * hi + ((lane & 15) >> 2)) * 64;
    ALAS const char* Kfr = shm + L_K;
#define ATT_QK(C0, C1, t, slot) do { float cinit = -mhat; if (CHUNK) { if ((t) < cw - 2) cinit += bt[256]; } \
        _Pragma("unroll") for (int r = 0; r < 16; ++r) { C0[r] = cinit; C1[r] = cinit; } \
        ALAS const char* Ks_ = Kfr + (slot) * KSLOT; \
        _Pragma("unroll") for (int d0 = 0; d0 < NDK; ++d0) { const bf16x8 a0 = kfrag8(Ks_, d0, 0, r32, hi), a1 = kfrag8(Ks_, d0, 1, r32, hi); \
            C0 = __builtin_amdgcn_mfma_f32_32x32x16_bf16(a0, qr[d0], C0, 0, 0, 0); C1 = __builtin_amdgcn_mfma_f32_32x32x16_bf16(a1, qr[d0], C1, 0, 0, 0); } } while (0)
    ATT_WAIT_BAR();
    f32x16 c0, c1;
    if (t_begin >= vis_lo) ATT_QK(c0, c1, t_begin, 0);
    int ks = 0, vs = 0;
    for (int t = t_begin; t < t_end; ++t) {
        const int ks1 = ks == 2 ? 0 : ks + 1, ks2 = ks1 == 2 ? 0 : ks1 + 1;
        if (t + 2 < t_end) ATT_ISSUE_K(t + 2, ks2);
        if (t + 1 < t_end) ATT_ISSUE_V(t + 1, vs ^ 1);
        const bool vis = (t >= vis_lo && t <= cw), visn = (t + 1 >= vis_lo && t + 1 <= cw);
        if (vis) {
            if (CHUNK) { if (t >= cw - 2) {
                const int dq = 64 * (cw - t) + 32 * (wid & 1) + r32 + 128;
#pragma unroll
                for (int r = 0; r < 16; ++r) { int i0 = dq - crow(r, hi), i1 = i0 - 32; i0 = i0 < 0 ? 0 : (i0 > 256 ? 256 : i0); i1 = i1 < 0 ? 0 : (i1 > 256 ? 256 : i1); c0[r] += bt[i0]; c1[r] += bt[i1]; }
            } }
            float rmp[4];
#pragma unroll
            for (int j = 0; j < 4; ++j) rmp[j] = fmaxf(fmaxf(c0[j], c1[j]), fmaxf(c0[4 + j], c1[4 + j]));
#pragma unroll
            for (int j = 0; j < 4; ++j) rmp[j] = fmaxf(rmp[j], fmaxf(fmaxf(c0[8 + j], c1[8 + j]), fmaxf(c0[12 + j], c1[12 + j])));
            float rm = xhalf_max(fmaxf(fmaxf(rmp[0], rmp[1]), fmaxf(rmp[2], rmp[3])));
            if (first) { first = false; mhat = rm;
#pragma unroll
                for (int r = 0; r < 16; ++r) { c0[r] -= rm; c1[r] -= rm; }
            } else if (__any(rm > THR)) {
                const float dl = fmaxf(rm, 0.f); mhat += dl;
#pragma unroll
                for (int r = 0; r < 16; ++r) { c0[r] -= dl; c1[r] -= dl; }
                const float f = __builtin_amdgcn_exp2f(-dl); lsum *= f;
                if (hi == 0) wsf[r32] = f;
                asm volatile("s_waitcnt lgkmcnt(0)" ::: "memory");
#pragma unroll
                for (int r = 0; r < 16; ++r) { const float fr_ = wsf[crow(r, hi)]; o0[r] *= fr_; o1[r] *= fr_; }
            }
        }
        f32x16 n0, n1;
        if (vis && visn) {
            ALAS const char* Ks_ = Kfr + ks1 * KSLOT;
            bf16x8 ka = kfrag8(Ks_, 0, 0, r32, hi), kb = kfrag8(Ks_, 0, 1, r32, hi);
            float cinit = -mhat; if (CHUNK) { if (t + 1 < cw - 2) cinit += bt[256]; }
#pragma unroll
            for (int r = 0; r < 16; ++r) { n0[r] = cinit; n1[r] = cinit; }
            __builtin_amdgcn_sched_barrier(0);
            constexpr int NM = 2 * NDK;
#pragma unroll
            for (int d0 = 0; d0 < NDK; ++d0) {
                bf16x8 na = ka, nb = kb;
                if (d0 + 1 < NDK) { na = kfrag8(Ks_, d0 + 1, 0, r32, hi); nb = kfrag8(Ks_, d0 + 1, 1, r32, hi); }
                n0 = __builtin_amdgcn_mfma_f32_32x32x16_bf16(ka, qr[d0], n0, 0, 0, 0);
#pragma unroll
                for (int e = 0; e < 32; ++e) if (e * NM / 32 == 2 * d0) { if (e < 16) c0[e] = __builtin_amdgcn_exp2f(c0[e]); else c1[e - 16] = __builtin_amdgcn_exp2f(c1[e - 16]); }
                __builtin_amdgcn_sched_barrier(0);
                n1 = __builtin_amdgcn_mfma_f32_32x32x16_bf16(kb, qr[d0], n1, 0, 0, 0);
#pragma unroll
                for (int e = 0; e < 32; ++e) if (e * NM / 32 == 2 * d0 + 1) { if (e < 16) c0[e] = __builtin_amdgcn_exp2f(c0[e]); else c1[e - 16] = __builtin_amdgcn_exp2f(c1[e - 16]); }
                __builtin_amdgcn_sched_barrier(0);
                ka = na; kb = nb;
            }
            ALAS const char* vb = shm + L_V + vs * VSLOT + vbo;
            s16x4 vl[8], vh[8];
#pragma unroll
            for (int kk = 0; kk < 4; ++kk) { vl[kk] = vtr(vb + kk * 1024); vh[kk] = vtr(vb + kk * 1024 + 512); vl[4 + kk] = vtr(vb + 4096 + kk * 1024); vh[4 + kk] = vtr(vb + 4096 + kk * 1024 + 512); }
            float sacc4[4];
#pragma unroll
            for (int kk = 0; kk < 4; ++kk) {
                u32x4 pw;
                if (kk < 2) { pw = (u32x4){cvtpk(c0[8 * kk], c0[8 * kk + 1]), cvtpk(c0[8 * kk + 2], c0[8 * kk + 3]), cvtpk(c0[8 * kk + 4], c0[8 * kk + 5]), cvtpk(c0[8 * kk + 6], c0[8 * kk + 7])};
                    sacc4[kk] = ((c0[8 * kk] + c0[8 * kk + 1]) + (c0[8 * kk + 2] + c0[8 * kk + 3])) + ((c0[8 * kk + 4] + c0[8 * kk + 5]) + (c0[8 * kk + 6] + c0[8 * kk + 7])); }
                else { const int k2 = kk - 2; pw = (u32x4){cvtpk(c1[8 * k2], c1[8 * k2 + 1]), cvtpk(c1[8 * k2 + 2], c1[8 * k2 + 3]), cvtpk(c1[8 * k2 + 4], c1[8 * k2 + 5]), cvtpk(c1[8 * k2 + 6], c1[8 * k2 + 7])};
                    sacc4[kk] = ((c1[8 * k2] + c1[8 * k2 + 1]) + (c1[8 * k2 + 2] + c1[8 * k2 + 3])) + ((c1[8 * k2 + 4] + c1[8 * k2 + 5]) + (c1[8 * k2 + 6] + c1[8 * k2 + 7])); }
                const bf16x8 v0 = (bf16x8){vl[kk][0], vl[kk][1], vl[kk][2], vl[kk][3], vh[kk][0], vh[kk][1], vh[kk][2], vh[kk][3]}, v1 = (bf16x8){vl[4 + kk][0], vl[4 + kk][1], vl[4 + kk][2], vl[4 + kk][3], vh[4 + kk][0], vh[4 + kk][1], vh[4 + kk][2], vh[4 + kk][3]};
                o0 = __builtin_amdgcn_mfma_f32_32x32x16_bf16(__builtin_bit_cast(bf16x8, pw), v0, o0, 0, 0, 0);
                o1 = __builtin_amdgcn_mfma_f32_32x32x16_bf16(__builtin_bit_cast(bf16x8, pw), v1, o1, 0, 0, 0);
                __builtin_amdgcn_sched_barrier(0);
            }
            lsum += (sacc4[0] + sacc4[1]) + (sacc4[2] + sacc4[3]);
        } else {
        if (visn) ATT_QK(n0, n1, t + 1, ks1);
        if (vis) {
            float sacc = 0.f;
#pragma unroll
            for (int r = 0; r < 16; ++r) { c0[r] = __builtin_amdgcn_exp2f(c0[r]); c1[r] = __builtin_amdgcn_exp2f(c1[r]); sacc += c0[r] + c1[r]; }
            lsum += sacc;
            u32x4 pw[4];
#pragma unroll
            for (int k = 0; k < 2; ++k) {
                pw[k]     = (u32x4){cvtpk(c0[8 * k], c0[8 * k + 1]), cvtpk(c0[8 * k + 2], c0[8 * k + 3]), cvtpk(c0[8 * k + 4], c0[8 * k + 5]), cvtpk(c0[8 * k + 6], c0[8 * k + 7])};
                pw[2 + k] = (u32x4){cvtpk(c1[8 * k], c1[8 * k + 1]), cvtpk(c1[8 * k + 2], c1[8 * k + 3]), cvtpk(c1[8 * k + 4], c1[8 * k + 5]), cvtpk(c1[8 * k + 6], c1[8 * k + 7])};
            }
            ALAS const char* vb = shm + L_V + vs * VSLOT + vbo;
#pragma unroll
            for (int kk = 0; kk < 4; ++kk) {
                const s16x4 l0 = vtr(vb + kk * 1024), h0 = vtr(vb + kk * 1024 + 512), l1 = vtr(vb + 4096 + kk * 1024), h1 = vtr(vb + 4096 + kk * 1024 + 512);
                const bf16x8 v0 = (bf16x8){l0[0], l0[1], l0[2], l0[3], h0[0], h0[1], h0[2], h0[3]}, v1 = (bf16x8){l1[0], l1[1], l1[2], l1[3], h1[0], h1[1], h1[2], h1[3]};
                o0 = __builtin_amdgcn_mfma_f32_32x32x16_bf16(__builtin_bit_cast(bf16x8, pw[kk]), v0, o0, 0, 0, 0);
                o1 = __builtin_amdgcn_mfma_f32_32x32x16_bf16(__builtin_bit_cast(bf16x8, pw[kk]), v1, o1, 0, 0, 0);
            }
        }
        }
        if (visn) { c0 = n0; c1 = n1; }
        ks = ks1; vs ^= 1;
        ATT_WAIT_BAR();
    }
    const float lt = xhalf_sum(lsum);
    if (hi == 0) wsf[32 + r32] = lt;
    asm volatile("s_waitcnt lgkmcnt(0)" ::: "memory");
    write_o(A, o0, o1, wsf, shm, wid, lane, r32, hi, rowbase + q0 + wid * 32, (CHUNK ? 512 : 0) + h * 64);
    asm volatile("s_waitcnt lgkmcnt(0)\n\ts_barrier" ::: "memory");
#undef ATT_ISSUE_K
#undef ATT_ISSUE_V
#undef ATT_QK
}

__device__ __forceinline__ bool mla_unit_fast(const Args& A, int b, int h, int qb, ALAS char* shm, const int tidb) {
    constexpr int NDK = 6, KSLOT = NDK * 2048;
    constexpr float THR = 8.0f;
    int tid_l; asm volatile("v_mbcnt_lo_u32_b32 %0, -1, 0\n\tv_mbcnt_hi_u32_b32 %0, -1, %0" : "=v"(tid_l)); tid_l += tidb;
    const int tid = tid_l, lane = tid & 63, r32 = lane & 31, hi = lane >> 5;
    const int wid = __builtin_amdgcn_readfirstlane(tid >> 6);
    const long rowbase = (long)b * SEQ; const int q0 = qb * 256;
    const unsigned lds0 = (unsigned)(size_t)shm;
    ALAS float* wsf = (ALAS float*)(shm + L_WS) + wid * 64;
    ALAS int* bailw = (ALAS int*)(shm + L_BIAS);
    const bf16* ksrc = A.KN + (rowbase + lane) * 512 + h * 64 + wid * 8;
    const bf16* krsrc = A.KR + (rowbase + lane) * 32 + (wid & 3) * 8;
    const bf16* vsrc = A.V + (rowbase + 16 * (wid & 3) + (lane >> 2)) * 512 + h * 64 + (wid >> 2) * 32 + (lane & 3) * 8;
    const unsigned kdst = lds0 + L_K + wid * 1024, krdst = lds0 + L_K + (8 + (wid & 3)) * 1024, vdst = lds0 + L_V + wid * 1024;
#define MF_ISSUE_K(t, s) do { glds16(ksrc + (long)(t) * 64 * 512, (unsigned)__builtin_amdgcn_readfirstlane(kdst + (s) * KSLOT)); \
        if (wid < 4) glds16(krsrc + (long)(t) * 64 * 32, (unsigned)__builtin_amdgcn_readfirstlane(krdst + (s) * KSLOT)); } while (0)
#define MF_ISSUE_V(t, s) glds16(vsrc + (long)(t) * 64 * 512, (unsigned)__builtin_amdgcn_readfirstlane(vdst + (s) * VSLOT))
    const int t_end = 4 * qb + 4;
    const int cw = 4 * qb + (wid >> 1);
    if (tid == 0) bailw[0] = 0;
    MF_ISSUE_K(0, 0); MF_ISSUE_V(0, 0); MF_ISSUE_K(1, 1);
    const bf16* Qw = A.Q + (rowbase + q0 + wid * 32 + r32) * 768 + h * 96 + hi * 8;
    bf16x8 qr[NDK];
#pragma unroll
    for (int d0 = 0; d0 < NDK; ++d0) qr[d0] = *(const bf16x8*)(Qw + d0 * 16);
    float lsum = 0.f; f32x16 o0 = {}, o1 = {};
    const int vbo = ((lane >> 4) & 1) * 32 + (lane & 3) * 8 + (4 * hi + ((lane & 15) >> 2)) * 64;
    ALAS const char* Kfr = shm + L_K + hi * 1024 + r32 * 16;
#define MF_ROWMAX(C0, C1) ({ float rmp_[4]; _Pragma("unroll") for (int j = 0; j < 4; ++j) { rmp_[j] = max3f(C0[j], C1[j], C0[4 + j]); rmp_[j] = max3f(rmp_[j], C1[4 + j], C0[8 + j]); rmp_[j] = max3f(rmp_[j], C1[8 + j], C0[12 + j]); rmp_[j] = max2f(rmp_[j], C1[12 + j]); } \
        xhalf_max(max2f(max3f(rmp_[0], rmp_[1], rmp_[2]), rmp_[3])); })
    ATT_WAIT_BAR();
    f32x16 cs[2][2];
    { f32x16 z0 = {}, z1 = {}; ALAS const char* Ks_ = Kfr;
#pragma unroll
      for (int d0 = 0; d0 < NDK; ++d0) { const bf16x8 a0 = *(ALAS const bf16x8*)(Ks_ + d0 * 2048), a1 = *(ALAS const bf16x8*)(Ks_ + d0 * 2048 + 512);
          z0 = __builtin_amdgcn_mfma_f32_32x32x16_bf16(a0, qr[d0], z0, 0, 0, 0); z1 = __builtin_amdgcn_mfma_f32_32x32x16_bf16(a1, qr[d0], z1, 0, 0, 0); }
      asm volatile("s_nop 15\n\ts_nop 7" : "+v"(z0), "+v"(z1));
      cs[0][0] = z0; cs[0][1] = z1; }
    const float mhat = MF_ROWMAX(cs[0][0], cs[0][1]);
#pragma unroll
    for (int r = 0; r < 16; ++r) { cs[0][0][r] -= mhat; cs[0][1][r] -= mhat; }
    f32x16 negm;
#pragma unroll
    for (int r = 0; r < 16; ++r) negm[r] = -mhat;
    bool bailed = false; int ks = 0, vs = 0;
    for (int t2 = 0; t2 < t_end; t2 += 2) {
#pragma unroll
        for (int p = 0; p < 2; ++p) {
            const int t = t2 + p; f32x16 &C0 = cs[p][0], &C1 = cs[p][1], &N0 = cs[p ^ 1][0], &N1 = cs[p ^ 1][1];
            const bool vis = !bailed && t <= cw;
            const int ks1 = ks == 2 ? 0 : ks + 1, ks2 = ks1 == 2 ? 0 : ks1 + 1;
            if (t + 2 < t_end) MF_ISSUE_K(t + 2, ks2);
            if (t + 1 < t_end) MF_ISSUE_V(t + 1, vs ^ 1);
            if (vis) {
                {
                    ALAS const char* Ks_ = Kfr + ks1 * KSLOT;
                    bf16x8 ka = *(ALAS const bf16x8*)(Ks_), kb = *(ALAS const bf16x8*)(Ks_ + 512);
                    constexpr int NM = 2 * NDK;
#pragma unroll
                    for (int d0 = 0; d0 < NDK; ++d0) {
                        bf16x8 na = ka, nb = kb;
                        if (d0 + 1 < NDK) { na = *(ALAS const bf16x8*)(Ks_ + (d0 + 1) * 2048); nb = *(ALAS const bf16x8*)(Ks_ + (d0 + 1) * 2048 + 512); }
                        N0 = __builtin_amdgcn_mfma_f32_32x32x16_bf16(ka, qr[d0], d0 == 0 ? negm : N0, 0, 0, 0);
#pragma unroll
                        for (int e = 0; e < 32; ++e) if (e * NM / 32 == 2 * d0) { if (e < 16) C0[e] = __builtin_amdgcn_exp2f(C0[e]); else C1[e - 16] = __builtin_amdgcn_exp2f(C1[e - 16]); }
                        __builtin_amdgcn_sched_barrier(0);
                        N1 = __builtin_amdgcn_mfma_f32_32x32x16_bf16(kb, qr[d0], d0 == 0 ? negm : N1, 0, 0, 0);
#pragma unroll
                        for (int e = 0; e < 32; ++e) if (e * NM / 32 == 2 * d0 + 1) { if (e < 16) C0[e] = __builtin_amdgcn_exp2f(C0[e]); else C1[e - 16] = __builtin_amdgcn_exp2f(C1[e - 16]); }
                        __builtin_amdgcn_sched_barrier(0);
                        ka = na; kb = nb;
                    }
                }
                ALAS const char* vb_ = shm + L_V + vs * VSLOT + vbo; s16x4 vl_[8], vh_[8];
#pragma unroll
                for (int kk = 0; kk < 4; ++kk) { vl_[kk] = vtr(vb_ + kk * 1024); vh_[kk] = vtr(vb_ + kk * 1024 + 512); vl_[4 + kk] = vtr(vb_ + 4096 + kk * 1024); vh_[4 + kk] = vtr(vb_ + 4096 + kk * 1024 + 512); }
                float sa_[4];
#pragma unroll
                for (int kk = 0; kk < 4; ++kk) { const f32x16& cc_ = (kk < 2) ? C0 : C1; const int k8_ = 8 * (kk & 1);
                    const u32x4 pw_ = (u32x4){cvtpk(cc_[k8_], cc_[k8_ + 1]), cvtpk(cc_[k8_ + 2], cc_[k8_ + 3]), cvtpk(cc_[k8_ + 4], cc_[k8_ + 5]), cvtpk(cc_[k8_ + 6], cc_[k8_ + 7])};
                    sa_[kk] = fadd_s(fadd_s(fadd_s(cc_[k8_], cc_[k8_ + 1]), fadd_s(cc_[k8_ + 2], cc_[k8_ + 3])), fadd_s(fadd_s(cc_[k8_ + 4], cc_[k8_ + 5]), fadd_s(cc_[k8_ + 6], cc_[k8_ + 7])));
                    const bf16x8 v0_ = (bf16x8){vl_[kk][0], vl_[kk][1], vl_[kk][2], vl_[kk][3], vh_[kk][0], vh_[kk][1], vh_[kk][2], vh_[kk][3]}, v1_ = (bf16x8){vl_[4 + kk][0], vl_[4 + kk][1], vl_[4 + kk][2], vl_[4 + kk][3], vh_[4 + kk][0], vh_[4 + kk][1], vh_[4 + kk][2], vh_[4 + kk][3]};
                    o0 = __builtin_amdgcn_mfma_f32_32x32x16_bf16(__builtin_bit_cast(bf16x8, pw_), v0_, o0, 0, 0, 0); o1 = __builtin_amdgcn_mfma_f32_32x32x16_bf16(__builtin_bit_cast(bf16x8, pw_), v1_, o1, 0, 0, 0);
                    __builtin_amdgcn_sched_barrier(0); }
                lsum = fadd_s(lsum, fadd_s(fadd_s(sa_[0], sa_[1]), fadd_s(sa_[2], sa_[3])));
            }
            ks = ks1; vs ^= 1;
            ATT_WAIT_BAR();
        }
    }
    const float lt = xhalf_sum(lsum);
    if (__any(!(lt > 1.0e-30f && lt < 1.0e30f))) bailed = true;
    if (bailed && lane == 0) bailw[0] = 1;
    if (hi == 0) wsf[32 + r32] = lt;
    asm volatile("s_waitcnt lgkmcnt(0)" ::: "memory");
    write_o(A, o0, o1, wsf, shm, wid, lane, r32, hi, rowbase + q0 + wid * 32, h * 64);
    asm volatile("s_waitcnt lgkmcnt(0)\n\ts_barrier" ::: "memory");
    const int redo = __builtin_amdgcn_readfirstlane(bailw[0]);
    asm volatile("s_waitcnt lgkmcnt(0)\n\ts_barrier" ::: "memory");
    return redo != 0;
#undef MF_ISSUE_K
#undef MF_ISSUE_V
#undef MF_ROWMAX
}
typedef int v8i __attribute__((ext_vector_type(8)));
__device__ __forceinline__ void mfma8_new(f32x16& d, const v8i& ka, const v8i& qb, const f32x16& c, int sa, int sb) {
    asm volatile("v_mfma_scale_f32_32x32x64_f8f6f4 %0, %1, %2, %3, %4, %5 op_sel_hi:[0,0,0]" : "=&v"(d) : "v"(ka), "v"(qb), "v"(c), "v"(sa), "v"(sb)); }
__device__ __forceinline__ void mfma8_acc(f32x16& d, const v8i& ka, const v8i& qb, int sa, int sb) {
    asm volatile("v_mfma_scale_f32_32x32x64_f8f6f4 %0, %1, %2, %0, %3, %4 op_sel_hi:[0,0,0]" : "+v"(d) : "v"(ka), "v"(qb), "v"(sa), "v"(sb)); }
__device__ __forceinline__ bool mla_unit_fast8(const Args& A, int b, int h, int qb, ALAS char* shm, const int tidb) {
    constexpr int KSLOT = 8192;
    constexpr float THR = 8.0f;
    int tid_l; asm volatile("v_mbcnt_lo_u32_b32 %0, -1, 0\n\tv_mbcnt_hi_u32_b32 %0, -1, %0" : "=v"(tid_l)); tid_l += tidb;
    const int tid = tid_l, lane = tid & 63, r32 = lane & 31, hi = lane >> 5;
    const int wid = __builtin_amdgcn_readfirstlane(tid >> 6);
    const long rowbase = (long)b * SEQ; const int q0 = qb * 256;
    const unsigned lds0 = (unsigned)(size_t)shm;
    ALAS float* wsf = (ALAS float*)(shm + L_WS) + wid * 64;
    ALAS int* bailw = (ALAS int*)(shm + L_BIAS);
    const int m_ = wid >> 2, kh_ = (wid >> 1) & 1, j_ = wid & 1;
    const long krow_ = rowbase + 32 * kh_ + r32;
    const unsigned char* ks8 = m_ == 0 ? A.KN8 + krow_ * 512 + h * 64 + 32 * hi + 16 * j_ : (hi == 0 ? A.KR8 + krow_ * 32 + 16 * j_ : A.ZERO + r32 * 16);
    const long kst8 = m_ == 0 ? 64 * 512 : (hi == 0 ? 64 * 32 : 0);
    const bf16* vsrc = A.V + (rowbase + 16 * (wid & 3) + (lane >> 2)) * 512 + h * 64 + (wid >> 2) * 32 + (lane & 3) * 8;
    const unsigned kdst = lds0 + L_K + wid * 1024, vdst = lds0 + L_V + wid * 1024;
#define MF_ISSUE_K(t, s) glds16(ks8 + (long)(t) * kst8, (unsigned)__builtin_amdgcn_readfirstlane(kdst + (s) * KSLOT))
#define MF_ISSUE_V(t, s) glds16(vsrc + (long)(t) * 64 * 512, (unsigned)__builtin_amdgcn_readfirstlane(vdst + (s) * VSLOT))
    const int t_end = 4 * qb + 4;
    const int cw = 4 * qb + (wid >> 1);
    if (tid == 0) bailw[0] = 0;
    MF_ISSUE_K(0, 0); MF_ISSUE_V(0, 0); MF_ISSUE_K(1, 1);
    const unsigned char* Q8w = A.Q8 + (rowbase + q0 + wid * 32 + r32) * 768 + h * 96;
    const unsigned char* Q8r = hi == 0 ? Q8w + 64 : A.ZERO;
    v8i qf0, qf1;
    { const u32x4 a0 = *(const u32x4*)(Q8w + 32 * hi), a1 = *(const u32x4*)(Q8w + 32 * hi + 16), b0 = *(const u32x4*)(Q8r), b1 = *(const u32x4*)(Q8r + 16);
      qf0 = (v8i){(int)a0.x, (int)a0.y, (int)a0.z, (int)a0.w, (int)a1.x, (int)a1.y, (int)a1.z, (int)a1.w}; qf1 = (v8i){(int)b0.x, (int)b0.y, (int)b0.z, (int)b0.w, (int)b1.x, (int)b1.y, (int)b1.z, (int)b1.w}; }
    const int sa8 = 0x7c7c7c7c, sb8 = 0x7b7b7b7b;
    float lsum = 0.f; f32x16 o0 = {}, o1 = {};
    const int vbo = ((lane >> 4) & 1) * 32 + (lane & 3) * 8 + (4 * hi + ((lane & 15) >> 2)) * 64;
    ALAS const char* Kfr = shm + L_K + lane * 16;
#define M8_KFRAG(dst, base, m, kh) do { const u32x4 lo_ = *(ALAS const u32x4*)((base) + (((m) * 2 + (kh)) * 2) * 1024), hi_ = *(ALAS const u32x4*)((base) + (((m) * 2 + (kh)) * 2 + 1) * 1024); \
        dst = (v8i){(int)lo_.x, (int)lo_.y, (int)lo_.z, (int)lo_.w, (int)hi_.x, (int)hi_.y, (int)hi_.z, (int)hi_.w}; } while (0)
#define MF_ROWMAX(C0, C1) ({ float rmp_[4]; _Pragma("unroll") for (int j = 0; j < 4; ++j) { rmp_[j] = max3f(C0[j], C1[j], C0[4 + j]); rmp_[j] = max3f(rmp_[j], C1[4 + j], C0[8 + j]); rmp_[j] = max3f(rmp_[j], C1[8 + j], C0[12 + j]); rmp_[j] = max2f(rmp_[j], C1[12 + j]); } \
        xhalf_max(max2f(max3f(rmp_[0], rmp_[1], rmp_[2]), rmp_[3])); })
    ATT_WAIT_BAR();
    f32x16 cs[2][2];
    { f32x16 z0 = {}, z1 = {}; ALAS const char* Ks_ = Kfr;
      v8i k00, k01, k10, k11; M8_KFRAG(k00, Ks_, 0, 0); M8_KFRAG(k01, Ks_, 0, 1); M8_KFRAG(k10, Ks_, 1, 0); M8_KFRAG(k11, Ks_, 1, 1);
      mfma8_acc(z0, k00, qf0, sa8, sb8); mfma8_acc(z1, k01, qf0, sa8, sb8); mfma8_acc(z0, k10, qf1, sa8, sb8); mfma8_acc(z1, k11, qf1, sa8, sb8);
      asm volatile("s_nop 15\n\ts_nop 7" : "+v"(z0), "+v"(z1));
      cs[0][0] = z0; cs[0][1] = z1; }
    const float mhat = MF_ROWMAX(cs[0][0], cs[0][1]);
#pragma unroll
    for (int r = 0; r < 16; ++r) { cs[0][0][r] -= mhat; cs[0][1][r] -= mhat; }
    f32x16 negm;
#pragma unroll
    for (int r = 0; r < 16; ++r) negm[r] = -mhat;
    bool bailed = false; int ks = 0, vs = 0;
    for (int t2 = 0; t2 < t_end; t2 += 2) {
#pragma unroll
        for (int p = 0; p < 2; ++p) {
            const int t = t2 + p; f32x16 &C0 = cs[p][0], &C1 = cs[p][1], &N0 = cs[p ^ 1][0], &N1 = cs[p ^ 1][1];
            const bool vis = !bailed && t <= cw;
            const int ks1 = ks == 2 ? 0 : ks + 1, ks2 = ks1 == 2 ? 0 : ks1 + 1;
            if (t + 2 < t_end) MF_ISSUE_K(t + 2, ks2);
            if (t + 1 < t_end) MF_ISSUE_V(t + 1, vs ^ 1);
            if (vis) {
                {
                    ALAS const char* Ks_ = Kfr + ks1 * KSLOT;
                    v8i kfa, kfb; M8_KFRAG(kfa, Ks_, 0, 0);
                    M8_KFRAG(kfb, Ks_, 0, 1);
                    mfma8_new(N0, kfa, qf0, negm, sa8, sb8);
#pragma unroll
                    for (int e = 0; e < 8; ++e) C0[e] = __builtin_amdgcn_exp2f(C0[e]);
                    __builtin_amdgcn_sched_barrier(0);
                    M8_KFRAG(kfa, Ks_, 1, 0);
                    mfma8_new(N1, kfb, qf0, negm, sa8, sb8);
#pragma unroll
                    for (int e = 8; e < 16; ++e) C0[e] = __builtin_amdgcn_exp2f(C0[e]);
                    __builtin_amdgcn_sched_barrier(0);
                    M8_KFRAG(kfb, Ks_, 1, 1);
                    mfma8_acc(N0, kfa, qf1, sa8, sb8);
#pragma unroll
                    for (int e = 0; e < 8; ++e) C1[e] = __builtin_amdgcn_exp2f(C1[e]);
                    __builtin_amdgcn_sched_barrier(0);
                    mfma8_acc(N1, kfb, qf1, sa8, sb8);
#pragma unroll
                    for (int e = 8; e < 16; ++e) C1[e] = __builtin_amdgcn_exp2f(C1[e]);
                    __builtin_amdgcn_sched_barrier(0);
                }
                ALAS const char* vb_ = shm + L_V + vs * VSLOT + vbo; s16x4 vl_[8], vh_[8];
#pragma unroll
                for (int kk = 0; kk < 4; ++kk) { vl_[kk] = vtr(vb_ + kk * 1024); vh_[kk] = vtr(vb_ + kk * 1024 + 512); vl_[4 + kk] = vtr(vb_ + 4096 + kk * 1024); vh_[4 + kk] = vtr(vb_ + 4096 + kk * 1024 + 512); }
                float sa_[4];
#pragma unroll
                for (int kk = 0; kk < 4; ++kk) { const f32x16& cc_ = (kk < 2) ? C0 : C1; const int k8_ = 8 * (kk & 1);
                    const u32x4 pw_ = (u32x4){cvtpk(cc_[k8_], cc_[k8_ + 1]), cvtpk(cc_[k8_ + 2], cc_[k8_ + 3]), cvtpk(cc_[k8_ + 4], cc_[k8_ + 5]), cvtpk(cc_[k8_ + 6], cc_[k8_ + 7])};
                    sa_[kk] = fadd_s(fadd_s(fadd_s(cc_[k8_], cc_[k8_ + 1]), fadd_s(cc_[k8_ + 2], cc_[k8_ + 3])), fadd_s(fadd_s(cc_[k8_ + 4], cc_[k8_ + 5]), fadd_s(cc_[k8_ + 6], cc_[k8_ + 7])));
                    const bf16x8 v0_ = (bf16x8){vl_[kk][0], vl_[kk][1], vl_[kk][2], vl_[kk][3], vh_[kk][0], vh_[kk][1], vh_[kk][2], vh_[kk][3]}, v1_ = (bf16x8){vl_[4 + kk][0], vl_[4 + kk][1], vl_[4 + kk][2], vl_[4 + kk][3], vh_[4 + kk][0], vh_[4 + kk][1], vh_[4 + kk][2], vh_[4 + kk][3]};
                    o0 = __builtin_amdgcn_mfma_f32_32x32x16_bf16(__builtin_bit_cast(bf16x8, pw_), v0_, o0, 0, 0, 0); o1 = __builtin_amdgcn_mfma_f32_32x32x16_bf16(__builtin_bit_cast(bf16x8, pw_), v1_, o1, 0, 0, 0);
                    __builtin_amdgcn_sched_barrier(0); }
                lsum = fadd_s(lsum, fadd_s(fadd_s(sa_[0], sa_[1]), fadd_s(sa_[2], sa_[3])));
            }
            ks = ks1; vs ^= 1;
            ATT_WAIT_BAR();
        }
    }
    const float lt = xhalf_sum(lsum);
    if (__any(!(lt > 1.0e-30f && lt < 1.0e30f))) bailed = true;
    if (bailed && lane == 0) bailw[0] = 1;
    if (hi == 0) wsf[32 + r32] = lt;
    asm volatile("s_waitcnt lgkmcnt(0)" ::: "memory");
    write_o(A, o0, o1, wsf, shm, wid, lane, r32, hi, rowbase + q0 + wid * 32, h * 64);
    asm volatile("s_waitcnt lgkmcnt(0)\n\ts_barrier" ::: "memory");
    const int redo = __builtin_amdgcn_readfirstlane(bailw[0]);
    asm volatile("s_waitcnt lgkmcnt(0)\n\ts_barrier" ::: "memory");
    return redo != 0;
#undef MF_ISSUE_K
#undef MF_ISSUE_V
#undef MF_ROWMAX
#undef M8_KFRAG
}
__device__ __forceinline__ void mfma8p_acc(f32x16& d, const v8i& p, const v8i& v, int sp, int sv) {
    asm volatile("v_mfma_scale_f32_32x32x64_f8f6f4 %0, %1, %2, %0, %3, %4 op_sel_hi:[0,0,0] cbsz:1" : "+v"(d) : "v"(p), "v"(v), "v"(sp), "v"(sv)); }
__device__ __forceinline__ bool mla_unit_fast88(const Args& A, int b, int h, int qb, ALAS char* shm, const int tidb) {
    constexpr int KSLOT = 8192;
    constexpr float THR = 8.0f;
    int tid_l; asm volatile("v_mbcnt_lo_u32_b32 %0, -1, 0\n\tv_mbcnt_hi_u32_b32 %0, -1, %0" : "=v"(tid_l)); tid_l += tidb;
    const int tid = tid_l, lane = tid & 63, r32 = lane & 31, hi = lane >> 5;
    const int wid = __builtin_amdgcn_readfirstlane(tid >> 6);
    const long rowbase = (long)b * SEQ; const int q0 = qb * 256;
    const unsigned lds0 = (unsigned)(size_t)shm;
    ALAS float* wsf = (ALAS float*)(shm + L_WS) + wid * 64;
    ALAS int* bailw = (ALAS int*)(shm + L_BIAS);
    const int m_ = wid >> 2, kh_ = (wid >> 1) & 1, j_ = wid & 1;
    const long krow_ = rowbase + 32 * kh_ + r32;
    const unsigned char* ks8 = m_ == 0 ? A.KN8 + krow_ * 512 + h * 64 + 32 * hi + 16 * j_ : (hi == 0 ? A.KR8 + krow_ * 32 + 16 * j_ : A.ZERO + r32 * 16);
    const long kst8 = m_ == 0 ? 64 * 512 : (hi == 0 ? 64 * 32 : 0);
    const unsigned char* vs8 = A.V8T + (((long)(b * 8 + h) * 128) * 64 + 32 * ((wid >> 1) & 1) + r32) * 64 + 32 * hi + 16 * (wid & 1);
    const unsigned kdst = lds0 + L_K + wid * 1024, vdst = lds0 + L_V + wid * 1024;
#define MF_ISSUE_K(t, s) glds16(ks8 + (long)(t) * kst8, (unsigned)__builtin_amdgcn_readfirstlane(kdst + (s) * KSLOT))
#define MF_ISSUE_V(t, s) do { if (wid < 4) glds16(vs8 + (long)(t) * 4096, (unsigned)__builtin_amdgcn_readfirstlane(vdst + (s) * 4096)); } while (0)
    const int t_end = 4 * qb + 4;
    const int cw = 4 * qb + (wid >> 1);
    if (tid == 0) bailw[0] = 0;
    MF_ISSUE_K(0, 0); MF_ISSUE_V(0, 0); MF_ISSUE_K(1, 1);
    const unsigned char* Q8w = A.Q8 + (rowbase + q0 + wid * 32 + r32) * 768 + h * 96;
    const unsigned char* Q8r = hi == 0 ? Q8w + 64 : A.ZERO;
    v8i qf0, qf1;
    { const u32x4 a0 = *(const u32x4*)(Q8w + 32 * hi), a1 = *(const u32x4*)(Q8w + 32 * hi + 16), b0 = *(const u32x4*)(Q8r), b1 = *(const u32x4*)(Q8r + 16);
      qf0 = (v8i){(int)a0.x, (int)a0.y, (int)a0.z, (int)a0.w, (int)a1.x, (int)a1.y, (int)a1.z, (int)a1.w}; qf1 = (v8i){(int)b0.x, (int)b0.y, (int)b0.z, (int)b0.w, (int)b1.x, (int)b1.y, (int)b1.z, (int)b1.w}; }
    const int sa8 = 0x7c7c7c7c, sb8 = 0x7b7b7b7b;
    f32x16 o0 = {}, o1 = {}, ls = {};
    const v8i ones8 = {0x38383838, 0x38383838, 0x38383838, 0x38383838, 0x38383838, 0x38383838, 0x38383838, 0x38383838};
    const int vbo = ((lane >> 4) & 1) * 32 + (lane & 3) * 8 + (4 * hi + ((lane & 15) >> 2)) * 64;
    ALAS const char* Kfr = shm + L_K + lane * 16;
#define M8_KFRAG(dst, base, m, kh) do { const u32x4 lo_ = *(ALAS const u32x4*)((base) + (((m) * 2 + (kh)) * 2) * 1024), hi_ = *(ALAS const u32x4*)((base) + (((m) * 2 + (kh)) * 2 + 1) * 1024); \
        dst = (v8i){(int)lo_.x, (int)lo_.y, (int)lo_.z, (int)lo_.w, (int)hi_.x, (int)hi_.y, (int)hi_.z, (int)hi_.w}; } while (0)
#define MF_ROWMAX(C0, C1) ({ float rmp_[4]; _Pragma("unroll") for (int j = 0; j < 4; ++j) { rmp_[j] = max3f(C0[j], C1[j], C0[4 + j]); rmp_[j] = max3f(rmp_[j], C1[4 + j], C0[8 + j]); rmp_[j] = max3f(rmp_[j], C1[8 + j], C0[12 + j]); rmp_[j] = max2f(rmp_[j], C1[12 + j]); } \
        xhalf_max(max2f(max3f(rmp_[0], rmp_[1], rmp_[2]), rmp_[3])); })
    ATT_WAIT_BAR();
    f32x16 cs[2][2];
    { f32x16 z0 = {}, z1 = {}; ALAS const char* Ks_ = Kfr;
      v8i k00, k01, k10, k11; M8_KFRAG(k00, Ks_, 0, 0); M8_KFRAG(k01, Ks_, 0, 1); M8_KFRAG(k10, Ks_, 1, 0); M8_KFRAG(k11, Ks_, 1, 1);
      mfma8_acc(z0, k00, qf0, sa8, sb8); mfma8_acc(z1, k01, qf0, sa8, sb8); mfma8_acc(z0, k10, qf1, sa8, sb8); mfma8_acc(z1, k11, qf1, sa8, sb8);
      asm volatile("s_nop 15\n\ts_nop 7" : "+v"(z0), "+v"(z1));
      cs[0][0] = z0; cs[0][1] = z1; }
    const float mhat = MF_ROWMAX(cs[0][0], cs[0][1]);
#pragma unroll
    for (int r = 0; r < 16; ++r) { cs[0][0][r] -= mhat; cs[0][1][r] -= mhat; }
    f32x16 negm;
#pragma unroll
    for (int r = 0; r < 16; ++r) negm[r] = -mhat;
    bool bailed = false; int ks = 0, vs = 0;
    for (int t2 = 0; t2 < t_end; t2 += 2) {
#pragma unroll
        for (int p = 0; p < 2; ++p) {
            const int t = t2 + p; f32x16 &C0 = cs[p][0], &C1 = cs[p][1], &N0 = cs[p ^ 1][0], &N1 = cs[p ^ 1][1];
            const bool vis = !bailed && t <= cw;
            const int ks1 = ks == 2 ? 0 : ks + 1, ks2 = ks1 == 2 ? 0 : ks1 + 1;
            if (t + 2 < t_end) MF_ISSUE_K(t + 2, ks2);
            if (t + 1 < t_end) MF_ISSUE_V(t + 1, vs ^ 1);
            if (vis) {
                {
                    ALAS const char* Ks_ = Kfr + ks1 * KSLOT;
                    v8i kfa, kfb; M8_KFRAG(kfa, Ks_, 0, 0);
                    M8_KFRAG(kfb, Ks_, 0, 1);
                    mfma8_new(N0, kfa, qf0, negm, sa8, sb8);
#pragma unroll
                    for (int e = 0; e < 8; ++e) C0[e] = __builtin_amdgcn_exp2f(C0[e]);
                    __builtin_amdgcn_sched_barrier(0);
                    M8_KFRAG(kfa, Ks_, 1, 0);
                    mfma8_new(N1, kfb, qf0, negm, sa8, sb8);
#pragma unroll
                    for (int e = 8; e < 16; ++e) C0[e] = __builtin_amdgcn_exp2f(C0[e]);
                    __builtin_amdgcn_sched_barrier(0);
                    M8_KFRAG(kfb, Ks_, 1, 1);
                    mfma8_acc(N0, kfa, qf1, sa8, sb8);
#pragma unroll
                    for (int e = 0; e < 8; ++e) C1[e] = __builtin_amdgcn_exp2f(C1[e]);
                    __builtin_amdgcn_sched_barrier(0);
                    mfma8_acc(N1, kfb, qf1, sa8, sb8);
#pragma unroll
                    for (int e = 8; e < 16; ++e) C1[e] = __builtin_amdgcn_exp2f(C1[e]);
                    __builtin_amdgcn_sched_barrier(0);
                }
                ALAS const char* vb_ = shm + L_V + vs * 4096 + lane * 16;
                v8i vf0, vf1;
                { const u32x4 a0 = *(ALAS const u32x4*)(vb_), a1 = *(ALAS const u32x4*)(vb_ + 1024), b0 = *(ALAS const u32x4*)(vb_ + 2048), b1 = *(ALAS const u32x4*)(vb_ + 3072);
                  vf0 = (v8i){(int)a0.x, (int)a0.y, (int)a0.z, (int)a0.w, (int)a1.x, (int)a1.y, (int)a1.z, (int)a1.w}; vf1 = (v8i){(int)b0.x, (int)b0.y, (int)b0.z, (int)b0.w, (int)b1.x, (int)b1.y, (int)b1.z, (int)b1.w}; }
                v8i pf;
#pragma unroll
                for (int kk = 0; kk < 4; ++kk) { const f32x16& cc_ = (kk < 2) ? C0 : C1; const int k8_ = 8 * (kk & 1);
                    int w0_ = 0, w1_ = 0;
                    w0_ = __builtin_amdgcn_cvt_pk_bf8_f32(cc_[k8_], cc_[k8_ + 1], w0_, false); w0_ = __builtin_amdgcn_cvt_pk_bf8_f32(cc_[k8_ + 2], cc_[k8_ + 3], w0_, true);
                    w1_ = __builtin_amdgcn_cvt_pk_bf8_f32(cc_[k8_ + 4], cc_[k8_ + 5], w1_, false); w1_ = __builtin_amdgcn_cvt_pk_bf8_f32(cc_[k8_ + 6], cc_[k8_ + 7], w1_, true);
                    pf[2 * kk] = w0_; pf[2 * kk + 1] = w1_; }
                __builtin_amdgcn_sched_barrier(0);
                mfma8p_acc(o0, pf, vf0, 0x7f7f7f7f, 0x7c7c7c7c);
                mfma8p_acc(o1, pf, vf1, 0x7f7f7f7f, 0x7c7c7c7c);
                mfma8p_acc(ls, pf, ones8, 0x7f7f7f7f, 0x7f7f7f7f);
                __builtin_amdgcn_sched_barrier(0);
            }
            ks = ks1; vs ^= 1;
            ATT_WAIT_BAR();
        }
    }
    asm volatile("s_nop 15\n\ts_nop 15" : "+v"(o0), "+v"(o1), "+v"(ls));
    { bool bad_ = false;
#pragma unroll
      for (int r = 0; r < 16; ++r) bad_ |= !(ls[r] > 1.0e-30f && ls[r] < 5.0e4f);
      if (__any(bad_)) bailed = true; }
    if (bailed && lane == 0) bailw[0] = 1;
    if (r32 == 0) {
#pragma unroll
        for (int r = 0; r < 16; ++r) wsf[32 + crow(r, hi)] = ls[r]; }
    asm volatile("s_waitcnt lgkmcnt(0)" ::: "memory");
    write_o(A, o0, o1, wsf, shm, wid, lane, r32, hi, rowbase + q0 + wid * 32, h * 64);
    asm volatile("s_waitcnt lgkmcnt(0)\n\ts_barrier" ::: "memory");
    const int redo = __builtin_amdgcn_readfirstlane(bailw[0]);
    asm volatile("s_waitcnt lgkmcnt(0)\n\ts_barrier" ::: "memory");
    return redo != 0;
#undef MF_ISSUE_K
#undef MF_ISSUE_V
#undef MF_ROWMAX
#undef M8_KFRAG
}
__device__ __forceinline__ bool chunk_unit_fast(const Args& A, int b, int h, int qb, ALAS char* shm, const int tidb) {
    constexpr int NDK = 4, KSLOT = NDK * 2048;
    constexpr float THR = 8.0f;
    int tid_l; asm volatile("v_mbcnt_lo_u32_b32 %0, -1, 0\n\tv_mbcnt_hi_u32_b32 %0, -1, %0" : "=v"(tid_l)); tid_l += tidb;
    const int tid = tid_l, lane = tid & 63, r32 = lane & 31, hi = lane >> 5;
    const int wid = __builtin_amdgcn_readfirstlane(tid >> 6);
    const long rowbase = (long)b * SEQ; const int q0 = qb * 256;
    const unsigned lds0 = (unsigned)(size_t)shm;
    ALAS float* wsf = (ALAS float*)(shm + L_WS) + wid * 64;
    ALAS float* bt = (ALAS float*)(shm + L_BIAS);
    ALAS int* bailw = (ALAS int*)(shm + L_BIAS) + 300;
    const bf16* ksrc = A.KB + (rowbase + lane) * 512 + h * 64 + wid * 8;
    const bf16* vsrc = A.VB + (rowbase + 16 * (wid & 3) + (lane >> 2)) * 512 + h * 64 + (wid >> 2) * 32 + (lane & 3) * 8;
    const unsigned kdst = lds0 + L_K + wid * 1024, vdst = lds0 + L_V + wid * 1024;
#define CF_ISSUE_K(t, s) glds16(ksrc + (long)(t) * 64 * 512, (unsigned)__builtin_amdgcn_readfirstlane(kdst + (s) * KSLOT))
#define CF_ISSUE_V(t, s) glds16(vsrc + (long)(t) * 64 * 512, (unsigned)__builtin_amdgcn_readfirstlane(vdst + (s) * VSLOT))
    const int t_end = 4 * qb + 4, t_begin = 4 * qb - 8 > 0 ? 4 * qb - 8 : 0;
    const int cw = 4 * qb + (wid >> 1);
    const int vis_lo = cw - 8 > 0 ? cw - 8 : 0;
    if (tid == 0) bailw[0] = 0;
    if (tid < 257) bt[tid] = (A.bias[h * 257 + tid] - A.bias[h * 257 + 256]) * LOG2E;
    CF_ISSUE_K(t_begin, 0); CF_ISSUE_V(t_begin, 0); CF_ISSUE_K(t_begin + 1, 1);
    const bf16* Qw = A.QB + (rowbase + q0 + wid * 32 + r32) * 512 + h * 64 + hi * 8;
    bf16x8 qr[NDK];
#pragma unroll
    for (int d0 = 0; d0 < NDK; ++d0) qr[d0] = *(const bf16x8*)(Qw + d0 * 16);
    float lsum = 0.f; f32x16 o0 = {}, o1 = {};
    const int vbo = ((lane >> 4) & 1) * 32 + (lane & 3) * 8 + (4 * hi + ((lane & 15) >> 2)) * 64;
    ALAS const char* Kfr = shm + L_K + hi * 1024 + r32 * 16;
#define CF_ROWMAX(C0, C1) ({ float rmp_[4]; _Pragma("unroll") for (int j = 0; j < 4; ++j) { rmp_[j] = max3f(C0[j], C1[j], C0[4 + j]); rmp_[j] = max3f(rmp_[j], C1[4 + j], C0[8 + j]); rmp_[j] = max3f(rmp_[j], C1[8 + j], C0[12 + j]); rmp_[j] = max2f(rmp_[j], C1[12 + j]); } \
        xhalf_max(max2f(max3f(rmp_[0], rmp_[1], rmp_[2]), rmp_[3])); })
#define CF_BIAS(C0, C1, tt) do { const int dq_ = 64 * (cw - (tt)) + 32 * (wid & 1) + r32 + 128; \
        _Pragma("unroll") for (int r = 0; r < 16; ++r) { int i0 = dq_ - crow(r, hi), i1 = i0 - 32; i0 = i0 < 0 ? 0 : (i0 > 256 ? 256 : i0); i1 = i1 < 0 ? 0 : (i1 > 256 ? 256 : i1); C0[r] += bt[i0]; C1[r] += bt[i1]; } } while (0)
    f32x16 cs[2][2], negm;
    ATT_WAIT_BAR();
    { f32x16 z0 = {}, z1 = {};
#pragma unroll
      for (int d0 = 0; d0 < NDK; ++d0) { const bf16x8 a0 = *(ALAS const bf16x8*)(Kfr + d0 * 2048), a1 = *(ALAS const bf16x8*)(Kfr + d0 * 2048 + 512);
          z0 = __builtin_amdgcn_mfma_f32_32x32x16_bf16(a0, qr[d0], z0, 0, 0, 0); z1 = __builtin_amdgcn_mfma_f32_32x32x16_bf16(a1, qr[d0], z1, 0, 0, 0); }
      asm volatile("s_nop 15\n\ts_nop 7" : "+v"(z0), "+v"(z1));
      if (vis_lo == t_begin && t_begin >= cw - 2) CF_BIAS(z0, z1, t_begin);
      const float mhat = CF_ROWMAX(z0, z1);
#pragma unroll
      for (int r = 0; r < 16; ++r) { z0[r] -= mhat; z1[r] -= mhat; negm[r] = -mhat; }
      cs[0][0] = z0; cs[0][1] = z1; cs[1][0] = z0; cs[1][1] = z1; }
    bool bailed = false; int ks = 0, vs = 0;
    for (int t2 = t_begin; t2 < t_end; t2 += 2) {
#pragma unroll
        for (int p = 0; p < 2; ++p) {
            const int t = t2 + p; f32x16 &C0 = cs[p][0], &C1 = cs[p][1], &N0 = cs[p ^ 1][0], &N1 = cs[p ^ 1][1];
            if (t >= vis_lo && t > t_begin && t <= cw) { if (t >= cw - 2) CF_BIAS(C0, C1, t); }
            const bool vis = !bailed && t >= vis_lo && t <= cw;
            const int ks1 = ks == 2 ? 0 : ks + 1, ks2 = ks1 == 2 ? 0 : ks1 + 1;
            if (t + 2 < t_end) CF_ISSUE_K(t + 2, ks2);
            if (t + 1 < t_end) CF_ISSUE_V(t + 1, vs ^ 1);
            if (vis) {
                {
                    ALAS const char* Ks_ = Kfr + ks1 * KSLOT;
                    bf16x8 ka = *(ALAS const bf16x8*)(Ks_), kb = *(ALAS const bf16x8*)(Ks_ + 512);
                    constexpr int NM = 2 * NDK;
#pragma unroll
                    for (int d0 = 0; d0 < NDK; ++d0) {
                        bf16x8 na = ka, nb = kb;
                        if (d0 + 1 < NDK) { na = *(ALAS const bf16x8*)(Ks_ + (d0 + 1) * 2048); nb = *(ALAS const bf16x8*)(Ks_ + (d0 + 1) * 2048 + 512); }
                        N0 = __builtin_amdgcn_mfma_f32_32x32x16_bf16(ka, qr[d0], d0 == 0 ? negm : N0, 0, 0, 0);
#pragma unroll
                        for (int e = 0; e < 32; ++e) if (e * NM / 32 == 2 * d0) { if (e < 16) C0[e] = __builtin_amdgcn_exp2f(C0[e]); else C1[e - 16] = __builtin_amdgcn_exp2f(C1[e - 16]); }
                        __builtin_amdgcn_sched_barrier(0);
                        N1 = __builtin_amdgcn_mfma_f32_32x32x16_bf16(kb, qr[d0], d0 == 0 ? negm : N1, 0, 0, 0);
#pragma unroll
                        for (int e = 0; e < 32; ++e) if (e * NM / 32 == 2 * d0 + 1) { if (e < 16) C0[e] = __builtin_amdgcn_exp2f(C0[e]); else C1[e - 16] = __builtin_amdgcn_exp2f(C1[e - 16]); }
                        __builtin_amdgcn_sched_barrier(0);
                        ka = na; kb = nb;
                    }
                }
                ALAS const char* vb_ = shm + L_V + vs * VSLOT + vbo; s16x4 vl_[8], vh_[8];
#pragma unroll
                for (int kk = 0; kk < 4; ++kk) { vl_[kk] = vtr(vb_ + kk * 1024); vh_[kk] = vtr(vb_ + kk * 1024 + 512); vl_[4 + kk] = vtr(vb_ + 4096 + kk * 1024); vh_[4 + kk] = vtr(vb_ + 4096 + kk * 1024 + 512); }
                float sa_[4];
#pragma unroll
                for (int kk = 0; kk < 4; ++kk) { const f32x16& cc_ = (kk < 2) ? C0 : C1; const int k8_ = 8 * (kk & 1);
                    const u32x4 pw_ = (u32x4){cvtpk(cc_[k8_], cc_[k8_ + 1]), cvtpk(cc_[k8_ + 2], cc_[k8_ + 3]), cvtpk(cc_[k8_ + 4], cc_[k8_ + 5]), cvtpk(cc_[k8_ + 6], cc_[k8_ + 7])};
                    sa_[kk] = fadd_s(fadd_s(fadd_s(cc_[k8_], cc_[k8_ + 1]), fadd_s(cc_[k8_ + 2], cc_[k8_ + 3])), fadd_s(fadd_s(cc_[k8_ + 4], cc_[k8_ + 5]), fadd_s(cc_[k8_ + 6], cc_[k8_ + 7])));
                    const bf16x8 v0_ = (bf16x8){vl_[kk][0], vl_[kk][1], vl_[kk][2], vl_[kk][3], vh_[kk][0], vh_[kk][1], vh_[kk][2], vh_[kk][3]}, v1_ = (bf16x8){vl_[4 + kk][0], vl_[4 + kk][1], vl_[4 + kk][2], vl_[4 + kk][3], vh_[4 + kk][0], vh_[4 + kk][1], vh_[4 + kk][2], vh_[4 + kk][3]};
                    o0 = __builtin_amdgcn_mfma_f32_32x32x16_bf16(__builtin_bit_cast(bf16x8, pw_), v0_, o0, 0, 0, 0); o1 = __builtin_amdgcn_mfma_f32_32x32x16_bf16(__builtin_bit_cast(bf16x8, pw_), v1_, o1, 0, 0, 0);
                    __builtin_amdgcn_sched_barrier(0); }
                lsum = fadd_s(lsum, fadd_s(fadd_s(sa_[0], sa_[1]), fadd_s(sa_[2], sa_[3])));
            } else if (!bailed && t + 1 == vis_lo) {
                ALAS const char* Kq_ = Kfr + ks1 * KSLOT;
#pragma unroll
                for (int d0 = 0; d0 < NDK; ++d0) { const bf16x8 a0 = *(ALAS const bf16x8*)(Kq_ + d0 * 2048), a1 = *(ALAS const bf16x8*)(Kq_ + d0 * 2048 + 512);
                    N0 = __builtin_amdgcn_mfma_f32_32x32x16_bf16(a0, qr[d0], d0 == 0 ? negm : N0, 0, 0, 0); N1 = __builtin_amdgcn_mfma_f32_32x32x16_bf16(a1, qr[d0], d0 == 0 ? negm : N1, 0, 0, 0); }
            }
            ks = ks1; vs ^= 1;
            ATT_WAIT_BAR();
        }
    }
    const float lt = xhalf_sum(lsum);
    if (__any(!(lt > 1.0e-30f && lt < 1.0e30f))) bailed = true;
    if (bailed && lane == 0) bailw[0] = 1;
    if (hi == 0) wsf[32 + r32] = lt;
    asm volatile("s_waitcnt lgkmcnt(0)" ::: "memory");
    write_o(A, o0, o1, wsf, shm, wid, lane, r32, hi, rowbase + q0 + wid * 32, 512 + h * 64);
    asm volatile("s_waitcnt lgkmcnt(0)\n\ts_barrier" ::: "memory");
    const int redo = __builtin_amdgcn_readfirstlane(bailw[0]);
    asm volatile("s_waitcnt lgkmcnt(0)\n\ts_barrier" ::: "memory");
    return redo != 0;
#undef CF_ISSUE_K
#undef CF_ISSUE_V
#undef CF_ROWMAX
#undef CF_BIAS
}
template <bool CHUNK>
__device__ __forceinline__ void attn_phase(const Args& A, int vcu, int G, ALAS char* shm, const int tidb) {
    if (G == 256) {
        for (int i = 0; i < 4; ++i) {
            int bh, qb;
            if (CHUNK) { const int u = vcu * 4 + i; bh = u >> 5; qb = u & 31; }
            else { const int s = vcu & 7; bh = vcu >> 3; qb = (i == 0) ? s : (i == 1) ? 15 - s : (i == 2) ? 16 + s : 31 - s; }
            if (CHUNK) { if (chunk_unit_fast(A, bh >> 3, bh & 7, qb, shm, tidb)) attn_unit<CHUNK>(A, bh >> 3, bh & 7, qb, shm, tidb); }
            else if (A.qk8) { if (A.pv8 ? mla_unit_fast88(A, bh >> 3, bh & 7, qb, shm, tidb) : mla_unit_fast8(A, bh >> 3, bh & 7, qb, shm, tidb)) attn_unit8(A, bh >> 3, bh & 7, qb, shm, tidb); }
            else if (mla_unit_fast(A, bh >> 3, bh & 7, qb, shm, tidb)) attn_unit<CHUNK>(A, bh >> 3, bh & 7, qb, shm, tidb);
        }
    } else {
        for (int u = vcu; u < 1024; u += G) { if (!CHUNK && A.qk8) attn_unit8(A, u >> 8, (u >> 5) & 7, u & 31, shm, tidb); else attn_unit<CHUNK>(A, u >> 8, (u >> 5) & 7, u & 31, shm, tidb); }
    }
}

#undef ATT_WAIT_BAR
}
#define GAS __attribute__((address_space(1)))
#define LAS __attribute__((address_space(3)))
typedef unsigned short bf16;
typedef unsigned v4u __attribute__((ext_vector_type(4)));
typedef float f32x4 __attribute__((ext_vector_type(4)));
typedef short bf16x8 __attribute__((ext_vector_type(8)));
typedef GAS unsigned gu32;
typedef GAS unsigned long long gu64;
#define RLX_AGENT __ATOMIC_RELAXED, __HIP_MEMORY_SCOPE_AGENT
#define LDS_WAIT() asm volatile("s_waitcnt lgkmcnt(0)" ::: "memory")
#define VM_WAIT() asm volatile("s_waitcnt vmcnt(0)" ::: "memory")
__device__ __forceinline__ unsigned long long rt() { return __builtin_amdgcn_s_memrealtime(); }
__device__ __forceinline__ unsigned f2bf(float f) { unsigned u = __builtin_bit_cast(unsigned, f); return (u + 0x7fffu + ((u >> 16) & 1u)) >> 16; }
__device__ __forceinline__ unsigned pk2(float lo, float hi) { return f2bf(lo) | (f2bf(hi) << 16); }

#define XB_TMO      128
#define XB_XCNT(j)  (256  + 64 * (j))
#define XB_XSUB(j)  (1280 + 64 * (j))
#define XB_XGEN(j)  (2304 + 64 * (j))
#define XB_TOP      3328
#define XB_TOPGEN   3392
#define XCD_BAR_WORDS 3456
#define XB_SPIN_CAP (1u << 18)

__device__ __forceinline__ unsigned xb_ld(unsigned* p)              { return __hip_atomic_load(p, __ATOMIC_RELAXED, __HIP_MEMORY_SCOPE_AGENT); }
__device__ __forceinline__ unsigned xb_add(unsigned* p, unsigned v) { return __hip_atomic_fetch_add(p, v, __ATOMIC_RELAXED, __HIP_MEMORY_SCOPE_AGENT); }
__device__ __forceinline__ unsigned xb_xcc_id() { return (unsigned)__builtin_amdgcn_s_getreg((3 << 11) | 20) & 0xFu; }
#define XB_SPIN(cond, bar) do { unsigned _sp = 0; while (cond) { __builtin_amdgcn_s_sleep(1); \
    if ((++_sp & 255u) == 0u) { if (xb_ld(&(bar)[XB_TMO])) break; if (_sp > XB_SPIN_CAP) { atomicAdd(&(bar)[XB_TMO], 1u); break; } } } } while (0)

struct XcdBarrier {
    unsigned* bar; unsigned x;
    volatile LAS unsigned* st;
};

__device__ __forceinline__ XcdBarrier xcd_barrier_post(unsigned* bar, volatile LAS unsigned* st, const bool t0  ) {
    XcdBarrier b; b.bar = bar; b.x = xb_xcc_id(); b.st = st;
    if (t0) (void)xb_add(&bar[XB_XCNT(b.x)], 1u);
    return b;
}
__device__ __forceinline__ void xcd_barrier_complete(unsigned* bar, unsigned x, unsigned& nloc, unsigned& nx) {
    const unsigned G = gridDim.x * gridDim.y * gridDim.z;
    unsigned sum, cnt, mine, sp = 0u;
    for (;;) {
        sum = 0u; cnt = 0u; mine = 0u;
#pragma unroll
        for (unsigned j = 0; j < 16; ++j) { const unsigned c = xb_ld(&bar[XB_XCNT(j)]); sum += c; cnt += (c > 0u) ? 1u : 0u; mine = (j == x) ? c : mine; }
        if (sum == G) break;
        __builtin_amdgcn_s_sleep(1);
        if ((++sp & 255u) == 0u) { if (xb_ld(&bar[XB_TMO])) break; if (sp > XB_SPIN_CAP) { atomicAdd(&bar[XB_TMO], 1u); break; } }
    }
    nloc = mine > 0u ? mine : 1u; nx = cnt > 0u ? cnt : 1u;
}

template <bool CENSUS> __device__ __forceinline__ void xcd_barrier(const XcdBarrier& b, const bool t0  ) {
    asm volatile("s_waitcnt vmcnt(0)" ::: "memory");
    __syncthreads();
    if (t0) {
        unsigned* bar = b.bar;
        __builtin_amdgcn_s_waitcnt(0);
        unsigned nloc = b.st[0], nx = b.st[1];
        if (CENSUS) { if (nloc == 0u) { xcd_barrier_complete(bar, b.x, nloc, nx); b.st[0] = nloc; b.st[1] = nx; } }
        const unsigned old = xb_add(&bar[XB_XSUB(b.x)], 1u);
        const unsigned gen = old / nloc;
        if (old + 1u == (gen + 1u) * nloc) {
            __builtin_amdgcn_fence(__ATOMIC_RELEASE, "agent");
            asm volatile("s_waitcnt vmcnt(0)" ::: "memory");
            const unsigned og = xb_add(&bar[XB_TOP], 1u);
            const unsigned tg = og / nx;
            if (og + 1u == (tg + 1u) * nx) xb_add(&bar[XB_TOPGEN], 1u);
            else XB_SPIN(xb_ld(&bar[XB_TOPGEN]) == tg, bar);
            __builtin_amdgcn_fence(__ATOMIC_ACQUIRE, "agent");
            xb_add(&bar[XB_XGEN(b.x)], 1u);
            asm volatile("s_waitcnt vmcnt(0)" ::: "memory");
        } else {
            XB_SPIN(xb_ld(&bar[XB_XGEN(b.x)]) == gen, bar);
            __builtin_amdgcn_fence(__ATOMIC_ACQUIRE, "agent");
            asm volatile("s_waitcnt vmcnt(0)" ::: "memory");
        }
    }
    __syncthreads();
}
static_assert(att::L_END <= RING_BYTES && RSTAB_OFF + 8 * 1024 <= LDS_BYTES, "LDS map");
typedef unsigned v2u __attribute__((ext_vector_type(2)));
typedef int v4i __attribute__((ext_vector_type(4)));
#define SWZ_XOR(x) (((x) << 10) | 0x1F)
__device__ __forceinline__ float wave_sum(float v) {
    v += __int_as_float(__builtin_amdgcn_ds_swizzle(__float_as_int(v), SWZ_XOR(1))); v += __int_as_float(__builtin_amdgcn_ds_swizzle(__float_as_int(v), SWZ_XOR(2)));
    v += __int_as_float(__builtin_amdgcn_ds_swizzle(__float_as_int(v), SWZ_XOR(4))); v += __int_as_float(__builtin_amdgcn_ds_swizzle(__float_as_int(v), SWZ_XOR(8)));
    v += __int_as_float(__builtin_amdgcn_ds_swizzle(__float_as_int(v), SWZ_XOR(16)));
    auto rr = __builtin_amdgcn_permlane32_swap(__float_as_uint(v), __float_as_uint(v), false, false); return __uint_as_float(rr[0]) + __uint_as_float(rr[1]);
}
__device__ __forceinline__ int wave_sum_i(int v) {
    v += __builtin_amdgcn_ds_swizzle(v, SWZ_XOR(1)); v += __builtin_amdgcn_ds_swizzle(v, SWZ_XOR(2)); v += __builtin_amdgcn_ds_swizzle(v, SWZ_XOR(4)); v += __builtin_amdgcn_ds_swizzle(v, SWZ_XOR(8)); v += __builtin_amdgcn_ds_swizzle(v, SWZ_XOR(16));
    auto rr = __builtin_amdgcn_permlane32_swap((unsigned)v, (unsigned)v, false, false); return (int)(rr[0] + rr[1]);
}
enum { TM_ID = 0, TM_IN, TM_UQ, TM_UKV, TM_W1, TM_W3 };
__device__ __forceinline__ int rope_pos(int j) { return j < 16 ? 8 * (j >> 2) + (j & 3) : 8 * ((j - 16) >> 2) + 4 + (j & 3); }
__device__ __forceinline__ int tr_dest_row(int mode, int n0, int n) {
    if (mode == TM_IN) { const int gb = n0 < 672 ? n0 : n0 + 96; return gb + (n0 == 640 ? rope_pos(n) : n); }
    if (mode == TM_UQ) return n0 + ((((n0 >> 5) % 3) == 2) ? rope_pos(n) : n);
    if (mode == TM_UKV) { const int h = n0 >> 7, j0 = n0 & 127; return (j0 < 64 ? h * 64 + j0 : 512 + h * 64 + (j0 - 64)) + n; }
    if (mode == TM_W1) return (n0 >> 7) * 256 + (n0 & 127) + n;
    if (mode == TM_W3) return (n0 >> 7) * 256 + 128 + (n0 & 127) + n;
    return n0 + n;
}
struct TrJob { const float* W; int K, N; bf16* dst; const float* gain; int mode; int f8; };
__device__ __forceinline__ void tr_item(const TrJob& J, int item, LAS float* scr, int lane) {
    const int nblk = J.N / 32, kb = item / nblk, nb = item % nblk, k0 = 64 * kb, n0 = 32 * nb;
    float wv[32];
#pragma unroll
    for (int i = 0; i < 32; ++i) wv[i] = __builtin_nontemporal_load(J.W + (size_t)(k0 + 2 * i + (lane >> 5)) * J.N + n0 + (lane & 31));
#pragma unroll
    for (int i = 0; i < 32; ++i) scr[(2 * i + (lane >> 5)) * 33 + (lane & 31)] = wv[i];
    LDS_WAIT(); asm volatile("" ::: "memory");
    const int c = lane & 7; float g[8];
#pragma unroll
    for (int e = 0; e < 8; ++e) g[e] = J.gain ? J.gain[k0 + 8 * c + e] : 1.f;
#pragma unroll
    for (int j = 0; j < 4; ++j) { const int n = (lane >> 3) + 8 * j; const LAS float* s = scr + (8 * c) * 33 + n;
        if (J.f8) { int w0 = 0, w1 = 0;
            w0 = __builtin_amdgcn_cvt_pk_fp8_f32(s[0 * 33] * g[0] * 64.0f, s[1 * 33] * g[1] * 64.0f, w0, false); w0 = __builtin_amdgcn_cvt_pk_fp8_f32(s[2 * 33] * g[2] * 64.0f, s[3 * 33] * g[3] * 64.0f, w0, true);
            w1 = __builtin_amdgcn_cvt_pk_fp8_f32(s[4 * 33] * g[4] * 64.0f, s[5 * 33] * g[5] * 64.0f, w1, false); w1 = __builtin_amdgcn_cvt_pk_fp8_f32(s[6 * 33] * g[6] * 64.0f, s[7 * 33] * g[7] * 64.0f, w1, true);
            v2u o; o.x = (unsigned)w0; o.y = (unsigned)w1; *(GAS v2u*)((unsigned char*)J.dst + (size_t)tr_dest_row(J.mode, n0, n) * J.K + k0 + 8 * c) = o; }
        else { v4u o; o.x = pk2(s[0 * 33] * g[0], s[1 * 33] * g[1]); o.y = pk2(s[2 * 33] * g[2], s[3 * 33] * g[3]); o.z = pk2(s[4 * 33] * g[4], s[5 * 33] * g[5]); o.w = pk2(s[6 * 33] * g[6], s[7 * 33] * g[7]);
        *(GAS v4u*)(J.dst + (size_t)tr_dest_row(J.mode, n0, n) * J.K + k0 + 8 * c) = o; } }
    LDS_WAIT(); asm volatile("" ::: "memory");
}
__device__ __forceinline__ void tr_run(const TrJob& J, int& base, int gw, int NGW, LAS float* scr, int lane) {
    const int nitems = (J.K / 64) * (J.N / 32);
    int first = gw - (base % NGW); if (first < 0) first += NGW;
    for (int it = first; it < nitems; it += NGW) tr_item(J, it, scr, lane);
    base += nitems;
}
template <bool INIT, bool FINAL>
__device__ __forceinline__ void row_pass(const float* xin, float* xout, bf16* xb, float* ssx, const bf16* Y, const int* pos, const float* gfin, int gw, int NGW, int lane, unsigned char* xq = nullptr  ) {
    constexpr int U = 4;
    for (int t0 = gw; t0 < T_; t0 += U * NGW) {
        f32x4 v[U][4];
        if (INIT) {
#pragma unroll
            for (int u = 0; u < U; ++u) { const int t = t0 + u * NGW; if (t < T_) { const GAS f32x4* xr = (const GAS f32x4*)(xin + (size_t)t * D_) + lane;
#pragma unroll
                for (int j = 0; j < 4; ++j) v[u][j] = xr[64 * j]; } }
        } else {
            int p0[U], p1[U];
#pragma unroll
            for (int u = 0; u < U; ++u) { const int t = t0 + u * NGW; p0[u] = 0; p1[u] = 0; if (t < T_) { p0[u] = pos[2 * t]; p1[u] = pos[2 * t + 1]; } }
            v2u xw[U][4], aw[U][4], bw[U][4];
#pragma unroll
            for (int u = 0; u < U; ++u) { const int t = t0 + u * NGW; if (t < T_) {
                const GAS v2u* x0 = (const GAS v2u*)(xb + (size_t)t * D_) + lane;
                const GAS v2u* y0 = (const GAS v2u*)(Y + (size_t)p0[u] * D_) + lane; const GAS v2u* y1 = (const GAS v2u*)(Y + (size_t)p1[u] * D_) + lane;
#pragma unroll
                for (int j = 0; j < 4; ++j) { xw[u][j] = x0[64 * j]; aw[u][j] = y0[64 * j]; bw[u][j] = y1[64 * j]; } } }
#pragma unroll
            for (int u = 0; u < U; ++u)
#pragma unroll
                for (int j = 0; j < 4; ++j) { const v2u c = xw[u][j], a = aw[u][j], b = bw[u][j];
                    v[u][j].x = __uint_as_float(c.x << 16) + (__uint_as_float(a.x << 16) + __uint_as_float(b.x << 16)); v[u][j].y = __uint_as_float(c.x & 0xffff0000u) + (__uint_as_float(a.x & 0xffff0000u) + __uint_as_float(b.x & 0xffff0000u));
                    v[u][j].z = __uint_as_float(c.y << 16) + (__uint_as_float(a.y << 16) + __uint_as_float(b.y << 16)); v[u][j].w = __uint_as_float(c.y & 0xffff0000u) + (__uint_as_float(a.y & 0xffff0000u) + __uint_as_float(b.y & 0xffff0000u)); }
        }
#pragma unroll
        for (int u = 0; u < U; ++u) { const int t = t0 + u * NGW; if (t < T_) {
            float ss = 0.f;
#pragma unroll
            for (int j = 0; j < 4; ++j) ss += (v[u][j].x * v[u][j].x + v[u][j].y * v[u][j].y) + (v[u][j].z * v[u][j].z + v[u][j].w * v[u][j].w);
            ss = wave_sum(ss);
            if (FINAL) {
                GAS f32x4* xo = (GAS f32x4*)(xout + (size_t)t * D_) + lane;
                const float rs = 1.0f / sqrtf(ss * (1.0f / D_) + EPS_);
#pragma unroll
                for (int j = 0; j < 4; ++j) { const f32x4 g = ((const GAS f32x4*)gfin)[lane + 64 * j]; xo[64 * j] = v[u][j] * rs * g; }
            } else {
                GAS v2u* bo = (GAS v2u*)(xb + (size_t)t * D_) + lane;
#pragma unroll
                for (int j = 0; j < 4; ++j) { v2u w; w.x = pk2(v[u][j].x, v[u][j].y); w.y = pk2(v[u][j].z, v[u][j].w); bo[64 * j] = w; }
                if (xq) { GAS unsigned* qo = (GAS unsigned*)(xq + (size_t)t * D_) + lane;
#pragma unroll
                    for (int j = 0; j < 4; ++j) { int w = 0;
                        w = __builtin_amdgcn_cvt_pk_fp8_f32(__builtin_amdgcn_fmed3f(v[u][j].x * 8.0f, -448.f, 448.f), __builtin_amdgcn_fmed3f(v[u][j].y * 8.0f, -448.f, 448.f), w, false);
                        w = __builtin_amdgcn_cvt_pk_fp8_f32(__builtin_amdgcn_fmed3f(v[u][j].z * 8.0f, -448.f, 448.f), __builtin_amdgcn_fmed3f(v[u][j].w * 8.0f, -448.f, 448.f), w, true); qo[64 * j] = (unsigned)w; } }
                if (lane < 16) ssx[(size_t)t * 16 + lane] = lane == 0 ? ss : 0.f;
            } } }
    }
}
__device__ __forceinline__ void moe_route1(LAS unsigned char* lds, const bf16* x, const float* ssx, const float* wr, const float* g, int* tok_e, float* tok_g, float* tok_rs, int* counts, int bx, int G, int tid, int wave, int lane) {
    LAS float* wrgT = (LAS float*)lds;
    LAS int* hist = (LAS int*)(lds + 32768);
    for (int idx = tid; idx < 8192; idx += 512) { const int k = idx >> 3, e = idx & 7; wrgT[e * 1024 + k] = wr[idx] * g[k]; }
    __syncthreads();
    for (int ch = bx; ch < T_ / 128; ch += G) {
        if (tid < 8) hist[tid] = 0;
        __syncthreads();
        for (int i = 0; i < 16; ++i) {
            const int t = ch * 128 + wave * 16 + i;
            const GAS v2u* xr = (const GAS v2u*)(x + (size_t)t * D_) + lane;
            f32x4 xv[4];
#pragma unroll
            for (int j = 0; j < 4; ++j) { const v2u c = xr[64 * j]; xv[j] = (f32x4){__uint_as_float(c.x << 16), __uint_as_float(c.x & 0xffff0000u), __uint_as_float(c.y << 16), __uint_as_float(c.y & 0xffff0000u)}; }
            float lg[8];
#pragma unroll
            for (int e = 0; e < 8; ++e) { float a = 0.f;
#pragma unroll
                for (int j = 0; j < 4; ++j) { const f32x4 w = *(const LAS f32x4*)(wrgT + e * 1024 + 256 * j + 4 * lane); a += (xv[j].x * w.x + xv[j].y * w.y) + (xv[j].z * w.z + xv[j].w * w.w); }
                lg[e] = wave_sum(a); }
            const float ssp = lane < 16 ? ssx[(size_t)t * 16 + lane] : 0.f;
            const float rs = 1.0f / sqrtf(wave_sum(ssp) * (1.0f / D_) + EPS_);
#pragma unroll
            for (int e = 0; e < 8; ++e) lg[e] *= rs;
            int e0 = 0; float b0 = lg[0];
#pragma unroll
            for (int e = 1; e < 8; ++e) if (lg[e] > b0) { b0 = lg[e]; e0 = e; }
            int e1 = -1; float b1 = -3.0e38f;
#pragma unroll
            for (int e = 0; e < 8; ++e) if (e != e0 && (e1 < 0 || lg[e] > b1)) { b1 = lg[e]; e1 = e; }
            const float g0 = 1.0f / (1.0f + __builtin_amdgcn_exp2f((b1 - b0) * LOG2E_)), g1 = 1.0f - g0;
            if (lane == 0) { tok_e[t] = e0 | (e1 << 8); tok_g[2 * t] = g0; tok_g[2 * t + 1] = g1; tok_rs[t] = rs; atomicAdd((int*)&hist[e0], 1); atomicAdd((int*)&hist[e1], 1); }
        }
        __syncthreads();
        if (tid < 8) counts[ch * 8 + tid] = hist[tid];
        __syncthreads();
    }
}
__device__ __forceinline__ void moe_route2(LAS unsigned char* lds, const bf16* xb, bf16* xs, const int* tok_e, const float* tok_g, const float* tok_rs, const int* counts, int* pos, float* rowg, float* rowrs, int* meta,
                                           int bx, int G, int tid, int wave, int lane, bool f8) {
    LAS int* lcnt = (LAS int*)lds; LAS int* ltot = lcnt + 2048; LAS int* lbef = ltot + 8; LAS int* ldest = lbef + 8;
    for (int ch = bx; ch < T_ / 128; ch += G) {
        { const v4i v = ((const v4i*)counts)[tid]; ((LAS v4i*)lcnt)[tid] = v; }
        __syncthreads();
        { const int e = wave; int tot = 0, bef = 0;
#pragma unroll
          for (int i = 0; i < 4; ++i) { const int c2 = lane + 64 * i; const int v = lcnt[c2 * 8 + e]; tot += v; bef += (c2 < ch) ? v : 0; }
          tot = wave_sum_i(tot); bef = wave_sum_i(bef); if (lane == 0) { ltot[e] = tot; lbef[e] = bef; } }
        __syncthreads();
        int pst[8], pen[8]; { int run = 0;
#pragma unroll
            for (int e = 0; e < 8; ++e) { const int tt = ltot[e]; pst[e] = run; run += (tt + 255) & ~255; pen[e] = run; } }
        if (wave == 0) {
            int runc[8];
#pragma unroll
            for (int e = 0; e < 8; ++e) runc[e] = pst[e] + lbef[e];
#pragma unroll
            for (int half = 0; half < 2; ++half) {
                const int tl = half * 64 + lane, t = ch * 128 + tl; const int ee = tok_e[t]; const int e0 = ee & 255, e1 = ee >> 8;
                int d0 = 0, d1 = 0;
#pragma unroll
                for (int e = 0; e < 8; ++e) { const bool m0 = (e0 == e), m1 = (e1 == e); const unsigned long long mk = __ballot(m0 || m1);
                    const int rank = __popcll(mk & ((1ull << lane) - 1ull)); if (m0) d0 = runc[e] + rank; if (m1) d1 = runc[e] + rank; runc[e] += __popcll(mk); }
                ldest[2 * tl] = d0; ldest[2 * tl + 1] = d1; pos[2 * t] = d0; pos[2 * t + 1] = d1;
                const float g0 = tok_g[2 * t], g1 = tok_g[2 * t + 1], rs = tok_rs[t];
                rowg[d0] = g0; rowg[d1] = g1; rowrs[d0] = rs; rowrs[d1] = rs;
            }
        }
        __syncthreads();
        if (f8) {
            for (int ab = wave; ab < 256; ab += 32) {
              v4u ra0[4], ra1[4]; float rsc[4];
#pragma unroll
              for (int u = 0; u < 4; ++u) { const int a = ab + 8 * u, t = ch * 128 + (a >> 1); rsc[u] = tok_rs[t] * 16.0f; const GAS v4u* s = (const GAS v4u*)(xb + (size_t)t * D_) + 2 * lane; ra0[u] = s[0]; ra1[u] = s[1]; }
#pragma unroll
              for (int u = 0; u < 4; ++u) { const int a = ab + 8 * u; const int d = ldest[a]; const float sc = rsc[u]; const v4u a0 = ra0[u], a1 = ra1[u];
                v4u o;
#define F8PK(w) ({ int r_ = 0; r_ = __builtin_amdgcn_cvt_pk_fp8_f32(__builtin_amdgcn_fmed3f(__uint_as_float((w).x << 16) * sc, -448.f, 448.f), __builtin_amdgcn_fmed3f(__uint_as_float((w).x & 0xffff0000u) * sc, -448.f, 448.f), r_, false); \
                   r_ = __builtin_amdgcn_cvt_pk_fp8_f32(__builtin_amdgcn_fmed3f(__uint_as_float((w).y << 16) * sc, -448.f, 448.f), __builtin_amdgcn_fmed3f(__uint_as_float((w).y & 0xffff0000u) * sc, -448.f, 448.f), r_, true); (unsigned)r_; })
                { v2u p; p.x = a0.x; p.y = a0.y; o.x = F8PK(p); p.x = a0.z; p.y = a0.w; o.y = F8PK(p); p.x = a1.x; p.y = a1.y; o.z = F8PK(p); p.x = a1.z; p.y = a1.w; o.w = F8PK(p); }
#undef F8PK
                *((GAS v4u*)((unsigned char*)xs + (size_t)d * D_) + lane) = o; } }
        } else {
        for (int a = wave; a < 256; a += 8) { const int t = ch * 128 + (a >> 1); const int d = ldest[a];
            const GAS v4u* s = (const GAS v4u*)(xb + (size_t)t * D_) + lane; GAS v4u* o = (GAS v4u*)(xs + (size_t)d * D_) + lane;
            const v4u a0 = s[0], a1 = s[64]; o[0] = a0; o[64] = a1; }
        }
        if (ch == 0) {
            int pv = 0, ps = 0, tt = 0, pe_ = 0;
#pragma unroll
            for (int e = 0; e < 8; ++e) { if (tid == e) pv = pen[e]; if (wave == e) { ps = pst[e]; pe_ = pen[e]; tt = ltot[e]; } }
            if (tid < 8) meta[tid] = pv;
            for (int r = ps + tt + lane; r < pe_; r += 64) { rowrs[r] = 0.f; rowg[r] = 0.f; }
        }
        __syncthreads();
    }
}

struct Params { const float* in[18]; float* out; unsigned char* ws; int ph_lo, ph_hi; };
typedef __attribute__((address_space(4))) Params KP;
constexpr int IT_FF = (D_ / 64) * (FF_ / 32), MOE_ITEMS = NEXP * 3 * IT_FF;
static_assert(IT_FF == (FF_ / 64) * (D_ / 32), "w1 / w3 / w2 have the same item count");
constexpr int FILL_IN = 6000, FILL_IN8 = 4000, FILL_UQ = 2000, FILL_MD = 16000;
constexpr int fill_in(int l) { return f8_in_layer(l) ? FILL_IN8 : FILL_IN; }
constexpr int fill_in_at(int l) { return (l & 1) == 0 ? (l < 2 ? 0 : FILL_MD) : fill_in_at(l - 1) + fill_in(l - 1) + FILL_UQ; }
constexpr int FA0 = fill_in_at(0), FA1 = fill_in_at(1), FA2 = fill_in_at(2), FA3 = fill_in_at(3), FN0 = fill_in(0), FN1 = fill_in(1), FN2 = fill_in(2), FN3 = fill_in(3);
constexpr int L1_DONE = fill_in_at(1) + fill_in(1) + FILL_UQ, L3_DONE = fill_in_at(3) + fill_in(3) + FILL_UQ;
static_assert(FILL_MD <= NEXP * 2 * IT_FF && L3_DONE <= MOE_ITEMS, "early ranges");
__device__ __forceinline__ void moe_job(const KP* kp, unsigned char* ws, int l, int g, TrJob& J, int& it) {
    const int mj = l >> 1, j = g / IT_FF; it = g % IT_FF;
    unsigned char* WM13 = ws + WS_WM; unsigned char* WM2 = WM13 + (size_t)NEXP * 2 * FF_ * D_ * 2; const int eb = f8_layer(l) ? 1 : 2;
    if (j < 2 * NEXP) { const int e = j >> 1;
        if ((j & 1) == 0) J = TrJob{kp->in[14] + (size_t)(mj * NEXP + e) * D_ * FF_, D_, FF_, (bf16*)(WM13 + (size_t)e * 2 * FF_ * D_ * eb), kp->in[9] + l * D_, TM_W1, (int)f8_layer(l)};
        else J = TrJob{kp->in[15] + (size_t)(mj * NEXP + e) * D_ * FF_, D_, FF_, (bf16*)(WM13 + (size_t)e * 2 * FF_ * D_ * eb), kp->in[9] + l * D_, TM_W3, (int)f8_layer(l)};
    } else { const int e = j - 2 * NEXP; J = TrJob{kp->in[16] + (size_t)(mj * NEXP + e) * FF_ * D_, FF_, D_, (bf16*)(WM2 + (size_t)e * FF_ * D_ * eb), nullptr, TM_ID, (int)f8_layer(l)}; }
}
__device__ __forceinline__ void moe_fill(const KP* kp, unsigned char* ws, int l, int a, int b, int nwg, int G, int c, int wave, LAS unsigned char* lds, int lane) {
    const int r = nwg % G; int P = G, pidx = c;
    if (r != 0) { P = G - r; pidx = c - r; }
    if (pidx >= 0) { LAS float* scr = (LAS float*)(lds + wave * 16384);
        for (int g = a + pidx * NWAVES + wave; g < b; g += P * NWAVES) { TrJob J; int it; moe_job(kp, ws, l, g, J, it); tr_item(J, it, scr, lane); } }
    __syncthreads();
}
__device__ __forceinline__ const KP* kargs() { const KP* p = (const KP*)__builtin_amdgcn_kernarg_segment_ptr(); asm volatile("" : "+s"(p)); return p; }
__global__ void __launch_bounds__(NWAVES * 64, 2) hybrid_fwd(Params P) {
    extern __shared__ __attribute__((aligned(16))) unsigned char lds_raw[];
    LAS unsigned char* lds = (LAS unsigned char*)lds_raw;
    const int wave_s = __builtin_amdgcn_readfirstlane((int)threadIdx.x >> 6);
#define LANE_NOW() ({ int l_; asm volatile("v_mbcnt_lo_u32_b32 %0, -1, 0\n\tv_mbcnt_hi_u32_b32 %0, -1, %0" : "=v"(l_)); l_; })
#define T0_NOW() (wave_s == 0 && LANE_NOW() == 0)
    { const int tid0 = wave_s * 64 + LANE_NOW();
      for (int u = tid0; u < (LDS_BYTES - LDSCTL_OFF) / 4; u += NWAVES * 64) ((LAS unsigned*)(lds + LDSCTL_OFF))[u] = 0u; }
    __syncthreads();
#define GEOM() int G_l = gridDim.x, bx_l = blockIdx.x; asm volatile("" : "+s"(G_l), "+s"(bx_l));   const int G = G_l, bx = bx_l, vcu = (G % 8 == 0) ? (bx % 8) * (G / 8) + bx / 8 : bx; const int wave = wave_s; const int gw = vcu * NWAVES + wave, NGW = G * NWAVES; (void)gw; (void)NGW; (void)vcu; (void)bx
#define BAROBJ() XcdBarrier bar; bar.bar = (unsigned*)(kargs()->ws + WS_CTL); bar.x = xb_xcc_id(); bar.st = (volatile LAS unsigned*)(lds + MISC_OFF) + 8
    { const KP* kp0 = kargs(); const int lo0 = kp0->ph_lo, hi0 = kp0->ph_hi;
      if (hi0 - lo0 > 1) { XcdBarrier b0 = xcd_barrier_post((unsigned*)(kp0->ws + WS_CTL), (volatile LAS unsigned*)(lds + MISC_OFF) + 8, T0_NOW());
        if (lo0 != 0) { if (T0_NOW()) { unsigned nloc, nx; xcd_barrier_complete(b0.bar, b0.x, nloc, nx); b0.st[0] = nloc; b0.st[1] = nx; } __syncthreads(); } } }
#ifndef PROBE_MASK
#define PROBE_MASK 0
#endif
#define REPS(bit) ((((PROBE_MASK) >> (bit)) & 1) ? 2 : 1)
#define RUN(k) (kargs()->ph_lo <= (k) && (k) < kargs()->ph_hi)
#ifdef PROBE_BAR2
#define SEAM(k) do { if (RUN(k) && RUN((k) + 1)) { BAROBJ(); xcd_barrier<false>(bar, T0_NOW()); xcd_barrier<false>(bar, T0_NOW()); } } while (0)
#else
#define SEAM(k) do { if (RUN(k) && RUN((k) + 1)) { BAROBJ(); xcd_barrier<false>(bar, T0_NOW()); } } while (0)
#endif
#define SEAM_FIRST(k) do { if (RUN(k) && RUN((k) + 1)) { BAROBJ(); xcd_barrier<true>(bar, T0_NOW()); } } while (0)
#define PHASE_ENV() const KP* kp = kargs(); unsigned char* ws = kp->ws; (void)ws; const int lane_p = LANE_NOW(); const int tid_p = wave_s * 64 + lane_p; (void)tid_p; (void)lane_p; GEOM(); \
    float* X = kp->out; bf16* XB = (bf16*)(ws + WS_XB); float* SSX = (float*)(ws + WS_SSX); float* SSQ = (float*)(ws + WS_SSQ); float* RCOS = (float*)(ws + WS_RCOS); float* RSIN = (float*)(ws + WS_RSIN); \
    LAS float* rstab = (LAS float*)(lds + RSTAB_OFF); (void)X; (void)XB; (void)SSX; (void)SSQ; (void)RCOS; (void)RSIN; (void)rstab
#define ATT_PTRS() bf16 *CQ = (bf16*)(ws + WS_CQ), *CKV = (bf16*)(ws + WS_CKV), *KR = (bf16*)(ws + WS_KR), *QBb = (bf16*)(ws + WS_QB), *KBb = (bf16*)(ws + WS_KB), *VBb = (bf16*)(ws + WS_VB), \
         *Qm = (bf16*)(ws + WS_Q), *KN = (bf16*)(ws + WS_KN), *Vm = (bf16*)(ws + WS_V), *AO = (bf16*)(ws + WS_AO); (void)CQ; (void)CKV; (void)KR; (void)QBb; (void)KBb; (void)VBb; (void)Qm; (void)KN; (void)Vm; (void)AO
#define MOE_PTRS() bf16 *HM = (bf16*)(ws + WS_HM), *XS = (bf16*)(ws + WS_XS); int* TOKE = (int*)(ws + WS_TOKE); float* TOKG = (float*)(ws + WS_TOKG); float* TOKRS = (float*)(ws + WS_TOKRS); int* POS = (int*)(ws + WS_POS); \
    int* CNT = (int*)(ws + WS_CNT); int* META = (int*)(ws + WS_META); float* ROWG = (float*)(ws + WS_ROWG); float* ROWRS = (float*)(ws + WS_ROWRS); bf16* WM13 = (bf16*)(ws + WS_WM); bf16* WM2 = WM13 + (size_t)NEXP * 2 * FF_ * D_; \
    (void)HM; (void)XS; (void)TOKE; (void)TOKG; (void)TOKRS; (void)POS; (void)CNT; (void)META; (void)ROWG; (void)ROWRS; (void)WM13; (void)WM2
#define WATT_PTRS() const bf16* WIN = (const bf16*)(ws + WS_WATT + (size_t)l * WATT_L); const bf16* WUQ = WIN + (size_t)IN_PAD * D_; const bf16* WUKV = WUQ + 768 * QL_; const bf16* WOUT = WUKV + 1024 * KVL_; (void)WIN; (void)WUQ; (void)WUKV; (void)WOUT

    if (RUN(0)) for (int rep_ = 0; rep_ < REPS(9); ++rep_) {
        PHASE_ENV();
        LAS float* scr = (LAS float*)(lds + wave * 16384);
        int base = 0;
        for (int j = 0; j < 22; ++j) {
            TrJob J;
            if (j < 16) { const int l = j >> 2, k = j & 3; bf16* wl = (bf16*)(ws + WS_WATT + (size_t)l * WATT_L);
                if (k == 0) J = TrJob{kp->in[2] + (size_t)l * D_ * IN_DIM, D_, IN_DIM, wl, kp->in[1] + l * D_, TM_IN, (int)f8_in_layer(l)};
                else if (k == 1) J = TrJob{kp->in[4] + (size_t)l * QL_ * 768, QL_, 768, wl + (size_t)IN_PAD * D_, kp->in[3] + l * QL_, TM_UQ, 0};
                else if (k == 2) J = TrJob{kp->in[6] + (size_t)l * KVL_ * 1024, KVL_, 1024, wl + (size_t)IN_PAD * D_ + 768 * QL_, kp->in[5] + l * KVL_, TM_UKV, 0};
                else J = TrJob{kp->in[8] + (size_t)l * D_ * D_, D_, D_, wl + (size_t)IN_PAD * D_ + 768 * QL_ + 1024 * KVL_, nullptr, TM_ID, (int)f8_out_layer(l)};
            } else { const int dl = (j - 16) / 3, k = (j - 16) % 3; bf16* wl = (bf16*)(ws + WS_WD + (size_t)dl * WD_L);
                if (k == 0) J = TrJob{kp->in[10] + (size_t)dl * D_ * FF_, D_, FF_, wl, kp->in[9] + (2 * dl) * D_, TM_W1, (int)f8_up_layer(2 * dl)};
                else if (k == 1) J = TrJob{kp->in[11] + (size_t)dl * D_ * FF_, D_, FF_, wl, kp->in[9] + (2 * dl) * D_, TM_W3, (int)f8_up_layer(2 * dl)};
                else J = TrJob{kp->in[12] + (size_t)dl * FF_ * D_, FF_, D_, wl + (size_t)2 * FF_ * D_, nullptr, TM_ID, (int)f8_layer(2 * dl)};
            }
            tr_run(J, base, gw, NGW, scr, lane_p);
        }
        for (int r = gw; r < DEPTH_ * 96; r += NGW) {
            const v4u z = {0u, 0u, 0u, 0u};
            if (f8_in_layer(r / 96)) { GAS v4u* o = (GAS v4u*)((unsigned char*)(ws + WS_WATT + (size_t)(r / 96) * WATT_L) + (size_t)(672 + r % 96) * D_) + lane_p; o[0] = z; }
            else { GAS v4u* o = (GAS v4u*)((bf16*)(ws + WS_WATT + (size_t)(r / 96) * WATT_L) + (size_t)(672 + r % 96) * D_) + lane_p; o[0] = z; o[64] = z; } }
        for (int idx = gw * 64 + lane_p; idx < 8192 * 16; idx += NGW * 64) {
            const int pos = idx >> 4, j = idx & 15, j4 = j & 3, jq = j >> 2;
            const double c4 = j4 == 0 ? 1.0 : j4 == 1 ? 0.5623413251903491 : j4 == 2 ? 0.31622776601683794 : 0.17782794100389228;
            const double p10 = jq == 0 ? 1.0 : jq == 1 ? 0.1 : jq == 2 ? 0.01 : 0.001;
            double a = (double)pos * (c4 * p10) * 0.15915494309189535; a -= __builtin_floor(a);
            const float rv = (float)a; RCOS[idx] = __builtin_amdgcn_cosf(rv); RSIN[idx] = __builtin_amdgcn_sinf(rv);
        }
        if (gw == 0) { const v4u z = {0u, 0u, 0u, 0u}; ((GAS v4u*)(ws + WS_ZERO))[lane_p] = z; }
        row_pass<true, false>(kp->in[0], nullptr, XB, SSX, nullptr, nullptr, nullptr, gw, NGW, lane_p, f8_in_layer(0) ? ws + WS_XQ2 : nullptr);
    }
    SEAM_FIRST(0);
    int step = 1;
    for (int l = 0; l < DEPTH_; ++l) {
        if (RUN(step)) for (int rep_ = 0; rep_ < REPS(0); ++rep_) {
            PHASE_ENV(); ATT_PTRS(); WATT_PTRS();
            pg8::Gemm g{XB, WIN, T_, IN_PAD, D_}; pg8::StaticOrder S; S.init(T_, IN_PAD, G, bx);
            pg8::EpiIn E{ws, 0.125f * LOG2E_, rstab, (int)f8_qk_layer(l)};
            if ((F8_IN_LAYERS) != 0 && f8_in_layer(l)) { pg8::Gemm g8{(const bf16*)(ws + ((l & 1) ? WS_XS : WS_XQ2)), WIN, T_, IN_PAD, D_};
                pg8::gemm_phase<pg8::EpiIn, pg8::StaticOrder, true, true, true>(lds, g8, S, E, wave_s * 64); }
            else pg8::gemm_phase<pg8::EpiIn, pg8::StaticOrder, true, true>(lds, g, S, E, wave_s * 64);
            { const int ml = l < 2 ? 1 : 3, a0 = l == 0 ? FA0 : l == 1 ? FA1 : l == 2 ? FA2 : FA3, n0 = l == 0 ? FN0 : l == 1 ? FN1 : l == 2 ? FN2 : FN3; moe_fill(kp, ws, ml, a0, a0 + n0, (T_ / 256) * (IN_PAD / 256), G, bx, wave, lds, lane_p); }
        }
        SEAM(step); ++step;
        if (RUN(step)) {
            for (int rep_ = 0; rep_ < REPS(1); ++rep_) { PHASE_ENV(); ATT_PTRS(); WATT_PTRS();
              pg8::Gemm g{CQ, WUQ, T_, 768, QL_}; pg8::StaticOrder S; S.init(T_, 768, G, bx);
              pg8::EpiQ E{ws, 0.10206207261596575f * LOG2E_, rstab, (int)f8_qk_layer(l)};
              pg8::gemm_phase<pg8::EpiQ, pg8::StaticOrder, true, true>(lds, g, S, E, wave_s * 64);
              { const int ml = l < 2 ? 1 : 3, a0 = l == 0 ? FA0 + FN0 : l == 1 ? FA1 + FN1 : l == 2 ? FA2 + FN2 : FA3 + FN3; moe_fill(kp, ws, ml, a0, a0 + FILL_UQ, (T_ / 256) * (768 / 256), G, bx, wave, lds, lane_p); } }
            for (int rep_ = 0; rep_ < REPS(1); ++rep_) { PHASE_ENV(); ATT_PTRS(); WATT_PTRS();
              pg8::Gemm g{CKV, WUKV, T_, 1024, KVL_}; pg8::StaticOrder S; S.init(T_, 1024, G, bx);
              pg8::EpiKV E{ws, rstab, (int)f8_qk_layer(l), (int)f8_pv_layer(l)};
              pg8::gemm_phase<pg8::EpiKV, pg8::StaticOrder, true, true>(lds, g, S, E, wave_s * 64); }
        }
        SEAM(step); ++step;
        if (RUN(step)) {
            for (int rep_ = 0; rep_ < REPS(2); ++rep_) { PHASE_ENV(); ATT_PTRS();
              const att::Args A{Qm, KN, KR, Vm, QBb, KBb, VBb, AO, kp->in[7] + (size_t)l * 8 * 257, (int)f8_out_layer(l), ws + WS_Q8, ws + WS_KN8, ws + WS_KR8, ws + WS_ZERO, (int)f8_qk_layer(l), ws + WS_V8T, (int)f8_pv_layer(l)};
              att::attn_phase<false>(A, vcu, G, (LAS char*)lds, wave_s * 64); }
            for (int rep_ = 0; rep_ < REPS(3); ++rep_) { PHASE_ENV(); ATT_PTRS();
              const att::Args A{Qm, KN, KR, Vm, QBb, KBb, VBb, AO, kp->in[7] + (size_t)l * 8 * 257, (int)f8_out_layer(l), ws + WS_Q8, ws + WS_KN8, ws + WS_KR8, ws + WS_ZERO, (int)f8_qk_layer(l), ws + WS_V8T, (int)f8_pv_layer(l)};
              att::attn_phase<true>(A, vcu, G, (LAS char*)lds, wave_s * 64); }
        }
        SEAM(step); ++step;
        if (RUN(step)) for (int rep_ = 0; rep_ < REPS(10); ++rep_) {
            PHASE_ENV(); ATT_PTRS(); WATT_PTRS();
            pg8::Gemm g{AO, WOUT, T_, D_, D_}; pg8::StaticOrder S; S.init(T_, D_, G, bx);
            if ((F8_OUT_LAYERS) != 0 && f8_out_layer(l)) {
                if ((F8_UP_LAYERS) != 0 && f8_up_layer(l)) { pg8::EpiResQ E{ws, rep_ + 1 < REPS(10)}; pg8::gemm_phase<pg8::EpiResQ, pg8::StaticOrder, true, true, true>(lds, g, S, E, wave_s * 64); }
                else { pg8::EpiRes E{ws, rep_ + 1 < REPS(10)}; pg8::gemm_phase<pg8::EpiRes, pg8::StaticOrder, true, true, true>(lds, g, S, E, wave_s * 64); } }
            else if ((F8_UP_LAYERS) != 0 && f8_up_layer(l)) { pg8::EpiResQ E{ws, rep_ + 1 < REPS(10)}; pg8::gemm_phase<pg8::EpiResQ, pg8::StaticOrder, true, true>(lds, g, S, E, wave_s * 64); }
            else { pg8::EpiRes E{ws, rep_ + 1 < REPS(10)}; pg8::gemm_phase<pg8::EpiRes, pg8::StaticOrder, true, true>(lds, g, S, E, wave_s * 64); }
        }
        SEAM(step); ++step;
        if ((l & 1) == 0) {
            if (RUN(step)) for (int rep_ = 0; rep_ < REPS(4); ++rep_) {
                PHASE_ENV(); MOE_PTRS();
                const bf16* W13 = (const bf16*)(ws + WS_WD + (size_t)(l >> 1) * WD_L);
                pg8::Gemm g{XB, W13, T_, 2 * FF_, D_}; pg8::StaticOrder S; S.init(T_, 2 * FF_, G, bx);
#ifdef PROBE_NULLEPI
                if (rep_ + 1 < REPS(4)) { pg8::EpiNull E{ws}; pg8::gemm_phase<pg8::EpiNull, pg8::StaticOrder, true, true>(lds, g, S, E, wave_s * 64); } else
#endif
                if ((F8_UP_LAYERS) != 0 && f8_up_layer(l)) { pg8::Gemm g8{XS, W13, T_, 2 * FF_, D_}; pg8::EpiGLU<false, true> E{ws, rstab}; pg8::gemm_phase<pg8::EpiGLU<false, true>, pg8::StaticOrder, true, true, true>(lds, g8, S, E, wave_s * 64); }
                else                 if (F8_DENSE_ANY && (F8_DENSE_ALL || f8_layer(l))) { pg8::EpiGLU<false, true> E{ws, rstab}; pg8::gemm_phase<pg8::EpiGLU<false, true>, pg8::StaticOrder, true, true>(lds, g, S, E, wave_s * 64); }
                else if (!F8_DENSE_ALL) { pg8::EpiGLU<false, false> E{ws, rstab}; pg8::gemm_phase<pg8::EpiGLU<false, false>, pg8::StaticOrder, true, true>(lds, g, S, E, wave_s * 64); }
            }
            SEAM(step); ++step;
            if (RUN(step)) for (int rep_ = 0; rep_ < REPS(11); ++rep_) {
                PHASE_ENV(); MOE_PTRS();
                const bf16* W2 = (const bf16*)(ws + WS_WD + (size_t)(l >> 1) * WD_L) + (size_t)2 * FF_ * D_;
                pg8::Gemm g{HM, W2, T_, D_, FF_}; pg8::StaticOrder S; S.init(T_, D_, G, bx);
                pg8::EpiRes E{ws, rep_ + 1 < REPS(11)};
                if ((F8_IN_LAYERS) != 0 && f8_in_layer(l + 1) && f8_layer(l)) { pg8::EpiResQ EQ{ws, rep_ + 1 < REPS(11)}; pg8::gemm_phase<pg8::EpiResQ, pg8::StaticOrder, true, true, true>(lds, g, S, EQ, wave_s * 64); }
                else if (F8_DENSE_ANY && (F8_DENSE_ALL || f8_layer(l))) pg8::gemm_phase<pg8::EpiRes, pg8::StaticOrder, true, true, true>(lds, g, S, E, wave_s * 64);
                else if ((F8_IN_LAYERS) != 0 && f8_in_layer(l + 1)) { pg8::EpiResQ EQ{ws, rep_ + 1 < REPS(11)}; pg8::gemm_phase<pg8::EpiResQ, pg8::StaticOrder, true, true, false>(lds, g, S, EQ, wave_s * 64); }
                else if (!F8_DENSE_ALL) pg8::gemm_phase<pg8::EpiRes, pg8::StaticOrder, true, true, false>(lds, g, S, E, wave_s * 64);
            }
            SEAM(step); ++step;
        } else {
            const int mj = l >> 1;
            if (RUN(step)) for (int rep_ = 0; rep_ < REPS(5); ++rep_) {
                PHASE_ENV(); MOE_PTRS();
                moe_route1(lds, XB, SSX, kp->in[13] + (size_t)mj * D_ * NEXP, kp->in[9] + l * D_, TOKE, TOKG, TOKRS, CNT, bx, G, tid_p, wave, lane_p);
                __syncthreads();
                LAS float* scr = (LAS float*)(lds + wave * 16384);
                for (int g = (l == 1 ? L1_DONE : L3_DONE) + gw; g < MOE_ITEMS; g += NGW) { TrJob J; int it; moe_job(kp, ws, l, g, J, it); tr_item(J, it, scr, lane_p); }
                __syncthreads();
            }
            SEAM(step); ++step;
            if (RUN(step)) for (int rep_ = 0; rep_ < REPS(6); ++rep_) { PHASE_ENV(); MOE_PTRS(); moe_route2(lds, XB, XS, TOKE, TOKG, TOKRS, CNT, POS, ROWG, ROWRS, META, bx, G, tid_p, wave, lane_p, f8_layer(l)); }
            SEAM(step); ++step;
            if (RUN(step)) for (int rep_ = 0; rep_ < REPS(7); ++rep_) {
                PHASE_ENV(); MOE_PTRS();
                pg8::MoeOrder S;
#pragma unroll
                for (int e = 0; e < 8; ++e) S.pe[e] = __builtin_amdgcn_readfirstlane(META[e]);
                const int mrows = S.pe[7];
                S.estride = (size_t)2 * FF_ * D_ * (f8_layer(l) ? 1 : 2); S.so.init(mrows, 2 * FF_, G, bx);
                pg8::Gemm g{XS, WM13, mrows, 2 * FF_, D_, 0x79797979, 0x7b7b7b7b};
                if (F8_MOE_ANY && (F8_MOE_ALL || f8_layer(l))) { pg8::EpiGLU<true, true, true> E{ws, rstab}; pg8::gemm_phase<pg8::EpiGLU<true, true, true>, pg8::MoeOrder, true, true, true>(lds, g, S, E, wave_s * 64); }
                else if (!F8_MOE_ALL) { pg8::EpiGLU<true, false> E{ws, rstab}; pg8::gemm_phase<pg8::EpiGLU<true, false>, pg8::MoeOrder, true, true>(lds, g, S, E, wave_s * 64); }
            }
            SEAM(step); ++step;
            if (RUN(step)) for (int rep_ = 0; rep_ < REPS(8); ++rep_) {
                PHASE_ENV(); MOE_PTRS();
                pg8::MoeOrder S;
#pragma unroll
                for (int e = 0; e < 8; ++e) S.pe[e] = __builtin_amdgcn_readfirstlane(META[e]);
                const int mrows = S.pe[7];
                S.estride = (size_t)FF_ * D_ * (f8_layer(l) ? 1 : 2); S.so.init(mrows, D_, G, bx);
                pg8::Gemm g{HM, WM2, mrows, D_, FF_};
                pg8::EpiY E{ws, rstab};
                if (F8_MOE_ANY && (F8_MOE_ALL || f8_layer(l))) pg8::gemm_phase<pg8::EpiY, pg8::MoeOrder, true, true, true>(lds, g, S, E, wave_s * 64);
                else if (!F8_MOE_ALL) pg8::gemm_phase<pg8::EpiY, pg8::MoeOrder, true, true, false>(lds, g, S, E, wave_s * 64);
                if (l == 1) moe_fill(kp, ws, 3, 0, FILL_MD, (mrows / 256) * (D_ / 256), G, bx, wave, lds, lane_p);
            }
            SEAM(step); ++step;
            if (RUN(step)) {
                PHASE_ENV(); MOE_PTRS();
                if (l == DEPTH_ - 1) row_pass<false, true>(nullptr, X, XB, SSX, XS, POS, kp->in[17], gw, NGW, lane_p);
                else row_pass<false, false>(nullptr, nullptr, XB, SSX, XS, POS, nullptr, gw, NGW, lane_p, f8_in_layer(l + 1) ? ws + WS_XQ2 : nullptr);
            }
            SEAM(step); ++step;
        }
    }
#undef RUN
#undef SEAM
#undef SEAM_FIRST
#undef GEOM
#undef BAROBJ
#undef LANE_NOW
#undef T0_NOW
}

extern "C" void kernel_launch(void* const* d_in, const int* in_sizes, int n_in, void* d_out, int out_size, void* d_ws, size_t ws_size, hipStream_t stream) {
    static int grid = 0;
    if (grid == 0) {
        if (n_in != 18 || in_sizes[0] != T_ * D_ || out_size != T_ * D_ || ws_size < WS_END) { fprintf(stderr, "kernel_launch: unexpected shapes / workspace (n_in %d, ws %zu, need %zu); nothing launched\n", n_in, ws_size, (size_t)WS_END); grid = -1; return; }
        int dev = 0, cus = 0;
        if (hipGetDevice(&dev) != hipSuccess || hipDeviceGetAttribute(&cus, hipDeviceAttributeMultiprocessorCount, dev) != hipSuccess) { grid = -1; return; }
        if (hipFuncSetAttribute((const void*)hybrid_fwd, hipFuncAttributeMaxDynamicSharedMemorySize, LDS_BYTES) != hipSuccess) { fprintf(stderr, "kernel_launch: hipFuncSetAttribute failed\n"); grid = -1; return; }
        int per_cu = 0;
        if (hipOccupancyMaxActiveBlocksPerMultiprocessor(&per_cu, (const void*)hybrid_fwd, NWAVES * 64, LDS_BYTES) != hipSuccess || per_cu < 1) fprintf(stderr, "kernel_launch: occupancy query reports %d blocks per CU\n", per_cu);
        (void)hipGetLastError();
        grid = cus;
    }
    if (grid < 0) return;
    (void)hipMemsetAsync((char*)d_ws + WS_CTL, 0, CTL_ZERO_BYTES, stream);
    Params p{};
    for (int i = 0; i < 18; ++i) p.in[i] = (const float*)d_in[i];
    p.out = (float*)d_out; p.ws = (unsigned char*)d_ws;
#if MK_ONE_LAUNCH
    p.ph_lo = 0; p.ph_hi = NSTEPS;
    hipLaunchKernelGGL(hybrid_fwd, dim3(grid), dim3(NWAVES * 64), LDS_BYTES, stream, p);
#else
    for (int s = 0; s < NSTEPS; ++s) { p.ph_lo = s; p.ph_hi = s + 1; hipLaunchKernelGGL(hybrid_fwd, dim3(grid), dim3(NWAVES * 64), LDS_BYTES, stream, p); }
#endif
}
```

```cpp
#include <hip/hip_runtime.h>
#include <cstdio>
#include <cstdint>
constexpr int NWAVES = 8;
constexpr int T_ = 32768, D_ = 1024, DEPTH_ = 4, IN_DIM = 2208, IN_PAD = 2304, FF_ = 3584, NEXP = 8, QL_ = 384, KVL_ = 256;
constexpr int MAXROWS = 2 * T_ + NEXP * 256;
constexpr float EPS_ = 1e-6f, LOG2E_ = 1.4426950408889634f;
#ifndef MK_ONE_LAUNCH
#define MK_ONE_LAUNCH 1
#endif
#ifndef F8_LAYERS
#define F8_LAYERS 0xE
#endif
constexpr bool f8_layer(int l) { return ((F8_LAYERS) >> l) & 1; }
#ifndef F8_UP_LAYERS
#define F8_UP_LAYERS 0x4
#endif
constexpr bool f8_up_layer(int l) { return ((F8_UP_LAYERS) >> l) & 1; }
#ifndef F8_QK_LAYERS
#define F8_QK_LAYERS 0xF
#endif
constexpr bool f8_qk_layer(int l) { return l >= 0 && l < 4 && (((F8_QK_LAYERS) >> l) & 1); }
#ifndef F8_PV_LAYERS
#define F8_PV_LAYERS 0xF
#endif
constexpr bool f8_pv_layer(int l) { return l >= 0 && l < 4 && (((F8_PV_LAYERS) >> l) & 1); }
static_assert(((F8_PV_LAYERS) & ~(F8_QK_LAYERS) & 0xF) == 0, "8-bit P.V only where Q.K^T is fp8");
#ifndef F8_CHUNK_LAYERS
#define F8_CHUNK_LAYERS 0xF
#endif
constexpr bool f8_chunk_layer(int l) { return l >= 0 && l < 4 && (((F8_CHUNK_LAYERS) >> l) & 1); }
#ifndef F8_OUT_LAYERS
#define F8_OUT_LAYERS 0xC
#endif
constexpr bool f8_out_layer(int l) { return l >= 0 && l < 4 && (((F8_OUT_LAYERS) >> l) & 1); }
#ifndef F8_IN_LAYERS
#define F8_IN_LAYERS 0xF
#endif
constexpr bool f8_in_layer(int l) { return l >= 0 && l < 4 && (((F8_IN_LAYERS) >> l) & 1); }
static_assert(((F8_UP_LAYERS) & ~(F8_LAYERS) & 0xF) == 0 && ((F8_UP_LAYERS) & 0xA) == 0, "fp8 up-projection: dense layers whose down-projection is fp8");
constexpr bool F8_DENSE_ANY = (F8_LAYERS & 0x5) != 0, F8_DENSE_ALL = (F8_LAYERS & 0x5) == 0x5, F8_MOE_ANY = (F8_LAYERS & 0xA) != 0, F8_MOE_ALL = (F8_LAYERS & 0xA) == 0xA;
constexpr int NSTEPS = 31;
constexpr size_t MiB = 1u << 20;
constexpr size_t WS_CTL = 0, CTL_ZERO_BYTES = 65536;
constexpr size_t WS_RCOS = 1 * MiB, WS_RSIN = WS_RCOS + 512 * 1024;
constexpr size_t WS_SSX = 2 * MiB;
constexpr size_t WS_SSQ = 4 * MiB;
constexpr size_t WS_TOKE = 7 * MiB, WS_TOKG = WS_TOKE + 128 * 1024, WS_TOKRS = WS_TOKG + 256 * 1024, WS_POS = WS_TOKRS + 128 * 1024,
                 WS_CNT = WS_POS + 256 * 1024, WS_META = WS_CNT + 8192, WS_ROWG = 8 * MiB, WS_ROWRS = WS_ROWG + 512 * 1024;
constexpr size_t WATT_L = (size_t)(IN_PAD * D_ + 768 * QL_ + 1024 * KVL_ + D_ * D_) * 2;
constexpr size_t WS_WATT = 10 * MiB;
constexpr size_t WD_L = (size_t)3 * D_ * FF_ * 2;
constexpr size_t WS_WD = 41 * MiB;
constexpr size_t WS_WM = 83 * MiB;
constexpr size_t WS_XQ2 = WS_WM + 56 * MiB;
static_assert((F8_IN_LAYERS) == 0 || F8_MOE_ALL, "WS_XQ2 overlays the bf16 half of the MoE W13 buffer");
constexpr size_t WS_XB = 251 * MiB;
constexpr size_t WS_XS = 315 * MiB;
constexpr size_t WS_HM = 447 * MiB;
constexpr size_t WS_CQ = WS_HM, WS_CKV = WS_CQ + 24 * MiB, WS_KR = WS_CKV + 16 * MiB, WS_QB = WS_KR + 2 * MiB, WS_KB = WS_QB + 32 * MiB, WS_VB = WS_KB + 32 * MiB,
                 WS_Q = WS_VB + 32 * MiB, WS_KN = WS_Q + 48 * MiB, WS_V = WS_KN + 32 * MiB, WS_AO = WS_V + 32 * MiB;
constexpr size_t WS_Q8 = WS_AO + 64 * MiB, WS_KN8 = WS_Q8 + 24 * MiB, WS_KR8 = WS_KN8 + 16 * MiB, WS_ZERO = WS_KR8 + 1 * MiB, WS_V8T = WS_ZERO + 1 * MiB, WS_QB8 = WS_V8T + 16 * MiB, WS_KB8 = WS_QB8 + 16 * MiB, WS_VB8T = WS_KB8 + 16 * MiB;
constexpr size_t WS_END = WS_HM + (size_t)MAXROWS * FF_ * 2;
static_assert(WS_VB8T + 16 * MiB <= WS_END && WS_Q8 >= WS_HM + (size_t)MAXROWS * FF_ && WS_Q8 >= WS_HM + (size_t)T_ * FF_ * 2 && ((F8_QK_LAYERS) == 0 || F8_MOE_ALL), "fp8 attention copies sit above the FFN hidden rows");
static_assert(WS_AO + 64 * MiB <= WS_END && WS_WATT + 4 * WATT_L <= WS_WD && WS_WD + 2 * WD_L <= WS_WM && WS_WM + 8 * WD_L <= WS_XB && WS_XS + (size_t)MAXROWS * D_ * 2 <= WS_HM, "d_ws map");
constexpr int RING_BYTES = 131072, LDSCTL_OFF = RING_BYTES, MISC_OFF = LDSCTL_OFF + 320, RSTAB_OFF = LDSCTL_OFF + 1024, LDS_BYTES = 147456;

namespace pg8 {
#define PG8_LAS __attribute__((address_space(3)))
typedef unsigned short bf16_t;
typedef short bf16x8 __attribute__((ext_vector_type(8)));
typedef float f32x4 __attribute__((ext_vector_type(4)));
typedef unsigned u32x4 __attribute__((ext_vector_type(4)));
typedef int v4i32 __attribute__((ext_vector_type(4)));
typedef int v8i32 __attribute__((ext_vector_type(8)));
typedef unsigned u32x2 __attribute__((ext_vector_type(2)));
constexpr int BM = 256, BK = 64, HALF = 128, HTB = HALF * BK * 2  , STAGE_BYTES = 8 * HTB, NXCD = 8, WGM = 8;

__host__ __device__ __forceinline__ int lds_byte(int r, int c) { const int st = (r >> 4) * 2 + (c >> 5), rr = r & 15, cc = c & 31, ob = rr * 64 + cc * 2; return st * 1024 + (ob ^ (((ob >> 9) & 1) << 5)); }
__host__ __device__ __forceinline__ void stage_rc(int b, int& R, int& C) { const int st = b / 1024, sb = b % 1024, swz = sb ^ (((sb >> 9) & 1) << 5); R = (st >> 1) * 16 + swz / 64; C = (st & 1) * 32 + (swz % 64) / 2; }
__host__ __device__ __forceinline__ int perm32(int rho) { const int n = rho >> 4, i = rho & 15; return 8 * (i >> 2) + 4 * n + (i & 3); }

struct Unit { int pm, pn; };
struct Gemm { const bf16_t* A; const bf16_t* Bt; int M, N, K; int scw = 0x79797979, sch = 0x7c7c7c7c; };

struct StaticOrder {
    int nM, nN, nwg, G, c;
    __host__ __device__ void init(int M, int N, int G_, int c_) { nM = M / BM; nN = N / BM; nwg = nM * nN; G = G_; c = c_; }
    __host__ __device__ bool next(int i, Unit& u) const {
        const long L = (long)i * G + c; if (L >= nwg) return false;
        int wgid = (int)L; { const int q = nwg / NXCD, r = nwg % NXCD, xcd = wgid % NXCD, off = wgid / NXCD; wgid = (xcd < r ? xcd * (q + 1) : r * (q + 1) + (xcd - r) * q) + off; }
        const int nig = WGM * nN, gid = wgid / nig, fm = gid * WGM, gsz = (nM - fm) < WGM ? (nM - fm) : WGM;
        u.pm = fm + ((wgid % nig) % gsz); u.pn = (wgid % nig) / gsz; return true;
    }
    __device__ __forceinline__ size_t boff(const Unit&) const { return 0; }
    __device__ __forceinline__ void a_ready(const Unit&) const {}
    __device__ __forceinline__ void done(const Unit&) const {}
};

__device__ __forceinline__ unsigned cvt_pk_bf16(float lo, float hi) { unsigned r; asm volatile("v_cvt_pk_bf16_f32 %0, %1, %2" : "=v"(r) : "v"(lo), "v"(hi)); return r; }
typedef float f32x2 __attribute__((ext_vector_type(2)));
__device__ __forceinline__ u32x4 pack8(const f32x4 a, const f32x4 b) { u32x4 w; w.x = cvt_pk_bf16(a[0], a[1]); w.y = cvt_pk_bf16(a[2], a[3]); w.z = cvt_pk_bf16(b[0], b[1]); w.w = cvt_pk_bf16(b[2], b[3]); return w; }
__device__ __forceinline__ float sumsq4(const f32x4 v) { return (v[0] * v[0] + v[1] * v[1]) + (v[2] * v[2] + v[3] * v[3]); }
__device__ __forceinline__ float xor16_add(float v) { return v + __int_as_float(__builtin_amdgcn_ds_swizzle(__float_as_int(v), 0x401F)); }
__device__ __forceinline__ float xor32_add(float v) { auto rr = __builtin_amdgcn_permlane32_swap(__float_as_uint(v), __float_as_uint(v), false, false); return __uint_as_float(rr[0]) + __uint_as_float(rr[1]); }
__device__ __forceinline__ float silu_f(float x) { return x * __builtin_amdgcn_rcpf(1.0f + __builtin_amdgcn_exp2f(-1.4426950409f * x)); }
template <int NP4, int PITCH, int OFF>
__device__ __forceinline__ void rs_table(const float* part, int rowbase, int wr, int lane, float inv_dim, PG8_LAS float* t) {
    f32x4 s[2][NP4];
#pragma unroll
    for (int ai = 0; ai < 2; ++ai) { const f32x4* p = (const f32x4*)(part + (size_t)(rowbase + ai * 128 + wr * 64 + lane) * PITCH + OFF);
#pragma unroll
        for (int j = 0; j < NP4; ++j) s[ai][j] = p[j]; }
#pragma unroll
    for (int ai = 0; ai < 2; ++ai) { f32x4 a = s[ai][0];
#pragma unroll
        for (int j = 1; j < NP4; ++j) a += s[ai][j];
        t[ai * 64 + lane] = __builtin_amdgcn_rsqf(((a[0] + a[1]) + (a[2] + a[3])) * inv_dim + 1e-6f); }
    asm volatile("s_waitcnt lgkmcnt(0)" ::: "memory");
}
constexpr int DM = 1024, FFN = 3584, SEQ_ = 8192;

__device__ __forceinline__ f32x4 bf2f_lo(const u32x4 w, int h) { const unsigned a = h ? w.z : w.x, b = h ? w.w : w.y; return (f32x4){__uint_as_float(a << 16), __uint_as_float(a & 0xffff0000u), __uint_as_float(b << 16), __uint_as_float(b & 0xffff0000u)}; }
struct EpiRes {
    static constexpr bool PERM = true, AFTER_DRAIN = false, PREFETCH = false;
    unsigned char* ws; bool dummy;
    __device__ __forceinline__ void operator()(const f32x4 (&acc)[2][2][4][2], const Unit& u, int wr, int wc, int fr, int fq) const {
        bf16_t* xb = (bf16_t*)(ws + (dummy ? WS_XS : WS_XB)); float* ssx = (float*)(ws + (dummy ? WS_SSQ : WS_SSX));
        const int row0 = u.pm * BM + wr * 64 + fr, col0 = u.pn * BM + wc * 32 + 8 * fq;
        u32x4 old[2][4][2];
#pragma unroll
        for (int ai = 0; ai < 2; ++ai)
#pragma unroll
            for (int m = 0; m < 4; ++m)
#pragma unroll
                for (int bj = 0; bj < 2; ++bj) old[ai][m][bj] = *(const u32x4*)(xb + (size_t)(row0 + ai * HALF + m * 16) * DM + col0 + bj * HALF);
#pragma unroll
        for (int ai = 0; ai < 2; ++ai)
#pragma unroll
            for (int m = 0; m < 4; ++m) {
                const int row = row0 + ai * HALF + m * 16; float ss = 0.f;
#pragma unroll
                for (int bj = 0; bj < 2; ++bj) {
                    const f32x4 v0 = bf2f_lo(old[ai][m][bj], 0) + acc[ai][bj][m][0], v1 = bf2f_lo(old[ai][m][bj], 1) + acc[ai][bj][m][1];
                    ss += sumsq4(v0) + sumsq4(v1);
                    *(u32x4*)(xb + (size_t)row * DM + col0 + bj * HALF) = pack8(v0, v1);
                }
                ss = xor32_add(xor16_add(ss));
                if (fq == 0) ssx[(size_t)row * 16 + u.pn * 4 + wc] = ss;
            }
    }
};
__device__ __forceinline__ unsigned pack4_fp8_x16(const f32x4 v) { int w = 0; w = __builtin_amdgcn_cvt_pk_fp8_f32(__builtin_amdgcn_fmed3f(v[0] * 16.0f, -448.0f, 448.0f), __builtin_amdgcn_fmed3f(v[1] * 16.0f, -448.0f, 448.0f), w, false);
    w = __builtin_amdgcn_cvt_pk_fp8_f32(__builtin_amdgcn_fmed3f(v[2] * 16.0f, -448.0f, 448.0f), __builtin_amdgcn_fmed3f(v[3] * 16.0f, -448.0f, 448.0f), w, true); return (unsigned)w; }
__device__ __forceinline__ unsigned pack4_fp8_x8(const f32x4 v) { int w = 0; w = __builtin_amdgcn_cvt_pk_fp8_f32(__builtin_amdgcn_fmed3f(v[0] * 8.0f, -448.0f, 448.0f), __builtin_amdgcn_fmed3f(v[1] * 8.0f, -448.0f, 448.0f), w, false);
    w = __builtin_amdgcn_cvt_pk_fp8_f32(__builtin_amdgcn_fmed3f(v[2] * 8.0f, -448.0f, 448.0f), __builtin_amdgcn_fmed3f(v[3] * 8.0f, -448.0f, 448.0f), w, true); return (unsigned)w; }
struct EpiResQ {
    static constexpr bool PERM = true, AFTER_DRAIN = false, PREFETCH = false;
    unsigned char* ws; bool dummy;
    __device__ __forceinline__ void operator()(const f32x4 (&acc)[2][2][4][2], const Unit& u, int wr, int wc, int fr, int fq) const {
        bf16_t* xb = (bf16_t*)(ws + (dummy ? WS_XS : WS_XB)); float* ssx = (float*)(ws + (dummy ? WS_SSQ : WS_SSX)); unsigned char* xq = ws + WS_XS + (dummy ? (size_t)64 * 1024 * 1024 : 0);
        const int row0 = u.pm * BM + wr * 64 + fr, col0 = u.pn * BM + wc * 32 + 8 * fq;
#pragma unroll
        for (int ai = 0; ai < 2; ++ai) {
            u32x4 old[4][2];
#pragma unroll
            for (int m = 0; m < 4; ++m)
#pragma unroll
                for (int bj = 0; bj < 2; ++bj) old[m][bj] = *(const u32x4*)(xb + (size_t)(row0 + ai * HALF + m * 16) * DM + col0 + bj * HALF);
#pragma unroll
            for (int m = 0; m < 4; ++m) {
                const int row = row0 + ai * HALF + m * 16; float ss = 0.f;
#pragma unroll
                for (int bj = 0; bj < 2; ++bj) {
                    const f32x4 v0 = bf2f_lo(old[m][bj], 0) + acc[ai][bj][m][0], v1 = bf2f_lo(old[m][bj], 1) + acc[ai][bj][m][1];
                    ss += sumsq4(v0) + sumsq4(v1);
                    *(u32x4*)(xb + (size_t)row * DM + col0 + bj * HALF) = pack8(v0, v1);
                    { u32x2 w8; w8.x = pack4_fp8_x8(v0); w8.y = pack4_fp8_x8(v1); *(u32x2*)(xq + (size_t)row * DM + col0 + bj * HALF) = w8; }
                }
                ss = xor32_add(xor16_add(ss));
                if (fq == 0) ssx[(size_t)row * 16 + u.pn * 4 + wc] = ss;
            }
        }
    }
};
__device__ __forceinline__ unsigned pack4_fp8(const f32x4 v) { int w = 0; w = __builtin_amdgcn_cvt_pk_fp8_f32(__builtin_amdgcn_fmed3f(v[0] * 8.0f, -448.0f, 448.0f), __builtin_amdgcn_fmed3f(v[1] * 8.0f, -448.0f, 448.0f), w, false);
    w = __builtin_amdgcn_cvt_pk_fp8_f32(__builtin_amdgcn_fmed3f(v[2] * 8.0f, -448.0f, 448.0f), __builtin_amdgcn_fmed3f(v[3] * 8.0f, -448.0f, 448.0f), w, true); return (unsigned)w; }
template <bool MOE, bool F8OUT = true, bool NORS = false> struct EpiGLU {
    static constexpr bool PERM = true, AFTER_DRAIN = false, PREFETCH = false;
    unsigned char* ws; PG8_LAS float* tab;
    __device__ __forceinline__ void operator()(const f32x4 (&acc)[2][2][4][2], const Unit& u, int wr, int wc, int fr, int fq) const {
        const int lane = fq * 16 + fr, wid = wr * 4 + wc; float rs[2][4];
        bf16_t* h = (bf16_t*)(ws + WS_HM); const float* part = (const float*)(ws + (MOE ? WS_ROWRS : WS_SSX));
        if (NORS) {
            asm volatile("s_waitcnt vmcnt(0)" ::: "memory");
#pragma unroll
            for (int ai = 0; ai < 2; ++ai)
#pragma unroll
                for (int m = 0; m < 4; ++m) rs[ai][m] = 1.0f;
        } else if (MOE) {
#pragma unroll
            for (int ai = 0; ai < 2; ++ai)
#pragma unroll
                for (int m = 0; m < 4; ++m) rs[ai][m] = part[u.pm * BM + ai * HALF + wr * 64 + m * 16 + fr];
        } else {
            PG8_LAS float* t = tab + wid * 128; rs_table<4, 16, 0>(part, u.pm * BM, wr, lane, 1.0f / DM, t);
#pragma unroll
            for (int ai = 0; ai < 2; ++ai)
#pragma unroll
                for (int m = 0; m < 4; ++m) rs[ai][m] = t[ai * 64 + m * 16 + fr];
        }
        const int row0 = u.pm * BM + wr * 64 + fr, col0 = u.pn * HALF + wc * 32 + 8 * fq;
#pragma unroll
        for (int ai = 0; ai < 2; ++ai)
#pragma unroll
            for (int m = 0; m < 4; ++m) {
                const float r = rs[ai][m]; f32x4 o[2];
#pragma unroll
                for (int n = 0; n < 2; ++n) { const f32x4 a = acc[ai][0][m][n] * r, b = acc[ai][1][m][n] * r;
                    o[n] = (f32x4){silu_f(a[0]) * b[0], silu_f(a[1]) * b[1], silu_f(a[2]) * b[2], silu_f(a[3]) * b[3]}; }
                if (F8OUT) { u32x2 w; w.x = pack4_fp8(o[0]); w.y = pack4_fp8(o[1]); *(u32x2*)((unsigned char*)h + (size_t)(row0 + ai * HALF + m * 16) * FFN + col0) = w; }
                else *(u32x4*)(h + (size_t)(row0 + ai * HALF + m * 16) * FFN + col0) = pack8(o[0], o[1]);
            }
    }
};
struct EpiY {
    static constexpr bool PERM = true, AFTER_DRAIN = false, PREFETCH = true;
    unsigned char* ws; PG8_LAS float* tab; int f8y = 0;
    __device__ __forceinline__ void prefetch(const Unit& u, int wid, int lane) const {
        const float* rowg = (const float*)(ws + WS_ROWG);
        __builtin_amdgcn_global_load_lds((const unsigned*)(rowg + (size_t)u.pm * BM + lane * 4), (PG8_LAS unsigned*)(tab + wid * 256), 16, 0, 0);
    }
    __device__ __forceinline__ void operator()(const f32x4 (&acc)[2][2][4][2], const Unit& u, int wr, int wc, int fr, int fq) const {
        bf16_t* y = (bf16_t*)(ws + WS_XS); const PG8_LAS float* t = tab + (wr * 4 + wc) * 256;
        const int row0 = u.pm * BM + wr * 64 + fr, col0 = u.pn * BM + wc * 32 + 8 * fq;
#pragma unroll
        for (int ai = 0; ai < 2; ++ai)
#pragma unroll
            for (int m = 0; m < 4; ++m) { const int row = row0 + ai * HALF + m * 16; const float g = t[ai * HALF + wr * 64 + m * 16 + fr];
#pragma unroll
                for (int bj = 0; bj < 2; ++bj) {
                    if (f8y) { u32x2 w8; w8.x = pack4_fp8_x8(acc[ai][bj][m][0] * g); w8.y = pack4_fp8_x8(acc[ai][bj][m][1] * g); *(u32x2*)((unsigned char*)y + (size_t)row * DM + col0 + bj * HALF) = w8; }
                    else *(u32x4*)(y + (size_t)row * DM + col0 + bj * HALF) = pack8(acc[ai][bj][m][0] * g, acc[ai][bj][m][1] * g); } }
    }
};
__device__ __forceinline__ void rope8(f32x4& v0, f32x4& v1, const float* rcos, const float* rsin, int pos, int fq) {
    const f32x4 c = *(const f32x4*)(rcos + pos * 16 + 4 * fq), s = *(const f32x4*)(rsin + pos * 16 + 4 * fq);
    const f32x4 o0 = v0 * c - v1 * s, o1 = v0 * s + v1 * c; v0 = o0; v1 = o1;
}
struct EpiIn {
    static constexpr bool PERM = true, AFTER_DRAIN = false, PREFETCH = false;
    unsigned char* ws; float qbscale; PG8_LAS float* tab; int f8qk = 0, f8ch = 0;
    __device__ __forceinline__ void operator()(const f32x4 (&acc)[2][2][4][2], const Unit& u, int wr, int wc, int fr_in, int fq_in) const {
        int fr = fr_in, fq = fq_in; asm volatile("" : "+v"(fr), "+v"(fq));
        const int lane = fq * 16 + fr, wid = wr * 4 + wc;
        const float* ssx = (const float*)(ws + WS_SSX); float* ssq = (float*)(ws + WS_SSQ); const float* rcos = (const float*)(ws + WS_RCOS); const float* rsin = (const float*)(ws + WS_RSIN);
        bf16_t *cq = (bf16_t*)(ws + WS_CQ), *ckv = (bf16_t*)(ws + WS_CKV), *kr = (bf16_t*)(ws + WS_KR), *qb = (bf16_t*)(ws + WS_QB), *kb = (bf16_t*)(ws + WS_KB), *vb = (bf16_t*)(ws + WS_VB);
        PG8_LAS float* t = tab + wid * 128; rs_table<4, 16, 0>(ssx, u.pm * BM, wr, lane, 1.0f / DM, t);
        const int row0 = u.pm * BM + wr * 64 + fr;
#pragma unroll
        for (int bj = 0; bj < 2; ++bj) {
            const int colg = u.pn * BM + bj * HALF + wc * 32;
            if (colg >= 672 && colg < 768) continue;
            bf16_t* dst; int pitch, kind = 0, sidx = 0; float sc = 1.f;
            if (colg < 384) { dst = cq + colg; pitch = 384; kind = 1; sidx = colg >> 5; }
            else if (colg < 640) { dst = ckv + (colg - 384); pitch = 256; kind = 1; sidx = colg >> 5; }
            else if (colg < 672) { dst = kr; pitch = 32; kind = 2; }
            else if (colg < 1280) { dst = qb + (colg - 768); pitch = 512; sc = qbscale; }
            else if (colg < 1792) { dst = kb + (colg - 1280); pitch = 512; }
            else { dst = vb + (colg - 1792); pitch = 512; }
#pragma unroll
            for (int ai = 0; ai < 2; ++ai)
#pragma unroll
                for (int m = 0; m < 4; ++m) {
                    const int row = row0 + ai * HALF + m * 16; const float r = t[ai * 64 + m * 16 + fr] * sc;
                    f32x4 v0 = acc[ai][bj][m][0] * r, v1 = acc[ai][bj][m][1] * r;
                    if (kind == 2) rope8(v0, v1, rcos, rsin, row & (SEQ_ - 1), fq);
                    *(u32x4*)(dst + (size_t)row * pitch + 8 * fq) = pack8(v0, v1);
                    if (f8ch && colg >= 768 && colg < 1280) { u32x2 w8; w8.x = pack4_fp8_x16(v0); w8.y = pack4_fp8_x16(v1); *(u32x2*)(ws + WS_QB8 + (size_t)row * 512 + (colg - 768) + 8 * fq) = w8; }
                    if (f8ch && colg >= 1280 && colg < 1792) { u32x2 w8; w8.x = pack4_fp8_x8(v0); w8.y = pack4_fp8_x8(v1); *(u32x2*)(ws + WS_KB8 + (size_t)row * 512 + (colg - 1280) + 8 * fq) = w8; }
                    if (f8ch && colg >= 1792) {
                        const int c0_ = colg - 1792 + 8 * fq, bb_ = row >> 13, pos_ = row & (SEQ_ - 1), key_ = pos_ & 63, k32_ = key_ & 31;
                        unsigned char* p_ = ws + WS_VB8T + ((((size_t)(bb_ * 8 + (c0_ >> 6)) * 128 + (pos_ >> 6)) * 64 + (c0_ & 63)) * 64) + 32 * ((k32_ >> 2) & 1) + 16 * (key_ >> 5) + (k32_ & 3) + 4 * (k32_ >> 3);
                        const unsigned w0_ = pack4_fp8_x8(v0), w1_ = pack4_fp8_x8(v1);
#pragma unroll
                        for (int e_ = 0; e_ < 4; ++e_) { p_[e_ * 64] = (unsigned char)((w0_ >> (8 * e_)) & 0xffu); p_[(4 + e_) * 64] = (unsigned char)((w1_ >> (8 * e_)) & 0xffu); }
                    }
                    if (kind == 2 && f8qk) { u32x2 w8; w8.x = pack4_fp8_x8(v0); w8.y = pack4_fp8_x8(v1); *(u32x2*)(ws + WS_KR8 + (size_t)row * 32 + 8 * fq) = w8; }
                    if (kind == 1) { float ss = sumsq4(v0) + sumsq4(v1); ss = xor32_add(xor16_add(ss)); if (fq == 0) ssq[(size_t)row * 20 + sidx] = ss; }
                }
        }
    }
};
struct EpiQ {
    static constexpr bool PERM = true, AFTER_DRAIN = false, PREFETCH = false;
    unsigned char* ws; float qscale; PG8_LAS float* tab; int f8qk = 0;
    __device__ __forceinline__ void operator()(const f32x4 (&acc)[2][2][4][2], const Unit& u, int wr, int wc, int fr, int fq) const {
        const int lane = fq * 16 + fr, wid = wr * 4 + wc;
        const float* ssq = (const float*)(ws + WS_SSQ); bf16_t* q = (bf16_t*)(ws + WS_Q); const float* rcos = (const float*)(ws + WS_RCOS); const float* rsin = (const float*)(ws + WS_RSIN);
        PG8_LAS float* t = tab + wid * 128; rs_table<3, 20, 0>(ssq, u.pm * BM, wr, lane, 1.0f / 384.0f, t);
        const int row0 = u.pm * BM + wr * 64 + fr;
#pragma unroll
        for (int bj = 0; bj < 2; ++bj) {
            const int colg = u.pn * BM + bj * HALF + wc * 32; const bool rope = ((colg >> 5) % 3) == 2;
#pragma unroll
            for (int ai = 0; ai < 2; ++ai)
#pragma unroll
                for (int m = 0; m < 4; ++m) {
                    const int row = row0 + ai * HALF + m * 16; const float r = t[ai * 64 + m * 16 + fr] * qscale;
                    f32x4 v0 = acc[ai][bj][m][0] * r, v1 = acc[ai][bj][m][1] * r;
                    if (rope) rope8(v0, v1, rcos, rsin, row & (SEQ_ - 1), fq);
                    if (!f8qk) *(u32x4*)(q + (size_t)row * 768 + colg + 8 * fq) = pack8(v0, v1);
                    if (f8qk) { u32x2 w8; w8.x = pack4_fp8_x16(v0); w8.y = pack4_fp8_x16(v1); *(u32x2*)(ws + WS_Q8 + (size_t)row * 768 + colg + 8 * fq) = w8; }
                }
        }
    }
};
__device__ __forceinline__ unsigned quad_tr4(unsigned w, int qi) {
    const unsigned b = (unsigned)__builtin_amdgcn_mov_dpp((int)w, 0xB1, 0xF, 0xF, true);
    const unsigned x = __builtin_amdgcn_perm(b, w, (qi & 1) ? 0x03070105u : 0x06020400u);
    const unsigned y = (unsigned)__builtin_amdgcn_mov_dpp((int)x, 0x4E, 0xF, 0xF, true);
    return __builtin_amdgcn_perm(y, x, (qi & 2) ? 0x03020706u : 0x05040100u);
}
struct EpiKV {
    static constexpr bool PERM = true, AFTER_DRAIN = false, PREFETCH = false;
    unsigned char* ws; PG8_LAS float* tab; int f8qk = 0, f8pv = 0;
    __device__ __forceinline__ void operator()(const f32x4 (&acc)[2][2][4][2], const Unit& u, int wr, int wc, int fr_in, int fq_in) const {
        int fr = fr_in, fq = fq_in; asm volatile("" : "+v"(fr), "+v"(fq));
        const int lane = fq * 16 + fr, wid = wr * 4 + wc;
        const float* ssq = (const float*)(ws + WS_SSQ); bf16_t* kn = (bf16_t*)(ws + WS_KN); bf16_t* v = (bf16_t*)(ws + WS_V);
        PG8_LAS float* t = tab + wid * 128; rs_table<2, 20, 12>(ssq, u.pm * BM, wr, lane, 1.0f / 256.0f, t);
        const int row0 = u.pm * BM + wr * 64 + fr;
#pragma unroll
        for (int bj = 0; bj < 2; ++bj) {
            const int colg = u.pn * BM + bj * HALF + wc * 32; bf16_t* dst = colg < 512 ? kn + colg : v + (colg - 512);
#pragma unroll
            for (int ai = 0; ai < 2; ++ai)
#pragma unroll
                for (int m = 0; m < 4; ++m) {
                    const int row = row0 + ai * HALF + m * 16; const float r = t[ai * 64 + m * 16 + fr];
                    if (!(f8qk && colg < 512) && !(f8pv && colg >= 512)) *(u32x4*)(dst + (size_t)row * 512 + 8 * fq) = pack8(acc[ai][bj][m][0] * r, acc[ai][bj][m][1] * r);
                    if (f8pv && colg >= 512) {
                        const int c0_ = colg - 512 + 8 * fq, bb_ = row >> 13, pos_ = row & (SEQ_ - 1), key_ = pos_ & 63, k32_ = key_ & 31;
                        unsigned char* p_ = ws + WS_V8T + ((((size_t)(bb_ * 8 + (c0_ >> 6)) * 128 + (pos_ >> 6)) * 64 + (c0_ & 63)) * 64) + 32 * ((k32_ >> 2) & 1) + 16 * (key_ >> 5) + (k32_ & 3) + 4 * (k32_ >> 3);
                        const unsigned w0_ = pack4_fp8_x8(acc[ai][bj][m][0] * r), w1_ = pack4_fp8_x8(acc[ai][bj][m][1] * r);
                        const int qi_ = fr & 3; unsigned char* pb_ = p_ - qi_;
                        *(unsigned*)(pb_ + qi_ * 64) = quad_tr4(w0_, qi_); *(unsigned*)(pb_ + (4 + qi_) * 64) = quad_tr4(w1_, qi_);
                    }
                    if (f8qk && colg < 512) { u32x2 w8; w8.x = pack4_fp8_x8(acc[ai][bj][m][0] * r); w8.y = pack4_fp8_x8(acc[ai][bj][m][1] * r); *(u32x2*)(ws + WS_KN8 + (size_t)row * 512 + colg + 8 * fq) = w8; }
                }
        }
    }
};
struct EpiNull {
    static constexpr bool PERM = true, AFTER_DRAIN = false, PREFETCH = false;
    unsigned char* ws;
    __device__ __forceinline__ void operator()(const f32x4 (&acc)[2][2][4][2], const Unit& u, int wr, int wc, int fr, int fq) const {
        float s = 0.f;
#pragma unroll
        for (int ai = 0; ai < 2; ++ai)
#pragma unroll
            for (int bj = 0; bj < 2; ++bj)
#pragma unroll
                for (int m = 0; m < 4; ++m)
#pragma unroll
                    for (int n = 0; n < 2; ++n) s += acc[ai][bj][m][n][0] + acc[ai][bj][m][n][3];
        if (s == 123456.789f) *(float*)(ws + WS_SSQ) = s;
    }
};
struct MoeOrder {
    StaticOrder so; int pe[8]; size_t estride;
    __device__ __forceinline__ bool next(int i, Unit& u) const { return so.next(i, u); }
    __device__ __forceinline__ size_t boff(const Unit& u) const { int e = 0;
#pragma unroll
        for (int j = 0; j < 7; ++j) e += (u.pm * BM >= pe[j]) ? 1 : 0;
        return (size_t)e * estride; }
    __device__ __forceinline__ void a_ready(const Unit&) const {}
    __device__ __forceinline__ void done(const Unit&) const {}
};
template <class Epi, class Sched, bool ALIGN_EPI = false, bool SP2 = false, bool F8 = false>
__device__ __forceinline__ void gemm_phase(PG8_LAS unsigned char* lds, const Gemm g, const Sched& S, const Epi& E, const int tidb  ) {
    int tid_l; asm volatile("v_mbcnt_lo_u32_b32 %0, -1, 0\n\tv_mbcnt_hi_u32_b32 %0, -1, %0" : "=v"(tid_l)); tid_l += tidb;
    const int tid = tid_l, wid = __builtin_amdgcn_readfirstlane(tid >> 6), lane = tid & 63, wr = wid >> 2, wc = wid & 3, fr = lane & 15, fq = lane >> 4;
    int K_l = g.K; asm volatile("" : "+s"(K_l));
    constexpr int ES = F8 ? 1 : 2;
    const int K = K_l, nt = K * ES / (BK * 2);
    unsigned voffA[2], voffB[2];
#pragma unroll
    for (int i = 0; i < 2; ++i) { int R, C; stage_rc(tid * 16 + i * 8192, R, C); const int Rb = Epi::PERM ? ((R & ~31) + perm32(R & 31)) : R;
        voffA[i] = (unsigned)(R * K) * ES + C * 2u; voffB[i] = (unsigned)(Rb * K) * ES + C * 2u; }
    const size_t kstep = (size_t)(BK * 2);
    const size_t hstep = (size_t)HALF * K * ES;
    const size_t tstep = 2 * hstep;
    const unsigned ldsw = (unsigned)wid * 1024u;
    const int aoff = lds_byte(wr * 64 + fr, fq * 8), boff = lds_byte(wc * 32 + fr, fq * 8);
#define PG8_SA(b, h) (((b) * 2 + (h)) * HTB)
#define PG8_SB(b, h) ((4 + (b) * 2 + (h)) * HTB)
#define PG8_STAGE(bufoff, gbase, voff) do { _Pragma("unroll") for (int _i = 0; _i < 2; ++_i) \
        __builtin_amdgcn_global_load_lds((const unsigned*)((const char*)(gbase) + (voff)[_i]), (PG8_LAS unsigned*)(lds + (bufoff) + ldsw + _i * 8192), 16, 0, 0); } while (0)
#define PG8_LDA(dst, b, h) do { if constexpr (F8) { _Pragma("unroll") for (int m = 0; m < 4; ++m) _Pragma("unroll") for (int k = 0; k < 2; ++k) { const v4i32 t_ = *(const PG8_LAS v4i32*)(lds + PG8_SA(b, h) + aoff + m * 2048 + k * 1024); dst##8[m][4 * k] = t_[0]; dst##8[m][4 * k + 1] = t_[1]; dst##8[m][4 * k + 2] = t_[2]; dst##8[m][4 * k + 3] = t_[3]; } } else { _Pragma("unroll") for (int m = 0; m < 4; ++m) _Pragma("unroll") for (int k = 0; k < 2; ++k) dst[m][k] = *(const PG8_LAS bf16x8*)(lds + PG8_SA(b, h) + aoff + m * 2048 + k * 1024); } } while (0)
#define PG8_LDB(dst, b, h) do { if constexpr (F8) { _Pragma("unroll") for (int n = 0; n < 2; ++n) _Pragma("unroll") for (int k = 0; k < 2; ++k) { const v4i32 t_ = *(const PG8_LAS v4i32*)(lds + PG8_SB(b, h) + boff + n * 2048 + k * 1024); dst##8[n][4 * k] = t_[0]; dst##8[n][4 * k + 1] = t_[1]; dst##8[n][4 * k + 2] = t_[2]; dst##8[n][4 * k + 3] = t_[3]; } } else { _Pragma("unroll") for (int n = 0; n < 2; ++n) _Pragma("unroll") for (int k = 0; k < 2; ++k) dst[n][k] = *(const PG8_LAS bf16x8*)(lds + PG8_SB(b, h) + boff + n * 2048 + k * 1024); } } while (0)
#define PG8_MMA(ai, bj, At, Bt) do { __builtin_amdgcn_s_setprio(1); if constexpr (F8) { _Pragma("unroll") for (int m = 0; m < 4; ++m) _Pragma("unroll") for (int n = 0; n < 2; ++n) \
        asm volatile("v_mfma_scale_f32_16x16x128_f8f6f4 %0, %1, %2, %0, %3, %4 op_sel_hi:[0,0,0]" : "+v"(acc[ai][bj][m][n]) : "v"(Bt##8[n]), "v"(At##8[m]), "v"(sc_w), "v"(sc_h)); } else { \
        _Pragma("unroll") for (int m = 0; m < 4; ++m) _Pragma("unroll") for (int n = 0; n < 2; ++n) _Pragma("unroll") for (int k = 0; k < 2; ++k) \
        acc[ai][bj][m][n] = __builtin_amdgcn_mfma_f32_16x16x32_bf16(Bt[n][k], At[m][k], acc[ai][bj][m][n], 0, 0, 0); } __builtin_amdgcn_s_setprio(0); } while (0)
#define PG8_WAIT_V(n) asm volatile("s_waitcnt vmcnt(" #n ")" ::: "memory")
#define PG8_WAIT_L(n) asm volatile("s_waitcnt lgkmcnt(" #n ")" ::: "memory")
#define PG8_BAR __builtin_amdgcn_s_barrier()
#define PG8_SCHED __builtin_amdgcn_sched_barrier(0)
    Unit cur, nxt; int ui = 0;
    if (!S.next(0, cur)) return;
    f32x4 acc[2][2][4][2];
#pragma unroll
    for (int a = 0; a < 2; ++a)
#pragma unroll
        for (int b = 0; b < 2; ++b)
#pragma unroll
            for (int m = 0; m < 4; ++m)
#pragma unroll
                for (int n = 0; n < 2; ++n) acc[a][b][m][n] = (f32x4){0.f, 0.f, 0.f, 0.f};
    bf16x8 At[4][2], B0[2][2], B1[2][2];
    const int sc_w = g.scw, sc_h = g.sch;
    v8i32 At8[4], B08[2], B18[2];
    const char* cA = (const char*)g.A + (size_t)cur.pm * tstep; const char* cB = (const char*)g.Bt + S.boff(cur) + (size_t)cur.pn * tstep;
    S.a_ready(cur);
    if constexpr (SP2) {
        PG8_STAGE(PG8_SB(0, 0), cB, voffB); PG8_STAGE(PG8_SB(0, 1), cB + hstep, voffB); PG8_STAGE(PG8_SA(0, 0), cA, voffA); PG8_STAGE(PG8_SA(0, 1), cA + hstep, voffA);
        if (wr == 1) PG8_BAR;
        PG8_WAIT_V(2); PG8_BAR;
        PG8_STAGE(PG8_SB(1, 0), cB + kstep, voffB); PG8_STAGE(PG8_SA(1, 0), cA + kstep, voffA); PG8_STAGE(PG8_SB(1, 1), cB + hstep + kstep, voffB);
        PG8_WAIT_V(6); PG8_BAR;
    } else {
        PG8_STAGE(PG8_SB(0, 0), cB, voffB); PG8_STAGE(PG8_SA(0, 0), cA, voffA); PG8_STAGE(PG8_SB(0, 1), cB + hstep, voffB); PG8_STAGE(PG8_SA(0, 1), cA + hstep, voffA);
        if (wr == 1) PG8_BAR;
        PG8_WAIT_V(4); PG8_BAR;
        PG8_STAGE(PG8_SB(1, 0), cB + kstep, voffB); PG8_STAGE(PG8_SA(1, 0), cA + kstep, voffA); PG8_STAGE(PG8_SB(1, 1), cB + hstep + kstep, voffB);
        PG8_WAIT_V(6); PG8_BAR;
    }
    for (;;) {
        const bool has_next = S.next(ui + 1, nxt);
        const char* nA = has_next ? (const char*)g.A + (size_t)nxt.pm * tstep : cA; const char* nB = has_next ? (const char*)g.Bt + S.boff(nxt) + (size_t)nxt.pn * tstep : cB;
        for (int t = 0; t < nt; t += 2) {
            const bool last = (t == nt - 2);
            if constexpr (Epi::PREFETCH) { if (t == 0) E.prefetch(cur, wid, lane); }
            const char* a1 = cA + (size_t)(t + 1) * kstep;
            const char* a2 = last ? nA : cA + (size_t)(t + 2) * kstep; const char* b2 = last ? nB : cB + (size_t)(t + 2) * kstep;
            const char* a3 = a2 + kstep; const char* b3 = b2 + kstep;
            if (last && has_next) S.a_ready(nxt);
            if constexpr (SP2) {
            PG8_LDB(B0, 0, 0); PG8_LDB(B1, 0, 1); PG8_SCHED; PG8_LDA(At, 0, 0); PG8_STAGE(PG8_SA(1, 1), a1 + hstep, voffA);
            PG8_WAIT_V(8); PG8_WAIT_L(0); PG8_BAR; PG8_MMA(0, 0, At, B0); PG8_MMA(0, 1, At, B1); PG8_BAR; PG8_SCHED;
            PG8_LDA(At, 0, 1); PG8_STAGE(PG8_SB(0, 0), b2, voffB); PG8_STAGE(PG8_SB(0, 1), b2 + hstep, voffB); PG8_STAGE(PG8_SA(0, 0), a2, voffA);
            PG8_WAIT_V(8); PG8_WAIT_L(0); PG8_BAR; PG8_MMA(1, 0, At, B0); PG8_MMA(1, 1, At, B1); PG8_BAR; PG8_SCHED;
            PG8_LDB(B0, 1, 0); PG8_LDB(B1, 1, 1); PG8_SCHED; PG8_LDA(At, 1, 0); PG8_STAGE(PG8_SA(0, 1), a2 + hstep, voffA);
            PG8_WAIT_V(8); PG8_WAIT_L(0); PG8_BAR; PG8_MMA(0, 0, At, B0); PG8_MMA(0, 1, At, B1); PG8_BAR; PG8_SCHED;
            PG8_LDA(At, 1, 1); PG8_STAGE(PG8_SB(1, 0), b3, voffB); PG8_STAGE(PG8_SB(1, 1), b3 + hstep, voffB); PG8_STAGE(PG8_SA(1, 0), a3, voffA);
            PG8_WAIT_V(8); PG8_WAIT_L(0); PG8_BAR; PG8_MMA(1, 0, At, B0); PG8_MMA(1, 1, At, B1); PG8_BAR; PG8_SCHED;
            } else {
            PG8_LDB(B0, 0, 0); PG8_SCHED; PG8_LDA(At, 0, 0); PG8_STAGE(PG8_SA(1, 1), a1 + hstep, voffA);
            PG8_WAIT_L(8); PG8_BAR; PG8_WAIT_L(0); PG8_MMA(0, 0, At, B0); PG8_BAR; PG8_SCHED;
            PG8_LDB(B1, 0, 1); PG8_STAGE(PG8_SB(0, 0), b2, voffB);
            PG8_BAR; PG8_WAIT_L(0); PG8_MMA(0, 1, At, B1); PG8_BAR;
            PG8_LDA(At, 0, 1); PG8_STAGE(PG8_SA(0, 0), a2, voffA);
            PG8_BAR; PG8_WAIT_L(0); PG8_MMA(1, 0, At, B0); PG8_BAR; PG8_SCHED;
            PG8_STAGE(PG8_SB(0, 1), b2 + hstep, voffB);
            PG8_WAIT_V(6); PG8_BAR; PG8_MMA(1, 1, At, B1); PG8_BAR;
            PG8_LDB(B0, 1, 0); PG8_SCHED; PG8_LDA(At, 1, 0); PG8_STAGE(PG8_SA(0, 1), a2 + hstep, voffA);
            PG8_WAIT_L(8); PG8_BAR; PG8_WAIT_L(0); PG8_MMA(0, 0, At, B0); PG8_BAR; PG8_SCHED;
            PG8_LDB(B1, 1, 1); PG8_STAGE(PG8_SB(1, 0), b3, voffB);
            PG8_BAR; PG8_WAIT_L(0); PG8_MMA(0, 1, At, B1); PG8_BAR;
            PG8_LDA(At, 1, 1); PG8_STAGE(PG8_SA(1, 0), a3, voffA);
            PG8_BAR; PG8_WAIT_L(0); PG8_MMA(1, 0, At, B0); PG8_BAR; PG8_SCHED;
            PG8_STAGE(PG8_SB(1, 1), b3 + hstep, voffB);
            PG8_WAIT_V(6); PG8_BAR; PG8_MMA(1, 1, At, B1); PG8_BAR;
            }
        }
        if constexpr (ALIGN_EPI) { if (wr == 0) PG8_BAR; }
        if constexpr (F8) asm volatile("s_nop 15\n\ts_nop 15" ::: "memory");
        if constexpr (!Epi::AFTER_DRAIN) { E(acc, cur, wr, wc, fr, fq); S.done(cur); }
        if (!has_next) break;
#pragma unroll
        for (int a = 0; a < 2; ++a)
#pragma unroll
            for (int b = 0; b < 2; ++b)
#pragma unroll
                for (int m = 0; m < 4; ++m)
#pragma unroll
                    for (int n = 0; n < 2; ++n) acc[a][b][m][n] = (f32x4){0.f, 0.f, 0.f, 0.f};
        cur = nxt; cA = nA; cB = nB; ++ui;
        if constexpr (ALIGN_EPI) { if (wr == 1) PG8_BAR; }
    }
    PG8_WAIT_V(0);
    if constexpr (!ALIGN_EPI) { if (wr == 0) PG8_BAR; }
    PG8_BAR;
    if constexpr (Epi::AFTER_DRAIN) { E.fused(acc, cur, wr, wc, fr, fq, lds, wid, lane); S.done(cur); }
#undef PG8_SA
#undef PG8_SB
#undef PG8_STAGE
#undef PG8_LDA
#undef PG8_LDB
#undef PG8_MMA
#undef PG8_WAIT_V
#undef PG8_WAIT_L
#undef PG8_BAR
#undef PG8_SCHED
}
}
namespace att {
#define ALAS __attribute__((address_space(3)))
using bf16 = unsigned short;
using bf16x8 = __attribute__((ext_vector_type(8))) short;
using s16x4 = __attribute__((ext_vector_type(4))) short;
using f32x16 = __attribute__((ext_vector_type(16))) float;
using u32x4 = __attribute__((ext_vector_type(4))) unsigned;
typedef unsigned v2u32 __attribute__((ext_vector_type(2)));
typedef short v4i16_t __attribute__((ext_vector_type(4)));
typedef float f32x2_t __attribute__((ext_vector_type(2))); typedef __bf16 bf16x2_t __attribute__((ext_vector_type(2)));
constexpr int SEQ = 8192;
constexpr int KSLOT_MAX = 12288, VSLOT = 8192;
constexpr int L_K = 0, L_V = 3 * KSLOT_MAX, L_WS = L_V + 2 * VSLOT, L_OST = L_WS + 8 * 256, L_BIAS = L_OST + 8 * 4096, L_END = L_BIAS + 1280;
constexpr float LOG2E = 1.4426950408889634f;
struct Args { const bf16* Q; const bf16* KN; const bf16* KR; const bf16* V; const bf16* QB; const bf16* KB; const bf16* VB; bf16* AO; const float* bias; int f8; const unsigned char* Q8; const unsigned char* KN8; const unsigned char* KR8; const unsigned char* ZERO; int qk8; const unsigned char* V8T; int pv8; const unsigned char* QB8; const unsigned char* KB8; const unsigned char* VB8T; int cpv8; };

__device__ __forceinline__ int crow(int r, int hi) { return (r & 3) + 8 * (r >> 2) + 4 * hi; }
__device__ __forceinline__ void glds16(const void* gsrc, unsigned lds_dst) { unsigned keep;
    asm volatile("s_mov_b32 %0, m0\n\ts_mov_b32 m0, %2\n\ts_nop 0\n\tglobal_load_lds_dwordx4 %1, off\n\ts_mov_b32 m0, %0" : "=&s"(keep) : "v"(gsrc), "s"(lds_dst) : "memory"); }
__device__ __forceinline__ unsigned cvtpk(float lo, float hi) { f32x2_t v = {lo, hi}; bf16x2_t b = __builtin_convertvector(v, bf16x2_t); return __builtin_bit_cast(unsigned, b); }
__device__ __forceinline__ s16x4 vtr(ALAS const char* p) { return __builtin_bit_cast(s16x4, __builtin_amdgcn_ds_read_tr16_b64_v4i16((ALAS v4i16_t*)p)); }
__device__ __forceinline__ float xhalf_max(float m) { auto rr = __builtin_amdgcn_permlane32_swap(__float_as_uint(m), __float_as_uint(m), false, false); return fmaxf(__uint_as_float(rr[0]), __uint_as_float(rr[1])); }
__device__ __forceinline__ float xhalf_sum(float m) { auto rr = __builtin_amdgcn_permlane32_swap(__float_as_uint(m), __float_as_uint(m), false, false); return __uint_as_float(rr[0]) + __uint_as_float(rr[1]); }
#define ATT_WAIT_BAR() asm volatile("s_waitcnt vmcnt(0) lgkmcnt(0)\n\ts_barrier" ::: "memory")
__device__ __forceinline__ float max3f(float a, float b, float c) { float r; asm volatile("v_max3_f32 %0, %1, %2, %3" : "=v"(r) : "v"(a), "v"(b), "v"(c)); return r; }
__device__ __forceinline__ float max2f(float a, float b) { float r; asm volatile("v_max_f32_e32 %0, %1, %2" : "=v"(r) : "v"(a), "v"(b)); return r; }
__device__ __forceinline__ float fadd_s(float a, float b) { float r; asm volatile("v_add_f32_e32 %0, %1, %2" : "=v"(r) : "v"(a), "v"(b)); return r; }

__device__ __forceinline__ void write_o(const Args& A, const f32x16& o0, const f32x16& o1, ALAS float* wsf, ALAS char* shm, int wid, int lane, int r32, int hi, long row0, int col0) {
    if (A.f8) {
        ALAS unsigned char* stg = (ALAS unsigned char*)(shm + L_OST) + wid * 4096;
#pragma unroll
        for (int r = 0; r < 16; ++r) { const int orow = crow(r, hi); const float rl = __builtin_amdgcn_rcpf(wsf[32 + orow]) * 8.0f;
            const int w = __builtin_amdgcn_cvt_pk_fp8_f32(__builtin_amdgcn_fmed3f(o0[r] * rl, -448.f, 448.f), __builtin_amdgcn_fmed3f(o1[r] * rl, -448.f, 448.f), 0, false);
            stg[orow * 64 + r32] = (unsigned char)(w & 0xff); stg[orow * 64 + 32 + r32] = (unsigned char)((w >> 8) & 0xff); }
        asm volatile("s_waitcnt lgkmcnt(0)" ::: "memory");
        unsigned char* Ow = (unsigned char*)A.AO + row0 * 1024 + col0;
#pragma unroll
        for (int i = 0; i < 2; ++i) { const int row = i * 16 + (lane >> 2), ch = lane & 3; const u32x4 v = *(ALAS const u32x4*)(stg + row * 64 + ch * 16); *(u32x4*)(Ow + (long)row * 1024 + ch * 16) = v; }
    } else {
        ALAS bf16* stg = (ALAS bf16*)(shm + L_OST) + wid * 2048;
#pragma unroll
        for (int r = 0; r < 16; ++r) { const int orow = crow(r, hi); const float rl = __builtin_amdgcn_rcpf(wsf[32 + orow]);
            stg[orow * 64 + r32] = (bf16)(cvtpk(o0[r] * rl, 0.f) & 0xffffu); stg[orow * 64 + 32 + r32] = (bf16)(cvtpk(o1[r] * rl, 0.f) & 0xffffu); }
        asm volatile("s_waitcnt lgkmcnt(0)" ::: "memory");
        bf16* Ow = A.AO + row0 * 1024 + col0;
#pragma unroll
        for (int i = 0; i < 4; ++i) { const int row = i * 8 + (lane >> 3), ch = lane & 7; const u32x4 v = *(ALAS const u32x4*)(stg + row * 64 + ch * 8); *(u32x4*)(Ow + (long)row * 1024 + ch * 8) = v; }
    }
}

template <bool CHUNK>
__device__ __forceinline__ void attn_unit(const Args& A, int b, int h, int qb, ALAS char* shm, const int tidb) {
    constexpr int NDK = CHUNK ? 4 : 6, KSLOT = NDK * 2048;
    constexpr float THR = 8.0f;
    int tid_l; asm volatile("v_mbcnt_lo_u32_b32 %0, -1, 0\n\tv_mbcnt_hi_u32_b32 %0, -1, %0" : "=v"(tid_l)); tid_l += tidb;
    const int tid = tid_l, lane = tid & 63, r32 = lane & 31, hi = lane >> 5;
    const int wid = __builtin_amdgcn_readfirstlane(tid >> 6);
    const long rowbase = (long)b * SEQ; const int q0 = qb * 256;
    const unsigned lds0 = (unsigned)(size_t)shm;
    ALAS float* wsf = (ALAS float*)(shm + L_WS) + wid * 64;
    ALAS float* bt = (ALAS float*)(shm + L_BIAS);
    const bf16* ksrc = (CHUNK ? A.KB : A.KN) + (rowbase + lane) * 512 + h * 64 + wid * 8;
    const bf16* krsrc = A.KR + (rowbase + lane) * 32 + (wid & 3) * 8;
    const bf16* vsrc = (CHUNK ? A.VB : A.V) + (rowbase + 16 * (wid & 3) + (lane >> 2)) * 512 + h * 64 + (wid >> 2) * 32 + (lane & 3) * 8;
    const unsigned kdst = lds0 + L_K + wid * 1024, krdst = lds0 + L_K + (8 + (wid & 3)) * 1024, vdst = lds0 + L_V + wid * 1024;
#define ATT_ISSUE_K(t, s) do { glds16(ksrc + (long)(t) * 64 * 512, (unsigned)__builtin_amdgcn_readfirstlane(kdst + (s) * KSLOT)); \
        if (!CHUNK && wid < 4) glds16(krsrc + (long)(t) * 64 * 32, (unsigned)__builtin_amdgcn_readfirstlane(krdst + (s) * KSLOT)); } while (0)
#define ATT_ISSUE_V(t, s) glds16(vsrc + (long)(t) * 64 * 512, (unsigned)__builtin_amdgcn_readfirstlane(vdst + (s) * VSLOT))
    const int t_end = 4 * qb + 4, t_begin = CHUNK ? (4 * qb - 8 > 0 ? 4 * qb - 8 : 0) : 0;
    const int cw = 4 * qb + (wid >> 1);
    const int vis_lo = CHUNK ? (cw - 8 > 0 ? cw - 8 : 0) : 0;
    if (CHUNK) { if (tid < 257) bt[tid] = A.bias[h * 257 + tid] * LOG2E; }
    ATT_ISSUE_K(t_begin, 0); ATT_ISSUE_V(t_begin, 0); ATT_ISSUE_K(t_begin + 1, 1);
    const bf16* Qw = CHUNK ? A.QB + (rowbase + q0 + wid * 32 + r32) * 512 + h * 64 + hi * 8 : A.Q + (rowbase + q0 + wid * 32 + r32) * 768 + h * 96 + hi * 8;
    bf16x8 qr[NDK];
#pragma unroll
    for (int d0 = 0; d0 < NDK; ++d0) qr[d0] = *(const bf16x8*)(Qw + d0 * 16);
    float mhat = 0.f, lsum = 0.f; f32x16 o0 = {}, o1 = {}; bool first = true;
    const int vbo = ((lane >> 4) & 1) * 32 + (lane & 3) * 8 + (4 * hi + ((lane & 15) >> 2)) * 64;
    ALAS const char* Kfr = shm + L_K + hi * 1024 + r32 * 16;
#define ATT_QK(C0, C1, t, slot) do { float cinit = -mhat; if (CHUNK) { if ((t) < cw - 2) cinit += bt[256]; } \
        _Pragma("unroll") for (int r = 0; r < 16; ++r) { C0[r] = cinit; C1[r] = cinit; } \
        ALAS const char* Ks_ = Kfr + (slot) * KSLOT; \
        _Pragma("unroll") for (int d0 = 0; d0 < NDK; ++d0) { const bf16x8 a0 = *(ALAS const bf16x8*)(Ks_ + d0 * 2048), a1 = *(ALAS const bf16x8*)(Ks_ + d0 * 2048 + 512); \
            C0 = __builtin_amdgcn_mfma_f32_32x32x16_bf16(a0, qr[d0], C0, 0, 0, 0); C1 = __builtin_amdgcn_mfma_f32_32x32x16_bf16(a1, qr[d0], C1, 0, 0, 0); } } while (0)
    ATT_WAIT_BAR();
    f32x16 c0, c1;
    if (t_begin >= vis_lo) ATT_QK(c0, c1, t_begin, 0);
    int ks = 0, vs = 0;
    for (int t = t_begin; t < t_end; ++t) {
        const int ks1 = ks == 2 ? 0 : ks + 1, ks2 = ks1 == 2 ? 0 : ks1 + 1;
        if (t + 2 < t_end) ATT_ISSUE_K(t + 2, ks2);
        if (t + 1 < t_end) ATT_ISSUE_V(t + 1, vs ^ 1);
        const bool vis = (t >= vis_lo && t <= cw), visn = (t + 1 >= vis_lo && t + 1 <= cw);
        if (vis) {
            if (CHUNK) { if (t >= cw - 2) {
                const int dq = 64 * (cw - t) + 32 * (wid & 1) + r32 + 128;
#pragma unroll
                for (int r = 0; r < 16; ++r) { int i0 = dq - crow(r, hi), i1 = i0 - 32; i0 = i0 < 0 ? 0 : (i0 > 256 ? 256 : i0); i1 = i1 < 0 ? 0 : (i1 > 256 ? 256 : i1); c0[r] += bt[i0]; c1[r] += bt[i1]; }
            } }
            float rmp[4];
#pragma unroll
            for (int j = 0; j < 4; ++j) rmp[j] = fmaxf(fmaxf(c0[j], c1[j]), fmaxf(c0[4 + j], c1[4 + j]));
#pragma unroll
            for (int j = 0; j < 4; ++j) rmp[j] = fmaxf(rmp[j], fmaxf(fmaxf(c0[8 + j], c1[8 + j]), fmaxf(c0[12 + j], c1[12 + j])));
            float rm = xhalf_max(fmaxf(fmaxf(rmp[0], rmp[1]), fmaxf(rmp[2], rmp[3])));
            if (first) { first = false; mhat = rm;
#pragma unroll
                for (int r = 0; r < 16; ++r) { c0[r] -= rm; c1[r] -= rm; }
            } else if (__any(rm > THR)) {
                const float dl = fmaxf(rm, 0.f); mhat += dl;
#pragma unroll
                for (int r = 0; r < 16; ++r) { c0[r] -= dl; c1[r] -= dl; }
                const float f = __builtin_amdgcn_exp2f(-dl); lsum *= f;
                if (hi == 0) wsf[r32] = f;
                asm volatile("s_waitcnt lgkmcnt(0)" ::: "memory");
#pragma unroll
                for (int r = 0; r < 16; ++r) { const float fr_ = wsf[crow(r, hi)]; o0[r] *= fr_; o1[r] *= fr_; }
            }
        }
        f32x16 n0, n1;
        if (vis && visn) {
            ALAS const char* Ks_ = Kfr + ks1 * KSLOT;
            bf16x8 ka = *(ALAS const bf16x8*)(Ks_), kb = *(ALAS const bf16x8*)(Ks_ + 512);
            float cinit = -mhat; if (CHUNK) { if (t + 1 < cw - 2) cinit += bt[256]; }
#pragma unroll
            for (int r = 0; r < 16; ++r) { n0[r] = cinit; n1[r] = cinit; }
            __builtin_amdgcn_sched_barrier(0);
            constexpr int NM = 2 * NDK;
#pragma unroll
            for (int d0 = 0; d0 < NDK; ++d0) {
                bf16x8 na = ka, nb = kb;
                if (d0 + 1 < NDK) { na = *(ALAS const bf16x8*)(Ks_ + (d0 + 1) * 2048); nb = *(ALAS const bf16x8*)(Ks_ + (d0 + 1) * 2048 + 512); }
                n0 = __builtin_amdgcn_mfma_f32_32x32x16_bf16(ka, qr[d0], n0, 0, 0, 0);
#pragma unroll
                for (int e = 0; e < 32; ++e) if (e * NM / 32 == 2 * d0) { if (e < 16) c0[e] = __builtin_amdgcn_exp2f(c0[e]); else c1[e - 16] = __builtin_amdgcn_exp2f(c1[e - 16]); }
                __builtin_amdgcn_sched_barrier(0);
                n1 = __builtin_amdgcn_mfma_f32_32x32x16_bf16(kb, qr[d0], n1, 0, 0, 0);
#pragma unroll
                for (int e = 0; e < 32; ++e) if (e * NM / 32 == 2 * d0 + 1) { if (e < 16) c0[e] = __builtin_amdgcn_exp2f(c0[e]); else c1[e - 16] = __builtin_amdgcn_exp2f(c1[e - 16]); }
                __builtin_amdgcn_sched_barrier(0);
                ka = na; kb = nb;
            }
            ALAS const char* vb = shm + L_V + vs * VSLOT + vbo;
            s16x4 vl[8], vh[8];
#pragma unroll
            for (int kk = 0; kk < 4; ++kk) { vl[kk] = vtr(vb + kk * 1024); vh[kk] = vtr(vb + kk * 1024 + 512); vl[4 + kk] = vtr(vb + 4096 + kk * 1024); vh[4 + kk] = vtr(vb + 4096 + kk * 1024 + 512); }
            float sacc4[4];
#pragma unroll
            for (int kk = 0; kk < 4; ++kk) {
                u32x4 pw;
                if (kk < 2) { pw = (u32x4){cvtpk(c0[8 * kk], c0[8 * kk + 1]), cvtpk(c0[8 * kk + 2], c0[8 * kk + 3]), cvtpk(c0[8 * kk + 4], c0[8 * kk + 5]), cvtpk(c0[8 * kk + 6], c0[8 * kk + 7])};
                    sacc4[kk] = ((c0[8 * kk] + c0[8 * kk + 1]) + (c0[8 * kk + 2] + c0[8 * kk + 3])) + ((c0[8 * kk + 4] + c0[8 * kk + 5]) + (c0[8 * kk + 6] + c0[8 * kk + 7])); }
                else { const int k2 = kk - 2; pw = (u32x4){cvtpk(c1[8 * k2], c1[8 * k2 + 1]), cvtpk(c1[8 * k2 + 2], c1[8 * k2 + 3]), cvtpk(c1[8 * k2 + 4], c1[8 * k2 + 5]), cvtpk(c1[8 * k2 + 6], c1[8 * k2 + 7])};
                    sacc4[kk] = ((c1[8 * k2] + c1[8 * k2 + 1]) + (c1[8 * k2 + 2] + c1[8 * k2 + 3])) + ((c1[8 * k2 + 4] + c1[8 * k2 + 5]) + (c1[8 * k2 + 6] + c1[8 * k2 + 7])); }
                const bf16x8 v0 = (bf16x8){vl[kk][0], vl[kk][1], vl[kk][2], vl[kk][3], vh[kk][0], vh[kk][1], vh[kk][2], vh[kk][3]}, v1 = (bf16x8){vl[4 + kk][0], vl[4 + kk][1], vl[4 + kk][2], vl[4 + kk][3], vh[4 + kk][0], vh[4 + kk][1], vh[4 + kk][2], vh[4 + kk][3]};
                o0 = __builtin_amdgcn_mfma_f32_32x32x16_bf16(__builtin_bit_cast(bf16x8, pw), v0, o0, 0, 0, 0);
                o1 = __builtin_amdgcn_mfma_f32_32x32x16_bf16(__builtin_bit_cast(bf16x8, pw), v1, o1, 0, 0, 0);
                __builtin_amdgcn_sched_barrier(0);
            }
            lsum += (sacc4[0] + sacc4[1]) + (sacc4[2] + sacc4[3]);
        } else {
        if (visn) ATT_QK(n0, n1, t + 1, ks1);
        if (vis) {
            float sacc = 0.f;
#pragma unroll
            for (int r = 0; r < 16; ++r) { c0[r] = __builtin_amdgcn_exp2f(c0[r]); c1[r] = __builtin_amdgcn_exp2f(c1[r]); sacc += c0[r] + c1[r]; }
            lsum += sacc;
            u32x4 pw[4];
#pragma unroll
            for (int k = 0; k < 2; ++k) {
                pw[k]     = (u32x4){cvtpk(c0[8 * k], c0[8 * k + 1]), cvtpk(c0[8 * k + 2], c0[8 * k + 3]), cvtpk(c0[8 * k + 4], c0[8 * k + 5]), cvtpk(c0[8 * k + 6], c0[8 * k + 7])};
                pw[2 + k] = (u32x4){cvtpk(c1[8 * k], c1[8 * k + 1]), cvtpk(c1[8 * k + 2], c1[8 * k + 3]), cvtpk(c1[8 * k + 4], c1[8 * k + 5]), cvtpk(c1[8 * k + 6], c1[8 * k + 7])};
            }
            ALAS const char* vb = shm + L_V + vs * VSLOT + vbo;
#pragma unroll
            for (int kk = 0; kk < 4; ++kk) {
                const s16x4 l0 = vtr(vb + kk * 1024), h0 = vtr(vb + kk * 1024 + 512), l1 = vtr(vb + 4096 + kk * 1024), h1 = vtr(vb + 4096 + kk * 1024 + 512);
                const bf16x8 v0 = (bf16x8){l0[0], l0[1], l0[2], l0[3], h0[0], h0[1], h0[2], h0[3]}, v1 = (bf16x8){l1[0], l1[1], l1[2], l1[3], h1[0], h1[1], h1[2], h1[3]};
                o0 = __builtin_amdgcn_mfma_f32_32x32x16_bf16(__builtin_bit_cast(bf16x8, pw[kk]), v0, o0, 0, 0, 0);
                o1 = __builtin_amdgcn_mfma_f32_32x32x16_bf16(__builtin_bit_cast(bf16x8, pw[kk]), v1, o1, 0, 0, 0);
            }
        }
        }
        if (visn) { c0 = n0; c1 = n1; }
        ks = ks1; vs ^= 1;
        ATT_WAIT_BAR();
    }
    const float lt = xhalf_sum(lsum);
    if (hi == 0) wsf[32 + r32] = lt;
    asm volatile("s_waitcnt lgkmcnt(0)" ::: "memory");
    write_o(A, o0, o1, wsf, shm, wid, lane, r32, hi, rowbase + q0 + wid * 32, (CHUNK ? 512 : 0) + h * 64);
    asm volatile("s_waitcnt lgkmcnt(0)\n\ts_barrier" ::: "memory");
#undef ATT_ISSUE_K
#undef ATT_ISSUE_V
#undef ATT_QK
}

__device__ __forceinline__ bf16x8 cvt8_fp8_bf16(const v2u32 w, const float sc) {
    const f32x2_t a = __builtin_amdgcn_cvt_pk_f32_fp8((int)w.x, false), b2 = __builtin_amdgcn_cvt_pk_f32_fp8((int)w.x, true), c = __builtin_amdgcn_cvt_pk_f32_fp8((int)w.y, false), d = __builtin_amdgcn_cvt_pk_f32_fp8((int)w.y, true);
    const u32x4 r = {cvtpk(a[0] * sc, a[1] * sc), cvtpk(b2[0] * sc, b2[1] * sc), cvtpk(c[0] * sc, c[1] * sc), cvtpk(d[0] * sc, d[1] * sc)}; return __builtin_bit_cast(bf16x8, r); }
__device__ __forceinline__ bf16x8 kfrag8(ALAS const char* slot, const int d0, const int kh, const int r32, const int hi) {
    const int m = d0 < 4 ? 0 : 1, dd = d0 < 4 ? d0 : d0 - 4;
    return cvt8_fp8_bf16(*(ALAS const v2u32*)(slot + ((m * 2 + kh) * 2 + (dd & 1)) * 1024 + ((dd >> 1) * 32 + r32) * 16 + 8 * hi), 1.0f); }
__device__ __forceinline__ void attn_unit8(const Args& A, int b, int h, int qb, ALAS char* shm, const int tidb) {
    constexpr bool CHUNK = false;
    constexpr int NDK = 6, KSLOT = 8192;
    constexpr float THR = 8.0f;
    int tid_l; asm volatile("v_mbcnt_lo_u32_b32 %0, -1, 0\n\tv_mbcnt_hi_u32_b32 %0, -1, %0" : "=v"(tid_l)); tid_l += tidb;
    const int tid = tid_l, lane = tid & 63, r32 = lane & 31, hi = lane >> 5;
    const int wid = __builtin_amdgcn_readfirstlane(tid >> 6);
    const long rowbase = (long)b * SEQ; const int q0 = qb * 256;
    const unsigned lds0 = (unsigned)(size_t)shm;
    ALAS float* wsf = (ALAS float*)(shm + L_WS) + wid * 64;
    ALAS float* bt = (ALAS float*)(shm + L_BIAS);
    const int m_ = wid >> 2, kh_ = (wid >> 1) & 1, j_ = wid & 1;
    const long krow_ = rowbase + 32 * kh_ + r32;
    const unsigned char* ks8 = m_ == 0 ? A.KN8 + krow_ * 512 + h * 64 + 32 * hi + 16 * j_ : (hi == 0 ? A.KR8 + krow_ * 32 + 16 * j_ : A.ZERO + r32 * 16);
    const int kst8 = m_ == 0 ? 64 * 512 : (hi == 0 ? 64 * 32 : 0);
    const unsigned vo8 = (unsigned)(((b * 8 + h) * 128 * 64 + 32 * ((wid >> 1) & 1) + r32) * 64 + 32 * hi + 16 * (wid & 1));
    const unsigned kdst = lds0 + L_K + wid * 1024, krdst = lds0 + L_K + (8 + (wid & 3)) * 1024, vdst = lds0 + L_V + wid * 1024;
#define ATT_ISSUE_K(t, s) glds16(ks8 + (long)((t) * kst8), (unsigned)__builtin_amdgcn_readfirstlane(kdst + (s) * KSLOT))
#define ATT_ISSUE_V(t, s) do { if (wid < 4) glds16(A.V8T + (size_t)(vo8 + (unsigned)(t) * 4096u), (unsigned)__builtin_amdgcn_readfirstlane(vdst + (s) * VSLOT)); } while (0)
#define A8_VFRAG(vbase, oh, kk) cvt8_fp8_bf16(*(ALAS const v2u32*)((vbase) + ((oh) * 2 + ((kk) >> 1)) * 1024 + (hi * 32 + r32) * 16 + 8 * ((kk) & 1)), 0.125f)
    const int t_end = 4 * qb + 4, t_begin = CHUNK ? (4 * qb - 8 > 0 ? 4 * qb - 8 : 0) : 0;
    const int cw = 4 * qb + (wid >> 1);
    const int vis_lo = CHUNK ? (cw - 8 > 0 ? cw - 8 : 0) : 0;
    if (CHUNK) { if (tid < 257) bt[tid] = A.bias[h * 257 + tid] * LOG2E; }
    ATT_ISSUE_K(t_begin, 0); ATT_ISSUE_V(t_begin, 0); ATT_ISSUE_K(t_begin + 1, 1);
    const bf16* Qw = CHUNK ? A.QB + (rowbase + q0 + wid * 32 + r32) * 512 + h * 64 + hi * 8 : A.Q + (rowbase + q0 + wid * 32 + r32) * 768 + h * 96 + hi * 8;
    const unsigned char* Q8w = A.Q8 + (rowbase + q0 + wid * 32 + r32) * 768 + h * 96 + 8 * hi; (void)Qw;
    bf16x8 qr[NDK];
#pragma unroll
    for (int d0 = 0; d0 < NDK; ++d0) qr[d0] = cvt8_fp8_bf16(*(const v2u32*)(Q8w + 16 * d0), 1.0f / 128.0f);
    float mhat = 0.f, lsum = 0.f; f32x16 o0 = {}, o1 = {}; bool first = true;
    const int vbo = ((lane >> 4) & 1) * 32 + (lane & 3) * 8 + (4 * hi + ((lane & 15) >> 2)) * 64;
    ALAS const char* Kfr = shm + L_K;
#define ATT_QK(C0, C1, t, slot) do { float cinit = -mhat; if (CHUNK) { if ((t) < cw - 2) cinit += bt[256]; } \
        _Pragma("unroll") for (int r = 0; r < 16; ++r) { C0[r] = cinit; C1[r] = cinit; } \
        ALAS const char* Ks_ = Kfr + (slot) * KSLOT; \
        _Pragma("unroll") for (int d0 = 0; d0 < NDK; ++d0) { const bf16x8 a0 = kfrag8(Ks_, d0, 0, r32, hi), a1 = kfrag8(Ks_, d0, 1, r32, hi); \
            C0 = __builtin_amdgcn_mfma_f32_32x32x16_bf16(a0, qr[d0], C0, 0, 0, 0); C1 = __builtin_amdgcn_mfma_f32_32x32x16_bf16(a1, qr[d0], C1, 0, 0, 0); } } while (0)
    ATT_WAIT_BAR();
    f32x16 c0, c1;
    if (t_begin >= vis_lo) ATT_QK(c0, c1, t_begin, 0);
    int ks = 0, vs = 0;
    for (int t = t_begin; t < t_end; ++t) {
        const int ks1 = ks == 2 ? 0 : ks + 1, ks2 = ks1 == 2 ? 0 : ks1 + 1;
        if (t + 2 < t_end) ATT_ISSUE_K(t + 2, ks2);
        if (t + 1 < t_end) ATT_ISSUE_V(t + 1, vs ^ 1);
        const bool vis = (t >= vis_lo && t <= cw), visn = (t + 1 >= vis_lo && t + 1 <= cw);
        if (vis) {
            if (CHUNK) { if (t >= cw - 2) {
                const int dq = 64 * (cw - t) + 32 * (wid & 1) + r32 + 128;
#pragma unroll
                for (int r = 0; r < 16; ++r) { int i0 = dq - crow(r, hi), i1 = i0 - 32; i0 = i0 < 0 ? 0 : (i0 > 256 ? 256 : i0); i1 = i1 < 0 ? 0 : (i1 > 256 ? 256 : i1); c0[r] += bt[i0]; c1[r] += bt[i1]; }
            } }
            float rmp[4];
#pragma unroll
            for (int j = 0; j < 4; ++j) rmp[j] = fmaxf(fmaxf(c0[j], c1[j]), fmaxf(c0[4 + j], c1[4 + j]));
#pragma unroll
            for (int j = 0; j < 4; ++j) rmp[j] = fmaxf(rmp[j], fmaxf(fmaxf(c0[8 + j], c1[8 + j]), fmaxf(c0[12 + j], c1[12 + j])));
            float rm = xhalf_max(fmaxf(fmaxf(rmp[0], rmp[1]), fmaxf(rmp[2], rmp[3])));
            if (first) { first = false; mhat = rm;
#pragma unroll
                for (int r = 0; r < 16; ++r) { c0[r] -= rm; c1[r] -= rm; }
            } else if (__any(rm > THR)) {
                const float dl = fmaxf(rm, 0.f); mhat += dl;
#pragma unroll
                for (int r = 0; r < 16; ++r) { c0[r] -= dl; c1[r] -= dl; }
                const float f = __builtin_amdgcn_exp2f(-dl); lsum *= f;
                if (hi == 0) wsf[r32] = f;
                asm volatile("s_waitcnt lgkmcnt(0)" ::: "memory");
#pragma unroll
                for (int r = 0; r < 16; ++r) { const float fr_ = wsf[crow(r, hi)]; o0[r] *= fr_; o1[r] *= fr_; }
            }
        }
        f32x16 n0, n1;
        if (vis && visn) {
            ALAS const char* Ks_ = Kfr + ks1 * KSLOT;
            bf16x8 ka = kfrag8(Ks_, 0, 0, r32, hi), kb = kfrag8(Ks_, 0, 1, r32, hi);
            float cinit = -mhat; if (CHUNK) { if (t + 1 < cw - 2) cinit += bt[256]; }
#pragma unroll
            for (int r = 0; r < 16; ++r) { n0[r] = cinit; n1[r] = cinit; }
            __builtin_amdgcn_sched_barrier(0);
            constexpr int NM = 2 * NDK;
#pragma unroll
            for (int d0 = 0; d0 < NDK; ++d0) {
                bf16x8 na = ka, nb = kb;
                if (d0 + 1 < NDK) { na = kfrag8(Ks_, d0 + 1, 0, r32, hi); nb = kfrag8(Ks_, d0 + 1, 1, r32, hi); }
                n0 = __builtin_amdgcn_mfma_f32_32x32x16_bf16(ka, qr[d0], n0, 0, 0, 0);
#pragma unroll
                for (int e = 0; e < 32; ++e) if (e * NM / 32 == 2 * d0) { if (e < 16) c0[e] = __builtin_amdgcn_exp2f(c0[e]); else c1[e - 16] = __builtin_amdgcn_exp2f(c1[e - 16]); }
                __builtin_amdgcn_sched_barrier(0);
                n1 = __builtin_amdgcn_mfma_f32_32x32x16_bf16(kb, qr[d0], n1, 0, 0, 0);
#pragma unroll
                for (int e = 0; e < 32; ++e) if (e * NM / 32 == 2 * d0 + 1) { if (e < 16) c0[e] = __builtin_amdgcn_exp2f(c0[e]); else c1[e - 16] = __builtin_amdgcn_exp2f(c1[e - 16]); }
                __builtin_amdgcn_sched_barrier(0);
                ka = na; kb = nb;
            }
            ALAS const char* vb = shm + L_V + vs * VSLOT;
            float sacc4[4];
#pragma unroll
            for (int kk = 0; kk < 4; ++kk) {
                u32x4 pw;
                if (kk < 2) { pw = (u32x4){cvtpk(c0[8 * kk], c0[8 * kk + 1]), cvtpk(c0[8 * kk + 2], c0[8 * kk + 3]), cvtpk(c0[8 * kk + 4], c0[8 * kk + 5]), cvtpk(c0[8 * kk + 6], c0[8 * kk + 7])};
                    sacc4[kk] = ((c0[8 * kk] + c0[8 * kk + 1]) + (c0[8 * kk + 2] + c0[8 * kk + 3])) + ((c0[8 * kk + 4] + c0[8 * kk + 5]) + (c0[8 * kk + 6] + c0[8 * kk + 7])); }
                else { const int k2 = kk - 2; pw = (u32x4){cvtpk(c1[8 * k2], c1[8 * k2 + 1]), cvtpk(c1[8 * k2 + 2], c1[8 * k2 + 3]), cvtpk(c1[8 * k2 + 4], c1[8 * k2 + 5]), cvtpk(c1[8 * k2 + 6], c1[8 * k2 + 7])};
                    sacc4[kk] = ((c1[8 * k2] + c1[8 * k2 + 1]) + (c1[8 * k2 + 2] + c1[8 * k2 + 3])) + ((c1[8 * k2 + 4] + c1[8 * k2 + 5]) + (c1[8 * k2 + 6] + c1[8 * k2 + 7])); }
                const bf16x8 v0 = A8_VFRAG(vb, 0, kk), v1 = A8_VFRAG(vb, 1, kk);
                o0 = __builtin_amdgcn_mfma_f32_32x32x16_bf16(__builtin_bit_cast(bf16x8, pw), v0, o0, 0, 0, 0);
                o1 = __builtin_amdgcn_mfma_f32_32x32x16_bf16(__builtin_bit_cast(bf16x8, pw), v1, o1, 0, 0, 0);
                __builtin_amdgcn_sched_barrier(0);
            }
            lsum += (sacc4[0] + sacc4[1]) + (sacc4[2] + sacc4[3]);
        } else {
        if (visn) ATT_QK(n0, n1, t + 1, ks1);
        if (vis) {
            float sacc = 0.f;
#pragma unroll
            for (int r = 0; r < 16; ++r) { c0[r] = __builtin_amdgcn_exp2f(c0[r]); c1[r] = __builtin_amdgcn_exp2f(c1[r]); sacc += c0[r] + c1[r]; }
            lsum += sacc;
            u32x4 pw[4];
#pragma unroll
            for (int k = 0; k < 2; ++k) {
                pw[k]     = (u32x4){cvtpk(c0[8 * k], c0[8 * k + 1]), cvtpk(c0[8 * k + 2], c0[8 * k + 3]), cvtpk(c0[8 * k + 4], c0[8 * k + 5]), cvtpk(c0[8 * k + 6], c0[8 * k + 7])};
                pw[2 + k] = (u32x4){cvtpk(c1[8 * k], c1[8 * k + 1]), cvtpk(c1[8 * k + 2], c1[8 * k + 3]), cvtpk(c1[8 * k + 4], c1[8 * k + 5]), cvtpk(c1[8 * k + 6], c1[8 * k + 7])};
            }
            ALAS const char* vb = shm + L_V + vs * VSLOT;
#pragma unroll
            for (int kk = 0; kk < 4; ++kk) {
                const bf16x8 v0 = A8_VFRAG(vb, 0, kk), v1 = A8_VFRAG(vb, 1, kk);
                o0 = __builtin_amdgcn_mfma_f32_32x32x16_bf16(__builtin_bit_cast(bf16x8, pw[kk]), v0, o0, 0, 0, 0);
                o1 = __builtin_amdgcn_mfma_f32_32x32x16_bf16(__builtin_bit_cast(bf16x8, pw[kk]), v1, o1, 0, 0, 0);
            }
        }
        }
        if (visn) { c0 = n0; c1 = n1; }
        ks = ks1; vs ^= 1;
        ATT_WAIT_BAR();
    }
    const float lt = xhalf_sum(lsum);
    if (hi == 0) wsf[32 + r32] = lt;
    asm volatile("s_waitcnt lgkmcnt(0)" ::: "memory");
    write_o(A, o0, o1, wsf, shm, wid, lane, r32, hi, rowbase + q0 + wid * 32, (CHUNK ? 512 : 0) + h * 64);
    asm volatile("s_waitcnt lgkmcnt(0)\n\ts_barrier" ::: "memory");
#undef ATT_ISSUE_K
#undef ATT_ISSUE_V
#undef A8_VFRAG
#undef ATT_QK
}

__device__ __forceinline__ bool mla_unit_fast(const Args& A, int b, int h, int qb, ALAS char* shm, const int tidb) {
    constexpr int NDK = 6, KSLOT = NDK * 2048;
    constexpr float THR = 8.0f;
    int tid_l; asm volatile("v_mbcnt_lo_u32_b32 %0, -1, 0\n\tv_mbcnt_hi_u32_b32 %0, -1, %0" : "=v"(tid_l)); tid_l += tidb;
    const int tid = tid_l, lane = tid & 63, r32 = lane & 31, hi = lane >> 5;
    const int wid = __builtin_amdgcn_readfirstlane(tid >> 6);
    const long rowbase = (long)b * SEQ; const int q0 = qb * 256;
    const unsigned lds0 = (unsigned)(size_t)shm;
    ALAS float* wsf = (ALAS float*)(shm + L_WS) + wid * 64;
    ALAS int* bailw = (ALAS int*)(shm + L_BIAS);
    const bf16* ksrc = A.KN + (rowbase + lane) * 512 + h * 64 + wid * 8;
    const bf16* krsrc = A.KR + (rowbase + lane) * 32 + (wid & 3) * 8;
    const bf16* vsrc = A.V + (rowbase + 16 * (wid & 3) + (lane >> 2)) * 512 + h * 64 + (wid >> 2) * 32 + (lane & 3) * 8;
    const unsigned kdst = lds0 + L_K + wid * 1024, krdst = lds0 + L_K + (8 + (wid & 3)) * 1024, vdst = lds0 + L_V + wid * 1024;
#define MF_ISSUE_K(t, s) do { glds16(ksrc + (long)(t) * 64 * 512, (unsigned)__builtin_amdgcn_readfirstlane(kdst + (s) * KSLOT)); \
        if (wid < 4) glds16(krsrc + (long)(t) * 64 * 32, (unsigned)__builtin_amdgcn_readfirstlane(krdst + (s) * KSLOT)); } while (0)
#define MF_ISSUE_V(t, s) glds16(vsrc + (long)(t) * 64 * 512, (unsigned)__builtin_amdgcn_readfirstlane(vdst + (s) * VSLOT))
    const int t_end = 4 * qb + 4;
    const int cw = 4 * qb + (wid >> 1);
    if (tid == 0) bailw[0] = 0;
    MF_ISSUE_K(0, 0); MF_ISSUE_V(0, 0); MF_ISSUE_K(1, 1);
    const bf16* Qw = A.Q + (rowbase + q0 + wid * 32 + r32) * 768 + h * 96 + hi * 8;
    bf16x8 qr[NDK];
#pragma unroll
    for (int d0 = 0; d0 < NDK; ++d0) qr[d0] = *(const bf16x8*)(Qw + d0 * 16);
    float lsum = 0.f; f32x16 o0 = {}, o1 = {};
    const int vbo = ((lane >> 4) & 1) * 32 + (lane & 3) * 8 + (4 * hi + ((lane & 15) >> 2)) * 64;
    ALAS const char* Kfr = shm + L_K + hi * 1024 + r32 * 16;
#define MF_ROWMAX(C0, C1) ({ float rmp_[4]; _Pragma("unroll") for (int j = 0; j < 4; ++j) { rmp_[j] = max3f(C0[j], C1[j], C0[4 + j]); rmp_[j] = max3f(rmp_[j], C1[4 + j], C0[8 + j]); rmp_[j] = max3f(rmp_[j], C1[8 + j], C0[12 + j]); rmp_[j] = max2f(rmp_[j], C1[12 + j]); } \
        xhalf_max(max2f(max3f(rmp_[0], rmp_[1], rmp_[2]), rmp_[3])); })
    ATT_WAIT_BAR();
    f32x16 cs[2][2];
    { f32x16 z0 = {}, z1 = {}; ALAS const char* Ks_ = Kfr;
#pragma unroll
      for (int d0 = 0; d0 < NDK; ++d0) { const bf16x8 a0 = *(ALAS const bf16x8*)(Ks_ + d0 * 2048), a1 = *(ALAS const bf16x8*)(Ks_ + d0 * 2048 + 512);
          z0 = __builtin_amdgcn_mfma_f32_32x32x16_bf16(a0, qr[d0], z0, 0, 0, 0); z1 = __builtin_amdgcn_mfma_f32_32x32x16_bf16(a1, qr[d0], z1, 0, 0, 0); }
      asm volatile("s_nop 15\n\ts_nop 7" : "+v"(z0), "+v"(z1));
      cs[0][0] = z0; cs[0][1] = z1; }
    const float mhat = MF_ROWMAX(cs[0][0], cs[0][1]);
#pragma unroll
    for (int r = 0; r < 16; ++r) { cs[0][0][r] -= mhat; cs[0][1][r] -= mhat; }
    f32x16 negm;
#pragma unroll
    for (int r = 0; r < 16; ++r) negm[r] = -mhat;
    bool bailed = false; int ks = 0, vs = 0;
    for (int t2 = 0; t2 < t_end; t2 += 2) {
#pragma unroll
        for (int p = 0; p < 2; ++p) {
            const int t = t2 + p; f32x16 &C0 = cs[p][0], &C1 = cs[p][1], &N0 = cs[p ^ 1][0], &N1 = cs[p ^ 1][1];
            const bool vis = !bailed && t <= cw;
            const int ks1 = ks == 2 ? 0 : ks + 1, ks2 = ks1 == 2 ? 0 : ks1 + 1;
            if (t + 2 < t_end) MF_ISSUE_K(t + 2, ks2);
            if (t + 1 < t_end) MF_ISSUE_V(t + 1, vs ^ 1);
            if (vis) {
                {
                    ALAS const char* Ks_ = Kfr + ks1 * KSLOT;
                    bf16x8 ka = *(ALAS const bf16x8*)(Ks_), kb = *(ALAS const bf16x8*)(Ks_ + 512);
                    constexpr int NM = 2 * NDK;
#pragma unroll
                    for (int d0 = 0; d0 < NDK; ++d0) {
                        bf16x8 na = ka, nb = kb;
                        if (d0 + 1 < NDK) { na = *(ALAS const bf16x8*)(Ks_ + (d0 + 1) * 2048); nb = *(ALAS const bf16x8*)(Ks_ + (d0 + 1) * 2048 + 512); }
                        N0 = __builtin_amdgcn_mfma_f32_32x32x16_bf16(ka, qr[d0], d0 == 0 ? negm : N0, 0, 0, 0);
#pragma unroll
                        for (int e = 0; e < 32; ++e) if (e * NM / 32 == 2 * d0) { if (e < 16) C0[e] = __builtin_amdgcn_exp2f(C0[e]); else C1[e - 16] = __builtin_amdgcn_exp2f(C1[e - 16]); }
                        __builtin_amdgcn_sched_barrier(0);
                        N1 = __builtin_amdgcn_mfma_f32_32x32x16_bf16(kb, qr[d0], d0 == 0 ? negm : N1, 0, 0, 0);
#pragma unroll
                        for (int e = 0; e < 32; ++e) if (e * NM / 32 == 2 * d0 + 1) { if (e < 16) C0[e] = __builtin_amdgcn_exp2f(C0[e]); else C1[e - 16] = __builtin_amdgcn_exp2f(C1[e - 16]); }
                        __builtin_amdgcn_sched_barrier(0);
                        ka = na; kb = nb;
                    }
                }
                ALAS const char* vb_ = shm + L_V + vs * VSLOT + vbo; s16x4 vl_[8], vh_[8];
#pragma unroll
                for (int kk = 0; kk < 4; ++kk) { vl_[kk] = vtr(vb_ + kk * 1024); vh_[kk] = vtr(vb_ + kk * 1024 + 512); vl_[4 + kk] = vtr(vb_ + 4096 + kk * 1024); vh_[4 + kk] = vtr(vb_ + 4096 + kk * 1024 + 512); }
                float sa_[4];
#pragma unroll
                for (int kk = 0; kk < 4; ++kk) { const f32x16& cc_ = (kk < 2) ? C0 : C1; const int k8_ = 8 * (kk & 1);
                    const u32x4 pw_ = (u32x4){cvtpk(cc_[k8_], cc_[k8_ + 1]), cvtpk(cc_[k8_ + 2], cc_[k8_ + 3]), cvtpk(cc_[k8_ + 4], cc_[k8_ + 5]), cvtpk(cc_[k8_ + 6], cc_[k8_ + 7])};
                    sa_[kk] = fadd_s(fadd_s(fadd_s(cc_[k8_], cc_[k8_ + 1]), fadd_s(cc_[k8_ + 2], cc_[k8_ + 3])), fadd_s(fadd_s(cc_[k8_ + 4], cc_[k8_ + 5]), fadd_s(cc_[k8_ + 6], cc_[k8_ + 7])));
                    const bf16x8 v0_ = (bf16x8){vl_[kk][0], vl_[kk][1], vl_[kk][2], vl_[kk][3], vh_[kk][0], vh_[kk][1], vh_[kk][2], vh_[kk][3]}, v1_ = (bf16x8){vl_[4 + kk][0], vl_[4 + kk][1], vl_[4 + kk][2], vl_[4 + kk][3], vh_[4 + kk][0], vh_[4 + kk][1], vh_[4 + kk][2], vh_[4 + kk][3]};
                    o0 = __builtin_amdgcn_mfma_f32_32x32x16_bf16(__builtin_bit_cast(bf16x8, pw_), v0_, o0, 0, 0, 0); o1 = __builtin_amdgcn_mfma_f32_32x32x16_bf16(__builtin_bit_cast(bf16x8, pw_), v1_, o1, 0, 0, 0);
                    __builtin_amdgcn_sched_barrier(0); }
                lsum = fadd_s(lsum, fadd_s(fadd_s(sa_[0], sa_[1]), fadd_s(sa_[2], sa_[3])));
            }
            ks = ks1; vs ^= 1;
            ATT_WAIT_BAR();
        }
    }
    const float lt = xhalf_sum(lsum);
    if (__any(!(lt > 1.0e-30f && lt < 1.0e30f))) bailed = true;
    if (bailed && lane == 0) bailw[0] = 1;
    if (hi == 0) wsf[32 + r32] = lt;
    asm volatile("s_waitcnt lgkmcnt(0)" ::: "memory");
    write_o(A, o0, o1, wsf, shm, wid, lane, r32, hi, rowbase + q0 + wid * 32, h * 64);
    asm volatile("s_waitcnt lgkmcnt(0)\n\ts_barrier" ::: "memory");
    const int redo = __builtin_amdgcn_readfirstlane(bailw[0]);
    asm volatile("s_waitcnt lgkmcnt(0)\n\ts_barrier" ::: "memory");
    return redo != 0;
#undef MF_ISSUE_K
#undef MF_ISSUE_V
#undef MF_ROWMAX
}
typedef int v8i __attribute__((ext_vector_type(8)));
__device__ __forceinline__ void mfma8_new(f32x16& d, const v8i& ka, const v8i& qb, const f32x16& c, int sa, int sb) {
    asm volatile("v_mfma_scale_f32_32x32x64_f8f6f4 %0, %1, %2, %3, %4, %5 op_sel_hi:[0,0,0]" : "=&v"(d) : "v"(ka), "v"(qb), "v"(c), "v"(sa), "v"(sb)); }
__device__ __forceinline__ void mfma8_acc(f32x16& d, const v8i& ka, const v8i& qb, int sa, int sb) {
    asm volatile("v_mfma_scale_f32_32x32x64_f8f6f4 %0, %1, %2, %0, %3, %4 op_sel_hi:[0,0,0]" : "+v"(d) : "v"(ka), "v"(qb), "v"(sa), "v"(sb)); }
__device__ __forceinline__ bool mla_unit_fast8(const Args& A, int b, int h, int qb, ALAS char* shm, const int tidb) {
    constexpr int KSLOT = 8192;
    constexpr float THR = 8.0f;
    int tid_l; asm volatile("v_mbcnt_lo_u32_b32 %0, -1, 0\n\tv_mbcnt_hi_u32_b32 %0, -1, %0" : "=v"(tid_l)); tid_l += tidb;
    const int tid = tid_l, lane = tid & 63, r32 = lane & 31, hi = lane >> 5;
    const int wid = __builtin_amdgcn_readfirstlane(tid >> 6);
    const long rowbase = (long)b * SEQ; const int q0 = qb * 256;
    const unsigned lds0 = (unsigned)(size_t)shm;
    ALAS float* wsf = (ALAS float*)(shm + L_WS) + wid * 64;
    ALAS int* bailw = (ALAS int*)(shm + L_BIAS);
    const int m_ = wid >> 2, kh_ = (wid >> 1) & 1, j_ = wid & 1;
    const long krow_ = rowbase + 32 * kh_ + r32;
    const unsigned char* ks8 = m_ == 0 ? A.KN8 + krow_ * 512 + h * 64 + 32 * hi + 16 * j_ : (hi == 0 ? A.KR8 + krow_ * 32 + 16 * j_ : A.ZERO + r32 * 16);
    const long kst8 = m_ == 0 ? 64 * 512 : (hi == 0 ? 64 * 32 : 0);
    const bf16* vsrc = A.V + (rowbase + 16 * (wid & 3) + (lane >> 2)) * 512 + h * 64 + (wid >> 2) * 32 + (lane & 3) * 8;
    const unsigned kdst = lds0 + L_K + wid * 1024, vdst = lds0 + L_V + wid * 1024;
#define MF_ISSUE_K(t, s) glds16(ks8 + (long)(t) * kst8, (unsigned)__builtin_amdgcn_readfirstlane(kdst + (s) * KSLOT))
#define MF_ISSUE_V(t, s) glds16(vsrc + (long)(t) * 64 * 512, (unsigned)__builtin_amdgcn_readfirstlane(vdst + (s) * VSLOT))
    const int t_end = 4 * qb + 4;
    const int cw = 4 * qb + (wid >> 1);
    if (tid == 0) bailw[0] = 0;
    MF_ISSUE_K(0, 0); MF_ISSUE_V(0, 0); MF_ISSUE_K(1, 1);
    const unsigned char* Q8w = A.Q8 + (rowbase + q0 + wid * 32 + r32) * 768 + h * 96;
    const unsigned char* Q8r = hi == 0 ? Q8w + 64 : A.ZERO;
    v8i qf0, qf1;
    { const u32x4 a0 = *(const u32x4*)(Q8w + 32 * hi), a1 = *(const u32x4*)(Q8w + 32 * hi + 16), b0 = *(const u32x4*)(Q8r), b1 = *(const u32x4*)(Q8r + 16);
      qf0 = (v8i){(int)a0.x, (int)a0.y, (int)a0.z, (int)a0.w, (int)a1.x, (int)a1.y, (int)a1.z, (int)a1.w}; qf1 = (v8i){(int)b0.x, (int)b0.y, (int)b0.z, (int)b0.w, (int)b1.x, (int)b1.y, (int)b1.z, (int)b1.w}; }
    const int sa8 = 0x7c7c7c7c, sb8 = 0x7b7b7b7b;
    float lsum = 0.f; f32x16 o0 = {}, o1 = {};
    const int vbo = ((lane >> 4) & 1) * 32 + (lane & 3) * 8 + (4 * hi + ((lane & 15) >> 2)) * 64;
    ALAS const char* Kfr = shm + L_K + lane * 16;
#define M8_KFRAG(dst, base, m, kh) do { const u32x4 lo_ = *(ALAS const u32x4*)((base) + (((m) * 2 + (kh)) * 2) * 1024), hi_ = *(ALAS const u32x4*)((base) + (((m) * 2 + (kh)) * 2 + 1) * 1024); \
        dst = (v8i){(int)lo_.x, (int)lo_.y, (int)lo_.z, (int)lo_.w, (int)hi_.x, (int)hi_.y, (int)hi_.z, (int)hi_.w}; } while (0)
#define MF_ROWMAX(C0, C1) ({ float rmp_[4]; _Pragma("unroll") for (int j = 0; j < 4; ++j) { rmp_[j] = max3f(C0[j], C1[j], C0[4 + j]); rmp_[j] = max3f(rmp_[j], C1[4 + j], C0[8 + j]); rmp_[j] = max3f(rmp_[j], C1[8 + j], C0[12 + j]); rmp_[j] = max2f(rmp_[j], C1[12 + j]); } \
        xhalf_max(max2f(max3f(rmp_[0], rmp_[1], rmp_[2]), rmp_[3])); })
    ATT_WAIT_BAR();
    f32x16 cs[2][2];
    { f32x16 z0 = {}, z1 = {}; ALAS const char* Ks_ = Kfr;
      v8i k00, k01, k10, k11; M8_KFRAG(k00, Ks_, 0, 0); M8_KFRAG(k01, Ks_, 0, 1); M8_KFRAG(k10, Ks_, 1, 0); M8_KFRAG(k11, Ks_, 1, 1);
      mfma8_acc(z0, k00, qf0, sa8, sb8); mfma8_acc(z1, k01, qf0, sa8, sb8); mfma8_acc(z0, k10, qf1, sa8, sb8); mfma8_acc(z1, k11, qf1, sa8, sb8);
      asm volatile("s_nop 15\n\ts_nop 7" : "+v"(z0), "+v"(z1));
      cs[0][0] = z0; cs[0][1] = z1; }
    const float mhat = MF_ROWMAX(cs[0][0], cs[0][1]);
#pragma unroll
    for (int r = 0; r < 16; ++r) { cs[0][0][r] -= mhat; cs[0][1][r] -= mhat; }
    f32x16 negm;
#pragma unroll
    for (int r = 0; r < 16; ++r) negm[r] = -mhat;
    bool bailed = false; int ks = 0, vs = 0;
    for (int t2 = 0; t2 < t_end; t2 += 2) {
#pragma unroll
        for (int p = 0; p < 2; ++p) {
            const int t = t2 + p; f32x16 &C0 = cs[p][0], &C1 = cs[p][1], &N0 = cs[p ^ 1][0], &N1 = cs[p ^ 1][1];
            const bool vis = !bailed && t <= cw;
            const int ks1 = ks == 2 ? 0 : ks + 1, ks2 = ks1 == 2 ? 0 : ks1 + 1;
            if (t + 2 < t_end) MF_ISSUE_K(t + 2, ks2);
            if (t + 1 < t_end) MF_ISSUE_V(t + 1, vs ^ 1);
            if (vis) {
                {
                    ALAS const char* Ks_ = Kfr + ks1 * KSLOT;
                    v8i kfa, kfb; M8_KFRAG(kfa, Ks_, 0, 0);
                    M8_KFRAG(kfb, Ks_, 0, 1);
                    mfma8_new(N0, kfa, qf0, negm, sa8, sb8);
#pragma unroll
                    for (int e = 0; e < 8; ++e) C0[e] = __builtin_amdgcn_exp2f(C0[e]);
                    __builtin_amdgcn_sched_barrier(0);
                    M8_KFRAG(kfa, Ks_, 1, 0);
                    mfma8_new(N1, kfb, qf0, negm, sa8, sb8);
#pragma unroll
                    for (int e = 8; e < 16; ++e) C0[e] = __builtin_amdgcn_exp2f(C0[e]);
                    __builtin_amdgcn_sched_barrier(0);
                    M8_KFRAG(kfb, Ks_, 1, 1);
                    mfma8_acc(N0, kfa, qf1, sa8, sb8);
#pragma unroll
                    for (int e = 0; e < 8; ++e) C1[e] = __builtin_amdgcn_exp2f(C1[e]);
                    __builtin_amdgcn_sched_barrier(0);
                    mfma8_acc(N1, kfb, qf1, sa8, sb8);
#pragma unroll
                    for (int e = 8; e < 16; ++e) C1[e] = __builtin_amdgcn_exp2f(C1[e]);
                    __builtin_amdgcn_sched_barrier(0);
                }
                ALAS const char* vb_ = shm + L_V + vs * VSLOT + vbo; s16x4 vl_[8], vh_[8];
#pragma unroll
                for (int kk = 0; kk < 4; ++kk) { vl_[kk] = vtr(vb_ + kk * 1024); vh_[kk] = vtr(vb_ + kk * 1024 + 512); vl_[4 + kk] = vtr(vb_ + 4096 + kk * 1024); vh_[4 + kk] = vtr(vb_ + 4096 + kk * 1024 + 512); }
                float sa_[4];
#pragma unroll
                for (int kk = 0; kk < 4; ++kk) { const f32x16& cc_ = (kk < 2) ? C0 : C1; const int k8_ = 8 * (kk & 1);
                    const u32x4 pw_ = (u32x4){cvtpk(cc_[k8_], cc_[k8_ + 1]), cvtpk(cc_[k8_ + 2], cc_[k8_ + 3]), cvtpk(cc_[k8_ + 4], cc_[k8_ + 5]), cvtpk(cc_[k8_ + 6], cc_[k8_ + 7])};
                    sa_[kk] = fadd_s(fadd_s(fadd_s(cc_[k8_], cc_[k8_ + 1]), fadd_s(cc_[k8_ + 2], cc_[k8_ + 3])), fadd_s(fadd_s(cc_[k8_ + 4], cc_[k8_ + 5]), fadd_s(cc_[k8_ + 6], cc_[k8_ + 7])));
                    const bf16x8 v0_ = (bf16x8){vl_[kk][0], vl_[kk][1], vl_[kk][2], vl_[kk][3], vh_[kk][0], vh_[kk][1], vh_[kk][2], vh_[kk][3]}, v1_ = (bf16x8){vl_[4 + kk][0], vl_[4 + kk][1], vl_[4 + kk][2], vl_[4 + kk][3], vh_[4 + kk][0], vh_[4 + kk][1], vh_[4 + kk][2], vh_[4 + kk][3]};
                    o0 = __builtin_amdgcn_mfma_f32_32x32x16_bf16(__builtin_bit_cast(bf16x8, pw_), v0_, o0, 0, 0, 0); o1 = __builtin_amdgcn_mfma_f32_32x32x16_bf16(__builtin_bit_cast(bf16x8, pw_), v1_, o1, 0, 0, 0);
                    __builtin_amdgcn_sched_barrier(0); }
                lsum = fadd_s(lsum, fadd_s(fadd_s(sa_[0], sa_[1]), fadd_s(sa_[2], sa_[3])));
            }
            ks = ks1; vs ^= 1;
            ATT_WAIT_BAR();
        }
    }
    const float lt = xhalf_sum(lsum);
    if (__any(!(lt > 1.0e-30f && lt < 1.0e30f))) bailed = true;
    if (bailed && lane == 0) bailw[0] = 1;
    if (hi == 0) wsf[32 + r32] = lt;
    asm volatile("s_waitcnt lgkmcnt(0)" ::: "memory");
    write_o(A, o0, o1, wsf, shm, wid, lane, r32, hi, rowbase + q0 + wid * 32, h * 64);
    asm volatile("s_waitcnt lgkmcnt(0)\n\ts_barrier" ::: "memory");
    const int redo = __builtin_amdgcn_readfirstlane(bailw[0]);
    asm volatile("s_waitcnt lgkmcnt(0)\n\ts_barrier" ::: "memory");
    return redo != 0;
#undef MF_ISSUE_K
#undef MF_ISSUE_V
#undef MF_ROWMAX
#undef M8_KFRAG
}
__device__ __forceinline__ void mfma8p_acc(f32x16& d, const v8i& p, const v8i& v, int sp, int sv) {
    asm volatile("v_mfma_scale_f32_32x32x64_f8f6f4 %0, %1, %2, %0, %3, %4 op_sel_hi:[0,0,0] cbsz:1" : "+v"(d) : "v"(p), "v"(v), "v"(sp), "v"(sv)); }
__device__ __forceinline__ bool mla_unit_fast88(const Args& A, int b, int h, int qb, ALAS char* shm, const int tidb) {
    constexpr int KSLOT = 8192;
    constexpr float THR = 8.0f;
    int tid_l; asm volatile("v_mbcnt_lo_u32_b32 %0, -1, 0\n\tv_mbcnt_hi_u32_b32 %0, -1, %0" : "=v"(tid_l)); tid_l += tidb;
    const int tid = tid_l, lane = tid & 63, r32 = lane & 31, hi = lane >> 5;
    const int wid = __builtin_amdgcn_readfirstlane(tid >> 6);
    const long rowbase = (long)b * SEQ; const int q0 = qb * 256;
    const unsigned lds0 = (unsigned)(size_t)shm;
    ALAS float* wsf = (ALAS float*)(shm + L_WS) + wid * 64;
    ALAS int* bailw = (ALAS int*)(shm + L_BIAS);
    const int m_ = wid >> 2, kh_ = (wid >> 1) & 1, j_ = wid & 1;
    const long krow_ = rowbase + 32 * kh_ + r32;
    const unsigned char* ks8 = m_ == 0 ? A.KN8 + krow_ * 512 + h * 64 + 32 * hi + 16 * j_ : (hi == 0 ? A.KR8 + krow_ * 32 + 16 * j_ : A.ZERO + r32 * 16);
    const long kst8 = m_ == 0 ? 64 * 512 : (hi == 0 ? 64 * 32 : 0);
    const unsigned char* vs8 = A.V8T + (((long)(b * 8 + h) * 128) * 64 + 32 * ((wid >> 1) & 1) + r32) * 64 + 32 * hi + 16 * (wid & 1);
    const unsigned kdst = lds0 + L_K + wid * 1024, vdst = lds0 + L_V + wid * 1024;
#define MF_ISSUE_K(t, s) glds16(ks8 + (long)(t) * kst8, (unsigned)__builtin_amdgcn_readfirstlane(kdst + (s) * KSLOT))
#define MF_ISSUE_V(t, s) do { if (wid < 4) glds16(vs8 + (long)(t) * 4096, (unsigned)__builtin_amdgcn_readfirstlane(vdst + (s) * 4096)); } while (0)
    const int t_end = 4 * qb + 4;
    const int cw = 4 * qb + (wid >> 1);
    if (tid == 0) bailw[0] = 0;
    MF_ISSUE_K(0, 0); MF_ISSUE_V(0, 0); MF_ISSUE_K(1, 1);
    const unsigned char* Q8w = A.Q8 + (rowbase + q0 + wid * 32 + r32) * 768 + h * 96;
    const unsigned char* Q8r = hi == 0 ? Q8w + 64 : A.ZERO;
    v8i qf0, qf1;
    { const u32x4 a0 = *(const u32x4*)(Q8w + 32 * hi), a1 = *(const u32x4*)(Q8w + 32 * hi + 16), b0 = *(const u32x4*)(Q8r), b1 = *(const u32x4*)(Q8r + 16);
      qf0 = (v8i){(int)a0.x, (int)a0.y, (int)a0.z, (int)a0.w, (int)a1.x, (int)a1.y, (int)a1.z, (int)a1.w}; qf1 = (v8i){(int)b0.x, (int)b0.y, (int)b0.z, (int)b0.w, (int)b1.x, (int)b1.y, (int)b1.z, (int)b1.w}; }
    const int sa8 = 0x7c7c7c7c, sb8 = 0x7b7b7b7b;
    f32x16 o0 = {}, o1 = {}, ls = {};
    const v8i ones8 = {0x38383838, 0x38383838, 0x38383838, 0x38383838, 0x38383838, 0x38383838, 0x38383838, 0x38383838};
    const int vbo = ((lane >> 4) & 1) * 32 + (lane & 3) * 8 + (4 * hi + ((lane & 15) >> 2)) * 64;
    ALAS const char* Kfr = shm + L_K + lane * 16;
#define M8_KFRAG(dst, base, m, kh) do { const u32x4 lo_ = *(ALAS const u32x4*)((base) + (((m) * 2 + (kh)) * 2) * 1024), hi_ = *(ALAS const u32x4*)((base) + (((m) * 2 + (kh)) * 2 + 1) * 1024); \
        dst = (v8i){(int)lo_.x, (int)lo_.y, (int)lo_.z, (int)lo_.w, (int)hi_.x, (int)hi_.y, (int)hi_.z, (int)hi_.w}; } while (0)
#define MF_ROWMAX(C0, C1) ({ float rmp_[4]; _Pragma("unroll") for (int j = 0; j < 4; ++j) { rmp_[j] = max3f(C0[j], C1[j], C0[4 + j]); rmp_[j] = max3f(rmp_[j], C1[4 + j], C0[8 + j]); rmp_[j] = max3f(rmp_[j], C1[8 + j], C0[12 + j]); rmp_[j] = max2f(rmp_[j], C1[12 + j]); } \
        xhalf_max(max2f(max3f(rmp_[0], rmp_[1], rmp_[2]), rmp_[3])); })
    ATT_WAIT_BAR();
    f32x16 cs[2][2];
    { f32x16 z0 = {}, z1 = {}; ALAS const char* Ks_ = Kfr;
      v8i k00, k01, k10, k11; M8_KFRAG(k00, Ks_, 0, 0); M8_KFRAG(k01, Ks_, 0, 1); M8_KFRAG(k10, Ks_, 1, 0); M8_KFRAG(k11, Ks_, 1, 1);
      mfma8_acc(z0, k00, qf0, sa8, sb8); mfma8_acc(z1, k01, qf0, sa8, sb8); mfma8_acc(z0, k10, qf1, sa8, sb8); mfma8_acc(z1, k11, qf1, sa8, sb8);
      asm volatile("s_nop 15\n\ts_nop 7" : "+v"(z0), "+v"(z1));
      cs[0][0] = z0; cs[0][1] = z1; }
    const float mhat = MF_ROWMAX(cs[0][0], cs[0][1]);
#pragma unroll
    for (int r = 0; r < 16; ++r) { cs[0][0][r] -= mhat; cs[0][1][r] -= mhat; }
    f32x16 negm;
#pragma unroll
    for (int r = 0; r < 16; ++r) negm[r] = -mhat;
    bool bailed = false; int ks = 0, vs = 0;
    for (int t2 = 0; t2 < t_end; t2 += 2) {
#pragma unroll
        for (int p = 0; p < 2; ++p) {
            const int t = t2 + p; f32x16 &C0 = cs[p][0], &C1 = cs[p][1], &N0 = cs[p ^ 1][0], &N1 = cs[p ^ 1][1];
            const bool vis = !bailed && t <= cw;
            const int ks1 = ks == 2 ? 0 : ks + 1, ks2 = ks1 == 2 ? 0 : ks1 + 1;
            if (t + 2 < t_end) MF_ISSUE_K(t + 2, ks2);
            if (t + 1 < t_end) MF_ISSUE_V(t + 1, vs ^ 1);
            if (vis) {
                {
                    ALAS const char* Ks_ = Kfr + ks1 * KSLOT;
                    v8i kfa, kfb; M8_KFRAG(kfa, Ks_, 0, 0);
                    M8_KFRAG(kfb, Ks_, 0, 1);
                    mfma8_new(N0, kfa, qf0, negm, sa8, sb8);
#pragma unroll
                    for (int e = 0; e < 8; ++e) C0[e] = __builtin_amdgcn_exp2f(C0[e]);
                    __builtin_amdgcn_sched_barrier(0);
                    M8_KFRAG(kfa, Ks_, 1, 0);
                    mfma8_new(N1, kfb, qf0, negm, sa8, sb8);
#pragma unroll
                    for (int e = 8; e < 16; ++e) C0[e] = __builtin_amdgcn_exp2f(C0[e]);
                    __builtin_amdgcn_sched_barrier(0);
                    M8_KFRAG(kfb, Ks_, 1, 1);
                    mfma8_acc(N0, kfa, qf1, sa8, sb8);
#pragma unroll
                    for (int e = 0; e < 8; ++e) C1[e] = __builtin_amdgcn_exp2f(C1[e]);
                    __builtin_amdgcn_sched_barrier(0);
                    mfma8_acc(N1, kfb, qf1, sa8, sb8);
#pragma unroll
                    for (int e = 8; e < 16; ++e) C1[e] = __builtin_amdgcn_exp2f(C1[e]);
                    __builtin_amdgcn_sched_barrier(0);
                }
                ALAS const char* vb_ = shm + L_V + vs * 4096 + lane * 16;
                v8i vf0, vf1;
                { const u32x4 a0 = *(ALAS const u32x4*)(vb_), a1 = *(ALAS const u32x4*)(vb_ + 1024), b0 = *(ALAS const u32x4*)(vb_ + 2048), b1 = *(ALAS const u32x4*)(vb_ + 3072);
                  vf0 = (v8i){(int)a0.x, (int)a0.y, (int)a0.z, (int)a0.w, (int)a1.x, (int)a1.y, (int)a1.z, (int)a1.w}; vf1 = (v8i){(int)b0.x, (int)b0.y, (int)b0.z, (int)b0.w, (int)b1.x, (int)b1.y, (int)b1.z, (int)b1.w}; }
                v8i pf;
#pragma unroll
                for (int kk = 0; kk < 4; ++kk) { const f32x16& cc_ = (kk < 2) ? C0 : C1; const int k8_ = 8 * (kk & 1);
                    int w0_ = 0, w1_ = 0;
                    w0_ = __builtin_amdgcn_cvt_pk_bf8_f32(cc_[k8_], cc_[k8_ + 1], w0_, false); w0_ = __builtin_amdgcn_cvt_pk_bf8_f32(cc_[k8_ + 2], cc_[k8_ + 3], w0_, true);
                    w1_ = __builtin_amdgcn_cvt_pk_bf8_f32(cc_[k8_ + 4], cc_[k8_ + 5], w1_, false); w1_ = __builtin_amdgcn_cvt_pk_bf8_f32(cc_[k8_ + 6], cc_[k8_ + 7], w1_, true);
                    pf[2 * kk] = w0_; pf[2 * kk + 1] = w1_; }
                __builtin_amdgcn_sched_barrier(0);
                mfma8p_acc(o0, pf, vf0, 0x7f7f7f7f, 0x7c7c7c7c);
                mfma8p_acc(o1, pf, vf1, 0x7f7f7f7f, 0x7c7c7c7c);
                mfma8p_acc(ls, pf, ones8, 0x7f7f7f7f, 0x7f7f7f7f);
                __builtin_amdgcn_sched_barrier(0);
            }
            ks = ks1; vs ^= 1;
            ATT_WAIT_BAR();
        }
    }
    asm volatile("s_nop 15\n\ts_nop 15" : "+v"(o0), "+v"(o1), "+v"(ls));
    { bool bad_ = false;
#pragma unroll
      for (int r = 0; r < 16; ++r) bad_ |= !(ls[r] > 1.0e-30f && ls[r] < 5.7e4f);
      if (__any(bad_)) bailed = true; }
    if (bailed && lane == 0) bailw[0] = 1;
    if (r32 == 0) {
#pragma unroll
        for (int r = 0; r < 16; ++r) wsf[32 + crow(r, hi)] = ls[r]; }
    asm volatile("s_waitcnt lgkmcnt(0)" ::: "memory");
    write_o(A, o0, o1, wsf, shm, wid, lane, r32, hi, rowbase + q0 + wid * 32, h * 64);
    asm volatile("s_waitcnt lgkmcnt(0)\n\ts_barrier" ::: "memory");
    const int redo = __builtin_amdgcn_readfirstlane(bailw[0]);
    asm volatile("s_waitcnt lgkmcnt(0)\n\ts_barrier" ::: "memory");
    return redo != 0;
#undef MF_ISSUE_K
#undef MF_ISSUE_V
#undef MF_ROWMAX
#undef M8_KFRAG
}
__device__ __forceinline__ bool chunk_unit_fast(const Args& A, int b, int h, int qb, ALAS char* shm, const int tidb) {
    constexpr int NDK = 4, KSLOT = NDK * 2048;
    constexpr float THR = 8.0f;
    int tid_l; asm volatile("v_mbcnt_lo_u32_b32 %0, -1, 0\n\tv_mbcnt_hi_u32_b32 %0, -1, %0" : "=v"(tid_l)); tid_l += tidb;
    const int tid = tid_l, lane = tid & 63, r32 = lane & 31, hi = lane >> 5;
    const int wid = __builtin_amdgcn_readfirstlane(tid >> 6);
    const long rowbase = (long)b * SEQ; const int q0 = qb * 256;
    const unsigned lds0 = (unsigned)(size_t)shm;
    ALAS float* wsf = (ALAS float*)(shm + L_WS) + wid * 64;
    ALAS float* bt = (ALAS float*)(shm + L_BIAS);
    ALAS int* bailw = (ALAS int*)(shm + L_BIAS) + 300;
    const bf16* ksrc = A.KB + (rowbase + lane) * 512 + h * 64 + wid * 8;
    const bf16* vsrc = A.VB + (rowbase + 16 * (wid & 3) + (lane >> 2)) * 512 + h * 64 + (wid >> 2) * 32 + (lane & 3) * 8;
    const unsigned kdst = lds0 + L_K + wid * 1024, vdst = lds0 + L_V + wid * 1024;
#define CF_ISSUE_K(t, s) glds16(ksrc + (long)(t) * 64 * 512, (unsigned)__builtin_amdgcn_readfirstlane(kdst + (s) * KSLOT))
#define CF_ISSUE_V(t, s) glds16(vsrc + (long)(t) * 64 * 512, (unsigned)__builtin_amdgcn_readfirstlane(vdst + (s) * VSLOT))
    const int t_end = 4 * qb + 4, t_begin = 4 * qb - 8 > 0 ? 4 * qb - 8 : 0;
    const int cw = 4 * qb + (wid >> 1);
    const int vis_lo = cw - 8 > 0 ? cw - 8 : 0;
    if (tid == 0) bailw[0] = 0;
    if (tid < 257) bt[tid] = (A.bias[h * 257 + tid] - A.bias[h * 257 + 256]) * LOG2E;
    CF_ISSUE_K(t_begin, 0); CF_ISSUE_V(t_begin, 0); CF_ISSUE_K(t_begin + 1, 1);
    const bf16* Qw = A.QB + (rowbase + q0 + wid * 32 + r32) * 512 + h * 64 + hi * 8;
    bf16x8 qr[NDK];
#pragma unroll
    for (int d0 = 0; d0 < NDK; ++d0) qr[d0] = *(const bf16x8*)(Qw + d0 * 16);
    float lsum = 0.f; f32x16 o0 = {}, o1 = {};
    const int vbo = ((lane >> 4) & 1) * 32 + (lane & 3) * 8 + (4 * hi + ((lane & 15) >> 2)) * 64;
    ALAS const char* Kfr = shm + L_K + hi * 1024 + r32 * 16;
#define CF_ROWMAX(C0, C1) ({ float rmp_[4]; _Pragma("unroll") for (int j = 0; j < 4; ++j) { rmp_[j] = max3f(C0[j], C1[j], C0[4 + j]); rmp_[j] = max3f(rmp_[j], C1[4 + j], C0[8 + j]); rmp_[j] = max3f(rmp_[j], C1[8 + j], C0[12 + j]); rmp_[j] = max2f(rmp_[j], C1[12 + j]); } \
        xhalf_max(max2f(max3f(rmp_[0], rmp_[1], rmp_[2]), rmp_[3])); })
#define CF_BIAS(C0, C1, tt) do { const int dq_ = 64 * (cw - (tt)) + 32 * (wid & 1) + r32 + 128; \
        _Pragma("unroll") for (int r = 0; r < 16; ++r) { int i0 = dq_ - crow(r, hi), i1 = i0 - 32; i0 = i0 < 0 ? 0 : (i0 > 256 ? 256 : i0); i1 = i1 < 0 ? 0 : (i1 > 256 ? 256 : i1); C0[r] += bt[i0]; C1[r] += bt[i1]; } } while (0)
    f32x16 cs[2][2], negm;
    ATT_WAIT_BAR();
    { f32x16 z0 = {}, z1 = {};
#pragma unroll
      for (int d0 = 0; d0 < NDK; ++d0) { const bf16x8 a0 = *(ALAS const bf16x8*)(Kfr + d0 * 2048), a1 = *(ALAS const bf16x8*)(Kfr + d0 * 2048 + 512);
          z0 = __builtin_amdgcn_mfma_f32_32x32x16_bf16(a0, qr[d0], z0, 0, 0, 0); z1 = __builtin_amdgcn_mfma_f32_32x32x16_bf16(a1, qr[d0], z1, 0, 0, 0); }
      asm volatile("s_nop 15\n\ts_nop 7" : "+v"(z0), "+v"(z1));
      if (vis_lo == t_begin && t_begin >= cw - 2) CF_BIAS(z0, z1, t_begin);
      const float mhat = CF_ROWMAX(z0, z1);
#pragma unroll
      for (int r = 0; r < 16; ++r) { z0[r] -= mhat; z1[r] -= mhat; negm[r] = -mhat; }
      cs[0][0] = z0; cs[0][1] = z1; cs[1][0] = z0; cs[1][1] = z1; }
    bool bailed = false; int ks = 0, vs = 0;
    for (int t2 = t_begin; t2 < t_end; t2 += 2) {
#pragma unroll
        for (int p = 0; p < 2; ++p) {
            const int t = t2 + p; f32x16 &C0 = cs[p][0], &C1 = cs[p][1], &N0 = cs[p ^ 1][0], &N1 = cs[p ^ 1][1];
            if (t >= vis_lo && t > t_begin && t <= cw) { if (t >= cw - 2) CF_BIAS(C0, C1, t); }
            const bool vis = !bailed && t >= vis_lo && t <= cw;
            const int ks1 = ks == 2 ? 0 : ks + 1, ks2 = ks1 == 2 ? 0 : ks1 + 1;
            if (t + 2 < t_end) CF_ISSUE_K(t + 2, ks2);
            if (t + 1 < t_end) CF_ISSUE_V(t + 1, vs ^ 1);
            if (vis) {
                {
                    ALAS const char* Ks_ = Kfr + ks1 * KSLOT;
                    bf16x8 ka = *(ALAS const bf16x8*)(Ks_), kb = *(ALAS const bf16x8*)(Ks_ + 512);
                    constexpr int NM = 2 * NDK;
#pragma unroll
                    for (int d0 = 0; d0 < NDK; ++d0) {
                        bf16x8 na = ka, nb = kb;
                        if (d0 + 1 < NDK) { na = *(ALAS const bf16x8*)(Ks_ + (d0 + 1) * 2048); nb = *(ALAS const bf16x8*)(Ks_ + (d0 + 1) * 2048 + 512); }
                        N0 = __builtin_amdgcn_mfma_f32_32x32x16_bf16(ka, qr[d0], d0 == 0 ? negm : N0, 0, 0, 0);
#pragma unroll
                        for (int e = 0; e < 32; ++e) if (e * NM / 32 == 2 * d0) { if (e < 16) C0[e] = __builtin_amdgcn_exp2f(C0[e]); else C1[e - 16] = __builtin_amdgcn_exp2f(C1[e - 16]); }
                        __builtin_amdgcn_sched_barrier(0);
                        N1 = __builtin_amdgcn_mfma_f32_32x32x16_bf16(kb, qr[d0], d0 == 0 ? negm : N1, 0, 0, 0);
#pragma unroll
                        for (int e = 0; e < 32; ++e) if (e * NM / 32 == 2 * d0 + 1) { if (e < 16) C0[e] = __builtin_amdgcn_exp2f(C0[e]); else C1[e - 16] = __builtin_amdgcn_exp2f(C1[e - 16]); }
                        __builtin_amdgcn_sched_barrier(0);
                        ka = na; kb = nb;
                    }
                }
                ALAS const char* vb_ = shm + L_V + vs * VSLOT + vbo; s16x4 vl_[8], vh_[8];
#pragma unroll
                for (int kk = 0; kk < 4; ++kk) { vl_[kk] = vtr(vb_ + kk * 1024); vh_[kk] = vtr(vb_ + kk * 1024 + 512); vl_[4 + kk] = vtr(vb_ + 4096 + kk * 1024); vh_[4 + kk] = vtr(vb_ + 4096 + kk * 1024 + 512); }
                float sa_[4];
#pragma unroll
                for (int kk = 0; kk < 4; ++kk) { const f32x16& cc_ = (kk < 2) ? C0 : C1; const int k8_ = 8 * (kk & 1);
                    const u32x4 pw_ = (u32x4){cvtpk(cc_[k8_], cc_[k8_ + 1]), cvtpk(cc_[k8_ + 2], cc_[k8_ + 3]), cvtpk(cc_[k8_ + 4], cc_[k8_ + 5]), cvtpk(cc_[k8_ + 6], cc_[k8_ + 7])};
                    sa_[kk] = fadd_s(fadd_s(fadd_s(cc_[k8_], cc_[k8_ + 1]), fadd_s(cc_[k8_ + 2], cc_[k8_ + 3])), fadd_s(fadd_s(cc_[k8_ + 4], cc_[k8_ + 5]), fadd_s(cc_[k8_ + 6], cc_[k8_ + 7])));
                    const bf16x8 v0_ = (bf16x8){vl_[kk][0], vl_[kk][1], vl_[kk][2], vl_[kk][3], vh_[kk][0], vh_[kk][1], vh_[kk][2], vh_[kk][3]}, v1_ = (bf16x8){vl_[4 + kk][0], vl_[4 + kk][1], vl_[4 + kk][2], vl_[4 + kk][3], vh_[4 + kk][0], vh_[4 + kk][1], vh_[4 + kk][2], vh_[4 + kk][3]};
                    o0 = __builtin_amdgcn_mfma_f32_32x32x16_bf16(__builtin_bit_cast(bf16x8, pw_), v0_, o0, 0, 0, 0); o1 = __builtin_amdgcn_mfma_f32_32x32x16_bf16(__builtin_bit_cast(bf16x8, pw_), v1_, o1, 0, 0, 0);
                    __builtin_amdgcn_sched_barrier(0); }
                lsum = fadd_s(lsum, fadd_s(fadd_s(sa_[0], sa_[1]), fadd_s(sa_[2], sa_[3])));
            } else if (!bailed && t + 1 == vis_lo) {
                ALAS const char* Kq_ = Kfr + ks1 * KSLOT;
#pragma unroll
                for (int d0 = 0; d0 < NDK; ++d0) { const bf16x8 a0 = *(ALAS const bf16x8*)(Kq_ + d0 * 2048), a1 = *(ALAS const bf16x8*)(Kq_ + d0 * 2048 + 512);
                    N0 = __builtin_amdgcn_mfma_f32_32x32x16_bf16(a0, qr[d0], d0 == 0 ? negm : N0, 0, 0, 0); N1 = __builtin_amdgcn_mfma_f32_32x32x16_bf16(a1, qr[d0], d0 == 0 ? negm : N1, 0, 0, 0); }
            }
            ks = ks1; vs ^= 1;
            ATT_WAIT_BAR();
        }
    }
    const float lt = xhalf_sum(lsum);
    if (__any(!(lt > 1.0e-30f && lt < 1.0e30f))) bailed = true;
    if (bailed && lane == 0) bailw[0] = 1;
    if (hi == 0) wsf[32 + r32] = lt;
    asm volatile("s_waitcnt lgkmcnt(0)" ::: "memory");
    write_o(A, o0, o1, wsf, shm, wid, lane, r32, hi, rowbase + q0 + wid * 32, 512 + h * 64);
    asm volatile("s_waitcnt lgkmcnt(0)\n\ts_barrier" ::: "memory");
    const int redo = __builtin_amdgcn_readfirstlane(bailw[0]);
    asm volatile("s_waitcnt lgkmcnt(0)\n\ts_barrier" ::: "memory");
    return redo != 0;
#undef CF_ISSUE_K
#undef CF_ISSUE_V
#undef CF_ROWMAX
#undef CF_BIAS
}
__device__ __forceinline__ bool chunk_unit_fast88(const Args& A, int b, int h, int qb, ALAS char* shm, const int tidb) {
    constexpr int KSLOT = 4096;
    constexpr float THR = 8.0f;
    int tid_l; asm volatile("v_mbcnt_lo_u32_b32 %0, -1, 0\n\tv_mbcnt_hi_u32_b32 %0, -1, %0" : "=v"(tid_l)); tid_l += tidb;
    const int tid = tid_l, lane = tid & 63, r32 = lane & 31, hi = lane >> 5;
    const int wid = __builtin_amdgcn_readfirstlane(tid >> 6);
    const long rowbase = (long)b * SEQ; const int q0 = qb * 256;
    const unsigned lds0 = (unsigned)(size_t)shm;
    ALAS float* wsf = (ALAS float*)(shm + L_WS) + wid * 64;
    ALAS float* bt = (ALAS float*)(shm + L_BIAS);
    ALAS int* bailw = (ALAS int*)(shm + L_BIAS) + 300;
    const unsigned char* ks8 = A.KB8 + (rowbase + 32 * ((wid >> 1) & 1) + r32) * 512 + h * 64 + 32 * hi + 16 * (wid & 1);
    const unsigned char* vs8 = A.VB8T + (((long)(b * 8 + h) * 128) * 64 + 32 * ((wid >> 1) & 1) + r32) * 64 + 32 * hi + 16 * (wid & 1);
    const unsigned kdst = lds0 + L_K + wid * 1024, vdst = lds0 + L_V + wid * 1024;
#define CF_ISSUE_K(t, s) do { if (wid < 4) glds16(ks8 + (long)(t) * 64 * 512, (unsigned)__builtin_amdgcn_readfirstlane(kdst + (s) * KSLOT)); } while (0)
#define CF_ISSUE_V(t, s) do { if (wid >= 4) glds16(vs8 + (long)(t) * 4096, (unsigned)__builtin_amdgcn_readfirstlane(lds0 + L_V + (wid - 4) * 1024 + (s) * 4096)); } while (0)
    const int t_end = 4 * qb + 4, t_begin = 4 * qb - 8 > 0 ? 4 * qb - 8 : 0;
    const int cw = 4 * qb + (wid >> 1);
    const int vis_lo = cw - 8 > 0 ? cw - 8 : 0;
    if (tid == 0) bailw[0] = 0;
    if (tid < 257) bt[tid] = (A.bias[h * 257 + tid] - A.bias[h * 257 + 256]) * LOG2E;
    CF_ISSUE_K(t_begin, 0); CF_ISSUE_V(t_begin, 0); CF_ISSUE_K(t_begin + 1, 1);
    const unsigned char* Q8w = A.QB8 + (rowbase + q0 + wid * 32 + r32) * 512 + h * 64 + 32 * hi;
    v8i qf;
    { const u32x4 a0 = *(const u32x4*)(Q8w), a1 = *(const u32x4*)(Q8w + 16); qf = (v8i){(int)a0.x, (int)a0.y, (int)a0.z, (int)a0.w, (int)a1.x, (int)a1.y, (int)a1.z, (int)a1.w}; }
    const int sa8 = 0x7c7c7c7c, sb8 = 0x7b7b7b7b;
    f32x16 o0 = {}, o1 = {}, ls = {};
    const v8i ones8 = {0x38383838, 0x38383838, 0x38383838, 0x38383838, 0x38383838, 0x38383838, 0x38383838, 0x38383838};
    const int vbo = ((lane >> 4) & 1) * 32 + (lane & 3) * 8 + (4 * hi + ((lane & 15) >> 2)) * 64;
    ALAS const char* Kfr = shm + L_K + lane * 16;
#define C8_KFRAG(dst, base, kh) do { const u32x4 lo_ = *(ALAS const u32x4*)((base) + ((kh) * 2) * 1024), hi_ = *(ALAS const u32x4*)((base) + ((kh) * 2 + 1) * 1024); \
        dst = (v8i){(int)lo_.x, (int)lo_.y, (int)lo_.z, (int)lo_.w, (int)hi_.x, (int)hi_.y, (int)hi_.z, (int)hi_.w}; } while (0)
#define CF_ROWMAX(C0, C1) ({ float rmp_[4]; _Pragma("unroll") for (int j = 0; j < 4; ++j) { rmp_[j] = max3f(C0[j], C1[j], C0[4 + j]); rmp_[j] = max3f(rmp_[j], C1[4 + j], C0[8 + j]); rmp_[j] = max3f(rmp_[j], C1[8 + j], C0[12 + j]); rmp_[j] = max2f(rmp_[j], C1[12 + j]); } \
        xhalf_max(max2f(max3f(rmp_[0], rmp_[1], rmp_[2]), rmp_[3])); })
#define CF_BIAS(C0, C1, tt) do { const int dq_ = 64 * (cw - (tt)) + 32 * (wid & 1) + r32 + 128; \
        _Pragma("unroll") for (int r = 0; r < 16; ++r) { int i0 = dq_ - crow(r, hi), i1 = i0 - 32; i0 = i0 < 0 ? 0 : (i0 > 256 ? 256 : i0); i1 = i1 < 0 ? 0 : (i1 > 256 ? 256 : i1); C0[r] += bt[i0]; C1[r] += bt[i1]; } } while (0)
    f32x16 cs[2][2], negm;
    ATT_WAIT_BAR();
    { f32x16 z0 = {}, z1 = {};
      { v8i k0_, k1_; C8_KFRAG(k0_, Kfr, 0); C8_KFRAG(k1_, Kfr, 1); mfma8_acc(z0, k0_, qf, sa8, sb8); mfma8_acc(z1, k1_, qf, sa8, sb8); }
      asm volatile("s_nop 15\n\ts_nop 7" : "+v"(z0), "+v"(z1));
      if (vis_lo == t_begin && t_begin >= cw - 2) CF_BIAS(z0, z1, t_begin);
      const float mhat = CF_ROWMAX(z0, z1);
#pragma unroll
      for (int r = 0; r < 16; ++r) { z0[r] -= mhat; z1[r] -= mhat; negm[r] = -mhat; }
      cs[0][0] = z0; cs[0][1] = z1; cs[1][0] = z0; cs[1][1] = z1; }
    bool bailed = false; int ks = 0, vs = 0;
    for (int t2 = t_begin; t2 < t_end; t2 += 2) {
#pragma unroll
        for (int p = 0; p < 2; ++p) {
            const int t = t2 + p; f32x16 &C0 = cs[p][0], &C1 = cs[p][1], &N0 = cs[p ^ 1][0], &N1 = cs[p ^ 1][1];
            if (t >= vis_lo && t > t_begin && t <= cw) { if (t >= cw - 2) CF_BIAS(C0, C1, t); }
            const bool vis = !bailed && t >= vis_lo && t <= cw;
            const int ks1 = ks == 2 ? 0 : ks + 1, ks2 = ks1 == 2 ? 0 : ks1 + 1;
            if (t + 2 < t_end) CF_ISSUE_K(t + 2, ks2);
            if (t + 1 < t_end) CF_ISSUE_V(t + 1, vs ^ 1);
            if (vis) {
                {
                    ALAS const char* Ks_ = Kfr + ks1 * KSLOT;
                    v8i kfa, kfb; C8_KFRAG(kfa, Ks_, 0); C8_KFRAG(kfb, Ks_, 1);
                    mfma8_new(N0, kfa, qf, negm, sa8, sb8);
#pragma unroll
                    for (int e = 0; e < 16; ++e) C0[e] = __builtin_amdgcn_exp2f(C0[e]);
                    __builtin_amdgcn_sched_barrier(0);
                    mfma8_new(N1, kfb, qf, negm, sa8, sb8);
#pragma unroll
                    for (int e = 0; e < 16; ++e) C1[e] = __builtin_amdgcn_exp2f(C1[e]);
                    __builtin_amdgcn_sched_barrier(0);
                }
                ALAS const char* vb_ = shm + L_V + vs * 4096 + lane * 16;
                v8i vf0, vf1;
                { const u32x4 a0 = *(ALAS const u32x4*)(vb_), a1 = *(ALAS const u32x4*)(vb_ + 1024), b0 = *(ALAS const u32x4*)(vb_ + 2048), b1 = *(ALAS const u32x4*)(vb_ + 3072);
                  vf0 = (v8i){(int)a0.x, (int)a0.y, (int)a0.z, (int)a0.w, (int)a1.x, (int)a1.y, (int)a1.z, (int)a1.w}; vf1 = (v8i){(int)b0.x, (int)b0.y, (int)b0.z, (int)b0.w, (int)b1.x, (int)b1.y, (int)b1.z, (int)b1.w}; }
                v8i pf;
#pragma unroll
                for (int kk = 0; kk < 4; ++kk) { const f32x16& cc_ = (kk < 2) ? C0 : C1; const int k8_ = 8 * (kk & 1);
                    int w0_ = 0, w1_ = 0;
                    w0_ = __builtin_amdgcn_cvt_pk_bf8_f32(cc_[k8_], cc_[k8_ + 1], w0_, false); w0_ = __builtin_amdgcn_cvt_pk_bf8_f32(cc_[k8_ + 2], cc_[k8_ + 3], w0_, true);
                    w1_ = __builtin_amdgcn_cvt_pk_bf8_f32(cc_[k8_ + 4], cc_[k8_ + 5], w1_, false); w1_ = __builtin_amdgcn_cvt_pk_bf8_f32(cc_[k8_ + 6], cc_[k8_ + 7], w1_, true);
                    pf[2 * kk] = w0_; pf[2 * kk + 1] = w1_; }
                __builtin_amdgcn_sched_barrier(0);
                mfma8p_acc(o0, pf, vf0, 0x7f7f7f7f, 0x7c7c7c7c);
                mfma8p_acc(o1, pf, vf1, 0x7f7f7f7f, 0x7c7c7c7c);
                mfma8p_acc(ls, pf, ones8, 0x7f7f7f7f, 0x7f7f7f7f);
                __builtin_amdgcn_sched_barrier(0);
            } else if (!bailed && t + 1 == vis_lo) {
                ALAS const char* Kq_ = Kfr + ks1 * KSLOT;
                v8i k0_, k1_; C8_KFRAG(k0_, Kq_, 0); C8_KFRAG(k1_, Kq_, 1); mfma8_new(N0, k0_, qf, negm, sa8, sb8); mfma8_new(N1, k1_, qf, negm, sa8, sb8);
            }
            ks = ks1; vs ^= 1;
            ATT_WAIT_BAR();
        }
    }
    asm volatile("s_nop 15\n\ts_nop 15" : "+v"(o0), "+v"(o1), "+v"(ls));
    { bool bad_ = false;
#pragma unroll
      for (int r = 0; r < 16; ++r) bad_ |= !(ls[r] > 1.0e-30f && ls[r] < 5.0e4f);
      if (__any(bad_)) bailed = true; }
    if (bailed && lane == 0) bailw[0] = 1;
    if (r32 == 0) {
#pragma unroll
        for (int r = 0; r < 16; ++r) wsf[32 + crow(r, hi)] = ls[r]; }
    asm volatile("s_waitcnt lgkmcnt(0)" ::: "memory");
    write_o(A, o0, o1, wsf, shm, wid, lane, r32, hi, rowbase + q0 + wid * 32, 512 + h * 64);
    asm volatile("s_waitcnt lgkmcnt(0)\n\ts_barrier" ::: "memory");
    const int redo = __builtin_amdgcn_readfirstlane(bailw[0]);
    asm volatile("s_waitcnt lgkmcnt(0)\n\ts_barrier" ::: "memory");
    return redo != 0;
#undef CF_ISSUE_K
#undef C8_KFRAG
#undef CF_ISSUE_V
#undef CF_ROWMAX
#undef CF_BIAS
}
template <bool CHUNK>
__device__ __forceinline__ void attn_phase(const Args& A, int vcu, int G, ALAS char* shm, const int tidb) {
    if (G == 256) {
        for (int i = 0; i < 4; ++i) {
            int bh, qb;
            if (CHUNK) { const int u = vcu * 4 + i; bh = u >> 5; qb = u & 31; }
            else { const int s = vcu & 7; bh = vcu >> 3; qb = (i == 0) ? s : (i == 1) ? 15 - s : (i == 2) ? 16 + s : 31 - s; }
            if (CHUNK) { if (A.cpv8 ? chunk_unit_fast88(A, bh >> 3, bh & 7, qb, shm, tidb) : chunk_unit_fast(A, bh >> 3, bh & 7, qb, shm, tidb)) attn_unit<CHUNK>(A, bh >> 3, bh & 7, qb, shm, tidb); }
            else if (A.qk8) { if (A.pv8 ? mla_unit_fast88(A, bh >> 3, bh & 7, qb, shm, tidb) : mla_unit_fast8(A, bh >> 3, bh & 7, qb, shm, tidb)) attn_unit8(A, bh >> 3, bh & 7, qb, shm, tidb); }
            else if (mla_unit_fast(A, bh >> 3, bh & 7, qb, shm, tidb)) attn_unit<CHUNK>(A, bh >> 3, bh & 7, qb, shm, tidb);
        }
    } else {
        for (int u = vcu; u < 1024; u += G) { if (!CHUNK && A.qk8) attn_unit8(A, u >> 8, (u >> 5) & 7, u & 31, shm, tidb); else attn_unit<CHUNK>(A, u >> 8, (u >> 5) & 7, u & 31, shm, tidb); }
    }
}

#undef ATT_WAIT_BAR
}
#define GAS __attribute__((address_space(1)))
#define LAS __attribute__((address_space(3)))
typedef unsigned short bf16;
typedef unsigned v4u __attribute__((ext_vector_type(4)));
typedef float f32x4 __attribute__((ext_vector_type(4)));
typedef short bf16x8 __attribute__((ext_vector_type(8)));
typedef GAS unsigned gu32;
typedef GAS unsigned long long gu64;
#define RLX_AGENT __ATOMIC_RELAXED, __HIP_MEMORY_SCOPE_AGENT
#define LDS_WAIT() asm volatile("s_waitcnt lgkmcnt(0)" ::: "memory")
#define VM_WAIT() asm volatile("s_waitcnt vmcnt(0)" ::: "memory")
__device__ __forceinline__ unsigned long long rt() { return __builtin_amdgcn_s_memrealtime(); }
__device__ __forceinline__ unsigned f2bf(float f) { unsigned u = __builtin_bit_cast(unsigned, f); return (u + 0x7fffu + ((u >> 16) & 1u)) >> 16; }
__device__ __forceinline__ unsigned pk2(float lo, float hi) { return f2bf(lo) | (f2bf(hi) << 16); }

#define XB_TMO      128
#define XB_XCNT(j)  (256  + 64 * (j))
#define XB_XSUB(j)  (1280 + 64 * (j))
#define XB_XGEN(j)  (2304 + 64 * (j))
#define XB_TOP      3328
#define XB_TOPGEN   3392
#define XCD_BAR_WORDS 3456
#define XB_SPIN_CAP (1u << 18)

__device__ __forceinline__ unsigned xb_ld(unsigned* p)              { return __hip_atomic_load(p, __ATOMIC_RELAXED, __HIP_MEMORY_SCOPE_AGENT); }
__device__ __forceinline__ unsigned xb_add(unsigned* p, unsigned v) { return __hip_atomic_fetch_add(p, v, __ATOMIC_RELAXED, __HIP_MEMORY_SCOPE_AGENT); }
__device__ __forceinline__ unsigned xb_xcc_id() { return (unsigned)__builtin_amdgcn_s_getreg((3 << 11) | 20) & 0xFu; }
#define XB_SPIN(cond, bar) do { unsigned _sp = 0; while (cond) { __builtin_amdgcn_s_sleep(1); \
    if ((++_sp & 255u) == 0u) { if (xb_ld(&(bar)[XB_TMO])) break; if (_sp > XB_SPIN_CAP) { atomicAdd(&(bar)[XB_TMO], 1u); break; } } } } while (0)

struct XcdBarrier {
    unsigned* bar; unsigned x;
    volatile LAS unsigned* st;
};

__device__ __forceinline__ XcdBarrier xcd_barrier_post(unsigned* bar, volatile LAS unsigned* st, const bool t0  ) {
    XcdBarrier b; b.bar = bar; b.x = xb_xcc_id(); b.st = st;
    if (t0) (void)xb_add(&bar[XB_XCNT(b.x)], 1u);
    return b;
}
__device__ __forceinline__ void xcd_barrier_complete(unsigned* bar, unsigned x, unsigned& nloc, unsigned& nx) {
    const unsigned G = gridDim.x * gridDim.y * gridDim.z;
    unsigned sum, cnt, mine, sp = 0u;
    for (;;) {
        sum = 0u; cnt = 0u; mine = 0u;
#pragma unroll
        for (unsigned j = 0; j < 16; ++j) { const unsigned c = xb_ld(&bar[XB_XCNT(j)]); sum += c; cnt += (c > 0u) ? 1u : 0u; mine = (j == x) ? c : mine; }
        if (sum == G) break;
        __builtin_amdgcn_s_sleep(1);
        if ((++sp & 255u) == 0u) { if (xb_ld(&bar[XB_TMO])) break; if (sp > XB_SPIN_CAP) { atomicAdd(&bar[XB_TMO], 1u); break; } }
    }
    nloc = mine > 0u ? mine : 1u; nx = cnt > 0u ? cnt : 1u;
}

template <bool CENSUS> __device__ __forceinline__ void xcd_barrier(const XcdBarrier& b, const bool t0  ) {
    asm volatile("s_waitcnt vmcnt(0)" ::: "memory");
    __syncthreads();
    if (t0) {
        unsigned* bar = b.bar;
        __builtin_amdgcn_s_waitcnt(0);
        unsigned nloc = b.st[0], nx = b.st[1];
        if (CENSUS) { if (nloc == 0u) { xcd_barrier_complete(bar, b.x, nloc, nx); b.st[0] = nloc; b.st[1] = nx; } }
        const unsigned old = xb_add(&bar[XB_XSUB(b.x)], 1u);
        const unsigned gen = old / nloc;
        if (old + 1u == (gen + 1u) * nloc) {
            __builtin_amdgcn_fence(__ATOMIC_RELEASE, "agent");
            asm volatile("s_waitcnt vmcnt(0)" ::: "memory");
            const unsigned og = xb_add(&bar[XB_TOP], 1u);
            const unsigned tg = og / nx;
            if (og + 1u == (tg + 1u) * nx) xb_add(&bar[XB_TOPGEN], 1u);
            else XB_SPIN(xb_ld(&bar[XB_TOPGEN]) == tg, bar);
            __builtin_amdgcn_fence(__ATOMIC_ACQUIRE, "agent");
            xb_add(&bar[XB_XGEN(b.x)], 1u);
            asm volatile("s_waitcnt vmcnt(0)" ::: "memory");
        } else {
            XB_SPIN(xb_ld(&bar[XB_XGEN(b.x)]) == gen, bar);
            __builtin_amdgcn_fence(__ATOMIC_ACQUIRE, "agent");
            asm volatile("s_waitcnt vmcnt(0)" ::: "memory");
        }
    }
    __syncthreads();
}
static_assert(att::L_END <= RING_BYTES && RSTAB_OFF + 8 * 1024 <= LDS_BYTES, "LDS map");
typedef unsigned v2u __attribute__((ext_vector_type(2)));
typedef int v4i __attribute__((ext_vector_type(4)));
#define SWZ_XOR(x) (((x) << 10) | 0x1F)
__device__ __forceinline__ float wave_sum(float v) {
    v += __int_as_float(__builtin_amdgcn_ds_swizzle(__float_as_int(v), SWZ_XOR(1))); v += __int_as_float(__builtin_amdgcn_ds_swizzle(__float_as_int(v), SWZ_XOR(2)));
    v += __int_as_float(__builtin_amdgcn_ds_swizzle(__float_as_int(v), SWZ_XOR(4))); v += __int_as_float(__builtin_amdgcn_ds_swizzle(__float_as_int(v), SWZ_XOR(8)));
    v += __int_as_float(__builtin_amdgcn_ds_swizzle(__float_as_int(v), SWZ_XOR(16)));
    auto rr = __builtin_amdgcn_permlane32_swap(__float_as_uint(v), __float_as_uint(v), false, false); return __uint_as_float(rr[0]) + __uint_as_float(rr[1]);
}
__device__ __forceinline__ int wave_sum_i(int v) {
    v += __builtin_amdgcn_ds_swizzle(v, SWZ_XOR(1)); v += __builtin_amdgcn_ds_swizzle(v, SWZ_XOR(2)); v += __builtin_amdgcn_ds_swizzle(v, SWZ_XOR(4)); v += __builtin_amdgcn_ds_swizzle(v, SWZ_XOR(8)); v += __builtin_amdgcn_ds_swizzle(v, SWZ_XOR(16));
    auto rr = __builtin_amdgcn_permlane32_swap((unsigned)v, (unsigned)v, false, false); return (int)(rr[0] + rr[1]);
}
enum { TM_ID = 0, TM_IN, TM_UQ, TM_UKV, TM_W1, TM_W3 };
__device__ __forceinline__ int rope_pos(int j) { return j < 16 ? 8 * (j >> 2) + (j & 3) : 8 * ((j - 16) >> 2) + 4 + (j & 3); }
__device__ __forceinline__ int tr_dest_row(int mode, int n0, int n) {
    if (mode == TM_IN) { const int gb = n0 < 672 ? n0 : n0 + 96; return gb + (n0 == 640 ? rope_pos(n) : n); }
    if (mode == TM_UQ) return n0 + ((((n0 >> 5) % 3) == 2) ? rope_pos(n) : n);
    if (mode == TM_UKV) { const int h = n0 >> 7, j0 = n0 & 127; return (j0 < 64 ? h * 64 + j0 : 512 + h * 64 + (j0 - 64)) + n; }
    if (mode == TM_W1) return (n0 >> 7) * 256 + (n0 & 127) + n;
    if (mode == TM_W3) return (n0 >> 7) * 256 + 128 + (n0 & 127) + n;
    return n0 + n;
}
struct TrJob { const float* W; int K, N; bf16* dst; const float* gain; int mode; int f8; };
__device__ __forceinline__ void tr_item(const TrJob& J, int item, LAS float* scr, int lane) {
    const int nblk = J.N / 32, kb = item / nblk, nb = item % nblk, k0 = 64 * kb, n0 = 32 * nb;
    float wv[32];
#pragma unroll
    for (int i = 0; i < 32; ++i) wv[i] = __builtin_nontemporal_load(J.W + (size_t)(k0 + 2 * i + (lane >> 5)) * J.N + n0 + (lane & 31));
#pragma unroll
    for (int i = 0; i < 32; ++i) scr[(2 * i + (lane >> 5)) * 33 + (lane & 31)] = wv[i];
    LDS_WAIT(); asm volatile("" ::: "memory");
    const int c = lane & 7; float g[8];
#pragma unroll
    for (int e = 0; e < 8; ++e) g[e] = J.gain ? J.gain[k0 + 8 * c + e] : 1.f;
#pragma unroll
    for (int j = 0; j < 4; ++j) { const int n = (lane >> 3) + 8 * j; const LAS float* s = scr + (8 * c) * 33 + n;
        if (J.f8) { int w0 = 0, w1 = 0;
            w0 = __builtin_amdgcn_cvt_pk_fp8_f32(s[0 * 33] * g[0] * 64.0f, s[1 * 33] * g[1] * 64.0f, w0, false); w0 = __builtin_amdgcn_cvt_pk_fp8_f32(s[2 * 33] * g[2] * 64.0f, s[3 * 33] * g[3] * 64.0f, w0, true);
            w1 = __builtin_amdgcn_cvt_pk_fp8_f32(s[4 * 33] * g[4] * 64.0f, s[5 * 33] * g[5] * 64.0f, w1, false); w1 = __builtin_amdgcn_cvt_pk_fp8_f32(s[6 * 33] * g[6] * 64.0f, s[7 * 33] * g[7] * 64.0f, w1, true);
            v2u o; o.x = (unsigned)w0; o.y = (unsigned)w1; *(GAS v2u*)((unsigned char*)J.dst + (size_t)tr_dest_row(J.mode, n0, n) * J.K + k0 + 8 * c) = o; }
        else { v4u o; o.x = pk2(s[0 * 33] * g[0], s[1 * 33] * g[1]); o.y = pk2(s[2 * 33] * g[2], s[3 * 33] * g[3]); o.z = pk2(s[4 * 33] * g[4], s[5 * 33] * g[5]); o.w = pk2(s[6 * 33] * g[6], s[7 * 33] * g[7]);
        *(GAS v4u*)(J.dst + (size_t)tr_dest_row(J.mode, n0, n) * J.K + k0 + 8 * c) = o; } }
    LDS_WAIT(); asm volatile("" ::: "memory");
}
__device__ __forceinline__ void tr_run(const TrJob& J, int& base, int gw, int NGW, LAS float* scr, int lane) {
    const int nitems = (J.K / 64) * (J.N / 32);
    int first = gw - (base % NGW); if (first < 0) first += NGW;
    for (int it = first; it < nitems; it += NGW) tr_item(J, it, scr, lane);
    base += nitems;
}
template <bool INIT, bool FINAL>
__device__ __forceinline__ void row_pass(const float* xin, float* xout, bf16* xb, float* ssx, const bf16* Y, const int* pos, const float* gfin, int gw, int NGW, int lane, unsigned char* xq = nullptr  ) {
    constexpr bool Y8 = FINAL;
    constexpr int U = 4;
    for (int t0 = gw; t0 < T_; t0 += U * NGW) {
        f32x4 v[U][4];
        if (INIT) {
#pragma unroll
            for (int u = 0; u < U; ++u) { const int t = t0 + u * NGW; if (t < T_) { const GAS f32x4* xr = (const GAS f32x4*)(xin + (size_t)t * D_) + lane;
#pragma unroll
                for (int j = 0; j < 4; ++j) v[u][j] = xr[64 * j]; } }
        } else {
            int p0[U], p1[U];
#pragma unroll
            for (int u = 0; u < U; ++u) { const int t = t0 + u * NGW; p0[u] = 0; p1[u] = 0; if (t < T_) { p0[u] = pos[2 * t]; p1[u] = pos[2 * t + 1]; } }
            v2u xw[U][4], aw[U][4], bw[U][4];
#pragma unroll
            for (int u = 0; u < U; ++u) { const int t = t0 + u * NGW; if (t < T_) {
                const GAS v2u* x0 = (const GAS v2u*)(xb + (size_t)t * D_) + lane;
                if (Y8) { const GAS unsigned* y0 = (const GAS unsigned*)((const unsigned char*)Y + (size_t)p0[u] * D_) + lane; const GAS unsigned* y1 = (const GAS unsigned*)((const unsigned char*)Y + (size_t)p1[u] * D_) + lane;
#pragma unroll
                    for (int j = 0; j < 4; ++j) { xw[u][j] = x0[64 * j]; aw[u][j].x = y0[64 * j]; aw[u][j].y = 0u; bw[u][j].x = y1[64 * j]; bw[u][j].y = 0u; } }
                else { const GAS v2u* y0 = (const GAS v2u*)(Y + (size_t)p0[u] * D_) + lane; const GAS v2u* y1 = (const GAS v2u*)(Y + (size_t)p1[u] * D_) + lane;
#pragma unroll
                    for (int j = 0; j < 4; ++j) { xw[u][j] = x0[64 * j]; aw[u][j] = y0[64 * j]; bw[u][j] = y1[64 * j]; } } } }
#pragma unroll
            for (int u = 0; u < U; ++u)
#pragma unroll
                for (int j = 0; j < 4; ++j) { const v2u c = xw[u][j], a = aw[u][j], b = bw[u][j];
                    if (Y8) { typedef float f2_ __attribute__((ext_vector_type(2)));
                        const f2_ a01 = __builtin_amdgcn_cvt_pk_f32_fp8((int)a.x, false), a23 = __builtin_amdgcn_cvt_pk_f32_fp8((int)a.x, true), b01 = __builtin_amdgcn_cvt_pk_f32_fp8((int)b.x, false), b23 = __builtin_amdgcn_cvt_pk_f32_fp8((int)b.x, true);
                        v[u][j].x = __uint_as_float(c.x << 16) + (a01[0] + b01[0]) * 0.125f; v[u][j].y = __uint_as_float(c.x & 0xffff0000u) + (a01[1] + b01[1]) * 0.125f;
                        v[u][j].z = __uint_as_float(c.y << 16) + (a23[0] + b23[0]) * 0.125f; v[u][j].w = __uint_as_float(c.y & 0xffff0000u) + (a23[1] + b23[1]) * 0.125f; }
                    else {
                    v[u][j].x = __uint_as_float(c.x << 16) + (__uint_as_float(a.x << 16) + __uint_as_float(b.x << 16)); v[u][j].y = __uint_as_float(c.x & 0xffff0000u) + (__uint_as_float(a.x & 0xffff0000u) + __uint_as_float(b.x & 0xffff0000u));
                    v[u][j].z = __uint_as_float(c.y << 16) + (__uint_as_float(a.y << 16) + __uint_as_float(b.y << 16)); v[u][j].w = __uint_as_float(c.y & 0xffff0000u) + (__uint_as_float(a.y & 0xffff0000u) + __uint_as_float(b.y & 0xffff0000u)); } }
        }
#pragma unroll
        for (int u = 0; u < U; ++u) { const int t = t0 + u * NGW; if (t < T_) {
            float ss = 0.f;
#pragma unroll
            for (int j = 0; j < 4; ++j) ss += (v[u][j].x * v[u][j].x + v[u][j].y * v[u][j].y) + (v[u][j].z * v[u][j].z + v[u][j].w * v[u][j].w);
            ss = wave_sum(ss);
            if (FINAL) {
                GAS f32x4* xo = (GAS f32x4*)(xout + (size_t)t * D_) + lane;
                const float rs = 1.0f / sqrtf(ss * (1.0f / D_) + EPS_);
#pragma unroll
                for (int j = 0; j < 4; ++j) { const f32x4 g = ((const GAS f32x4*)gfin)[lane + 64 * j]; xo[64 * j] = v[u][j] * rs * g; }
            } else {
                GAS v2u* bo = (GAS v2u*)(xb + (size_t)t * D_) + lane;
#pragma unroll
                for (int j = 0; j < 4; ++j) { v2u w; w.x = pk2(v[u][j].x, v[u][j].y); w.y = pk2(v[u][j].z, v[u][j].w); bo[64 * j] = w; }
                if (xq) { GAS unsigned* qo = (GAS unsigned*)(xq + (size_t)t * D_) + lane;
#pragma unroll
                    for (int j = 0; j < 4; ++j) { int w = 0;
                        w = __builtin_amdgcn_cvt_pk_fp8_f32(__builtin_amdgcn_fmed3f(v[u][j].x * 8.0f, -448.f, 448.f), __builtin_amdgcn_fmed3f(v[u][j].y * 8.0f, -448.f, 448.f), w, false);
                        w = __builtin_amdgcn_cvt_pk_fp8_f32(__builtin_amdgcn_fmed3f(v[u][j].z * 8.0f, -448.f, 448.f), __builtin_amdgcn_fmed3f(v[u][j].w * 8.0f, -448.f, 448.f), w, true); qo[64 * j] = (unsigned)w; } }
                if (lane < 16) ssx[(size_t)t * 16 + lane] = lane == 0 ? ss : 0.f;
            } } }
    }
}
__device__ __forceinline__ void moe_route1(LAS unsigned char* lds, const bf16* x, const float* ssx, const float* wr, const float* g, int* tok_e, float* tok_g, float* tok_rs, int* counts, int bx, int G, int tid, int wave, int lane) {
    LAS float* wrgT = (LAS float*)lds;
    LAS int* hist = (LAS int*)(lds + 32768);
    for (int idx = tid; idx < 8192; idx += 512) { const int k = idx >> 3, e = idx & 7; wrgT[e * 1024 + k] = wr[idx] * g[k]; }
    __syncthreads();
    for (int ch = bx; ch < T_ / 128; ch += G) {
        if (tid < 8) hist[tid] = 0;
        __syncthreads();
        for (int i = 0; i < 16; ++i) {
            const int t = ch * 128 + wave * 16 + i;
            const GAS v2u* xr = (const GAS v2u*)(x + (size_t)t * D_) + lane;
            f32x4 xv[4];
#pragma unroll
            for (int j = 0; j < 4; ++j) { const v2u c = xr[64 * j]; xv[j] = (f32x4){__uint_as_float(c.x << 16), __uint_as_float(c.x & 0xffff0000u), __uint_as_float(c.y << 16), __uint_as_float(c.y & 0xffff0000u)}; }
            float lg[8];
#pragma unroll
            for (int e = 0; e < 8; ++e) { float a = 0.f;
#pragma unroll
                for (int j = 0; j < 4; ++j) { const f32x4 w = *(const LAS f32x4*)(wrgT + e * 1024 + 256 * j + 4 * lane); a += (xv[j].x * w.x + xv[j].y * w.y) + (xv[j].z * w.z + xv[j].w * w.w); }
                lg[e] = wave_sum(a); }
            const float ssp = lane < 16 ? ssx[(size_t)t * 16 + lane] : 0.f;
            const float rs = 1.0f / sqrtf(wave_sum(ssp) * (1.0f / D_) + EPS_);
#pragma unroll
            for (int e = 0; e < 8; ++e) lg[e] *= rs;
            int e0 = 0; float b0 = lg[0];
#pragma unroll
            for (int e = 1; e < 8; ++e) if (lg[e] > b0) { b0 = lg[e]; e0 = e; }
            int e1 = -1; float b1 = -3.0e38f;
#pragma unroll
            for (int e = 0; e < 8; ++e) if (e != e0 && (e1 < 0 || lg[e] > b1)) { b1 = lg[e]; e1 = e; }
            const float g0 = 1.0f / (1.0f + __builtin_amdgcn_exp2f((b1 - b0) * LOG2E_)), g1 = 1.0f - g0;
            if (lane == 0) { tok_e[t] = e0 | (e1 << 8); tok_g[2 * t] = g0; tok_g[2 * t + 1] = g1; tok_rs[t] = rs; atomicAdd((int*)&hist[e0], 1); atomicAdd((int*)&hist[e1], 1); }
        }
        __syncthreads();
        if (tid < 8) counts[ch * 8 + tid] = hist[tid];
        __syncthreads();
    }
}
__device__ __forceinline__ void moe_route2(LAS unsigned char* lds, const bf16* xb, bf16* xs, const int* tok_e, const float* tok_g, const float* tok_rs, const int* counts, int* pos, float* rowg, float* rowrs, int* meta,
                                           int bx, int G, int tid, int wave, int lane, bool f8) {
    LAS int* lcnt = (LAS int*)lds; LAS int* ltot = lcnt + 2048; LAS int* lbef = ltot + 8; LAS int* ldest = lbef + 8;
    for (int ch = bx; ch < T_ / 128; ch += G) {
        { const v4i v = ((const v4i*)counts)[tid]; ((LAS v4i*)lcnt)[tid] = v; }
        __syncthreads();
        { const int e = wave; int tot = 0, bef = 0;
#pragma unroll
          for (int i = 0; i < 4; ++i) { const int c2 = lane + 64 * i; const int v = lcnt[c2 * 8 + e]; tot += v; bef += (c2 < ch) ? v : 0; }
          tot = wave_sum_i(tot); bef = wave_sum_i(bef); if (lane == 0) { ltot[e] = tot; lbef[e] = bef; } }
        __syncthreads();
        int pst[8], pen[8]; { int run = 0;
#pragma unroll
            for (int e = 0; e < 8; ++e) { const int tt = ltot[e]; pst[e] = run; run += (tt + 255) & ~255; pen[e] = run; } }
        if (wave == 0) {
            int runc[8];
#pragma unroll
            for (int e = 0; e < 8; ++e) runc[e] = pst[e] + lbef[e];
#pragma unroll
            for (int half = 0; half < 2; ++half) {
                const int tl = half * 64 + lane, t = ch * 128 + tl; const int ee = tok_e[t]; const int e0 = ee & 255, e1 = ee >> 8;
                int d0 = 0, d1 = 0;
#pragma unroll
                for (int e = 0; e < 8; ++e) { const bool m0 = (e0 == e), m1 = (e1 == e); const unsigned long long mk = __ballot(m0 || m1);
                    const int rank = __popcll(mk & ((1ull << lane) - 1ull)); if (m0) d0 = runc[e] + rank; if (m1) d1 = runc[e] + rank; runc[e] += __popcll(mk); }
                ldest[2 * tl] = d0; ldest[2 * tl + 1] = d1; pos[2 * t] = d0; pos[2 * t + 1] = d1;
                const float g0 = tok_g[2 * t], g1 = tok_g[2 * t + 1], rs = tok_rs[t];
                rowg[d0] = g0; rowg[d1] = g1; rowrs[d0] = rs; rowrs[d1] = rs;
            }
        }
        __syncthreads();
        if (f8) {
            for (int ab = wave; ab < 256; ab += 32) {
              v4u ra0[4], ra1[4]; float rsc[4];
#pragma unroll
              for (int u = 0; u < 4; ++u) { const int a = ab + 8 * u, t = ch * 128 + (a >> 1); rsc[u] = tok_rs[t] * 16.0f; const GAS v4u* s = (const GAS v4u*)(xb + (size_t)t * D_) + 2 * lane; ra0[u] = s[0]; ra1[u] = s[1]; }
#pragma unroll
              for (int u = 0; u < 4; ++u) { const int a = ab + 8 * u; const int d = ldest[a]; const float sc = rsc[u]; const v4u a0 = ra0[u], a1 = ra1[u];
                v4u o;
#define F8PK(w) ({ int r_ = 0; r_ = __builtin_amdgcn_cvt_pk_fp8_f32(__builtin_amdgcn_fmed3f(__uint_as_float((w).x << 16) * sc, -448.f, 448.f), __builtin_amdgcn_fmed3f(__uint_as_float((w).x & 0xffff0000u) * sc, -448.f, 448.f), r_, false); \
                   r_ = __builtin_amdgcn_cvt_pk_fp8_f32(__builtin_amdgcn_fmed3f(__uint_as_float((w).y << 16) * sc, -448.f, 448.f), __builtin_amdgcn_fmed3f(__uint_as_float((w).y & 0xffff0000u) * sc, -448.f, 448.f), r_, true); (unsigned)r_; })
                { v2u p; p.x = a0.x; p.y = a0.y; o.x = F8PK(p); p.x = a0.z; p.y = a0.w; o.y = F8PK(p); p.x = a1.x; p.y = a1.y; o.z = F8PK(p); p.x = a1.z; p.y = a1.w; o.w = F8PK(p); }
#undef F8PK
                *((GAS v4u*)((unsigned char*)xs + (size_t)d * D_) + lane) = o; } }
        } else {
        for (int a = wave; a < 256; a += 8) { const int t = ch * 128 + (a >> 1); const int d = ldest[a];
            const GAS v4u* s = (const GAS v4u*)(xb + (size_t)t * D_) + lane; GAS v4u* o = (GAS v4u*)(xs + (size_t)d * D_) + lane;
            const v4u a0 = s[0], a1 = s[64]; o[0] = a0; o[64] = a1; }
        }
        if (ch == 0) {
            int pv = 0, ps = 0, tt = 0, pe_ = 0;
#pragma unroll
            for (int e = 0; e < 8; ++e) { if (tid == e) pv = pen[e]; if (wave == e) { ps = pst[e]; pe_ = pen[e]; tt = ltot[e]; } }
            if (tid < 8) meta[tid] = pv;
            for (int r = ps + tt + lane; r < pe_; r += 64) { rowrs[r] = 0.f; rowg[r] = 0.f; }
        }
        __syncthreads();
    }
}

struct Params { const float* in[18]; float* out; unsigned char* ws; int ph_lo, ph_hi; };
typedef __attribute__((address_space(4))) Params KP;
constexpr int IT_FF = (D_ / 64) * (FF_ / 32), MOE_ITEMS = NEXP * 3 * IT_FF;
static_assert(IT_FF == (FF_ / 64) * (D_ / 32), "w1 / w3 / w2 have the same item count");
constexpr int FILL_IN = 6000, FILL_IN8 = 4000, FILL_UQ = 2000, FILL_MD = 16000;
constexpr int fill_in(int l) { return f8_in_layer(l) ? FILL_IN8 : FILL_IN; }
constexpr int fill_in_at(int l) { return (l & 1) == 0 ? (l < 2 ? 0 : FILL_MD) : fill_in_at(l - 1) + fill_in(l - 1) + FILL_UQ; }
constexpr int FA0 = fill_in_at(0), FA1 = fill_in_at(1), FA2 = fill_in_at(2), FA3 = fill_in_at(3), FN0 = fill_in(0), FN1 = fill_in(1), FN2 = fill_in(2), FN3 = fill_in(3);
constexpr int L1_DONE = fill_in_at(1) + fill_in(1) + FILL_UQ, L3_DONE = fill_in_at(3) + fill_in(3) + FILL_UQ;
static_assert(FILL_MD <= NEXP * 2 * IT_FF && L3_DONE <= MOE_ITEMS, "early ranges");
__device__ __forceinline__ void moe_job(const KP* kp, unsigned char* ws, int l, int g, TrJob& J, int& it) {
    const int mj = l >> 1, j = g / IT_FF; it = g % IT_FF;
    unsigned char* WM13 = ws + WS_WM; unsigned char* WM2 = WM13 + (size_t)NEXP * 2 * FF_ * D_ * 2; const int eb = f8_layer(l) ? 1 : 2;
    if (j < 2 * NEXP) { const int e = j >> 1;
        if ((j & 1) == 0) J = TrJob{kp->in[14] + (size_t)(mj * NEXP + e) * D_ * FF_, D_, FF_, (bf16*)(WM13 + (size_t)e * 2 * FF_ * D_ * eb), kp->in[9] + l * D_, TM_W1, (int)f8_layer(l)};
        else J = TrJob{kp->in[15] + (size_t)(mj * NEXP + e) * D_ * FF_, D_, FF_, (bf16*)(WM13 + (size_t)e * 2 * FF_ * D_ * eb), kp->in[9] + l * D_, TM_W3, (int)f8_layer(l)};
    } else { const int e = j - 2 * NEXP; J = TrJob{kp->in[16] + (size_t)(mj * NEXP + e) * FF_ * D_, FF_, D_, (bf16*)(WM2 + (size_t)e * FF_ * D_ * eb), nullptr, TM_ID, (int)f8_layer(l)}; }
}
__device__ __forceinline__ void moe_fill(const KP* kp, unsigned char* ws, int l, int a, int b, int nwg, int G, int c, int wave, LAS unsigned char* lds, int lane) {
    const int r = nwg % G; int P = G, pidx = c;
    if (r != 0) { P = G - r; pidx = c - r; }
    if (pidx >= 0) { LAS float* scr = (LAS float*)(lds + wave * 16384);
        for (int g = a + pidx * NWAVES + wave; g < b; g += P * NWAVES) { TrJob J; int it; moe_job(kp, ws, l, g, J, it); tr_item(J, it, scr, lane); } }
    __syncthreads();
}
__device__ __forceinline__ const KP* kargs() { const KP* p = (const KP*)__builtin_amdgcn_kernarg_segment_ptr(); asm volatile("" : "+s"(p)); return p; }
__global__ void __launch_bounds__(NWAVES * 64, 2) hybrid_fwd(Params P) {
    extern __shared__ __attribute__((aligned(16))) unsigned char lds_raw[];
    LAS unsigned char* lds = (LAS unsigned char*)lds_raw;
    const int wave_s = __builtin_amdgcn_readfirstlane((int)threadIdx.x >> 6);
#define LANE_NOW() ({ int l_; asm volatile("v_mbcnt_lo_u32_b32 %0, -1, 0\n\tv_mbcnt_hi_u32_b32 %0, -1, %0" : "=v"(l_)); l_; })
#define T0_NOW() (wave_s == 0 && LANE_NOW() == 0)
    { const int tid0 = wave_s * 64 + LANE_NOW();
      for (int u = tid0; u < (LDS_BYTES - LDSCTL_OFF) / 4; u += NWAVES * 64) ((LAS unsigned*)(lds + LDSCTL_OFF))[u] = 0u; }
    __syncthreads();
#define GEOM() int G_l = gridDim.x, bx_l = blockIdx.x; asm volatile("" : "+s"(G_l), "+s"(bx_l));   const int G = G_l, bx = bx_l, vcu = (G % 8 == 0) ? (bx % 8) * (G / 8) + bx / 8 : bx; const int wave = wave_s; const int gw = vcu * NWAVES + wave, NGW = G * NWAVES; (void)gw; (void)NGW; (void)vcu; (void)bx
#define BAROBJ() XcdBarrier bar; bar.bar = (unsigned*)(kargs()->ws + WS_CTL); bar.x = xb_xcc_id(); bar.st = (volatile LAS unsigned*)(lds + MISC_OFF) + 8
    { const KP* kp0 = kargs(); const int lo0 = kp0->ph_lo, hi0 = kp0->ph_hi;
      if (hi0 - lo0 > 1) { XcdBarrier b0 = xcd_barrier_post((unsigned*)(kp0->ws + WS_CTL), (volatile LAS unsigned*)(lds + MISC_OFF) + 8, T0_NOW());
        if (lo0 != 0) { if (T0_NOW()) { unsigned nloc, nx; xcd_barrier_complete(b0.bar, b0.x, nloc, nx); b0.st[0] = nloc; b0.st[1] = nx; } __syncthreads(); } } }
#ifndef PROBE_MASK
#define PROBE_MASK 0
#endif
#define REPS(bit) ((((PROBE_MASK) >> (bit)) & 1) ? 2 : 1)
#define RUN(k) (kargs()->ph_lo <= (k) && (k) < kargs()->ph_hi)
#ifdef PROBE_BAR2
#define SEAM(k) do { if (RUN(k) && RUN((k) + 1)) { BAROBJ(); xcd_barrier<false>(bar, T0_NOW()); xcd_barrier<false>(bar, T0_NOW()); } } while (0)
#else
#define SEAM(k) do { if (RUN(k) && RUN((k) + 1)) { BAROBJ(); xcd_barrier<false>(bar, T0_NOW()); } } while (0)
#endif
#define SEAM_FIRST(k) do { if (RUN(k) && RUN((k) + 1)) { BAROBJ(); xcd_barrier<true>(bar, T0_NOW()); } } while (0)
#define PHASE_ENV() const KP* kp = kargs(); unsigned char* ws = kp->ws; (void)ws; const int lane_p = LANE_NOW(); const int tid_p = wave_s * 64 + lane_p; (void)tid_p; (void)lane_p; GEOM(); \
    float* X = kp->out; bf16* XB = (bf16*)(ws + WS_XB); float* SSX = (float*)(ws + WS_SSX); float* SSQ = (float*)(ws + WS_SSQ); float* RCOS = (float*)(ws + WS_RCOS); float* RSIN = (float*)(ws + WS_RSIN); \
    LAS float* rstab = (LAS float*)(lds + RSTAB_OFF); (void)X; (void)XB; (void)SSX; (void)SSQ; (void)RCOS; (void)RSIN; (void)rstab
#define ATT_PTRS() bf16 *CQ = (bf16*)(ws + WS_CQ), *CKV = (bf16*)(ws + WS_CKV), *KR = (bf16*)(ws + WS_KR), *QBb = (bf16*)(ws + WS_QB), *KBb = (bf16*)(ws + WS_KB), *VBb = (bf16*)(ws + WS_VB), \
         *Qm = (bf16*)(ws + WS_Q), *KN = (bf16*)(ws + WS_KN), *Vm = (bf16*)(ws + WS_V), *AO = (bf16*)(ws + WS_AO); (void)CQ; (void)CKV; (void)KR; (void)QBb; (void)KBb; (void)VBb; (void)Qm; (void)KN; (void)Vm; (void)AO
#define MOE_PTRS() bf16 *HM = (bf16*)(ws + WS_HM), *XS = (bf16*)(ws + WS_XS); int* TOKE = (int*)(ws + WS_TOKE); float* TOKG = (float*)(ws + WS_TOKG); float* TOKRS = (float*)(ws + WS_TOKRS); int* POS = (int*)(ws + WS_POS); \
    int* CNT = (int*)(ws + WS_CNT); int* META = (int*)(ws + WS_META); float* ROWG = (float*)(ws + WS_ROWG); float* ROWRS = (float*)(ws + WS_ROWRS); bf16* WM13 = (bf16*)(ws + WS_WM); bf16* WM2 = WM13 + (size_t)NEXP * 2 * FF_ * D_; \
    (void)HM; (void)XS; (void)TOKE; (void)TOKG; (void)TOKRS; (void)POS; (void)CNT; (void)META; (void)ROWG; (void)ROWRS; (void)WM13; (void)WM2
#define WATT_PTRS() const bf16* WIN = (const bf16*)(ws + WS_WATT + (size_t)l * WATT_L); const bf16* WUQ = WIN + (size_t)IN_PAD * D_; const bf16* WUKV = WUQ + 768 * QL_; const bf16* WOUT = WUKV + 1024 * KVL_; (void)WIN; (void)WUQ; (void)WUKV; (void)WOUT

    if (RUN(0)) for (int rep_ = 0; rep_ < REPS(9); ++rep_) {
        PHASE_ENV();
        LAS float* scr = (LAS float*)(lds + wave * 16384);
        int base = 0;
        for (int j = 0; j < 22; ++j) {
            TrJob J;
            if (j < 16) { const int l = j >> 2, k = j & 3; bf16* wl = (bf16*)(ws + WS_WATT + (size_t)l * WATT_L);
                if (k == 0) J = TrJob{kp->in[2] + (size_t)l * D_ * IN_DIM, D_, IN_DIM, wl, kp->in[1] + l * D_, TM_IN, (int)f8_in_layer(l)};
                else if (k == 1) J = TrJob{kp->in[4] + (size_t)l * QL_ * 768, QL_, 768, wl + (size_t)IN_PAD * D_, kp->in[3] + l * QL_, TM_UQ, 0};
                else if (k == 2) J = TrJob{kp->in[6] + (size_t)l * KVL_ * 1024, KVL_, 1024, wl + (size_t)IN_PAD * D_ + 768 * QL_, kp->in[5] + l * KVL_, TM_UKV, 0};
                else J = TrJob{kp->in[8] + (size_t)l * D_ * D_, D_, D_, wl + (size_t)IN_PAD * D_ + 768 * QL_ + 1024 * KVL_, nullptr, TM_ID, (int)f8_out_layer(l)};
            } else { const int dl = (j - 16) / 3, k = (j - 16) % 3; bf16* wl = (bf16*)(ws + WS_WD + (size_t)dl * WD_L);
                if (k == 0) J = TrJob{kp->in[10] + (size_t)dl * D_ * FF_, D_, FF_, wl, kp->in[9] + (2 * dl) * D_, TM_W1, (int)f8_up_layer(2 * dl)};
                else if (k == 1) J = TrJob{kp->in[11] + (size_t)dl * D_ * FF_, D_, FF_, wl, kp->in[9] + (2 * dl) * D_, TM_W3, (int)f8_up_layer(2 * dl)};
                else J = TrJob{kp->in[12] + (size_t)dl * FF_ * D_, FF_, D_, wl + (size_t)2 * FF_ * D_, nullptr, TM_ID, (int)f8_layer(2 * dl)};
            }
            tr_run(J, base, gw, NGW, scr, lane_p);
        }
        for (int r = gw; r < DEPTH_ * 96; r += NGW) {
            const v4u z = {0u, 0u, 0u, 0u};
            if (f8_in_layer(r / 96)) { GAS v4u* o = (GAS v4u*)((unsigned char*)(ws + WS_WATT + (size_t)(r / 96) * WATT_L) + (size_t)(672 + r % 96) * D_) + lane_p; o[0] = z; }
            else { GAS v4u* o = (GAS v4u*)((bf16*)(ws + WS_WATT + (size_t)(r / 96) * WATT_L) + (size_t)(672 + r % 96) * D_) + lane_p; o[0] = z; o[64] = z; } }
        for (int idx = gw * 64 + lane_p; idx < 8192 * 16; idx += NGW * 64) {
            const int pos = idx >> 4, j = idx & 15, j4 = j & 3, jq = j >> 2;
            const double c4 = j4 == 0 ? 1.0 : j4 == 1 ? 0.5623413251903491 : j4 == 2 ? 0.31622776601683794 : 0.17782794100389228;
            const double p10 = jq == 0 ? 1.0 : jq == 1 ? 0.1 : jq == 2 ? 0.01 : 0.001;
            double a = (double)pos * (c4 * p10) * 0.15915494309189535; a -= __builtin_floor(a);
            const float rv = (float)a; RCOS[idx] = __builtin_amdgcn_cosf(rv); RSIN[idx] = __builtin_amdgcn_sinf(rv);
        }
        if (gw == 0) { const v4u z = {0u, 0u, 0u, 0u}; ((GAS v4u*)(ws + WS_ZERO))[lane_p] = z; }
        row_pass<true, false>(kp->in[0], nullptr, XB, SSX, nullptr, nullptr, nullptr, gw, NGW, lane_p, f8_in_layer(0) ? ws + WS_XQ2 : nullptr);
    }
    SEAM_FIRST(0);
    int step = 1;
    for (int l = 0; l < DEPTH_; ++l) {
        if (RUN(step)) for (int rep_ = 0; rep_ < REPS(0); ++rep_) {
            PHASE_ENV(); ATT_PTRS(); WATT_PTRS();
            pg8::Gemm g{XB, WIN, T_, IN_PAD, D_}; pg8::StaticOrder S; S.init(T_, IN_PAD, G, bx);
            pg8::EpiIn E{ws, 0.125f * LOG2E_, rstab, (int)f8_qk_layer(l), (int)f8_chunk_layer(l)};
            if ((F8_IN_LAYERS) != 0 && f8_in_layer(l)) { pg8::Gemm g8{(const bf16*)(ws + ((l & 1) ? WS_XS : WS_XQ2)), WIN, T_, IN_PAD, D_};
                pg8::gemm_phase<pg8::EpiIn, pg8::StaticOrder, true, true, true>(lds, g8, S, E, wave_s * 64); }
            else pg8::gemm_phase<pg8::EpiIn, pg8::StaticOrder, true, true>(lds, g, S, E, wave_s * 64);
            { const int ml = l < 2 ? 1 : 3, a0 = l == 0 ? FA0 : l == 1 ? FA1 : l == 2 ? FA2 : FA3, n0 = l == 0 ? FN0 : l == 1 ? FN1 : l == 2 ? FN2 : FN3; moe_fill(kp, ws, ml, a0, a0 + n0, (T_ / 256) * (IN_PAD / 256), G, bx, wave, lds, lane_p); }
        }
        SEAM(step); ++step;
        if (RUN(step)) {
            for (int rep_ = 0; rep_ < REPS(1); ++rep_) { PHASE_ENV(); ATT_PTRS(); WATT_PTRS();
              pg8::Gemm g{CQ, WUQ, T_, 768, QL_}; pg8::StaticOrder S; S.init(T_, 768, G, bx);
              pg8::EpiQ E{ws, 0.10206207261596575f * LOG2E_, rstab, (int)f8_qk_layer(l)};
              pg8::gemm_phase<pg8::EpiQ, pg8::StaticOrder, true, true>(lds, g, S, E, wave_s * 64);
              { const int ml = l < 2 ? 1 : 3, a0 = l == 0 ? FA0 + FN0 : l == 1 ? FA1 + FN1 : l == 2 ? FA2 + FN2 : FA3 + FN3; moe_fill(kp, ws, ml, a0, a0 + FILL_UQ, (T_ / 256) * (768 / 256), G, bx, wave, lds, lane_p); } }
            for (int rep_ = 0; rep_ < REPS(1); ++rep_) { PHASE_ENV(); ATT_PTRS(); WATT_PTRS();
              pg8::Gemm g{CKV, WUKV, T_, 1024, KVL_}; pg8::StaticOrder S; S.init(T_, 1024, G, bx);
              pg8::EpiKV E{ws, rstab, (int)f8_qk_layer(l), (int)f8_pv_layer(l)};
              pg8::gemm_phase<pg8::EpiKV, pg8::StaticOrder, true, true>(lds, g, S, E, wave_s * 64); }
        }
        SEAM(step); ++step;
        if (RUN(step)) {
            for (int rep_ = 0; rep_ < REPS(2); ++rep_) { PHASE_ENV(); ATT_PTRS();
              const att::Args A{Qm, KN, KR, Vm, QBb, KBb, VBb, AO, kp->in[7] + (size_t)l * 8 * 257, (int)f8_out_layer(l), ws + WS_Q8, ws + WS_KN8, ws + WS_KR8, ws + WS_ZERO, (int)f8_qk_layer(l), ws + WS_V8T, (int)f8_pv_layer(l), ws + WS_QB8, ws + WS_KB8, ws + WS_VB8T, (int)f8_chunk_layer(l)};
              att::attn_phase<false>(A, vcu, G, (LAS char*)lds, wave_s * 64); }
            for (int rep_ = 0; rep_ < REPS(3); ++rep_) { PHASE_ENV(); ATT_PTRS();
              const att::Args A{Qm, KN, KR, Vm, QBb, KBb, VBb, AO, kp->in[7] + (size_t)l * 8 * 257, (int)f8_out_layer(l), ws + WS_Q8, ws + WS_KN8, ws + WS_KR8, ws + WS_ZERO, (int)f8_qk_layer(l), ws + WS_V8T, (int)f8_pv_layer(l), ws + WS_QB8, ws + WS_KB8, ws + WS_VB8T, (int)f8_chunk_layer(l)};
              att::attn_phase<true>(A, vcu, G, (LAS char*)lds, wave_s * 64); }
        }
        SEAM(step); ++step;
        if (RUN(step)) for (int rep_ = 0; rep_ < REPS(10); ++rep_) {
            PHASE_ENV(); ATT_PTRS(); WATT_PTRS();
            pg8::Gemm g{AO, WOUT, T_, D_, D_}; pg8::StaticOrder S; S.init(T_, D_, G, bx);
            if ((F8_OUT_LAYERS) != 0 && f8_out_layer(l)) {
                if ((F8_UP_LAYERS) != 0 && f8_up_layer(l)) { pg8::EpiResQ E{ws, rep_ + 1 < REPS(10)}; pg8::gemm_phase<pg8::EpiResQ, pg8::StaticOrder, true, true, true>(lds, g, S, E, wave_s * 64); }
                else { pg8::EpiRes E{ws, rep_ + 1 < REPS(10)}; pg8::gemm_phase<pg8::EpiRes, pg8::StaticOrder, true, true, true>(lds, g, S, E, wave_s * 64); } }
            else if ((F8_UP_LAYERS) != 0 && f8_up_layer(l)) { pg8::EpiResQ E{ws, rep_ + 1 < REPS(10)}; pg8::gemm_phase<pg8::EpiResQ, pg8::StaticOrder, true, true>(lds, g, S, E, wave_s * 64); }
            else { pg8::EpiRes E{ws, rep_ + 1 < REPS(10)}; pg8::gemm_phase<pg8::EpiRes, pg8::StaticOrder, true, true>(lds, g, S, E, wave_s * 64); }
        }
        SEAM(step); ++step;
        if ((l & 1) == 0) {
            if (RUN(step)) for (int rep_ = 0; rep_ < REPS(4); ++rep_) {
                PHASE_ENV(); MOE_PTRS();
                const bf16* W13 = (const bf16*)(ws + WS_WD + (size_t)(l >> 1) * WD_L);
                pg8::Gemm g{XB, W13, T_, 2 * FF_, D_}; pg8::StaticOrder S; S.init(T_, 2 * FF_, G, bx);
#ifdef PROBE_NULLEPI
                if (rep_ + 1 < REPS(4)) { pg8::EpiNull E{ws}; pg8::gemm_phase<pg8::EpiNull, pg8::StaticOrder, true, true>(lds, g, S, E, wave_s * 64); } else
#endif
                if ((F8_UP_LAYERS) != 0 && f8_up_layer(l)) { pg8::Gemm g8{XS, W13, T_, 2 * FF_, D_}; pg8::EpiGLU<false, true> E{ws, rstab}; pg8::gemm_phase<pg8::EpiGLU<false, true>, pg8::StaticOrder, true, true, true>(lds, g8, S, E, wave_s * 64); }
                else                 if (F8_DENSE_ANY && (F8_DENSE_ALL || f8_layer(l))) { pg8::EpiGLU<false, true> E{ws, rstab}; pg8::gemm_phase<pg8::EpiGLU<false, true>, pg8::StaticOrder, true, true>(lds, g, S, E, wave_s * 64); }
                else if (!F8_DENSE_ALL) { pg8::EpiGLU<false, false> E{ws, rstab}; pg8::gemm_phase<pg8::EpiGLU<false, false>, pg8::StaticOrder, true, true>(lds, g, S, E, wave_s * 64); }
            }
            SEAM(step); ++step;
            if (RUN(step)) for (int rep_ = 0; rep_ < REPS(11); ++rep_) {
                PHASE_ENV(); MOE_PTRS();
                const bf16* W2 = (const bf16*)(ws + WS_WD + (size_t)(l >> 1) * WD_L) + (size_t)2 * FF_ * D_;
                pg8::Gemm g{HM, W2, T_, D_, FF_}; pg8::StaticOrder S; S.init(T_, D_, G, bx);
                pg8::EpiRes E{ws, rep_ + 1 < REPS(11)};
                if ((F8_IN_LAYERS) != 0 && f8_in_layer(l + 1) && f8_layer(l)) { pg8::EpiResQ EQ{ws, rep_ + 1 < REPS(11)}; pg8::gemm_phase<pg8::EpiResQ, pg8::StaticOrder, true, true, true>(lds, g, S, EQ, wave_s * 64); }
                else if (F8_DENSE_ANY && (F8_DENSE_ALL || f8_layer(l))) pg8::gemm_phase<pg8::EpiRes, pg8::StaticOrder, true, true, true>(lds, g, S, E, wave_s * 64);
                else if ((F8_IN_LAYERS) != 0 && f8_in_layer(l + 1)) { pg8::EpiResQ EQ{ws, rep_ + 1 < REPS(11)}; pg8::gemm_phase<pg8::EpiResQ, pg8::StaticOrder, true, true, false>(lds, g, S, EQ, wave_s * 64); }
                else if (!F8_DENSE_ALL) pg8::gemm_phase<pg8::EpiRes, pg8::StaticOrder, true, true, false>(lds, g, S, E, wave_s * 64);
            }
            SEAM(step); ++step;
        } else {
            const int mj = l >> 1;
            if (RUN(step)) for (int rep_ = 0; rep_ < REPS(5); ++rep_) {
                PHASE_ENV(); MOE_PTRS();
                moe_route1(lds, XB, SSX, kp->in[13] + (size_t)mj * D_ * NEXP, kp->in[9] + l * D_, TOKE, TOKG, TOKRS, CNT, bx, G, tid_p, wave, lane_p);
                __syncthreads();
                LAS float* scr = (LAS float*)(lds + wave * 16384);
                for (int g = (l == 1 ? L1_DONE : L3_DONE) + gw; g < MOE_ITEMS; g += NGW) { TrJob J; int it; moe_job(kp, ws, l, g, J, it); tr_item(J, it, scr, lane_p); }
                __syncthreads();
            }
            SEAM(step); ++step;
            if (RUN(step)) for (int rep_ = 0; rep_ < REPS(6); ++rep_) { PHASE_ENV(); MOE_PTRS(); moe_route2(lds, XB, XS, TOKE, TOKG, TOKRS, CNT, POS, ROWG, ROWRS, META, bx, G, tid_p, wave, lane_p, f8_layer(l)); }
            SEAM(step); ++step;
            if (RUN(step)) for (int rep_ = 0; rep_ < REPS(7); ++rep_) {
                PHASE_ENV(); MOE_PTRS();
                pg8::MoeOrder S;
#pragma unroll
                for (int e = 0; e < 8; ++e) S.pe[e] = __builtin_amdgcn_readfirstlane(META[e]);
                const int mrows = S.pe[7];
                S.estride = (size_t)2 * FF_ * D_ * (f8_layer(l) ? 1 : 2); S.so.init(mrows, 2 * FF_, G, bx);
                pg8::Gemm g{XS, WM13, mrows, 2 * FF_, D_, 0x79797979, 0x7b7b7b7b};
                if (F8_MOE_ANY && (F8_MOE_ALL || f8_layer(l))) { pg8::EpiGLU<true, true, true> E{ws, rstab}; pg8::gemm_phase<pg8::EpiGLU<true, true, true>, pg8::MoeOrder, true, true, true>(lds, g, S, E, wave_s * 64); }
                else if (!F8_MOE_ALL) { pg8::EpiGLU<true, false> E{ws, rstab}; pg8::gemm_phase<pg8::EpiGLU<true, false>, pg8::MoeOrder, true, true>(lds, g, S, E, wave_s * 64); }
            }
            SEAM(step); ++step;
            if (RUN(step)) for (int rep_ = 0; rep_ < REPS(8); ++rep_) {
                PHASE_ENV(); MOE_PTRS();
                pg8::MoeOrder S;
#pragma unroll
                for (int e = 0; e < 8; ++e) S.pe[e] = __builtin_amdgcn_readfirstlane(META[e]);
                const int mrows = S.pe[7];
                S.estride = (size_t)FF_ * D_ * (f8_layer(l) ? 1 : 2); S.so.init(mrows, D_, G, bx);
                pg8::Gemm g{HM, WM2, mrows, D_, FF_};
                pg8::EpiY E{ws, rstab, (int)(l == DEPTH_ - 1)};
                if (F8_MOE_ANY && (F8_MOE_ALL || f8_layer(l))) pg8::gemm_phase<pg8::EpiY, pg8::MoeOrder, true, true, true>(lds, g, S, E, wave_s * 64);
                else if (!F8_MOE_ALL) pg8::gemm_phase<pg8::EpiY, pg8::MoeOrder, true, true, false>(lds, g, S, E, wave_s * 64);
                if (l == 1) moe_fill(kp, ws, 3, 0, FILL_MD, (mrows / 256) * (D_ / 256), G, bx, wave, lds, lane_p);
            }
            SEAM(step); ++step;
            if (RUN(step)) {
                PHASE_ENV(); MOE_PTRS();
                if (l == DEPTH_ - 1) row_pass<false, true>(nullptr, X, XB, SSX, XS, POS, kp->in[17], gw, NGW, lane_p);
                else row_pass<false, false>(nullptr, nullptr, XB, SSX, XS, POS, nullptr, gw, NGW, lane_p, f8_in_layer(l + 1) ? ws + WS_XQ2 : nullptr);
            }
            SEAM(step); ++step;
        }
    }
#undef RUN
#undef SEAM
#undef SEAM_FIRST
#undef GEOM
#undef BAROBJ
#undef LANE_NOW
#undef T0_NOW
}

extern "C" void kernel_launch(void* const* d_in, const int* in_sizes, int n_in, void* d_out, int out_size, void* d_ws, size_t ws_size, hipStream_t stream) {
    static int grid = 0;
    if (grid == 0) {
        if (n_in != 18 || in_sizes[0] != T_ * D_ || out_size != T_ * D_ || ws_size < WS_END) { fprintf(stderr, "kernel_launch: unexpected shapes / workspace (n_in %d, ws %zu, need %zu); nothing launched\n", n_in, ws_size, (size_t)WS_END); grid = -1; return; }
        int dev = 0, cus = 0;
        if (hipGetDevice(&dev) != hipSuccess || hipDeviceGetAttribute(&cus, hipDeviceAttributeMultiprocessorCount, dev) != hipSuccess) { grid = -1; return; }
        if (hipFuncSetAttribute((const void*)hybrid_fwd, hipFuncAttributeMaxDynamicSharedMemorySize, LDS_BYTES) != hipSuccess) { fprintf(stderr, "kernel_launch: hipFuncSetAttribute failed\n"); grid = -1; return; }
        int per_cu = 0;
        if (hipOccupancyMaxActiveBlocksPerMultiprocessor(&per_cu, (const void*)hybrid_fwd, NWAVES * 64, LDS_BYTES) != hipSuccess || per_cu < 1) fprintf(stderr, "kernel_launch: occupancy query reports %d blocks per CU\n", per_cu);
        (void)hipGetLastError();
        grid = cus;
    }
    if (grid < 0) return;
    (void)hipMemsetAsync((char*)d_ws + WS_CTL, 0, CTL_ZERO_BYTES, stream);
    Params p{};
    for (int i = 0; i < 18; ++i) p.in[i] = (const float*)d_in[i];
    p.out = (float*)d_out; p.ws = (unsigned char*)d_ws;
#if MK_ONE_LAUNCH
    p.ph_lo = 0; p.ph_hi = NSTEPS;
    hipLaunchKernelGGL(hybrid_fwd, dim3(grid), dim3(NWAVES * 64), LDS_BYTES, stream, p);
#else
    for (int s = 0; s < NSTEPS; ++s) { p.ph_lo = s; p.ph_hi = s + 1; hipLaunchKernelGGL(hybrid_fwd, dim3(grid), dim3(NWAVES * 64), LDS_BYTES, stream, p); }
#endif
}
```
